# Optimizing an MI355X kernel written in HIP

```python
import jax
import jax.numpy as jnp
from jax import lax
import numpy as np

D_MODEL = 1024
BATCH = 8
SEQ = 4096
DEPTH = 1

GRID_W = 64
CTX_LEN = 256
HEAD_DIM = 64
ATT_HEADS = 8
ATT_KV_HEADS = 2
ATT_GROUPS = ATT_HEADS // ATT_KV_HEADS
ATT_DIM = ATT_HEADS * HEAD_DIM
KV_DIM = ATT_KV_HEADS * HEAD_DIM
WINDOW = 128
BLOCK = 128
ROPE_BASE = 10000.0
ATT_SCALE = HEAD_DIM ** -0.5
NEG_INF = -1e30
RWKV_HEADS = 8
RWKV_DIM = RWKV_HEADS * HEAD_DIM
DECAY_LORA = 64
ICL_LORA = 64
GATE_LORA = 128
GN_EPS = 64e-5
N_EXPERTS = 32
TOP_K = 4
D_EXPERT = D_MODEL
SWIGLU_LIMIT = 7.0
SWIGLU_ALPHA = 1.702
MOE_BLOCK = 128
RMS_EPS = 1e-6
ATT_COLS = ATT_DIM + 2 * KV_DIM
RWKV_SIZES = (RWKV_DIM, RWKV_DIM, RWKV_DIM, DECAY_LORA, DECAY_LORA, ICL_LORA, ICL_LORA, GATE_LORA)
RWKV_COLS = sum(RWKV_SIZES)
RWKV_OFFSETS = tuple(int(o) for o in np.cumsum(RWKV_SIZES)[:-1])
GATE_COLS = 2 * D_MODEL
PROJ_COLS = ATT_COLS + RWKV_COLS + GATE_COLS
F32 = jnp.float32

kernel_name = 'hybrid_gqa_rwkv7_moe_diffusion_layer'


def rms_norm(x, g):
    xf = x.astype(F32)
    y = xf * lax.rsqrt(jnp.mean(xf * xf, axis=-1, keepdims=True) + RMS_EPS)
    return y.astype(x.dtype) * g


def modulate(h, shift, scale):
    return h * (1.0 + scale) + shift


def _rotate_half(t, ang):
    cos = jnp.cos(ang)[None, :, None, :].astype(t.dtype)
    sin = jnp.sin(ang)[None, :, None, :].astype(t.dtype)
    t1, t2 = jnp.split(t, 2, axis=-1)
    return jnp.concatenate([t1 * cos - t2 * sin, t2 * cos + t1 * sin], axis=-1)


def axial_rope(t):
    L = t.shape[1]
    n_rows = L // GRID_W
    row = jnp.repeat(jnp.arange(n_rows, dtype=F32), GRID_W, total_repeat_length=L)
    col = jnp.tile(jnp.arange(GRID_W, dtype=F32), n_rows)
    half = HEAD_DIM // 2
    inv_freq = ROPE_BASE ** (-jnp.arange(0, half, 2, dtype=F32) / half)
    t_row, t_col = jnp.split(t, 2, axis=-1)
    return jnp.concatenate([_rotate_half(t_row, row[:, None] * inv_freq[None, :]),
                            _rotate_half(t_col, col[:, None] * inv_freq[None, :])], axis=-1)


def token_shift(z, mu_prev, mu_next):
    prev = jnp.pad(z[:, :-1], ((0, 0), (1, 0), (0, 0)))
    nxt = jnp.pad(z[:, 1:], ((0, 0), (0, 1), (0, 0)))
    return z + mu_prev * (prev - z) + mu_next * (nxt - z)


def rwkv_features(z, p):
    B, L, _ = z.shape
    r, k, v, wl_f, wl_b, al_f, al_b, gl = jnp.split(z, RWKV_OFFSETS, axis=-1)

    def heads(t):
        return t.reshape(B, L, RWKV_HEADS, HEAD_DIM)

    def decay(w_low, w0, w2):
        w = (w0 + jnp.tanh(w_low) @ w2).astype(F32)
        w = -jax.nn.softplus(-w) - 0.5
        return heads(jnp.exp(-jnp.exp(w)))

    icl_f = jax.nn.sigmoid(p['a0_f'] + al_f @ p['a2_f'])
    icl_b = jax.nn.sigmoid(p['a0_b'] + al_b @ p['a2_b'])
    kk = heads(k * p['k_k']).astype(F32)
    kk = (kk / jnp.maximum(jnp.sqrt(jnp.sum(kk * kk, axis=-1, keepdims=True)), 1e-12)).astype(z.dtype)
    return dict(
        r=heads(r), v=heads(v),
        k_f=heads(k * (1.0 + (icl_f - 1.0) * p['k_a'])),
        k_b=heads(k * (1.0 + (icl_b - 1.0) * p['k_a'])),
        dec_f=decay(wl_f, p['w0_f'], p['w2_f']),
        dec_b=decay(wl_b, p['w0_b'], p['w2_b']),
        a=-kk, b_f=kk * heads(icl_f), b_b=kk * heads(icl_b),
        gate=jax.nn.sigmoid(gl) @ p['g2'])


def wkv_scan(r, w, k, v, a, b, state0, reverse):
    def step(S, inp):
        r_t, w_t, k_t, v_t, a_t, b_t = inp
        sa = jnp.einsum('bhij,bhj->bhi', S, a_t)
        S = S * w_t[:, :, None, :] + sa[..., None] * b_t[:, :, None, :] + v_t[..., None] * k_t[:, :, None, :]
        return S, jnp.einsum('bhij,bhj->bhi', S, r_t)

    xs = tuple(jnp.moveaxis(t.astype(F32), 1, 0) for t in (r, w, k, v, a, b))
    S, ys = lax.scan(step, state0, xs, reverse=reverse)
    return jnp.moveaxis(ys, 0, 1), S


def bidir_scan(f, s0_f, s0_b):
    y_f, s_f = wkv_scan(f['r'], f['dec_f'], f['k_f'], f['v'], f['a'], f['b_f'], s0_f, False)
    y_b, s_b = wkv_scan(f['r'], f['dec_b'], f['k_b'], f['v'], f['a'], f['b_b'], s0_b, True)
    return y_f + y_b, s_f, s_b


def rwkv_output(y, f, p):
    B, L = y.shape[:2]
    mean = jnp.mean(y, axis=-1, keepdims=True)
    var = jnp.mean(jnp.square(y - mean), axis=-1, keepdims=True)
    yn = ((y - mean) * lax.rsqrt(var + GN_EPS)).reshape(B, L, RWKV_DIM)
    yn = (yn * p['ln_x_w'] + p['ln_x_b']).astype(f['v'].dtype)
    bonus = jnp.sum(f['r'] * (f['k_f'] + f['k_b']) * p['r_k'], axis=-1, keepdims=True) * f['v']
    return (yn + bonus.reshape(B, L, RWKV_DIM)) * f['gate']


def project(h, p):
    B, L, _ = h.shape
    z = h @ p['w_in'] + p['b_in']
    z_att, z_rwkv, z_gate = jnp.split(z, [ATT_COLS, ATT_COLS + RWKV_COLS], axis=-1)
    q, k, v = jnp.split(z_att, [ATT_DIM, ATT_DIM + KV_DIM], axis=-1)
    q = q.reshape(B, L, ATT_HEADS, HEAD_DIM)
    k = k.reshape(B, L, ATT_KV_HEADS, HEAD_DIM)
    v = v.reshape(B, L, ATT_KV_HEADS, HEAD_DIM)
    feats = rwkv_features(token_shift(z_rwkv, p['mu_prev'], p['mu_next']), p)
    return q, k, v, feats, z_gate


def sink_softmax(logits, sinks):
    sink = jnp.broadcast_to(sinks.reshape(ATT_KV_HEADS, ATT_GROUPS, 1, 1).astype(F32), logits.shape[:-1] + (1,))
    return jax.nn.softmax(jnp.concatenate([logits, sink], axis=-1), axis=-1)[..., :-1]


def window_attention(q, k, v, k_ctx, v_ctx, sinks):
    B, L = q.shape[:2]
    nb = L // BLOCK
    band = BLOCK + 2 * WINDOW
    qb = jnp.moveaxis(q.reshape(B, nb, BLOCK, ATT_KV_HEADS, ATT_GROUPS, HEAD_DIM), 1, 0)
    kp = jnp.pad(k, ((0, 0), (WINDOW, WINDOW), (0, 0), (0, 0)))
    vp = jnp.pad(v, ((0, 0), (WINDOW, WINDOW), (0, 0), (0, 0)))
    k_off = jnp.arange(band) - WINDOW
    rel = k_off[None, :] - jnp.arange(BLOCK)[:, None]

    def one_block(args):
        n, q_n = args
        k_n = lax.dynamic_slice_in_dim(kp, n * BLOCK, band, axis=1)
        v_n = lax.dynamic_slice_in_dim(vp, n * BLOCK, band, axis=1)
        kpos = n * BLOCK + k_off
        valid = (jnp.abs(rel) <= WINDOW) & ((kpos >= 0) & (kpos < L))[None, :]
        s_lat = jnp.einsum('bqkgd,bskd->bkgqs', q_n, k_n).astype(F32) * ATT_SCALE
        s_lat = jnp.where(valid, s_lat, NEG_INF)
        s_ctx = jnp.einsum('bqkgd,bckd->bkgqc', q_n, k_ctx).astype(F32) * ATT_SCALE
        prob = sink_softmax(jnp.concatenate([s_lat, s_ctx], axis=-1), sinks).astype(v.dtype)
        return (jnp.einsum('bkgqs,bskd->bqkgd', prob[..., :band], v_n)
                + jnp.einsum('bkgqc,bckd->bqkgd', prob[..., band:], v_ctx))

    o = lax.map(one_block, (jnp.arange(nb), qb))
    return jnp.moveaxis(o, 0, 1).reshape(B, L, ATT_DIM)


def context_attention(q, k, v, sinks):
    B, C = q.shape[:2]
    qg = q.reshape(B, C, ATT_KV_HEADS, ATT_GROUPS, HEAD_DIM)
    s = jnp.einsum('bqkgd,bckd->bkgqc', qg, k).astype(F32) * ATT_SCALE
    prob = sink_softmax(s, sinks).astype(v.dtype)
    return jnp.einsum('bkgqc,bckd->bqkgd', prob, v).reshape(B, C, ATT_DIM)


def merge_branches(att, rwk, z_gate, p):
    g_att, g_rwkv = jnp.split(jax.nn.sigmoid(z_gate), 2, axis=-1)
    merged = g_att * (att @ p['w_up_att']) + g_rwkv * (rwk @ p['w_up_rwkv'])
    return merged @ p['w_out']


def moe_ffn(h, p):
    B, L, D = h.shape
    xt = h.reshape(-1, D)
    T = xt.shape[0]
    TK = T * TOP_K
    logits = (xt @ p['w_router'] + p['b_router']).astype(F32)
    top_val, top_idx = lax.top_k(logits, TOP_K)
    gates = jax.nn.softmax(top_val, axis=-1).astype(h.dtype)
    flat_e = top_idx.reshape(-1).astype(jnp.int32)
    flat_tok = jnp.repeat(jnp.arange(T, dtype=jnp.int32), TOP_K)
    order = jnp.argsort(flat_e)
    e_sorted = flat_e[order]
    counts = jnp.zeros((N_EXPERTS,), jnp.int32).at[flat_e].add(1)
    padded = ((counts + MOE_BLOCK - 1) // MOE_BLOCK) * MOE_BLOCK
    start = jnp.cumsum(counts) - counts
    p_end = jnp.cumsum(padded)
    p_start = p_end - padded
    dest = p_start[e_sorted] + jnp.arange(TK, dtype=jnp.int32) - start[e_sorted]
    n_blocks = -(-TK // MOE_BLOCK) + N_EXPERTS
    n_slots = n_blocks * MOE_BLOCK
    slot_tok = jnp.full((n_slots,), T, jnp.int32).at[dest].set(flat_tok[order])
    slot_g = jnp.zeros((n_slots,), h.dtype).at[dest].set(gates.reshape(-1)[order])
    block_exp = jnp.minimum(jnp.searchsorted(p_end, jnp.arange(n_blocks, dtype=jnp.int32) * MOE_BLOCK, side='right'),
                            N_EXPERTS - 1).astype(jnp.int32)
    x_pad = jnp.concatenate([xt, jnp.zeros((1, D), xt.dtype)], axis=0)
    xb = x_pad[slot_tok].reshape(n_blocks, MOE_BLOCK, D)
    w_gu, b_gu, w_dn, b_dn = p['w_gate_up'], p['b_gate_up'], p['w_down'], p['b_down']

    def expert_block(args):
        e, x_b = args
        gu = x_b @ w_gu[e] + b_gu[e]
        gate = jnp.minimum(gu[..., ::2], SWIGLU_LIMIT)
        up = jnp.clip(gu[..., 1::2], -SWIGLU_LIMIT, SWIGLU_LIMIT)
        return ((up + 1.0) * (gate * jax.nn.sigmoid(SWIGLU_ALPHA * gate))) @ w_dn[e] + b_dn[e]

    yb = lax.map(expert_block, (block_exp, xb)).reshape(n_slots, D)
    y = jnp.zeros((T + 1, D), yb.dtype).at[slot_tok].add(yb * slot_g[:, None])[:T]
    return y.reshape(B, L, D)


def setup_inputs(seed: int = 0) -> dict:
    key = jax.random.key(seed)
    ks = iter(jax.random.split(key, 48))
    D = D_MODEL

    def nrm(shape, scale):
        return scale * jax.random.normal(next(ks), shape, F32)

    def gain(shape):
        return 1.0 + nrm(shape, 0.05)

    return {
        'x': nrm((BATCH, SEQ, D), 1.0),
        'c': nrm((BATCH, D), 1.0),
        'ctx': nrm((BATCH, CTX_LEN, D), 1.0),
        'c_ctx': nrm((D,), 1.0),
        'w_ada': nrm((DEPTH, D, 6 * D), 0.5 * D ** -0.5),
        'b_ada': nrm((DEPTH, 6 * D), 0.02),
        'g_pre_mix': gain((DEPTH, D)),
        'g_post_mix': gain((DEPTH, D)),
        'g_pre_ffn': gain((DEPTH, D)),
        'g_post_ffn': gain((DEPTH, D)),
        'w_in': nrm((DEPTH, D, PROJ_COLS), D ** -0.5),
        'b_in': nrm((DEPTH, PROJ_COLS), 0.02),
        'mu_prev': jax.random.uniform(next(ks), (DEPTH, RWKV_COLS), F32, 0.0, 0.5),
        'mu_next': jax.random.uniform(next(ks), (DEPTH, RWKV_COLS), F32, 0.0, 0.5),
        'att_sinks': nrm((DEPTH, ATT_HEADS), 0.5),
        'w0_f': jax.random.uniform(next(ks), (DEPTH, RWKV_DIM), F32, -5.0, 0.0),
        'w0_b': jax.random.uniform(next(ks), (DEPTH, RWKV_DIM), F32, -5.0, 0.0),
        'w2_f': nrm((DEPTH, DECAY_LORA, RWKV_DIM), 0.5 * DECAY_LORA ** -0.5),
        'w2_b': nrm((DEPTH, DECAY_LORA, RWKV_DIM), 0.5 * DECAY_LORA ** -0.5),
        'a0_f': nrm((DEPTH, RWKV_DIM), 0.5),
        'a0_b': nrm((DEPTH, RWKV_DIM), 0.5),
        'a2_f': nrm((DEPTH, ICL_LORA, RWKV_DIM), 0.5 * ICL_LORA ** -0.5),
        'a2_b': nrm((DEPTH, ICL_LORA, RWKV_DIM), 0.5 * ICL_LORA ** -0.5),
        'g2': nrm((DEPTH, GATE_LORA, RWKV_DIM), GATE_LORA ** -0.5),
        'k_k': 0.85 + nrm((DEPTH, RWKV_DIM), 0.05),
        'k_a': gain((DEPTH, RWKV_DIM)),
        'r_k': nrm((DEPTH, RWKV_HEADS, HEAD_DIM), 0.1),
        'ln_x_w': gain((DEPTH, RWKV_DIM)),
        'ln_x_b': nrm((DEPTH, RWKV_DIM), 0.02),
        'w_up_att': nrm((DEPTH, ATT_DIM, D), ATT_DIM ** -0.5),
        'w_up_rwkv': nrm((DEPTH, RWKV_DIM, D), RWKV_DIM ** -0.5),
        'w_out': nrm((DEPTH, D, D), D ** -0.5),
        'w_router': nrm((DEPTH, D, N_EXPERTS), D ** -0.5),
        'b_router': nrm((DEPTH, N_EXPERTS), 0.01),
        'w_gate_up': nrm((DEPTH, N_EXPERTS, D, 2 * D_EXPERT), D ** -0.5),
        'b_gate_up': nrm((DEPTH, N_EXPERTS, 2 * D_EXPERT), 0.02),
        'w_down': nrm((DEPTH, N_EXPERTS, D_EXPERT, D), D_EXPERT ** -0.5),
        'b_down': nrm((DEPTH, N_EXPERTS, D), 0.02),
    }


def reference(x, c, ctx, c_ctx, w_ada, b_ada, g_pre_mix, g_post_mix, g_pre_ffn, g_post_ffn,
              w_in, b_in, mu_prev, mu_next, att_sinks, w0_f, w0_b, w2_f, w2_b, a0_f, a0_b,
              a2_f, a2_b, g2, k_k, k_a, r_k, ln_x_w, ln_x_b, w_up_att, w_up_rwkv, w_out,
              w_router, b_router, w_gate_up, b_gate_up, w_down, b_down):
    B = x.shape[0]
    silu_c = jax.nn.silu(c)
    silu_cc = jax.nn.silu(c_ctx)
    for l in range(DEPTH):
        p = dict(w_in=w_in[l], b_in=b_in[l], mu_prev=mu_prev[l], mu_next=mu_next[l], sinks=att_sinks[l],
                 w0_f=w0_f[l], w0_b=w0_b[l], w2_f=w2_f[l], w2_b=w2_b[l], a0_f=a0_f[l], a0_b=a0_b[l],
                 a2_f=a2_f[l], a2_b=a2_b[l], g2=g2[l], k_k=k_k[l], k_a=k_a[l], r_k=r_k[l],
                 ln_x_w=ln_x_w[l], ln_x_b=ln_x_b[l], w_up_att=w_up_att[l], w_up_rwkv=w_up_rwkv[l],
                 w_out=w_out[l], w_router=w_router[l], b_router=b_router[l], w_gate_up=w_gate_up[l],
                 b_gate_up=b_gate_up[l], w_down=w_down[l], b_down=b_down[l])
        mx = [m[:, None, :] for m in jnp.split(silu_c @ w_ada[l] + b_ada[l], 6, axis=-1)]
        mc = jnp.split(silu_cc @ w_ada[l] + b_ada[l], 6, axis=-1)
        hc = modulate(rms_norm(ctx, g_pre_mix[l]), mc[0], mc[1])
        qc, kc, vc, fc, zc_gate = project(hc, p)
        zero_state = jnp.zeros((B, RWKV_HEADS, HEAD_DIM, HEAD_DIM), F32)
        yc, sc_f, sc_b = bidir_scan(fc, zero_state, zero_state)
        hx = modulate(rms_norm(x, g_pre_mix[l]), mx[0], mx[1])
        q, k, v, fx, zx_gate = project(hx, p)
        att_x = window_attention(axial_rope(q), axial_rope(k), v, kc, vc, p['sinks'])
        yx, _, _ = bidir_scan(fx, sc_f, sc_b)
        mix_x = merge_branches(att_x, rwkv_output(yx, fx, p), zx_gate, p)
        x = x + mx[2] * rms_norm(mix_x, g_post_mix[l])
        hf = modulate(rms_norm(x, g_pre_ffn[l]), mx[3], mx[4])
        x = x + mx[5] * rms_norm(moe_ffn(hf, p), g_post_ffn[l])
        if l + 1 < DEPTH:
            mix_c = merge_branches(context_attention(qc, kc, vc, p['sinks']), rwkv_output(yc, fc, p), zc_gate, p)
            ctx = ctx + mc[2] * rms_norm(mix_c, g_post_mix[l])
            hcf = modulate(rms_norm(ctx, g_pre_ffn[l]), mc[3], mc[4])
            ctx = ctx + mc[5] * rms_norm(moe_ffn(hcf, p), g_post_ffn[l])
    return x
```

```cpp
#include <hip/hip_runtime.h>
#include <cstdio>
#include <cstdint>

#ifndef MK_ONE_LAUNCH
#define MK_ONE_LAUNCH 1
#endif
#ifndef PROBE_QTR0
#define PROBE_QTR0 0u
#endif
#ifndef PROBE_HI
#define PROBE_HI (PROBE_PHASE + 1)
#endif
#ifndef SCAN_CHUNKED
#define SCAN_CHUNKED 1
#endif
#ifndef SCAN_FORCE_DIRECT
#define SCAN_FORCE_DIRECT 0
#endif
#ifndef DBG_SCAN
#define DBG_SCAN 0
#define DBG_DIR 0
#define DBG_MODE 0
#define DBG_CHUNK 0
#endif
#ifndef DBG_NOA
#define DBG_NOA 0
#define DBG_NOB 0
#endif
#ifndef DBG_D
#define DBG_D 0
#endif
#ifndef DBG_TI
#define DBG_TI 0
#endif
#ifndef CS_LOCKSTEP
#define CS_LOCKSTEP 0
#endif

#define GAS __attribute__((address_space(1)))
#define LAS __attribute__((address_space(3)))
typedef unsigned short bf16_t;
typedef short bf16x8 __attribute__((ext_vector_type(8)));
typedef short s16x4 __attribute__((ext_vector_type(4)));
typedef float f32x4 __attribute__((ext_vector_type(4)));
typedef float f32x16 __attribute__((ext_vector_type(16)));
typedef unsigned u32x4 __attribute__((ext_vector_type(4)));
typedef unsigned u32x2 __attribute__((ext_vector_type(2)));

constexpr int NB = 8, SEQ = 4096, T = NB * SEQ, D = 1024, CL = 256, TC = NB * CL, ROWS = T + TC;
constexpr int NH = 8, HD = 64, NKV = 2, RD = 512;
constexpr int NE = 32, TOPK = 4, DE = 1024;
constexpr int PROJ_SRC = 4736;
constexpr int ZP = 4864;
constexpr int ZC_Q = 0, ZC_K = 512, ZC_V = 640, ZC_R = 768, ZC_RK = 1280, ZC_RV = 1792, ZC_LORA = 2304, ZC_G = 2816;
constexpr int NTILE_N = ZP / 256;
constexpr float RMS_EPS = 1e-6f, GN_EPS = 64e-5f;

constexpr size_t MiB = 1u << 20;
constexpr size_t WS_CTL = 0, CTL_BYTES = 1 * MiB;
constexpr size_t WS_WIN = 1 * MiB;
constexpr size_t WS_WUPA = 11 * MiB, WS_WUPR = 12 * MiB;
constexpr size_t WS_WOUT = 13 * MiB;
constexpr size_t WS_LORA = 15 * MiB;
constexpr size_t WS_MISC = 15 * MiB + 512 * 1024;
constexpr size_t WS_WGU = 16 * MiB;
constexpr size_t WS_WDN = 144 * MiB;
constexpr size_t WS_HX = 208 * MiB;
constexpr size_t WS_YF = 208 * MiB, WS_YB = 240 * MiB;
constexpr size_t WS_HF = 208 * MiB;
constexpr size_t WS_Z = 276 * MiB;
constexpr size_t WS_SLOT_TOK = 272 * MiB;
constexpr size_t WS_FEAT = 599 * MiB;
constexpr size_t FEAT_STRIDE = 34 * MiB;
constexpr size_t WS_MERGED = 769 * MiB;
constexpr size_t WS_MIX = 599 * MiB;
constexpr size_t WS_QR = 939 * MiB;
constexpr size_t WS_RWK = 939 * MiB;
constexpr size_t WS_KA = 971 * MiB;
constexpr size_t WS_VT = 980 * MiB;
constexpr size_t WS_ATT = 990 * MiB;
constexpr size_t WS_SLOT_GATE = 276 * MiB;
constexpr size_t WS_TOKK = 280 * MiB;
constexpr size_t WS_H = 281 * MiB;
constexpr int MAXTILES = 544, MAXSLOT = MAXTILES * 256;
constexpr size_t WS_YBUF = 553 * MiB;
constexpr size_t WS_END = 1024 * MiB;
static_assert(WS_YBUF + (size_t)MAXSLOT * 1024 * 2 <= WS_QR, "ws map");
static_assert(WS_H + (size_t)MAXSLOT * 1024 * 2 <= WS_YBUF, "ws map");
static_assert(WS_Z + (size_t)ROWS * ZP * 2 <= WS_FEAT, "ws map");
static_assert(WS_FEAT + 10 * FEAT_STRIDE <= WS_QR, "ws map");
static_assert(WS_ATT + (size_t)T * 512 * 2 <= WS_END, "ws map");
static_assert(WS_VT + 9 * MiB <= WS_ATT && WS_KA + (size_t)ROWS * 128 * 2 <= WS_VT, "ws map");
enum { F_R = 0, F_V, F_A, F_KF, F_KB, F_BF, F_BB, F_WF, F_WB, F_G };
constexpr int CW_BAR = 4096;
constexpr int CW_CNT = 8192;
constexpr int CW_QATT = 8320, CW_QTR = 8384;
constexpr int CW_MOD = 16384;
static_assert((CW_MOD + 9 * 6144) * 4 <= (int)CTL_BYTES, "ctl");

constexpr int RING_BYTES = 131072;
constexpr int MISC_OFF = RING_BYTES + 320;
constexpr int LDS_BYTES = 147456;

#define LDS_WAIT() asm volatile("s_waitcnt lgkmcnt(0)" ::: "memory")
#define VM_WAIT() asm volatile("s_waitcnt vmcnt(0)" ::: "memory")
__device__ __forceinline__ float bf2f(unsigned b) { return __uint_as_float(b << 16); }
__device__ __forceinline__ unsigned f2bf(float f) { unsigned u = __float_as_uint(f); return (u + 0x7fffu + ((u >> 16) & 1u)) >> 16; }
__device__ __forceinline__ unsigned pk2(float lo, float hi) { return f2bf(lo) | (f2bf(hi) << 16); }
__device__ __forceinline__ float lo16(unsigned w) { return __uint_as_float(w << 16); }
__device__ __forceinline__ float hi16(unsigned w) { return __uint_as_float(w & 0xffff0000u); }
__device__ __forceinline__ float sigmoidf_(float x) { return __builtin_amdgcn_rcpf(1.0f + __expf(-x)); }
__device__ __forceinline__ float wave_sum(float v) {
#pragma unroll
    for (int o = 1; o < 64; o <<= 1) v += __shfl_xor(v, o);
    return v;
}

#define XB_TMO      128
#define XB_XCNT(j)  (256  + 64 * (j))
#define XB_XSUB(j)  (1280 + 64 * (j))
#define XB_XGEN(j)  (2304 + 64 * (j))
#define XB_TOP      3328
#define XB_TOPGEN   3392
#define XCD_BAR_WORDS 3456
#define XB_SPIN_CAP (1u << 22)
__device__ __forceinline__ unsigned xb_ld(unsigned* p)              { return __hip_atomic_load(p, __ATOMIC_RELAXED, __HIP_MEMORY_SCOPE_AGENT); }
__device__ __forceinline__ unsigned xb_add(unsigned* p, unsigned v) { return __hip_atomic_fetch_add(p, v, __ATOMIC_RELAXED, __HIP_MEMORY_SCOPE_AGENT); }
__device__ __forceinline__ unsigned xb_xcc_id() { return (unsigned)__builtin_amdgcn_s_getreg((3 << 11) | 20) & 0xFu; }
#define XB_SPIN(cond, bar) do { unsigned _sp = 0; while (cond) { __builtin_amdgcn_s_sleep(1); \
    if ((++_sp & 255u) == 0u) { if (xb_ld(&(bar)[XB_TMO])) break; if (_sp > XB_SPIN_CAP) { atomicAdd(&(bar)[XB_TMO], 1u); break; } } } } while (0)
struct XcdBarrier { unsigned* bar; unsigned x; volatile LAS unsigned* st; };
__device__ __forceinline__ XcdBarrier xcd_barrier_post(unsigned* bar, volatile LAS unsigned* st) {
    XcdBarrier b; b.bar = bar; b.x = xb_xcc_id(); b.st = st;
    if (threadIdx.x == 0) (void)xb_add(&bar[XB_XCNT(b.x)], 1u);
    return b;
}
__device__ __forceinline__ void xcd_barrier_complete(unsigned* bar, unsigned x, unsigned& nloc, unsigned& nx) {
    const unsigned G = gridDim.x * gridDim.y * gridDim.z;
    unsigned sum, cnt, mine, sp = 0u;
    for (;;) {
        sum = 0u; cnt = 0u; mine = 0u;
#pragma unroll
        for (unsigned j = 0; j < 16; ++j) { const unsigned c = xb_ld(&bar[XB_XCNT(j)]); sum += c; cnt += (c > 0u) ? 1u : 0u; mine = (j == x) ? c : mine; }
        if (sum == G) break;
        __builtin_amdgcn_s_sleep(1);
        if ((++sp & 255u) == 0u) { if (xb_ld(&bar[XB_TMO])) break; if (sp > XB_SPIN_CAP) { atomicAdd(&bar[XB_TMO], 1u); break; } }
    }
    nloc = mine > 0u ? mine : 1u; nx = cnt > 0u ? cnt : 1u;
}
__device__ __forceinline__ void xcd_barrier(const XcdBarrier& b) {
    asm volatile("s_waitcnt vmcnt(0)" ::: "memory");
    __syncthreads();
    if (threadIdx.x == 0) {
        unsigned* bar = b.bar;
        __builtin_amdgcn_s_waitcnt(0);
        unsigned nloc = b.st[0], nx = b.st[1];
        if (nloc == 0u) { xcd_barrier_complete(bar, b.x, nloc, nx); b.st[0] = nloc; b.st[1] = nx; }
        const unsigned old = xb_add(&bar[XB_XSUB(b.x)], 1u);
        const unsigned gen = old / nloc;
        if (old + 1u == (gen + 1u) * nloc) {
            __builtin_amdgcn_fence(__ATOMIC_RELEASE, "agent");
            asm volatile("s_waitcnt vmcnt(0)" ::: "memory");
            const unsigned og = xb_add(&bar[XB_TOP], 1u);
            const unsigned tg = og / nx;
            if (og + 1u == (tg + 1u) * nx) xb_add(&bar[XB_TOPGEN], 1u);
            else XB_SPIN(xb_ld(&bar[XB_TOPGEN]) == tg, bar);
            __builtin_amdgcn_fence(__ATOMIC_ACQUIRE, "agent");
            xb_add(&bar[XB_XGEN(b.x)], 1u);
            asm volatile("s_waitcnt vmcnt(0)" ::: "memory");
        } else {
            XB_SPIN(xb_ld(&bar[XB_XGEN(b.x)]) == gen, bar);
            __builtin_amdgcn_fence(__ATOMIC_ACQUIRE, "agent");
            asm volatile("s_waitcnt vmcnt(0)" ::: "memory");
        }
    }
    __syncthreads();
}

namespace pg8 {
constexpr int BM = 256, BK = 64, HALF = 128, HTB = HALF * BK * 2, STAGE_BYTES = 8 * HTB;
__host__ __device__ __forceinline__ int lds_byte(int r, int c) { const int st = (r >> 4) * 2 + (c >> 5), rr = r & 15, cc = c & 31, ob = rr * 64 + cc * 2; return st * 1024 + (ob ^ (((ob >> 9) & 1) << 5)); }
__host__ __device__ __forceinline__ void stage_rc(int b, int& R, int& C) { const int st = b / 1024, sb = b % 1024, swz = sb ^ (((sb >> 9) & 1) << 5); R = (st >> 1) * 16 + swz / 64; C = (st & 1) * 32 + (swz % 64) / 2; }
__host__ __device__ __forceinline__ int perm32(int rho) { const int n = rho >> 4, i = rho & 15; return 8 * (i >> 2) + 4 * n + (i & 3); }

struct GUnit { const char* B; int pm, pn, e, lrow0; };

template <int K, class Epi, class Sched>
__device__ __forceinline__ void gemm_phase(LAS unsigned char* lds, const char* Aroot, const Sched& S, const Epi& E) {
    const int tid = threadIdx.x, wid = __builtin_amdgcn_readfirstlane(tid >> 6), lane = tid & 63, wr = wid >> 2, wc = wid & 3, fr = lane & 15, fq = lane >> 4;
    constexpr int nt = K / BK;
    int Rr[2], Cc[2]; unsigned voffB[2];
#pragma unroll
    for (int i = 0; i < 2; ++i) { int R, C; stage_rc(tid * 16 + i * 8192, R, C); const int Rb = Epi::PERM ? ((R & ~31) + perm32(R & 31)) : R;
        Rr[i] = R; Cc[i] = C; voffB[i] = (unsigned)(Rb * K + C) * 2u; }
    constexpr size_t kstep = (size_t)(BK * 2);
    constexpr size_t hstep = (size_t)HALF * K * 2;
    const unsigned ldsw = (unsigned)wid * 1024u;
    const int aoff = lds_byte(wr * 64 + fr, fq * 8), boff = lds_byte(wc * 32 + fr, fq * 8);
#define PG8_SA(b, h) (((b) * 2 + (h)) * HTB)
#define PG8_SB(b, h) ((4 + (b) * 2 + (h)) * HTB)
#define PG8_STAGEB(bufoff, gbase) do { _Pragma("unroll") for (int _i = 0; _i < 2; ++_i) \
        __builtin_amdgcn_global_load_lds((const unsigned*)((const char*)(gbase) + voffB[_i]), (LAS unsigned*)(lds + (bufoff) + ldsw + _i * 8192), 16, 0, 0); } while (0)
#define PG8_STAGEA(bufoff, base, o0, o1, kb) do { \
        __builtin_amdgcn_global_load_lds((const unsigned*)((base) + (size_t)(kb) + (size_t)(o0)), (LAS unsigned*)(lds + (bufoff) + ldsw), 16, 0, 0); \
        __builtin_amdgcn_global_load_lds((const unsigned*)((base) + (size_t)(kb) + (size_t)(o1)), (LAS unsigned*)(lds + (bufoff) + ldsw + 8192), 16, 0, 0); } while (0)
#define PG8_LDA(dst, b, h) do { _Pragma("unroll") for (int m = 0; m < 4; ++m) _Pragma("unroll") for (int k = 0; k < 2; ++k) dst[m][k] = *(const LAS bf16x8*)(lds + PG8_SA(b, h) + aoff + m * 2048 + k * 1024); } while (0)
#define PG8_LDB(dst, b, h) do { _Pragma("unroll") for (int n = 0; n < 2; ++n) _Pragma("unroll") for (int k = 0; k < 2; ++k) dst[n][k] = *(const LAS bf16x8*)(lds + PG8_SB(b, h) + boff + n * 2048 + k * 1024); } while (0)
#define PG8_MMA(ai, bj, At, Bt) do { __builtin_amdgcn_s_setprio(1); _Pragma("unroll") for (int m = 0; m < 4; ++m) _Pragma("unroll") for (int n = 0; n < 2; ++n) _Pragma("unroll") for (int k = 0; k < 2; ++k) \
        acc[ai][bj][m][n] = __builtin_amdgcn_mfma_f32_16x16x32_bf16(Bt[n][k], At[m][k], acc[ai][bj][m][n], 0, 0, 0); __builtin_amdgcn_s_setprio(0); } while (0)
#define PG8_WAIT_V(n) asm volatile("s_waitcnt vmcnt(" #n ")" ::: "memory")
#define PG8_WAIT_L(n) asm volatile("s_waitcnt lgkmcnt(" #n ")" ::: "memory")
#define PG8_BAR __builtin_amdgcn_s_barrier()
#define PG8_SCHED __builtin_amdgcn_sched_barrier(0)
    GUnit cur, nxt; int ui = 0;
    if (!S.next(0, cur)) return;
    f32x4 acc[2][2][4][2];
#pragma unroll
    for (int a = 0; a < 2; ++a)
#pragma unroll
        for (int b = 0; b < 2; ++b)
#pragma unroll
            for (int m = 0; m < 4; ++m)
#pragma unroll
                for (int n = 0; n < 2; ++n) acc[a][b][m][n] = (f32x4){0.f, 0.f, 0.f, 0.f};
    bf16x8 At[4][2], B0[2][2], B1[2][2];
    unsigned c00, c01, c10, c11;
    const char* cA = Aroot;
    if constexpr (Sched::GATHER) {
        c00 = S.arow(cur, Rr[0]) * (unsigned)(K * 2) + (unsigned)Cc[0] * 2u; c01 = S.arow(cur, Rr[1]) * (unsigned)(K * 2) + (unsigned)Cc[1] * 2u;
        c10 = S.arow(cur, HALF + Rr[0]) * (unsigned)(K * 2) + (unsigned)Cc[0] * 2u; c11 = S.arow(cur, HALF + Rr[1]) * (unsigned)(K * 2) + (unsigned)Cc[1] * 2u;
    } else {
        c00 = (unsigned)(Rr[0] * K + Cc[0]) * 2u; c01 = (unsigned)(Rr[1] * K + Cc[1]) * 2u; c10 = c00 + (unsigned)(HALF * K * 2); c11 = c01 + (unsigned)(HALF * K * 2);
        cA = Aroot + (size_t)S.arow(cur, 0) * (size_t)(K * 2);
    }
    const char* cB = cur.B;
    PG8_STAGEB(PG8_SB(0, 0), cB); PG8_STAGEA(PG8_SA(0, 0), cA, c00, c01, 0); PG8_STAGEB(PG8_SB(0, 1), cB + hstep); PG8_STAGEA(PG8_SA(0, 1), cA, c10, c11, 0);
    if (wr == 1) PG8_BAR;
    PG8_WAIT_V(4); PG8_BAR;
    PG8_STAGEB(PG8_SB(1, 0), cB + kstep); PG8_STAGEA(PG8_SA(1, 0), cA, c00, c01, kstep); PG8_STAGEB(PG8_SB(1, 1), cB + hstep + kstep);
    PG8_WAIT_V(6); PG8_BAR;
    for (;;) {
        const bool has_next = S.next(ui + 1, nxt);
        unsigned n00 = c00, n01 = c01, n10 = c10, n11 = c11; const char* nB = cB; const char* nA = cA;
        if (has_next) {
            if constexpr (Sched::GATHER) {
                n00 = S.arow(nxt, Rr[0]) * (unsigned)(K * 2) + (unsigned)Cc[0] * 2u; n01 = S.arow(nxt, Rr[1]) * (unsigned)(K * 2) + (unsigned)Cc[1] * 2u;
                n10 = S.arow(nxt, HALF + Rr[0]) * (unsigned)(K * 2) + (unsigned)Cc[0] * 2u; n11 = S.arow(nxt, HALF + Rr[1]) * (unsigned)(K * 2) + (unsigned)Cc[1] * 2u;
            } else nA = Aroot + (size_t)S.arow(nxt, 0) * (size_t)(K * 2);
            nB = nxt.B;
        }
        for (int t = 0; t < nt; t += 2) {
            const bool last = (t == nt - 2);
            const size_t k1 = (size_t)(t + 1) * kstep;
            const size_t k2 = last ? 0 : (size_t)(t + 2) * kstep, k3 = k2 + kstep;
            const unsigned a00 = last ? n00 : c00, a01 = last ? n01 : c01, a10 = last ? n10 : c10, a11 = last ? n11 : c11; const char* a2 = last ? nA : cA;
            const char* b2 = last ? nB : cB + (size_t)(t + 2) * kstep; const char* b3 = b2 + kstep;
            PG8_LDB(B0, 0, 0); PG8_SCHED; PG8_LDA(At, 0, 0); PG8_STAGEA(PG8_SA(1, 1), cA, c10, c11, k1);
            PG8_WAIT_L(8); PG8_BAR; PG8_WAIT_L(0); PG8_MMA(0, 0, At, B0); PG8_BAR; PG8_SCHED;
            PG8_LDB(B1, 0, 1); PG8_STAGEB(PG8_SB(0, 0), b2);
            PG8_BAR; PG8_WAIT_L(0); PG8_MMA(0, 1, At, B1); PG8_BAR;
            PG8_LDA(At, 0, 1); PG8_STAGEA(PG8_SA(0, 0), a2, a00, a01, k2);
            PG8_BAR; PG8_WAIT_L(0); PG8_MMA(1, 0, At, B0); PG8_BAR; PG8_SCHED;
            PG8_STAGEB(PG8_SB(0, 1), b2 + hstep);
            PG8_WAIT_V(6); PG8_BAR; PG8_MMA(1, 1, At, B1); PG8_BAR;
            PG8_LDB(B0, 1, 0); PG8_SCHED; PG8_LDA(At, 1, 0); PG8_STAGEA(PG8_SA(0, 1), a2, a10, a11, k2);
            PG8_WAIT_L(8); PG8_BAR; PG8_WAIT_L(0); PG8_MMA(0, 0, At, B0); PG8_BAR; PG8_SCHED;
            PG8_LDB(B1, 1, 1); PG8_STAGEB(PG8_SB(1, 0), b3);
            PG8_BAR; PG8_WAIT_L(0); PG8_MMA(0, 1, At, B1); PG8_BAR;
            PG8_LDA(At, 1, 1); PG8_STAGEA(PG8_SA(1, 0), a2, a00, a01, k3);
            PG8_BAR; PG8_WAIT_L(0); PG8_MMA(1, 0, At, B0); PG8_BAR; PG8_SCHED;
            PG8_STAGEB(PG8_SB(1, 1), b3 + hstep);
            PG8_WAIT_V(6); PG8_BAR; PG8_MMA(1, 1, At, B1); PG8_BAR;
        }
        E(acc, cur, wr, wc, fr, fq);
        if (!has_next) break;
#pragma unroll
        for (int a = 0; a < 2; ++a)
#pragma unroll
            for (int b = 0; b < 2; ++b)
#pragma unroll
                for (int m = 0; m < 4; ++m)
#pragma unroll
                    for (int n = 0; n < 2; ++n) acc[a][b][m][n] = (f32x4){0.f, 0.f, 0.f, 0.f};
        cur = nxt; cB = nB; cA = nA; c00 = n00; c01 = n01; c10 = n10; c11 = n11; ++ui;
    }
    PG8_WAIT_V(0);
    if (wr == 0) PG8_BAR;
    PG8_BAR;
#undef PG8_SA
#undef PG8_SB
#undef PG8_STAGEA
#undef PG8_STAGEB
#undef PG8_LDA
#undef PG8_LDB
#undef PG8_MMA
#undef PG8_WAIT_V
#undef PG8_WAIT_L
#undef PG8_BAR
#undef PG8_SCHED
}
}
using pg8::GUnit;

struct Args { const float* in[38]; float* out; unsigned char* ws; int ph_lo, ph_hi, bar_region, pad; };
enum { I_X = 0, I_C, I_CTX, I_CCTX, I_WADA, I_BADA, I_GPREMIX, I_GPOSTMIX, I_GPREFFN, I_GPOSTFFN, I_WIN, I_BIN, I_MUP, I_MUN, I_SINKS, I_W0F, I_W0B, I_W2F, I_W2B,
       I_A0F, I_A0B, I_A2F, I_A2B, I_G2, I_KK, I_KA, I_RK, I_LNW, I_LNB, I_WUPA, I_WUPR, I_WOUT, I_WROUTER, I_BROUTER, I_WGU, I_BGU, I_WDN, I_BDN };

typedef float f32x2_t __attribute__((ext_vector_type(2)));
typedef __bf16 bf16x2_t __attribute__((ext_vector_type(2)));
__device__ __forceinline__ unsigned cvt_pk_bf16_asm(float lo, float hi) { unsigned r; asm volatile("v_cvt_pk_bf16_f32 %0, %1, %2" : "=v"(r) : "v"(lo), "v"(hi)); return r; }
__device__ __forceinline__ unsigned cvt_pk_bf16(float lo, float hi) { const f32x2_t v = {lo, hi}; const bf16x2_t b = __builtin_convertvector(v, bf16x2_t); return __builtin_bit_cast(unsigned, b); }

__device__ __forceinline__ void tile_order(int L, int nM, int nN, int& pm, int& pn) {
    const int nwg = nM * nN; int wgid = L;
    { const int q = nwg / 8, r = nwg % 8, xcd = wgid % 8, off = wgid / 8; wgid = (xcd < r ? xcd * (q + 1) : r * (q + 1) + (xcd - r) * q) + off; }
    const int nig = 8 * nN, gid = wgid / nig, fm = gid * 8, gsz = (nM - fm) < 8 ? (nM - fm) : 8;
    pm = fm + ((wgid % nig) % gsz); pn = (wgid % nig) / gsz;
}

struct SchedProj {           static constexpr bool GATHER = false;
    const char* Bt; int G, c;
    __device__ __forceinline__ bool next(int i, GUnit& u) const {
        const int L = i * G + c; constexpr int NXU = 128 * NTILE_N;
        if (L >= NXU + 72) return false;
        int pm, pn;
        if (L < NXU) tile_order(L, 128, NTILE_N, pm, pn); else { const int l2 = L - NXU; pm = 128 + l2 / 9; pn = 2 + l2 % 9; }
        u.pm = pm; u.pn = pn; u.e = 0; u.lrow0 = 0; u.B = Bt + (size_t)pn * 256 * D * 2; return true;
    }
    __device__ __forceinline__ unsigned arow(const GUnit& u, int r) const { return (unsigned)(u.pm * 256 + r); }
};
template <int K> struct SchedDense {
    static constexpr bool GATHER = false;
    const char* Bt; int G, c;
    __device__ __forceinline__ bool next(int i, GUnit& u) const {
        const int L = i * G + c; if (L >= 128 * 4) return false;
        int pm, pn; tile_order(L, 128, 4, pm, pn);
        u.pm = pm; u.pn = pn; u.e = 0; u.lrow0 = 0; u.B = Bt + (size_t)pn * 256 * K * 2; return true;
    }
    __device__ __forceinline__ unsigned arow(const GUnit& u, int r) const { return (unsigned)(u.pm * 256 + r); }
};
template <int NPN, bool GATHER_> struct SchedMoe {
    static constexpr bool GATHER = GATHER_;
    const char* Bt; int G, c; const LAS int* tstart; const int* cnt; const int* slot_tok;
    __device__ __forceinline__ bool next(int i, GUnit& u) const {
        const int L = i * G + c; const int TT = tstart[NE];
        if (L >= TT * NPN) return false;
        const int rt = L / NPN, pn = L % NPN; int e = 0;
#pragma unroll
        for (int j = 1; j < NE; ++j) e += (tstart[j] <= rt) ? 1 : 0;
        u.pm = rt; u.pn = pn; u.e = e; u.lrow0 = (rt - tstart[e]) * 256;
        u.B = Bt + ((size_t)e * (NPN * 256) + (size_t)pn * 256) * DE * 2; return true;
    }
    __device__ __forceinline__ unsigned arow(const GUnit& u, int r) const {
        if (GATHER) { const int lr = u.lrow0 + r; const int n = cnt[u.e]; return (lr < n) ? (unsigned)slot_tok[u.e * T + lr] : 0u; }
        return (unsigned)(u.pm * 256 + r);
    }
};

struct EpiZ {
    static constexpr bool PERM = true;
    bf16_t* Z; const float* bias;
    __device__ __forceinline__ void operator()(const f32x4 (&acc)[2][2][4][2], const GUnit& u, int wr, int wc, int fr, int fq) const {
        const int row0 = u.pm * 256 + wr * 64 + fr, col0 = u.pn * 256 + wc * 32 + 8 * fq;
        f32x4 bv[2][2];
#pragma unroll
        for (int bj = 0; bj < 2; ++bj)
#pragma unroll
            for (int n = 0; n < 2; ++n) bv[bj][n] = *(const f32x4*)(bias + col0 + bj * 128 + 4 * n);
#pragma unroll
        for (int ai = 0; ai < 2; ++ai)
#pragma unroll
            for (int m = 0; m < 4; ++m) { bf16_t* rowp = Z + (size_t)(row0 + ai * 128 + m * 16) * ZP + col0;
#pragma unroll
                for (int bj = 0; bj < 2; ++bj) { const f32x4 v0 = acc[ai][bj][m][0] + bv[bj][0], v1 = acc[ai][bj][m][1] + bv[bj][1];
                    u32x4 w; w.x = cvt_pk_bf16(v0[0], v0[1]); w.y = cvt_pk_bf16(v0[2], v0[3]); w.z = cvt_pk_bf16(v1[0], v1[1]); w.w = cvt_pk_bf16(v1[2], v1[3]);
                    *(u32x4*)(rowp + bj * 128) = w; } }
    }
};
template <bool SECOND> struct EpiUp {
    static constexpr bool PERM = true;
    bf16_t* O; const bf16_t* Z;
    __device__ __forceinline__ void operator()(const f32x4 (&acc)[2][2][4][2], const GUnit& u, int wr, int wc, int fr, int fq) const {
        const int row0 = u.pm * 256 + wr * 64 + fr, col0 = u.pn * 256 + wc * 32 + 8 * fq;
#pragma unroll
        for (int ai = 0; ai < 2; ++ai)
#pragma unroll
            for (int m = 0; m < 4; ++m) { const size_t row = (size_t)(row0 + ai * 128 + m * 16);
#pragma unroll
                for (int bj = 0; bj < 2; ++bj) {
                    const u32x4 g = *(const u32x4*)(Z + row * ZP + ZC_G + (SECOND ? 1024 : 0) + col0 + bj * 128);
                    const f32x4 a0 = acc[ai][bj][m][0], a1 = acc[ai][bj][m][1];
                    float o[8];
                    o[0] = sigmoidf_(lo16(g.x)) * a0[0]; o[1] = sigmoidf_(hi16(g.x)) * a0[1]; o[2] = sigmoidf_(lo16(g.y)) * a0[2]; o[3] = sigmoidf_(hi16(g.y)) * a0[3];
                    o[4] = sigmoidf_(lo16(g.z)) * a1[0]; o[5] = sigmoidf_(hi16(g.z)) * a1[1]; o[6] = sigmoidf_(lo16(g.w)) * a1[2]; o[7] = sigmoidf_(hi16(g.w)) * a1[3];
                    bf16_t* op = O + row * 1024 + col0 + bj * 128;
                    if (SECOND) { const u32x4 p = *(const u32x4*)op;
                        o[0] += lo16(p.x); o[1] += hi16(p.x); o[2] += lo16(p.y); o[3] += hi16(p.y); o[4] += lo16(p.z); o[5] += hi16(p.z); o[6] += lo16(p.w); o[7] += hi16(p.w); }
                    u32x4 w; w.x = cvt_pk_bf16(o[0], o[1]); w.y = cvt_pk_bf16(o[2], o[3]); w.z = cvt_pk_bf16(o[4], o[5]); w.w = cvt_pk_bf16(o[6], o[7]);
                    *(u32x4*)op = w; } }
    }
};
struct EpiMix {
    static constexpr bool PERM = false;
    float* C;
    __device__ __forceinline__ void operator()(const f32x4 (&acc)[2][2][4][2], const GUnit& u, int wr, int wc, int fr, int fq) const {
        const int row0 = u.pm * 256 + wr * 64 + fr, col0 = u.pn * 256 + wc * 32 + 4 * fq;
#pragma unroll
        for (int ai = 0; ai < 2; ++ai)
#pragma unroll
            for (int m = 0; m < 4; ++m) { float* rowp = C + (size_t)(row0 + ai * 128 + m * 16) * 1024 + col0;
#pragma unroll
                for (int bj = 0; bj < 2; ++bj)
#pragma unroll
                    for (int n = 0; n < 2; ++n) *(f32x4*)(rowp + bj * 128 + n * 16) = acc[ai][bj][m][n]; }
    }
};
__device__ __forceinline__ float swiglu1(float g, float up) {
    g = fminf(g, 7.0f); up = fminf(fmaxf(up, -7.0f), 7.0f);
    return (up + 1.0f) * (g * sigmoidf_(1.702f * g));
}
struct EpiMoe1 {
    static constexpr bool PERM = true;
    bf16_t* H; const float* bgu;
    __device__ __forceinline__ void operator()(const f32x4 (&acc)[2][2][4][2], const GUnit& u, int wr, int wc, int fr, int fq) const {
        const int row0 = u.pm * 256 + wr * 64 + fr, col0 = u.pn * 256 + wc * 32 + 8 * fq;
        const float* b = bgu + (size_t)u.e * 2048 + col0;
        f32x4 bv[2][2];
#pragma unroll
        for (int bj = 0; bj < 2; ++bj)
#pragma unroll
            for (int n = 0; n < 2; ++n) bv[bj][n] = *(const f32x4*)(b + bj * 128 + 4 * n);
#pragma unroll
        for (int ai = 0; ai < 2; ++ai)
#pragma unroll
            for (int m = 0; m < 4; ++m) { bf16_t* rowp = H + (size_t)(row0 + ai * 128 + m * 16) * 1024 + (col0 >> 1);
#pragma unroll
                for (int bj = 0; bj < 2; ++bj) { const f32x4 v0 = acc[ai][bj][m][0] + bv[bj][0], v1 = acc[ai][bj][m][1] + bv[bj][1];
                    u32x2 w; w.x = cvt_pk_bf16(swiglu1(v0[0], v0[1]), swiglu1(v0[2], v0[3])); w.y = cvt_pk_bf16(swiglu1(v1[0], v1[1]), swiglu1(v1[2], v1[3]));
                    *(u32x2*)(rowp + bj * 64) = w; } }
    }
};
struct EpiMoe2 {
    static constexpr bool PERM = true;
    bf16_t* Y; const float* bdn; const float* slot_gate; const int* cnt;
    __device__ __forceinline__ void operator()(const f32x4 (&acc)[2][2][4][2], const GUnit& u, int wr, int wc, int fr, int fq) const {
        const int r0 = wr * 64 + fr, col0 = u.pn * 256 + wc * 32 + 8 * fq;
        const float* b = bdn + (size_t)u.e * 1024 + col0; const int n_e = cnt[u.e];
        f32x4 bv[2][2];
#pragma unroll
        for (int bj = 0; bj < 2; ++bj)
#pragma unroll
            for (int n = 0; n < 2; ++n) bv[bj][n] = *(const f32x4*)(b + bj * 128 + 4 * n);
#pragma unroll
        for (int ai = 0; ai < 2; ++ai)
#pragma unroll
            for (int m = 0; m < 4; ++m) { const int r = r0 + ai * 128 + m * 16; const int lr = u.lrow0 + r;
                const float gt = (lr < n_e) ? slot_gate[(size_t)u.e * T + lr] : 0.0f;
                bf16_t* rowp = Y + (size_t)(u.pm * 256 + r) * 1024 + col0;
#pragma unroll
                for (int bj = 0; bj < 2; ++bj) { const f32x4 v0 = (acc[ai][bj][m][0] + bv[bj][0]) * gt, v1 = (acc[ai][bj][m][1] + bv[bj][1]) * gt;
                    u32x4 w; w.x = cvt_pk_bf16(v0[0], v0[1]); w.y = cvt_pk_bf16(v0[2], v0[3]); w.z = cvt_pk_bf16(v1[0], v1[1]); w.w = cvt_pk_bf16(v1[2], v1[3]);
                    *(u32x4*)(rowp + bj * 128) = w; } }
    }
};

__device__ __forceinline__ void p0_transpose_item(const float* W, int K, int N, bf16_t* WT, int row_off, LAS float* scr, int item, int lane) {
    const int nblk = N / 32, kb = item / nblk, nb = item % nblk, k0 = 64 * kb, n0 = 32 * nb;
#pragma unroll 8
    for (int i = 0; i < 32; ++i) { const int kk = 2 * i + (lane >> 5); scr[kk * 33 + (lane & 31)] = W[(size_t)(k0 + kk) * N + n0 + (lane & 31)]; }
    LDS_WAIT(); asm volatile("" ::: "memory");
    const int c = lane & 7;
#pragma unroll
    for (int j = 0; j < 4; ++j) { const int n = (lane >> 3) + 8 * j; const LAS float* s = scr + (8 * c) * 33 + n;
        u32x4 o; o.x = pk2(s[0 * 33], s[1 * 33]); o.y = pk2(s[2 * 33], s[3 * 33]); o.z = pk2(s[4 * 33], s[5 * 33]); o.w = pk2(s[6 * 33], s[7 * 33]);
        *(u32x4*)(WT + (size_t)(row_off + n0 + n) * K + k0 + 8 * c) = o; }
    LDS_WAIT(); asm volatile("" ::: "memory");
}
__device__ __forceinline__ void p0_prologue(const Args& a, LAS unsigned char* lds, int tid, int lane, int wave, int G) {
    unsigned char* ws = a.ws;
    {
        float* MOD = (float*)(ws + WS_CTL) + CW_MOD;
        LAS float* sl = (LAS float*)lds;
        LAS float* red = sl + 9 * 1024;
        if (blockIdx.x < 96) {
            for (int i = tid; i < 9 * 1024; i += 512) { const int r = i >> 10, k = i & 1023; const float v = (r < 8) ? a.in[I_C][r * D + k] : a.in[I_CCTX][k]; sl[i] = v * sigmoidf_(v); }
            __syncthreads();
            for (int it = blockIdx.x; it < 96; it += G) {
                const int n = it * 64 + lane; float acc[9];
#pragma unroll
                for (int r = 0; r < 9; ++r) acc[r] = 0.f;
                const float* w = a.in[I_WADA] + (size_t)(wave * 128) * 6144 + n;
#pragma unroll 8
                for (int kk = 0; kk < 128; ++kk) { const float wv = w[(size_t)kk * 6144];
#pragma unroll
                    for (int r = 0; r < 9; ++r) acc[r] += sl[r * 1024 + wave * 128 + kk] * wv; }
#pragma unroll
                for (int r = 0; r < 9; ++r) red[(wave * 9 + r) * 64 + lane] = acc[r];
                __syncthreads();
                for (int i = tid; i < 9 * 64; i += 512) { const int r = i >> 6, c = i & 63; float s = a.in[I_BADA][it * 64 + c];
#pragma unroll
                    for (int w8 = 0; w8 < 8; ++w8) s += red[(w8 * 9 + r) * 64 + c];
                    MOD[r * 6144 + it * 64 + c] = s; }
                __syncthreads();
            }
        }
        __syncthreads();
    }
    {
        float* misc = (float*)(ws + WS_MISC);
        const int gt = blockIdx.x * 512 + tid, NGT = G * 512;
        for (int n = gt; n < ZP; n += NGT) misc[n] = (n < 2688) ? a.in[I_BIN][n] : ((n < 2816) ? 0.f : a.in[I_BIN][n - 128]);
        for (int n = gt; n < 1024; n += NGT) { const int p = n >> 4, i = n & 15; const float inv = powf(10000.0f, -(float)i / 16.0f); float s, c; sincosf((float)p * inv, &s, &c); misc[ZP + n] = c; misc[ZP + 1024 + n] = s; }
        u32x4* zr = (u32x4*)((bf16_t*)(ws + WS_WIN) + (size_t)2688 * D);
        for (int n = gt; n < 128 * D / 8; n += NGT) zr[n] = (u32x4){0u, 0u, 0u, 0u};
    }
    {
        LAS float* scr = (LAS float*)(lds + wave * 8704);
        const int gw = blockIdx.x * 8 + wave, NGW = G * 8;
        constexpr int J_IN = 16 * (PROJ_SRC / 32), J_UP = 8 * 32, J_OUT = 16 * 32, J_L = 16, J_G2 = 32, J_GU1 = 16 * 64, J_DN1 = 16 * 32;
        constexpr int NITEMS = J_IN + 2 * J_UP + J_OUT + 4 * J_L + J_G2;
        bf16_t* lora = (bf16_t*)(ws + WS_LORA);
        for (int it = gw; it < NITEMS; it += NGW) {
            int r = it;
            if (r < J_IN) { const int nb = r % (PROJ_SRC / 32); p0_transpose_item(a.in[I_WIN], D, PROJ_SRC, (bf16_t*)(ws + WS_WIN), (nb * 32 >= 2688) ? 128 : 0, scr, r, lane); continue; } r -= J_IN;
            if (r < J_UP) { p0_transpose_item(a.in[I_WUPA], 512, D, (bf16_t*)(ws + WS_WUPA), 0, scr, r, lane); continue; } r -= J_UP;
            if (r < J_UP) { p0_transpose_item(a.in[I_WUPR], 512, D, (bf16_t*)(ws + WS_WUPR), 0, scr, r, lane); continue; } r -= J_UP;
            if (r < J_OUT) { p0_transpose_item(a.in[I_WOUT], D, D, (bf16_t*)(ws + WS_WOUT), 0, scr, r, lane); continue; } r -= J_OUT;
            if (r < J_L) { p0_transpose_item(a.in[I_W2F], 64, 512, lora, 0, scr, r, lane); continue; } r -= J_L;
            if (r < J_L) { p0_transpose_item(a.in[I_W2B], 64, 512, lora + 32768, 0, scr, r, lane); continue; } r -= J_L;
            if (r < J_L) { p0_transpose_item(a.in[I_A2F], 64, 512, lora + 2 * 32768, 0, scr, r, lane); continue; } r -= J_L;
            if (r < J_L) { p0_transpose_item(a.in[I_A2B], 64, 512, lora + 3 * 32768, 0, scr, r, lane); continue; } r -= J_L;
            p0_transpose_item(a.in[I_G2], 128, 512, lora + 4 * 32768, 0, scr, r, lane);
        }
    }
}

__device__ __forceinline__ int queue_pull(unsigned* q, LAS unsigned char* lds, int tid) {
    volatile LAS int* w = (volatile LAS int*)(lds + RING_BYTES + 256);
    __syncthreads();
    if (tid == 0) *w = (int)__hip_atomic_fetch_add(q, 1u, __ATOMIC_RELAXED, __HIP_MEMORY_SCOPE_AGENT);
    __syncthreads();
    return *w;
}
__device__ __forceinline__ void moe_weight_copies(const Args& a, LAS unsigned char* lds, int tid, int lane, int wave) {
    unsigned char* ws = a.ws;
    LAS float* scr = (LAS float*)(lds + wave * 8704);
    constexpr int J_GU1 = 16 * 64, J_DN1 = 16 * 32, NCHUNK = (NE * J_GU1 + NE * J_DN1) / 64;
    unsigned* q = (unsigned*)(ws + WS_CTL) + CW_QTR;
    for (;;) {
        const int ch = queue_pull(q, lds, tid);
        if (ch >= NCHUNK) break;
#pragma unroll 1
        for (int k = 0; k < 8; ++k) {
            int r = ch * 64 + wave * 8 + k;
            if (r < NE * J_GU1) { const int e = r / J_GU1; p0_transpose_item(a.in[I_WGU] + (size_t)e * D * 2048, D, 2048, (bf16_t*)(ws + WS_WGU) + (size_t)e * 2048 * D, 0, scr, r % J_GU1, lane); }
            else { r -= NE * J_GU1; const int e = r / J_DN1; p0_transpose_item(a.in[I_WDN] + (size_t)e * DE * D, DE, D, (bf16_t*)(ws + WS_WDN) + (size_t)e * D * DE, 0, scr, r % J_DN1, lane); }
        }
    }
}

__device__ __forceinline__ void p1_norm(const Args& a, int lane, int wave, int G) {
    const float* MOD = (const float*)(a.ws + WS_CTL) + CW_MOD;
    bf16_t* HX = (bf16_t*)(a.ws + WS_HX);
    const int gw = blockIdx.x * 8 + wave, NGW = G * 8;
    f32x4 gsc[4], sh[4]; int cur_r = -1;
    f32x4 gpm[4];
#pragma unroll
    for (int j = 0; j < 4; ++j) gpm[j] = ((const f32x4*)a.in[I_GPREMIX])[64 * j + lane];
    for (int m = 2 * gw; m < ROWS; m += 2 * NGW) {
        const int m1 = m + 1;
        const float* x0 = (m < T) ? a.in[I_X] + (size_t)m * D : a.in[I_CTX] + (size_t)(m - T) * D;
        const float* x1 = (m1 < T) ? a.in[I_X] + (size_t)m1 * D : a.in[I_CTX] + (size_t)(m1 - T) * D;
        f32x4 v0[4], v1[4]; float s0 = 0.f, s1 = 0.f;
#pragma unroll
        for (int j = 0; j < 4; ++j) { v0[j] = ((const f32x4*)x0)[64 * j + lane]; v1[j] = ((const f32x4*)x1)[64 * j + lane]; }
#pragma unroll
        for (int j = 0; j < 4; ++j) { s0 += (v0[j].x * v0[j].x + v0[j].y * v0[j].y) + (v0[j].z * v0[j].z + v0[j].w * v0[j].w); s1 += (v1[j].x * v1[j].x + v1[j].y * v1[j].y) + (v1[j].z * v1[j].z + v1[j].w * v1[j].w); }
#pragma unroll
        for (int o = 1; o < 64; o <<= 1) { s0 += __shfl_xor(s0, o); s1 += __shfl_xor(s1, o); }
#pragma unroll
        for (int rr = 0; rr < 2; ++rr) {
            const int mm = rr ? m1 : m; if (rr && m1 == m) break;
            const int r = (mm < T) ? (mm >> 12) : 8;
            if (r != cur_r) { cur_r = r;
#pragma unroll
                for (int j = 0; j < 4; ++j) { sh[j] = ((const f32x4*)(MOD + r * 6144))[64 * j + lane]; gsc[j] = gpm[j] * (((const f32x4*)(MOD + r * 6144 + 1024))[64 * j + lane] + 1.0f); } }
            const float rstd = __builtin_amdgcn_rsqf((rr ? s1 : s0) * (1.f / D) + RMS_EPS);
            unsigned long long* o8 = (unsigned long long*)(HX + (size_t)mm * D) + lane;
#pragma unroll
            for (int j = 0; j < 4; ++j) { const f32x4 h = (rr ? v1[j] : v0[j]) * rstd * gsc[j] + sh[j];
                o8[64 * j] = (unsigned long long)cvt_pk_bf16(h.x, h.y) | ((unsigned long long)cvt_pk_bf16(h.z, h.w) << 32); }
        }
    }
}

constexpr size_t WS_ACT = WS_HX;
__device__ __forceinline__ void p3a_pointwise(const Args& a, int tid, int G) {
    unsigned char* ws = a.ws;
    const bf16_t* Z = (const bf16_t*)(ws + WS_Z);
    bf16_t* FB = (bf16_t*)(ws + WS_FEAT); bf16_t* ACT = (bf16_t*)(ws + WS_ACT);
    const float* rc = (const float*)(ws + WS_MISC) + ZP; const float* rs = rc + 1024;
    const int cv = tid % 240, rg = tid / 240;
    float mp[8], mn[8];
    if (tid < 480) {
#pragma unroll
        for (int j = 0; j < 8; ++j) { mp[j] = a.in[I_MUP][8 * cv + j]; mn[j] = a.in[I_MUN][8 * cv + j]; }
    }
    for (int unit = blockIdx.x; unit < ROWS / 16; unit += G) {
        const int row0 = unit * 16;
        const bool isx = row0 < T;
        const int slen = isx ? SEQ : CL;
        const int pos0 = isx ? (row0 & (SEQ - 1)) : ((row0 - T) & (CL - 1));
        if (tid < 480) {
            const int r0 = row0 + 8 * rg, p0 = pos0 + 8 * rg;
            const bf16_t* zp = Z + (size_t)r0 * ZP + ZC_R + 8 * cv;
            u32x4 prv = (u32x4){0u, 0u, 0u, 0u};
            if (p0 > 0) prv = *(const u32x4*)(zp - ZP);
            u32x4 cur = *(const u32x4*)zp;
#pragma unroll
            for (int i = 0; i < 8; ++i) {
                u32x4 nxt = (u32x4){0u, 0u, 0u, 0u};
                if (p0 + i < slen - 1) nxt = *(const u32x4*)(zp + (size_t)(i + 1) * ZP);
                float o[8];
#pragma unroll
                for (int j = 0; j < 4; ++j) {
                    const float c0 = lo16(cur[j]), c1 = hi16(cur[j]);
                    o[2 * j] = c0 + mp[2 * j] * (lo16(prv[j]) - c0) + mn[2 * j] * (lo16(nxt[j]) - c0);
                    o[2 * j + 1] = c1 + mp[2 * j + 1] * (hi16(prv[j]) - c1) + mn[2 * j + 1] * (hi16(nxt[j]) - c1);
                }
                bf16_t* op;
                if (cv < 64) op = FB + (size_t)F_R * (FEAT_STRIDE / 2) + (size_t)(r0 + i) * RD + 8 * cv;
                else if (cv < 128) op = FB + (size_t)F_A * (FEAT_STRIDE / 2) + (size_t)(r0 + i) * RD + 8 * (cv - 64);
                else if (cv < 192) op = FB + (size_t)F_V * (FEAT_STRIDE / 2) + (size_t)(r0 + i) * RD + 8 * (cv - 128);
                else {
                    op = ACT + (size_t)(r0 + i) * 384 + 8 * (cv - 192);
                    if (cv < 208) {
#pragma unroll
                        for (int j = 0; j < 8; ++j) o[j] = 1.0f - 2.0f * __builtin_amdgcn_rcpf(__expf(2.0f * o[j]) + 1.0f);
                    } else if (cv >= 224) {
#pragma unroll
                        for (int j = 0; j < 8; ++j) o[j] = sigmoidf_(o[j]);
                    }
                }
                u32x4 w; w.x = pk2(o[0], o[1]); w.y = pk2(o[2], o[3]); w.z = pk2(o[4], o[5]); w.w = pk2(o[6], o[7]);
                *(u32x4*)op = w;
                prv = cur; cur = nxt;
            }
        }
        {
            bf16_t* QR = (bf16_t*)(ws + WS_QR); bf16_t* KA = (bf16_t*)(ws + WS_KA); bf16_t* VT = (bf16_t*)(ws + WS_VT);
#pragma unroll 1
            for (int idx = tid; idx < 16 * 40; idx += 512) {
                const int tk = idx / 40, j = idx % 40; const int row = row0 + tk, pos = pos0 + tk;
                const int hh = j >> 2, part = (j >> 1) & 1, sub = j & 1;
                const bool isq = hh < 8;
                if (isq && !isx) continue;
                const int zc = isq ? (ZC_Q + hh * 64) : (ZC_K + (hh - 8) * 64);
                const bf16_t* zp = Z + (size_t)row * ZP + zc + part * 32 + sub * 8;
                const u32x4 t1 = *(const u32x4*)zp, t2 = *(const u32x4*)(zp + 16);
                float x1[8], x2[8], o1[8], o2[8];
#pragma unroll
                for (int q = 0; q < 4; ++q) { x1[2 * q] = lo16(t1[q]); x1[2 * q + 1] = hi16(t1[q]); x2[2 * q] = lo16(t2[q]); x2[2 * q + 1] = hi16(t2[q]); }
                if (isx) {
                    const int p = part ? (pos & 63) : (pos >> 6);
                    const float sc = isq ? 0.125f : 1.0f;
                    const f32x4 cA = *(const f32x4*)(rc + p * 16 + sub * 8), cB = *(const f32x4*)(rc + p * 16 + sub * 8 + 4), sA = *(const f32x4*)(rs + p * 16 + sub * 8), sB = *(const f32x4*)(rs + p * 16 + sub * 8 + 4);
#pragma unroll
                    for (int q = 0; q < 8; ++q) { const float c = q < 4 ? cA[q & 3] : cB[q & 3], s = q < 4 ? sA[q & 3] : sB[q & 3];
                        o1[q] = (x1[q] * c - x2[q] * s) * sc; o2[q] = (x2[q] * c + x1[q] * s) * sc; }
                } else {
#pragma unroll
                    for (int q = 0; q < 8; ++q) { o1[q] = x1[q]; o2[q] = x2[q]; }
                }
                u32x4 w1, w2;
#pragma unroll
                for (int q = 0; q < 4; ++q) { w1[q] = pk2(o1[2 * q], o1[2 * q + 1]); w2[q] = pk2(o2[2 * q], o2[2 * q + 1]); }
                bf16_t* op = isq ? (QR + (size_t)row * 512 + hh * 64 + part * 32 + sub * 8) : (KA + (size_t)row * 128 + (hh - 8) * 64 + part * 32 + sub * 8);
                *(u32x4*)op = w1; *(u32x4*)(op + 16) = w2;
            }
            if (tid < 256) {
                const int cidx = tid & 127, tg = tid >> 7; const int g = cidx >> 6, d = cidx & 63;
                unsigned short vv[8];
#pragma unroll
                for (int q = 0; q < 8; ++q) vv[q] = Z[(size_t)(row0 + 8 * tg + q) * ZP + ZC_V + cidx];
                u32x4 w; w.x = vv[0] | ((unsigned)vv[1] << 16); w.y = vv[2] | ((unsigned)vv[3] << 16); w.z = vv[4] | ((unsigned)vv[5] << 16); w.w = vv[6] | ((unsigned)vv[7] << 16);
                bf16_t* op;
                if (isx) { const int b = row0 >> 12; op = VT + ((size_t)(b * 2 + g) * 64 + d) * SEQ + pos0 + 8 * tg; }
                else { const int b = (row0 - T) >> 8; op = VT + (size_t)NB * 2 * 64 * SEQ + ((size_t)(b * 2 + g) * 64 + d) * CL + pos0 + 8 * tg; }
                *(u32x4*)op = w;
            }
        }
    }
}

__device__ __forceinline__ void p3b_features(const Args& a, LAS unsigned char* lds, int tid, int lane, int wave, int G) {
    unsigned char* ws = a.ws;
    const bf16_t* lora = (const bf16_t*)(ws + WS_LORA);
    const bf16_t* ACT = (const bf16_t*)(ws + WS_ACT);
    bf16_t* FB = (bf16_t*)(ws + WS_FEAT);
    const int h = blockIdx.x & 7;
    constexpr int P64 = 72, P128 = 136;
    LAS bf16_t* WL = (LAS bf16_t*)lds;
    LAS bf16_t* WG2 = WL + 4 * 64 * P64;
    __syncthreads();
    for (int i = tid; i < 4 * 64 * 8; i += 512) { const int m = i >> 9, r = (i >> 3) & 63, c = i & 7; const int ch = 16 * ((r >> 2) & 3) + 4 * (r >> 4) + (r & 3);
        *(LAS u32x4*)(WL + (m * 64 + r) * P64 + 8 * c) = *(const u32x4*)(lora + (size_t)m * 32768 + (size_t)(h * 64 + ch) * 64 + 8 * c); }
    for (int i = tid; i < 64 * 16; i += 512) { const int r = i >> 4, c = i & 15; const int ch = 16 * ((r >> 2) & 3) + 4 * (r >> 4) + (r & 3);
        *(LAS u32x4*)(WG2 + r * P128 + 8 * c) = *(const u32x4*)(lora + (size_t)4 * 32768 + (size_t)(h * 64 + ch) * 128 + 8 * c); }
    __syncthreads();
    const int tk = lane & 15, cg = lane >> 4;
    f32x4 w0f[4], w0b[4], a0f[4], a0b[4], kkw[4], kaw[4];
#pragma unroll
    for (int cs = 0; cs < 4; ++cs) { const int c = h * 64 + 16 * cg + 4 * cs;
        w0f[cs] = *(const f32x4*)(a.in[I_W0F] + c); w0b[cs] = *(const f32x4*)(a.in[I_W0B] + c); a0f[cs] = *(const f32x4*)(a.in[I_A0F] + c); a0b[cs] = *(const f32x4*)(a.in[I_A0B] + c);
        kkw[cs] = *(const f32x4*)(a.in[I_KK] + c); kaw[cs] = *(const f32x4*)(a.in[I_KA] + c); }
    for (int tt = blockIdx.x >> 3; tt < ROWS / 128; tt += (G >> 3)) {
        const int row = tt * 128 + 16 * wave + tk;
        bf16x8 bfr[12];
        const bf16_t* ap = ACT + (size_t)row * 384 + 8 * cg;
#pragma unroll
        for (int kb = 0; kb < 12; ++kb) bfr[kb] = *(const bf16x8*)(ap + 32 * kb);
        bf16_t* frow = FB + (size_t)row * RD + h * 64 + 16 * cg;
        u32x2 kraw[4];
#pragma unroll
        for (int cs = 0; cs < 4; ++cs) kraw[cs] = *(const u32x2*)(frow + (size_t)F_A * (FEAT_STRIDE / 2) + 4 * cs);
        auto store16 = [&](int arr, const f32x4 (&v)[4]) {
            u32x4 w0, w1;
            w0.x = cvt_pk_bf16_asm(v[0][0], v[0][1]); w0.y = cvt_pk_bf16_asm(v[0][2], v[0][3]); w0.z = cvt_pk_bf16_asm(v[1][0], v[1][1]); w0.w = cvt_pk_bf16_asm(v[1][2], v[1][3]);
            w1.x = cvt_pk_bf16_asm(v[2][0], v[2][1]); w1.y = cvt_pk_bf16_asm(v[2][2], v[2][3]); w1.z = cvt_pk_bf16_asm(v[3][0], v[3][1]); w1.w = cvt_pk_bf16_asm(v[3][2], v[3][3]);
            u32x4* p = (u32x4*)(frow + (size_t)arr * (FEAT_STRIDE / 2)); p[0] = w0; p[1] = w1;
        };
        auto lora_mm = [&](int m, int kb0, f32x4 (&acc)[4]) {
#pragma unroll
            for (int cs = 0; cs < 4; ++cs) acc[cs] = (f32x4){0.f, 0.f, 0.f, 0.f};
            const int nkb = (m == 4) ? 4 : 2;
#pragma unroll
            for (int kb = 0; kb < 4; ++kb) if (kb < nkb) {
#pragma unroll
                for (int cs = 0; cs < 4; ++cs) {
                    const bf16x8 afr = (m == 4) ? *(const LAS bf16x8*)(WG2 + (16 * cs + tk) * P128 + 32 * kb + 8 * cg) : *(const LAS bf16x8*)(WL + (m * 64 + 16 * cs + tk) * P64 + 32 * kb + 8 * cg);
                    acc[cs] = __builtin_amdgcn_mfma_f32_16x16x32_bf16(afr, bfr[kb0 + kb], acc[cs], 0, 0, 0);
                }
            }
        };
        f32x4 acc[4];
        lora_mm(0, 0, acc);
#pragma unroll
        for (int cs = 0; cs < 4; ++cs)
#pragma unroll
            for (int j = 0; j < 4; ++j) acc[cs][j] = SCAN_CHUNKED ? (-0.60653065971f * sigmoidf_(acc[cs][j] + w0f[cs][j])) : (__expf(-0.60653065971f * sigmoidf_(acc[cs][j] + w0f[cs][j])) - 1.0f);
        store16(F_WF, acc);
        lora_mm(1, 2, acc);
#pragma unroll
        for (int cs = 0; cs < 4; ++cs)
#pragma unroll
            for (int j = 0; j < 4; ++j) acc[cs][j] = SCAN_CHUNKED ? (-0.60653065971f * sigmoidf_(acc[cs][j] + w0b[cs][j])) : (__expf(-0.60653065971f * sigmoidf_(acc[cs][j] + w0b[cs][j])) - 1.0f);
        store16(F_WB, acc);
        lora_mm(4, 8, acc);
        asm volatile("s_nop 7\n\ts_nop 7" ::: "memory");
        store16(F_G, acc);
        f32x4 iclf[4], iclb[4];
        lora_mm(2, 4, iclf);
        lora_mm(3, 6, iclb);
#pragma unroll
        for (int cs = 0; cs < 4; ++cs)
#pragma unroll
            for (int j = 0; j < 4; ++j) { iclf[cs][j] = sigmoidf_(iclf[cs][j] + a0f[cs][j]); iclb[cs][j] = sigmoidf_(iclb[cs][j] + a0b[cs][j]); }
        f32x4 kv[4]; float nrm = 0.f;
#pragma unroll
        for (int cs = 0; cs < 4; ++cs) {
            kv[cs] = (f32x4){lo16(kraw[cs].x), hi16(kraw[cs].x), lo16(kraw[cs].y), hi16(kraw[cs].y)};
            const f32x4 kk = kv[cs] * kkw[cs];
            nrm += (kk[0] * kk[0] + kk[1] * kk[1]) + (kk[2] * kk[2] + kk[3] * kk[3]);
        }
        nrm += __shfl_xor(nrm, 16); nrm += __shfl_xor(nrm, 32);
        const float inv = 1.0f / fmaxf(sqrtf(nrm), 1e-12f);
        f32x4 oa[4], obf[4], obb[4], okf[4], okb[4];
#pragma unroll
        for (int cs = 0; cs < 4; ++cs) {
            const f32x4 kkn = kv[cs] * kkw[cs] * inv;
            oa[cs] = -kkn; obf[cs] = kkn * iclf[cs]; obb[cs] = kkn * iclb[cs];
            okf[cs] = kv[cs] * ((iclf[cs] - 1.0f) * kaw[cs] + 1.0f); okb[cs] = kv[cs] * ((iclb[cs] - 1.0f) * kaw[cs] + 1.0f);
        }
        store16(F_A, oa); store16(F_BF, obf); store16(F_BB, obb); store16(F_KF, okf); store16(F_KB, okb);
    }
}

__device__ __forceinline__ void p4_attention(const Args& a, LAS unsigned char* lds, int tid, int lane, int wave, int G) {
    unsigned char* ws = a.ws;
    const bf16_t* QR = (const bf16_t*)(ws + WS_QR); const bf16_t* KA = (const bf16_t*)(ws + WS_KA); const bf16_t* VT = (const bf16_t*)(ws + WS_VT);
    bf16_t* ATT = (bf16_t*)(ws + WS_ATT);
    constexpr int KP = 72;
    LAS bf16_t* Ks = (LAS bf16_t*)lds; LAS bf16_t* Vs = Ks + 64 * KP;
    const int qi = lane & 31, hf = lane >> 5;
    unsigned* qatt = (unsigned*)(ws + WS_CTL) + CW_QATT;
    for (;;) {
        const int unit = queue_pull(qatt, lds, tid);
        if (unit >= NB * NKV * (SEQ / 64)) break;
        const int qb = unit & 63, g = (unit >> 6) & 1, b = unit >> 7;
        const int q0 = qb * 64;
        const int head = g * 4 + (wave >> 1), qloc = 32 * (wave & 1) + qi;
        const size_t qrow = (size_t)b * SEQ + q0 + qloc;
        bf16x8 qf[4];
#pragma unroll
        for (int s = 0; s < 4; ++s) qf[s] = *(const bf16x8*)(QR + qrow * 512 + head * 64 + 16 * s + 8 * hf);
        float m = a.in[I_SINKS][head], lsum = hf ? 0.f : 1.f;
        f32x16 O0, O1;
#pragma unroll
        for (int r = 0; r < 16; ++r) { O0[r] = 0.f; O1[r] = 0.f; }
        for (int kt = 0; kt < 9; ++kt) {
            const int kp0 = q0 - 128 + 64 * kt;
            if (kt < 5 && (kp0 < 0 || kp0 >= SEQ)) continue;
            __syncthreads();
            {
                const int rr = tid >> 3, ch = tid & 7;
                const bf16_t* kp = (kt < 5) ? KA + ((size_t)b * SEQ + kp0 + rr) * 128 + g * 64 + 8 * ch
                                            : KA + ((size_t)T + b * CL + 64 * (kt - 5) + rr) * 128 + g * 64 + 8 * ch;
                const bf16_t* vp = (kt < 5) ? VT + ((size_t)(b * 2 + g) * 64 + rr) * SEQ + kp0 + 8 * ch
                                            : VT + (size_t)NB * 2 * 64 * SEQ + ((size_t)(b * 2 + g) * 64 + rr) * CL + 64 * (kt - 5) + 8 * ch;
                const u32x4 kvv = *(const u32x4*)kp, vvv = *(const u32x4*)vp;
                *(LAS u32x4*)(Ks + rr * KP + 8 * ch) = kvv; *(LAS u32x4*)(Vs + rr * KP + 8 * ch) = vvv;
            }
            __syncthreads();
            f32x16 X0, X1;
#pragma unroll
            for (int r = 0; r < 16; ++r) { X0[r] = 0.f; X1[r] = 0.f; }
#pragma unroll
            for (int s = 0; s < 4; ++s) {
                const bf16x8 k0 = *(const LAS bf16x8*)(Ks + qi * KP + 16 * s + 8 * hf), k1 = *(const LAS bf16x8*)(Ks + (32 + qi) * KP + 16 * s + 8 * hf);
                X0 = __builtin_amdgcn_mfma_f32_32x32x16_bf16(k0, qf[s], X0, 0, 0, 0);
                X1 = __builtin_amdgcn_mfma_f32_32x32x16_bf16(k1, qf[s], X1, 0, 0, 0);
            }
            if (kt == 0 || kt == 4) {
#pragma unroll
                for (int r = 0; r < 16; ++r) { const int k0i = (r & 3) + 8 * (r >> 2) + 4 * hf, k1i = 32 + k0i;
                    const bool v0 = (kt == 0) ? (k0i >= qloc) : (k0i <= qloc), v1 = (kt == 0) ? (k1i >= qloc) : (k1i <= qloc);
                    X0[r] = v0 ? X0[r] : -1e30f; X1[r] = v1 ? X1[r] : -1e30f; }
            }
            float mx = -1e30f;
#pragma unroll
            for (int r = 0; r < 16; ++r) mx = fmaxf(mx, fmaxf(X0[r], X1[r]));
            mx = fmaxf(mx, __shfl_xor(mx, 32));
            const float mn = fmaxf(m, mx), alpha = __expf(m - mn);
            m = mn;
            float ps = 0.f;
#pragma unroll
            for (int r = 0; r < 16; ++r) { X0[r] = __expf(X0[r] - mn); X1[r] = __expf(X1[r] - mn); ps += X0[r] + X1[r]; }
            lsum = lsum * alpha + ps;
#pragma unroll
            for (int r = 0; r < 16; ++r) { O0[r] *= alpha; O1[r] *= alpha; }
#pragma unroll
            for (int kg = 0; kg < 2; ++kg)
#pragma unroll
                for (int s2 = 0; s2 < 2; ++s2) {
                    bf16x8 pf;
#pragma unroll
                    for (int j = 0; j < 4; ++j) { const float p0 = kg ? X1[8 * s2 + 2 * j] : X0[8 * s2 + 2 * j], p1 = kg ? X1[8 * s2 + 2 * j + 1] : X0[8 * s2 + 2 * j + 1];
                        const unsigned w = cvt_pk_bf16(p0, p1); pf[2 * j] = (short)(w & 0xffff); pf[2 * j + 1] = (short)(w >> 16); }
                    const int kb = 32 * kg + 16 * s2 + 4 * hf;
#pragma unroll
                    for (int dg = 0; dg < 2; ++dg) {
                        const LAS bf16_t* vr = Vs + (32 * dg + qi) * KP + kb;
                        const s16x4 va = *(const LAS s16x4*)vr, vb = *(const LAS s16x4*)(vr + 8);
                        bf16x8 vf; vf[0] = va[0]; vf[1] = va[1]; vf[2] = va[2]; vf[3] = va[3]; vf[4] = vb[0]; vf[5] = vb[1]; vf[6] = vb[2]; vf[7] = vb[3];
                        if (dg == 0) O0 = __builtin_amdgcn_mfma_f32_32x32x16_bf16(vf, pf, O0, 0, 0, 0);
                        else O1 = __builtin_amdgcn_mfma_f32_32x32x16_bf16(vf, pf, O1, 0, 0, 0);
                    }
                }
        }
        const float ltot = lsum + __shfl_xor(lsum, 32);
        const float inv = 1.0f / ltot;
        bf16_t* op = ATT + qrow * 512 + head * 64;
#pragma unroll
        for (int dg = 0; dg < 2; ++dg)
#pragma unroll
            for (int rq = 0; rq < 4; ++rq) {
                const int d0 = 32 * dg + 8 * rq + 4 * hf;
                u32x2 w;
                if (dg == 0) { w.x = cvt_pk_bf16(O0[4 * rq] * inv, O0[4 * rq + 1] * inv); w.y = cvt_pk_bf16(O0[4 * rq + 2] * inv, O0[4 * rq + 3] * inv); }
                else { w.x = cvt_pk_bf16(O1[4 * rq] * inv, O1[4 * rq + 1] * inv); w.y = cvt_pk_bf16(O1[4 * rq + 2] * inv, O1[4 * rq + 3] * inv); }
                *(u32x2*)(op + d0) = w;
            }
    }
}

template <int CTRL> __device__ __forceinline__ float dpp_add(float x) {
    return x + __builtin_bit_cast(float, __builtin_amdgcn_update_dpp(0, __builtin_bit_cast(int, x), CTRL, 0xf, 0xf, false));
}
__device__ __forceinline__ float row16_sum(float x) { x = dpp_add<0x128>(x); x = dpp_add<0x124>(x); x = dpp_add<0x122>(x); x = dpp_add<0x121>(x); return x; }
template <int VAR> __device__ __forceinline__ void p4_scan(const Args& a, LAS unsigned char* lds, int tid, int lane, int wave, int G) {
    unsigned char* ws = a.ws;
    const bf16_t* FB = (const bf16_t*)(ws + WS_FEAT);
    constexpr int TS = 32, NBLK = (CL + SEQ) / TS;
    constexpr int OPF = TS * 5 * 64;
    LAS float* OPS = (LAS float*)lds;
    LAS float* VB = OPS + 2 * OPF;
    LAS float* YBUF = VB + 2 * TS * 32;
    const int rl = 4 * wave + (lane >> 4), cg = lane & 15;
    for (int unit = blockIdx.x; unit < NB * NH * 4; unit += G) {
        const int half = unit & 1, dir = (unit >> 1) & 1, h = (unit >> 2) & 7, b = unit >> 5;
        const size_t astr = FEAT_STRIDE / 2;
        const bf16_t* arrp[5] = { FB + (size_t)(dir ? F_WB : F_WF) * astr, FB + (size_t)F_A * astr, FB + (size_t)(dir ? F_BB : F_BF) * astr, FB + (size_t)(dir ? F_KB : F_KF) * astr, FB + (size_t)F_R * astr };
        const bf16_t* vp = FB + (size_t)F_V * astr;
        bf16_t* Y = (bf16_t*)(ws + (dir ? WS_YB : WS_YF));
        auto row_of = [&](int s) -> int { return (s < CL) ? (T + b * CL + (dir ? (CL - 1 - s) : s)) : (b * SEQ + (dir ? (SEQ - 1 - (s - CL)) : (s - CL))); };
        u32x2 pre[6];
        auto fetch = [&](int blk) {
#pragma unroll
            for (int it = 0; it < 6; ++it) { const int q = tid + 512 * it; pre[it] = (u32x2){0u, 0u};
                if (q < TS * 88) { const int st = q / 88, rem = q % 88; const int row = row_of(blk * TS + st);
                    if (rem < 80) { const int ar = rem >> 4, ci = rem & 15; const bf16_t* p = (ar == 0 ? arrp[0] : ar == 1 ? arrp[1] : ar == 2 ? arrp[2] : ar == 3 ? arrp[3] : arrp[4]);
                        pre[it] = *(const u32x2*)(p + (size_t)row * RD + h * 64 + 4 * ci); }
                    else { const int ci = rem - 80; pre[it] = *(const u32x2*)(vp + (size_t)row * RD + h * 64 + half * 32 + 4 * ci); } } }
        };
        auto commit = [&](int buf) {
#pragma unroll
            for (int it = 0; it < 6; ++it) { const int q = tid + 512 * it;
                if (q < TS * 88) { const int st = q / 88, rem = q % 88;
                    f32x4 v = (f32x4){lo16(pre[it].x), hi16(pre[it].x), lo16(pre[it].y), hi16(pre[it].y)};
                    if (SCAN_CHUNKED && rem < 16) { v[0] = __expf(v[0]) - 1.0f; v[1] = __expf(v[1]) - 1.0f; v[2] = __expf(v[2]) - 1.0f; v[3] = __expf(v[3]) - 1.0f; }
                    if (rem < 80) *(LAS f32x4*)(OPS + buf * OPF + st * 320 + rem * 4) = v;
                    else *(LAS f32x4*)(VB + buf * TS * 32 + st * 32 + (rem - 80) * 4) = v; } }
        };
        __syncthreads();
        fetch(0); commit(0);
        __syncthreads();
        f32x4 S = (f32x4){0.f, 0.f, 0.f, 0.f};
        for (int blk = 0; blk < NBLK; ++blk) {
            const int buf = blk & 1;
            if (blk + 1 < NBLK) fetch(blk + 1);
            const LAS float* ob = OPS + buf * OPF + 4 * cg; const LAS float* vb = VB + buf * TS * 32 + rl; LAS float* yb = YBUF + buf * TS * 32 + rl;
            float ykeep = 0.f;
            f32x4 qw[3], qa[3], qb[3], qk[3], qr[3]; float qv[3];
#define SCAN_LOAD(st_, sl_) do { qw[sl_] = *(const LAS f32x4*)(ob + (st_) * 320); qa[sl_] = *(const LAS f32x4*)(ob + (st_) * 320 + 64); qb[sl_] = *(const LAS f32x4*)(ob + (st_) * 320 + 128); \
                qk[sl_] = *(const LAS f32x4*)(ob + (st_) * 320 + 192); qr[sl_] = *(const LAS f32x4*)(ob + (st_) * 320 + 256); qv[sl_] = vb[(st_) * 32]; } while (0)
            SCAN_LOAD(0, 0); SCAN_LOAD(1, 1);
#pragma unroll
            for (int st = 0; st < TS; ++st) {
                if (st + 2 < TS && (VAR != 2 || st < 1)) SCAN_LOAD(st + 2, (st + 2) % 3);
                const f32x4 ow = qw[st % 3], av = DBG_NOA ? (f32x4){0.f, 0.f, 0.f, 0.f} : qa[st % 3], bv = DBG_NOB ? (f32x4){0.f, 0.f, 0.f, 0.f} : qb[st % 3], kv = qk[st % 3], rv = qr[st % 3]; const float vi = qv[st % 3];
                float sa = fmaf(S[3], av[3], fmaf(S[2], av[2], fmaf(S[1], av[1], S[0] * av[0])));
                const f32x4 S1 = S + S * ow + kv * vi;
                if (VAR != 1) sa = row16_sum(sa);
                S = S1 + bv * sa;
                float y = fmaf(S[3], rv[3], fmaf(S[2], rv[2], fmaf(S[1], rv[1], S[0] * rv[0])));
                if (VAR != 1) y = row16_sum(y);
                ykeep = (cg == (st & 15)) ? y : ykeep;
                if ((st & 15) == 15) yb[((st & ~15) + cg) * 32] = ykeep;
            }
#undef SCAN_LOAD
            if (blk + 1 < NBLK) commit(buf ^ 1);
            __syncthreads();
            if (blk >= CL / TS) {
                const int st = tid >> 4, pr = tid & 15;
                const int row = row_of(blk * TS + st);
                const float y0 = YBUF[buf * TS * 32 + st * 32 + 2 * pr], y1 = YBUF[buf * TS * 32 + st * 32 + 2 * pr + 1];
                *(unsigned*)(Y + (size_t)row * RD + h * 64 + half * 32 + 2 * pr) = pk2(y0, y1);
            }
        }
    }
}

constexpr int CS_SLOT = 16384, CS_AT = 0, CS_RT = 2304, CS_BH = 4608, CS_KH = 6912, CS_VV = 9216, CS_AAK = 11520, CS_TT = 12800, CS_ARK = 14080, CS_GC = 15360;
constexpr int CS_SCR = 4 * CS_SLOT, CS_SCR_BYTES = 6144, CS_BT = 0, CS_KT = 2304, CS_NN = 4608, CS_FLAGS = CS_SCR + 4 * CS_SCR_BYTES;
typedef short v4i16_t __attribute__((ext_vector_type(4)));
__device__ __forceinline__ bf16x8 pack8(f32x4 x, f32x4 y) {
    u32x4 w; w.x = cvt_pk_bf16(x[0], x[1]); w.y = cvt_pk_bf16(x[2], x[3]); w.z = cvt_pk_bf16(y[0], y[1]); w.w = cvt_pk_bf16(y[2], y[3]);
    return __builtin_bit_cast(bf16x8, w);
}
__device__ __forceinline__ bf16x8 join8(s16x4 x, s16x4 y) { bf16x8 r; r[0] = x[0]; r[1] = x[1]; r[2] = x[2]; r[3] = x[3]; r[4] = y[0]; r[5] = y[1]; r[6] = y[2]; r[7] = y[3]; return r; }
__device__ __forceinline__ s16x4 lds_tr4(const LAS unsigned char* p) { return __builtin_bit_cast(s16x4, __builtin_amdgcn_ds_read_tr16_b64_v4i16((LAS v4i16_t*)p)); }
template <int CTRL> __device__ __forceinline__ float dpp_shr_add(float x) {
    return x + __builtin_bit_cast(float, __builtin_amdgcn_update_dpp(0, __builtin_bit_cast(int, x), CTRL, 0xf, 0xf, true));
}
template <bool TEST> __device__ __forceinline__ void p4_scan_chunked(const Args& a, LAS unsigned char* lds, int tid, int lane, int wave, int G) {
    unsigned char* ws = a.ws;
    const bf16_t* FB = (const bf16_t*)(ws + WS_FEAT);
    const size_t astr = FEAT_STRIDE / 2;
    constexpr int NCH = (CL + SEQ) / 16;
    volatile LAS unsigned* flags = (volatile LAS unsigned*)(lds + CS_FLAGS);
    for (int unit = blockIdx.x; unit < NB * NH * 2; unit += G) {
        const int dir = unit & 1, h = (unit >> 1) & 7, b = unit >> 4;
        __syncthreads();
        for (int i = tid; i < (CS_FLAGS + 64) / 16; i += 512) *(LAS u32x4*)(lds + 16 * i) = (u32x4){0u, 0u, 0u, 0u};
        __syncthreads();
        auto row_of = [&](int s) -> int { return (s < CL) ? (T + b * CL + (dir ? (CL - 1 - s) : s)) : (b * SEQ + (dir ? (SEQ - 1 - (s - CL)) : (s - CL))); };
        if (wave < 4) {
            const int il = lane & 15, g = lane >> 4, ich = 16 * wave + il;
            bf16_t* Y = (bf16_t*)(ws + (dir ? WS_YB : WS_YF));
            f32x4 ST[4];
#pragma unroll
            for (int jt = 0; jt < 4; ++jt) ST[jt] = (f32x4){0.f, 0.f, 0.f, 0.f};
            const f32x4 zero4 = (f32x4){0.f, 0.f, 0.f, 0.f}; const s16x4 z16 = (s16x4){0, 0, 0, 0};
            const int troff = (4 * g + (il >> 2)) * 144 + 8 * (il & 3);
            for (int c = 0; c < NCH; ++c) {
                const int slot = c & 3; LAS unsigned char* sb = lds + slot * CS_SLOT;
                while (flags[slot] != (unsigned)(c + 1)) __builtin_amdgcn_s_sleep(1);
                __builtin_amdgcn_fence(__ATOMIC_ACQUIRE, "workgroup");
                const bf16x8 sf0 = pack8(ST[0], ST[1]), sf1 = pack8(ST[2], ST[3]);
                const LAS unsigned char* atp = sb + CS_AT + il * 144 + 8 * g;
                const bf16x8 a0 = join8(*(const LAS s16x4*)(atp), *(const LAS s16x4*)(atp + 32)), a1 = join8(*(const LAS s16x4*)(atp + 64), *(const LAS s16x4*)(atp + 96));
                const LAS unsigned char* rtp = sb + CS_RT + il * 144 + 8 * g;
                const bf16x8 r0 = join8(*(const LAS s16x4*)(rtp), *(const LAS s16x4*)(rtp + 32)), r1 = join8(*(const LAS s16x4*)(rtp + 64), *(const LAS s16x4*)(rtp + 96));
                const bf16x8 aak = *(const LAS bf16x8*)(sb + CS_AAK + il * 80 + 16 * g);
                const bf16x8 ttf = *(const LAS bf16x8*)(sb + CS_TT + il * 80 + 16 * g);
                const bf16x8 ark = *(const LAS bf16x8*)(sb + CS_ARK + il * 80 + 16 * g);
                const s16x4 vv = lds_tr4(sb + CS_VV + troff + 32 * wave);
                f32x4 zw1 = zero4, zyy = zero4, zuu = zero4; asm volatile("" : "+v"(zw1), "+v"(zyy), "+v"(zuu));
                f32x4 w1 = __builtin_amdgcn_mfma_f32_16x16x32_bf16(a0, sf0, zw1, 0, 0, 0);
                w1 = __builtin_amdgcn_mfma_f32_16x16x32_bf16(a1, sf1, w1, 0, 0, 0);
                w1 = __builtin_amdgcn_mfma_f32_16x16x32_bf16(aak, join8(vv, z16), w1, 0, 0, 0);
                f32x4 yy = __builtin_amdgcn_mfma_f32_16x16x32_bf16(r0, sf0, zyy, 0, 0, 0);
                yy = __builtin_amdgcn_mfma_f32_16x16x32_bf16(r1, sf1, yy, 0, 0, 0);
                const bf16x8 w1f = pack8(w1, zero4);
                const f32x4 uu = __builtin_amdgcn_mfma_f32_16x16x32_bf16(ttf, w1f, zuu, 0, 0, 0);
                bf16x8 uv; { u32x4 w; w.x = cvt_pk_bf16(uu[0], uu[1]); w.y = cvt_pk_bf16(uu[2], uu[3]); const u32x2 v2 = __builtin_bit_cast(u32x2, vv); w.z = v2.x; w.w = v2.y; uv = __builtin_bit_cast(bf16x8, w); }
#pragma unroll
                for (int jt = 0; jt < 4; ++jt) {
                    const f32x4 gc = *(const LAS f32x4*)(sb + CS_GC + (16 * jt + 4 * g) * 4);
                    const bf16x8 bk = join8(lds_tr4(sb + CS_BH + troff + 32 * jt), lds_tr4(sb + CS_KH + troff + 32 * jt));
                    ST[jt] = __builtin_amdgcn_mfma_f32_16x16x32_bf16(bk, uv, ST[jt] * gc, 0, 0, 0);
                }
                yy = __builtin_amdgcn_mfma_f32_16x16x32_bf16(ark, uv, yy, 0, 0, 0);
                asm volatile("s_waitcnt lgkmcnt(0)" ::: "memory");
                if (lane == 0) __hip_atomic_fetch_add((LAS unsigned*)(lds + CS_FLAGS) + 4 + slot, 1u, __ATOMIC_RELEASE, __HIP_MEMORY_SCOPE_WORKGROUP);
                if (c >= CL / 16) {
#pragma unroll
                    for (int rg = 0; rg < 4; ++rg) { const int row = row_of(16 * c + 4 * g + rg); Y[(size_t)row * RD + h * 64 + ich] = (bf16_t)f2bf(yy[rg]); }
                }
            }
        } else {
            const int p = wave - 4, jg = lane >> 4, t = lane & 15;
            LAS unsigned char* scr = lds + CS_SCR + p * CS_SCR_BYTES;
            u32x4 raw[6][2];
            auto load_raw = [&](int c) {
                const size_t ro = (size_t)row_of(16 * c + t) * RD + h * 64 + 16 * jg;
#pragma unroll
                for (int hf = 0; hf < 2; ++hf) {
                    raw[0][hf] = *(const u32x4*)(FB + (size_t)(dir ? F_WB : F_WF) * astr + ro + 8 * hf); raw[1][hf] = *(const u32x4*)(FB + (size_t)F_A * astr + ro + 8 * hf);
                    raw[2][hf] = *(const u32x4*)(FB + (size_t)(dir ? F_BB : F_BF) * astr + ro + 8 * hf); raw[3][hf] = *(const u32x4*)(FB + (size_t)(dir ? F_KB : F_KF) * astr + ro + 8 * hf);
                    raw[4][hf] = *(const u32x4*)(FB + (size_t)F_R * astr + ro + 8 * hf); raw[5][hf] = *(const u32x4*)(FB + (size_t)F_V * astr + ro + 8 * hf); }
            };
            load_raw(p);
            const int tn = lane & 15, gq = lane >> 4;
            for (int c = p; c < NCH; c += 4) {
                const int slot = c & 3; LAS unsigned char* sb = lds + slot * CS_SLOT;
                float cs[16], lwv[16];
#pragma unroll
                for (int q = 0; q < 8; ++q) { const unsigned w = raw[0][q >> 2][q & 3]; lwv[2 * q] = lo16(w); lwv[2 * q + 1] = hi16(w); }
#pragma unroll
                for (int q = 0; q < 16; ++q) { float x = lwv[q]; x = dpp_shr_add<0x111>(x); x = dpp_shr_add<0x112>(x); x = dpp_shr_add<0x114>(x); x = dpp_shr_add<0x118>(x); cs[q] = x; }
                float Gc[16], Gi[16], Gp[16], G15[16];
#pragma unroll
                for (int q = 0; q < 16; ++q) { Gc[q] = __expf(cs[q]); Gi[q] = __expf(-cs[q]); Gp[q] = __expf(cs[q] - lwv[q]); G15[q] = __shfl(Gc[q], (lane & 48) | 15); }
                while (flags[4 + slot] != (unsigned)(4 * (c >> 2))) __builtin_amdgcn_s_sleep(1);
                __builtin_amdgcn_fence(__ATOMIC_ACQUIRE, "workgroup");
                {
                    u32x4 wa[2], wr[2], wb[2], wk[2], wbh[2], wkh[2];
#pragma unroll
                    for (int q = 0; q < 8; ++q) {
                        const unsigned ua = raw[1][q >> 2][q & 3], ub = raw[2][q >> 2][q & 3], uk = raw[3][q >> 2][q & 3], ur = raw[4][q >> 2][q & 3];
                        const float a0 = lo16(ua) * Gp[2 * q], a1 = hi16(ua) * Gp[2 * q + 1], r0 = lo16(ur) * Gc[2 * q], r1 = hi16(ur) * Gc[2 * q + 1];
                        const float b0 = lo16(ub) * Gi[2 * q], b1 = hi16(ub) * Gi[2 * q + 1], k0 = lo16(uk) * Gi[2 * q], k1 = hi16(uk) * Gi[2 * q + 1];
                        wa[q >> 2][q & 3] = cvt_pk_bf16(a0, a1); wr[q >> 2][q & 3] = cvt_pk_bf16(r0, r1); wb[q >> 2][q & 3] = cvt_pk_bf16(b0, b1); wk[q >> 2][q & 3] = cvt_pk_bf16(k0, k1);
                        wbh[q >> 2][q & 3] = cvt_pk_bf16(b0 * G15[2 * q], b1 * G15[2 * q + 1]); wkh[q >> 2][q & 3] = cvt_pk_bf16(k0 * G15[2 * q], k1 * G15[2 * q + 1]);
                    }
                    const int ro = t * 144 + 32 * jg;
#pragma unroll
                    for (int hf = 0; hf < 2; ++hf) {
                        *(LAS u32x4*)(sb + CS_AT + ro + 16 * hf) = wa[hf]; *(LAS u32x4*)(sb + CS_RT + ro + 16 * hf) = wr[hf];
                        *(LAS u32x4*)(scr + CS_BT + ro + 16 * hf) = wb[hf]; *(LAS u32x4*)(scr + CS_KT + ro + 16 * hf) = wk[hf];
                        *(LAS u32x4*)(sb + CS_BH + ro + 16 * hf) = wbh[hf]; *(LAS u32x4*)(sb + CS_KH + ro + 16 * hf) = wkh[hf];
                        *(LAS u32x4*)(sb + CS_VV + ro + 16 * hf) = raw[5][hf];
                    }
                    if (t == 15) {
#pragma unroll
                        for (int q = 0; q < 4; ++q) *(LAS f32x4*)(sb + CS_GC + (16 * jg + 4 * q) * 4) = (f32x4){Gc[4 * q], Gc[4 * q + 1], Gc[4 * q + 2], Gc[4 * q + 3]};
                    }
                }
                if (c + 4 < NCH) load_raw(c + 4);
                asm volatile("s_waitcnt lgkmcnt(0)" ::: "memory");
                f32x4 m0 = (f32x4){0.f, 0.f, 0.f, 0.f}, m1 = m0, m3 = m0, m4 = m0;
                asm volatile("" : "+v"(m0), "+v"(m1), "+v"(m3), "+v"(m4));
#pragma unroll
                for (int ks = 0; ks < 2; ++ks) {
                    const bf16x8 xa = *(const LAS bf16x8*)(sb + CS_AT + tn * 144 + 64 * ks + 16 * gq), xr = *(const LAS bf16x8*)(sb + CS_RT + tn * 144 + 64 * ks + 16 * gq);
                    const bf16x8 yb = *(const LAS bf16x8*)(scr + CS_BT + tn * 144 + 64 * ks + 16 * gq), yk = *(const LAS bf16x8*)(scr + CS_KT + tn * 144 + 64 * ks + 16 * gq);
                    m0 = __builtin_amdgcn_mfma_f32_16x16x32_bf16(yb, xa, m0, 0, 0, 0);
                    m1 = __builtin_amdgcn_mfma_f32_16x16x32_bf16(yk, xa, m1, 0, 0, 0);
                    m3 = __builtin_amdgcn_mfma_f32_16x16x32_bf16(yb, xr, m3, 0, 0, 0);
                    m4 = __builtin_amdgcn_mfma_f32_16x16x32_bf16(yk, xr, m4, 0, 0, 0);
                }
                {
                    f32x4 n0, q1, q3, q4;
#pragma unroll
                    for (int rg = 0; rg < 4; ++rg) { const int s = 4 * gq + rg; const bool lt = s < tn, le = s <= tn;
                        n0[rg] = lt ? m0[rg] : 0.f; q1[rg] = lt ? m1[rg] : 0.f; q3[rg] = le ? m3[rg] : 0.f; q4[rg] = le ? m4[rg] : 0.f;
                        *(LAS float*)(scr + CS_NN + (s * 16 + tn) * 4) = n0[rg]; }
                    u32x2 w1; w1.x = cvt_pk_bf16(q1[0], q1[1]); w1.y = cvt_pk_bf16(q1[2], q1[3]);
                    *(LAS u32x2*)(sb + CS_AAK + tn * 80 + 16 * gq) = w1;
                    u32x4 w3; w3.x = cvt_pk_bf16(q3[0], q3[1]); w3.y = cvt_pk_bf16(q3[2], q3[3]); w3.z = cvt_pk_bf16(q4[0], q4[1]); w3.w = cvt_pk_bf16(q4[2], q4[3]);
                    *(LAS u32x4*)(sb + CS_ARK + tn * 80 + 16 * gq) = w3;
                }
                asm volatile("s_waitcnt lgkmcnt(0)" ::: "memory");
                float Tc[16];
#pragma unroll
                for (int s = 0; s < 16; ++s) Tc[s] = (s == tn) ? 1.0f : 0.0f;
                {
                    const LAS f32x4* NR = (const LAS f32x4*)(scr + CS_NN);
                    f32x4 cq[4], nq[4];
#pragma unroll
                    for (int k = 0; k < 4; ++k) { cq[k] = NR[4 * 14 + k]; nq[k] = cq[k]; }
#pragma unroll
                    for (int s = 14; s >= 0; --s) {
                        if (s > 0) {
#pragma unroll
                            for (int k = 0; k < 4; ++k) if (4 * k + 3 > s - 1) nq[k] = NR[4 * (s - 1) + k];
                        }
                        float acc0 = 0.f, acc1 = 0.f;
#pragma unroll
                        for (int q = s + 1; q < 16; ++q) { if (q & 1) acc1 += Tc[q] * cq[q >> 2][q & 3]; else acc0 += Tc[q] * cq[q >> 2][q & 3]; }
                        Tc[s] = (s < tn) ? (acc0 + acc1) : Tc[s];
#pragma unroll
                        for (int k = 0; k < 4; ++k) cq[k] = nq[k];
                    }
                }
                if (lane < 16) {
#pragma unroll
                    for (int g4 = 0; g4 < 4; ++g4) { u32x2 w; w.x = cvt_pk_bf16(Tc[4 * g4], Tc[4 * g4 + 1]); w.y = cvt_pk_bf16(Tc[4 * g4 + 2], Tc[4 * g4 + 3]); *(LAS u32x2*)(sb + CS_TT + tn * 80 + 16 * g4) = w; }
                }
                __builtin_amdgcn_fence(__ATOMIC_RELEASE, "workgroup");
                asm volatile("s_waitcnt lgkmcnt(0)" ::: "memory");
                if (lane == 0) flags[slot] = (unsigned)(c + 1);
            }
        }
    }
}

__device__ __forceinline__ void p5_rwkv_out(const Args& a, int lane, int wave, int G) {
    unsigned char* ws = a.ws;
    const bf16_t* FB = (const bf16_t*)(ws + WS_FEAT); const size_t astr = FEAT_STRIDE / 2;
    const bf16_t* YF = (const bf16_t*)(ws + WS_YF); const bf16_t* YBk = (const bf16_t*)(ws + WS_YB);
    bf16_t* RWK = (bf16_t*)(ws + WS_RWK);
    const int gw = blockIdx.x * 8 + wave, NGW = G * 8;
    const int c0 = 8 * lane;
    float lnw[8], lnb[8], rk[8];
#pragma unroll
    for (int j = 0; j < 8; ++j) { lnw[j] = a.in[I_LNW][c0 + j]; lnb[j] = a.in[I_LNB][c0 + j]; rk[j] = a.in[I_RK][c0 + j]; }
    auto ld8 = [&](const bf16_t* p, float (&o)[8]) { const u32x4 w = *(const u32x4*)p;
#pragma unroll
        for (int j = 0; j < 4; ++j) { o[2 * j] = lo16(w[j]); o[2 * j + 1] = hi16(w[j]); } };
    for (int mb = 2 * gw; mb < T; mb += 2 * NGW) {
        u32x4 w[2][7];
#pragma unroll
        for (int rr = 0; rr < 2; ++rr) { const size_t o = (size_t)(mb + rr) * RD + c0;
            w[rr][0] = *(const u32x4*)(YF + o); w[rr][1] = *(const u32x4*)(YBk + o); w[rr][2] = *(const u32x4*)(FB + F_R * astr + o); w[rr][3] = *(const u32x4*)(FB + F_KF * astr + o);
            w[rr][4] = *(const u32x4*)(FB + F_KB * astr + o); w[rr][5] = *(const u32x4*)(FB + F_V * astr + o); w[rr][6] = *(const u32x4*)(FB + F_G * astr + o); }
#pragma unroll
        for (int rr = 0; rr < 2; ++rr) {
            const size_t o = (size_t)(mb + rr) * RD + c0;
            float yf[8], yb[8], r[8], kf[8], kb[8], v[8], g[8];
#pragma unroll
            for (int j = 0; j < 4; ++j) { yf[2 * j] = lo16(w[rr][0][j]); yf[2 * j + 1] = hi16(w[rr][0][j]); yb[2 * j] = lo16(w[rr][1][j]); yb[2 * j + 1] = hi16(w[rr][1][j]);
                r[2 * j] = lo16(w[rr][2][j]); r[2 * j + 1] = hi16(w[rr][2][j]); kf[2 * j] = lo16(w[rr][3][j]); kf[2 * j + 1] = hi16(w[rr][3][j]);
                kb[2 * j] = lo16(w[rr][4][j]); kb[2 * j + 1] = hi16(w[rr][4][j]); v[2 * j] = lo16(w[rr][5][j]); v[2 * j + 1] = hi16(w[rr][5][j]); g[2 * j] = lo16(w[rr][6][j]); g[2 * j + 1] = hi16(w[rr][6][j]); }
            float s = 0.f, bs = 0.f;
#pragma unroll
            for (int j = 0; j < 8; ++j) { yf[j] += yb[j]; s += yf[j]; bs += r[j] * (kf[j] + kb[j]) * rk[j]; }
            s += __shfl_xor(s, 1); s += __shfl_xor(s, 2); s += __shfl_xor(s, 4);
            bs += __shfl_xor(bs, 1); bs += __shfl_xor(bs, 2); bs += __shfl_xor(bs, 4);
            const float mean = s * (1.f / 64.f); float q = 0.f;
#pragma unroll
            for (int j = 0; j < 8; ++j) { yf[j] -= mean; q += yf[j] * yf[j]; }
            q += __shfl_xor(q, 1); q += __shfl_xor(q, 2); q += __shfl_xor(q, 4);
            const float rstd = __builtin_amdgcn_rsqf(q * (1.f / 64.f) + GN_EPS);
            float out[8];
#pragma unroll
            for (int j = 0; j < 8; ++j) out[j] = (yf[j] * rstd * lnw[j] + lnb[j] + bs * v[j]) * g[j];
            u32x4 ww; ww.x = cvt_pk_bf16(out[0], out[1]); ww.y = cvt_pk_bf16(out[2], out[3]); ww.z = cvt_pk_bf16(out[4], out[5]); ww.w = cvt_pk_bf16(out[6], out[7]);
            *(u32x4*)(RWK + o) = ww;
        }
    }
}

template <bool PROBE> __device__ __forceinline__ void p9_postmix_router(const Args& a, LAS unsigned char* lds, int tid, int lane, int wave, int G) {
    unsigned char* ws = a.ws;
    const float* MOD = (const float*)(ws + WS_CTL) + CW_MOD;
    const float* MIX = (const float*)(ws + WS_MIX);
    bf16_t* HF = (bf16_t*)(ws + (PROBE ? WS_H + 160 * MiB : WS_HF));
    int* cnt = (int*)(ws + WS_CTL) + (PROBE ? 12000 : CW_CNT);
    int* slot_tok = (int*)(ws + (PROBE ? WS_H + 240 * MiB : WS_SLOT_TOK)); float* slot_gate = (float*)(ws + (PROBE ? WS_H + 248 * MiB : WS_SLOT_GATE)); unsigned* tokk = (unsigned*)(ws + (PROBE ? WS_H + 256 * MiB : WS_TOKK));
    constexpr int HP = 1028;
    LAS float* HL = (LAS float*)lds;
    LAS float* PART = HL + 16 * HP;
    LAS int* SEL_E = (LAS int*)(lds + 90112); LAS float* SEL_G = (LAS float*)(lds + 90112 + 2048); LAS int* SEL_M = (LAS int*)(lds + 90112 + 4096);
    LAS int* HIST = (LAS int*)(lds + 90112 + 6144); LAS int* BASE = HIST + 32;
    int nsel = 0;
    const int ti = lane & 15, kq = lane >> 4;
    float wb0[32], wb1[32];
    {
        const float* wr = a.in[I_WROUTER];
#pragma unroll
        for (int ks = 0; ks < 32; ++ks) { const int k = 128 * wave + 4 * ks + kq; wb0[ks] = wr[k * NE + ti]; wb1[ks] = wr[k * NE + 16 + ti]; }
    }
    const float brt = a.in[I_BROUTER][lane & 31];
    for (int unit = blockIdx.x; unit < T / 16; unit += G) {
        const int tok0 = unit * 16;
        __syncthreads();
        {
            const int m0 = tok0 + 2 * wave; const int b = m0 >> 12;
            f32x4 v[2][4]; float s[2] = {0.f, 0.f};
#pragma unroll
            for (int tt = 0; tt < 2; ++tt) { const f32x4* mr = (const f32x4*)(MIX + (size_t)(m0 + tt) * D) + lane;
#pragma unroll
                for (int j = 0; j < 4; ++j) { v[tt][j] = mr[64 * j]; s[tt] += (v[tt][j].x * v[tt][j].x + v[tt][j].y * v[tt][j].y) + (v[tt][j].z * v[tt][j].z + v[tt][j].w * v[tt][j].w); } }
            f32x4 xv[2][4];
#pragma unroll
            for (int tt = 0; tt < 2; ++tt) { const f32x4* xr = (const f32x4*)(a.in[I_X] + (size_t)(m0 + tt) * D) + lane;
#pragma unroll
                for (int j = 0; j < 4; ++j) xv[tt][j] = xr[64 * j]; }
#pragma unroll
            for (int o = 1; o < 64; o <<= 1) { s[0] += __shfl_xor(s[0], o); s[1] += __shfl_xor(s[1], o); }
            float s2[2] = {0.f, 0.f};
#pragma unroll
            for (int j = 0; j < 4; ++j) {
                const f32x4 g = ((const f32x4*)a.in[I_GPOSTMIX])[64 * j + lane], gt = ((const f32x4*)(MOD + b * 6144 + 2048))[64 * j + lane];
#pragma unroll
                for (int tt = 0; tt < 2; ++tt) {
                    const float rstd = __builtin_amdgcn_rsqf(s[tt] * (1.f / D) + RMS_EPS);
                    v[tt][j] = xv[tt][j] + gt * (v[tt][j] * rstd * g);
                    ((f32x4*)((PROBE ? (float*)(ws + WS_H) : a.out) + (size_t)(m0 + tt) * D))[64 * j + lane] = v[tt][j];
                    s2[tt] += (v[tt][j].x * v[tt][j].x + v[tt][j].y * v[tt][j].y) + (v[tt][j].z * v[tt][j].z + v[tt][j].w * v[tt][j].w);
                }
            }
#pragma unroll
            for (int o = 1; o < 64; o <<= 1) { s2[0] += __shfl_xor(s2[0], o); s2[1] += __shfl_xor(s2[1], o); }
#pragma unroll
            for (int j = 0; j < 4; ++j) {
                const f32x4 g = ((const f32x4*)a.in[I_GPREFFN])[64 * j + lane], sh = ((const f32x4*)(MOD + b * 6144 + 3072))[64 * j + lane], sc = ((const f32x4*)(MOD + b * 6144 + 4096))[64 * j + lane];
#pragma unroll
                for (int tt = 0; tt < 2; ++tt) {
                    const float rstd2 = __builtin_amdgcn_rsqf(s2[tt] * (1.f / D) + RMS_EPS);
                    const f32x4 hv = (v[tt][j] * rstd2 * g) * (sc + 1.0f) + sh;
                    ((unsigned long long*)(HF + (size_t)(m0 + tt) * D))[64 * j + lane] = (unsigned long long)pk2(hv.x, hv.y) | ((unsigned long long)pk2(hv.z, hv.w) << 32);
                    *(LAS f32x4*)(HL + (2 * wave + tt) * HP + 256 * j + 4 * lane) = hv;
                }
            }
        }
        __syncthreads();
        {
            f32x4 acc0 = (f32x4){0.f, 0.f, 0.f, 0.f}, acc1 = acc0;
#pragma unroll
            for (int ks = 0; ks < 32; ++ks) {
                const float av = HL[ti * HP + 128 * wave + 4 * ks + kq];
                acc0 = __builtin_amdgcn_mfma_f32_16x16x4f32(av, wb0[ks], acc0, 0, 0, 0);
                acc1 = __builtin_amdgcn_mfma_f32_16x16x4f32(av, wb1[ks], acc1, 0, 0, 0);
            }
#pragma unroll
            for (int r = 0; r < 4; ++r) { PART[(wave * 16 + 4 * kq + r) * 32 + ti] = acc0[r]; PART[(wave * 16 + 4 * kq + r) * 32 + 16 + ti] = acc1[r]; }
        }
        __syncthreads();
        {
            const int tl = 2 * wave + (lane >> 5); const int m = tok0 + tl;
            const int e = lane & 31;
            float lg = brt;
#pragma unroll
            for (int w = 0; w < 8; ++w) lg += PART[(w * 16 + tl) * 32 + e];
            float tv[4]; int ti4[4];
#pragma unroll
            for (int k = 0; k < 4; ++k) {
                float bv = lg; int bi = e;
#pragma unroll
                for (int o = 1; o < 32; o <<= 1) { const float ov = __shfl_xor(bv, o); const int oi = __shfl_xor(bi, o); if (ov > bv || (ov == bv && oi < bi)) { bv = ov; bi = oi; } }
                tv[k] = bv; ti4[k] = bi;
                if (e == bi) lg = -3.0e38f;
            }
            const float e1 = __expf(tv[1] - tv[0]), e2 = __expf(tv[2] - tv[0]), e3 = __expf(tv[3] - tv[0]);
            const float inv = 1.0f / (1.0f + e1 + e2 + e3);
            if (e < 4) {
                const int ek = e == 0 ? ti4[0] : e == 1 ? ti4[1] : e == 2 ? ti4[2] : ti4[3];
                const float gk = (e == 0 ? 1.0f : e == 1 ? e1 : e == 2 ? e2 : e3) * inv;
                const int si = nsel * 64 + tl * 4 + e;
                SEL_E[si] = ek; SEL_G[si] = gk; SEL_M[si] = m;
            }
        }
        ++nsel;
    }
    __syncthreads();
    if (tid < 32) HIST[tid] = 0;
    __syncthreads();
    int my_e = 0, my_lr = 0; const bool have = tid < nsel * 64;
    if (have) { my_e = SEL_E[tid]; my_lr = __hip_atomic_fetch_add(HIST + my_e, 1, __ATOMIC_RELAXED, __HIP_MEMORY_SCOPE_WORKGROUP); }
    __syncthreads();
    if (tid < 32) { const int n = HIST[tid]; BASE[tid] = n ? atomicAdd(cnt + tid, n) : 0; }
    __syncthreads();
    if (have) { const int rank = BASE[my_e] + my_lr; const int m = SEL_M[tid];
        slot_tok[my_e * T + rank] = m; slot_gate[(size_t)my_e * T + rank] = SEL_G[tid];
        tokk[m * 4 + (tid & 3)] = ((unsigned)my_e << 20) | (unsigned)rank; }
}

__device__ __forceinline__ void moe_table(const Args& a, LAS int* tstart, int tid) {
    const int* cnt = (const int*)(a.ws + WS_CTL) + CW_CNT;
    __syncthreads();
    if (tid == 0) { int acc = 0; for (int e = 0; e < NE; ++e) { tstart[e] = acc; acc += (__hip_atomic_load(cnt + e, __ATOMIC_RELAXED, __HIP_MEMORY_SCOPE_AGENT) + 255) >> 8; } tstart[NE] = acc; }
    __syncthreads();
}

template <bool PROBE> __device__ __forceinline__ void p12_combine(const Args& a, LAS int* tstart, int lane, int wave, int G) {
    unsigned char* ws = a.ws;
    const float* MOD = (const float*)(ws + WS_CTL) + CW_MOD;
    const bf16_t* YB = (const bf16_t*)(ws + WS_YBUF); const unsigned* tokk = (const unsigned*)(ws + WS_TOKK);
    const int gw = blockIdx.x * 8 + wave, NGW = G * 8;
    for (int m0 = gw; m0 < T; m0 += 2 * NGW) {
        const int m1 = (m0 + NGW < T) ? m0 + NGW : m0;
        const u32x4 tk0 = *(const u32x4*)(tokk + m0 * 4), tk1 = *(const u32x4*)(tokk + m1 * 4);
        unsigned long long yr[2][4][4]; f32x4 xr[2][4];
#pragma unroll
        for (int r = 0; r < 2; ++r) {
            const int m = r ? m1 : m0;
#pragma unroll
            for (int k = 0; k < 4; ++k) {
                const unsigned tk = r ? tk1[k] : tk0[k]; const int e = (int)(tk >> 20), rank = (int)(tk & 0xfffffu);
                const unsigned long long* yp = (const unsigned long long*)(YB + ((size_t)tstart[e] * 256 + rank) * D) + lane;
#pragma unroll
                for (int j = 0; j < 4; ++j) yr[r][k][j] = yp[64 * j];
            }
#pragma unroll
            for (int j = 0; j < 4; ++j) xr[r][j] = ((const f32x4*)(a.out + (size_t)m * D))[64 * j + lane];
        }
#pragma unroll
        for (int r = 0; r < 2; ++r) {
            const int m = r ? m1 : m0; const int b = m >> 12;
            f32x4 y[4]; float s = 0.f;
#pragma unroll
            for (int j = 0; j < 4; ++j) { y[j] = (f32x4){0.f, 0.f, 0.f, 0.f};
#pragma unroll
                for (int k = 0; k < 4; ++k) { const unsigned lo = (unsigned)yr[r][k][j], hi = (unsigned)(yr[r][k][j] >> 32); y[j] += (f32x4){lo16(lo), hi16(lo), lo16(hi), hi16(hi)}; }
                s += (y[j][0] * y[j][0] + y[j][1] * y[j][1]) + (y[j][2] * y[j][2] + y[j][3] * y[j][3]); }
            const float rstd = __builtin_amdgcn_rsqf(wave_sum(s) * (1.f / D) + RMS_EPS);
            if (r == 0 || m1 != m0) {
#pragma unroll
                for (int j = 0; j < 4; ++j) {
                    const f32x4 g = ((const f32x4*)a.in[I_GPOSTFFN])[64 * j + lane], gt = ((const f32x4*)(MOD + b * 6144 + 5120))[64 * j + lane];
                    ((f32x4*)((PROBE ? (float*)(ws + WS_H) : a.out) + (size_t)m * D))[64 * j + lane] = xr[r][j] + gt * (y[j] * rstd * g);
                }
            }
        }
    }
}

constexpr int N_PHASES = 13;
__global__ void __launch_bounds__(512, 2) mega_fwd(Args args) {
    extern __shared__ __attribute__((aligned(16))) unsigned char lds_raw[];
    LAS unsigned char* lds = (LAS unsigned char*)lds_raw;
    const int tid = threadIdx.x, lane = tid & 63, wave = __builtin_amdgcn_readfirstlane(tid >> 6);
    const int G = gridDim.x;
    volatile LAS unsigned* MISC = (volatile LAS unsigned*)(lds + MISC_OFF);
    LAS int* tstart = (LAS int*)(lds + RING_BYTES);
    for (int u = tid; u < (LDS_BYTES - RING_BYTES) / 4; u += 512) ((LAS unsigned*)(lds + RING_BYTES))[u] = 0u;
    __syncthreads();
    unsigned char* ws = args.ws;
    const int lo = args.ph_lo, hi = args.ph_hi;
    unsigned* barw = (unsigned*)(ws + WS_CTL) + (args.bar_region ? (131072 + (args.bar_region - 1) * 4096) : CW_BAR);
    XcdBarrier bar; bar.bar = barw; bar.x = 0; bar.st = nullptr;
    if (hi - lo > 1) bar = xcd_barrier_post(barw, MISC + 8);
#ifndef PH_MASK
#define PH_MASK 0x1FFF
#endif
#define IN(k) (((PH_MASK >> (k)) & 1) && lo <= (k) && (k) < hi)
#define SEAM(k) do { if (IN(k) && IN((k) + 1)) xcd_barrier(bar); } while (0)

    if (IN(0)) { p0_prologue(args, lds, tid, lane, wave, G); SEAM(0); }
    if (IN(1)) { p1_norm(args, lane, wave, G); SEAM(1); }
    if (IN(2)) {
        SchedProj S{(const char*)(ws + WS_WIN), G, (int)blockIdx.x};
        EpiZ E{(bf16_t*)(ws + WS_Z), (const float*)(ws + WS_MISC)};
        pg8::gemm_phase<1024, EpiZ, SchedProj>(lds, (const char*)(ws + WS_HX), S, E);
        SEAM(2);
    }
    if (IN(3)) { p3a_pointwise(args, tid, G); if (IN(4)) xcd_barrier(bar); p3b_features(args, lds, tid, lane, wave, G); SEAM(3); }
    if (IN(5)) { if (SCAN_CHUNKED && !SCAN_FORCE_DIRECT) p4_scan_chunked<false>(args, lds, tid, lane, wave, G); else p4_scan<0>(args, lds, tid, lane, wave, G);
        p4_attention(args, lds, tid, lane, wave, G);
        moe_weight_copies(args, lds, tid, lane, wave);
        SEAM(5); }
#if DBG_SCAN
    if (IN(6) && blockIdx.x == 0) {
        const bf16_t* Yt = (const bf16_t*)(ws + (DBG_DIR ? WS_YB : WS_YF)); const bf16_t* Y2 = (const bf16_t*)(ws + 272 * MiB);
        LAS float* red = (LAS float*)lds; float* dbg = (float*)(ws + WS_CTL) + 12288;
        int first = -1; float worst = 0.f;
        for (int ci = 0; ci < 256; ++ci) {
            float e2 = 0.f, r2 = 0.f;
            for (int i = tid; i < 16 * 512; i += 512) { const int cc = DBG_DIR ? (255 - ci) : ci; const size_t o = (size_t)(cc * 16) * 512 + i; const float yt = bf2f(Yt[o]), y2 = bf2f(Y2[o]); e2 += (yt - y2) * (yt - y2); r2 += yt * yt; }
            e2 = wave_sum(e2); r2 = wave_sum(r2);
            __syncthreads(); if (lane == 0) { red[wave] = e2; red[8 + wave] = r2; } __syncthreads();
            float E = 0.f, R = 0.f; for (int w8 = 0; w8 < 8; ++w8) { E += red[w8]; R += red[8 + w8]; }
            const float rel = sqrtf(E / fmaxf(R, 1e-20f));
            if (first < 0 && !(rel < 0.03f)) first = ci;
            if (ci == DBG_CHUNK) { worst = rel;
                if (DBG_MODE == 2) { float z = 0.f; for (int i = tid; i < 16 * 512; i += 512) { const int cc = DBG_DIR ? (255 - ci) : ci; z += ((Y2[(size_t)(cc * 16) * 512 + i] & 0x7fff) > 0x7f80) ? 1.f : 0.f; }
                    z = wave_sum(z); __syncthreads(); if (lane == 0) red[16 + wave] = z; __syncthreads(); float Z = 0.f; for (int w8 = 0; w8 < 8; ++w8) Z += red[16 + w8]; worst = Z / 8192.f; } }
        }
        if (tid == 0) dbg[0] = DBG_MODE ? worst : ((first < 0) ? 0.f : (float)(first + 1) / 256.f);
    }
#endif
    if (IN(6)) {
        p5_rwkv_out(args, lane, wave, G);
        SchedDense<512> S{(const char*)(ws + WS_WUPA), G, (int)blockIdx.x};
        EpiUp<false> E{(bf16_t*)(ws + WS_MERGED), (const bf16_t*)(ws + WS_Z)};
        pg8::gemm_phase<512, EpiUp<false>, SchedDense<512>>(lds, (const char*)(ws + WS_ATT), S, E);
        SEAM(6);
    }
    if (IN(7)) {
        SchedDense<512> S{(const char*)(ws + WS_WUPR), G, (int)blockIdx.x};
        EpiUp<true> E{(bf16_t*)(ws + WS_MERGED), (const bf16_t*)(ws + WS_Z)};
        pg8::gemm_phase<512, EpiUp<true>, SchedDense<512>>(lds, (const char*)(ws + WS_RWK), S, E);
        SEAM(7);
    }
    if (IN(8)) {
        SchedDense<1024> S{(const char*)(ws + WS_WOUT), G, (int)blockIdx.x};
        EpiMix E{(float*)(ws + WS_MIX)};
        pg8::gemm_phase<1024, EpiMix, SchedDense<1024>>(lds, (const char*)(ws + WS_MERGED), S, E);
        SEAM(8);
    }
    if (IN(9)) { p9_postmix_router<false>(args, lds, tid, lane, wave, G); SEAM(9); }
    if (IN(10)) {
        moe_table(args, tstart, tid);
        SchedMoe<8, true> S{(const char*)(ws + WS_WGU), G, (int)blockIdx.x, tstart, (const int*)(ws + WS_CTL) + CW_CNT, (const int*)(ws + WS_SLOT_TOK)};
        EpiMoe1 E{(bf16_t*)(ws + WS_H), args.in[I_BGU]};
        pg8::gemm_phase<1024, EpiMoe1, SchedMoe<8, true>>(lds, (const char*)(ws + WS_HF), S, E);
        SEAM(10);
    }
    if (IN(11)) {
        moe_table(args, tstart, tid);
        SchedMoe<4, false> S{(const char*)(ws + WS_WDN), G, (int)blockIdx.x, tstart, (const int*)(ws + WS_CTL) + CW_CNT, (const int*)(ws + WS_SLOT_TOK)};
        EpiMoe2 E{(bf16_t*)(ws + WS_YBUF), args.in[I_BDN], (const float*)(ws + WS_SLOT_GATE), (const int*)(ws + WS_CTL) + CW_CNT};
        pg8::gemm_phase<1024, EpiMoe2, SchedMoe<4, false>>(lds, (const char*)(ws + WS_H), S, E);
        SEAM(11);
    }
    if (IN(12)) { moe_table(args, tstart, tid); p12_combine<false>(args, tstart, lane, wave, G); }
#ifdef PROBE_PHASE
    if (lo == 15 && blockIdx.x == 0 && tid < 32) { unsigned* ctl = (unsigned*)(ws + WS_CTL); if (tid == 0) { ctl[CW_QATT] = 0u; ctl[CW_QTR] = PROBE_QTR0; } ctl[CW_CNT + tid] = 0u; }
    if (lo == 16) p9_postmix_router<true>(args, lds, tid, lane, wave, G);
    if (lo == 17) { moe_table(args, tstart, tid); p12_combine<true>(args, tstart, lane, wave, G); }
    if (lo == 13) p3a_pointwise(args, tid, G);
    if (lo == 14) p3b_features(args, lds, tid, lane, wave, G);
#endif
#undef IN
#undef SEAM
}

extern "C" void kernel_launch(void* const* d_in, const int* in_sizes, int n_in, void* d_out, int out_size, void* d_ws, size_t ws_size, hipStream_t stream) {
    static int grid = 0;
    if (grid == 0) {
        if (n_in != 38 || out_size != T * D || ws_size < WS_END) { fprintf(stderr, "kernel_launch: unexpected problem shape (n_in %d, out %d, ws %zu)\n", n_in, out_size, ws_size); grid = -1; return; }
        int dev = 0, cus = 0, per_cu = 0;
        if (hipGetDevice(&dev) != hipSuccess || hipDeviceGetAttribute(&cus, hipDeviceAttributeMultiprocessorCount, dev) != hipSuccess) { grid = -1; return; }
        if (hipFuncSetAttribute((const void*)mega_fwd, hipFuncAttributeMaxDynamicSharedMemorySize, LDS_BYTES) != hipSuccess) { fprintf(stderr, "kernel_launch: hipFuncSetAttribute failed\n"); grid = -1; return; }
        if (hipOccupancyMaxActiveBlocksPerMultiprocessor(&per_cu, (const void*)mega_fwd, 512, LDS_BYTES) != hipSuccess || per_cu < 1) fprintf(stderr, "kernel_launch: occupancy query says %d\n", per_cu);
        (void)hipGetLastError();
        grid = cus;
    }
    if (grid < 0) return;
    (void)hipMemsetAsync((char*)d_ws + WS_CTL, 0, CTL_BYTES, stream);
    Args a{};
    for (int i = 0; i < 38; ++i) a.in[i] = (const float*)d_in[i];
    a.out = (float*)d_out; a.ws = (unsigned char*)d_ws;
#if MK_ONE_LAUNCH
    a.ph_lo = 0; a.ph_hi = N_PHASES;
    hipLaunchKernelGGL(mega_fwd, dim3(grid), dim3(512), LDS_BYTES, stream, a);
#ifdef PROBE_PHASE
#ifdef PROBE_PRE
    { a.ph_lo = PROBE_PRE; a.ph_hi = PROBE_PRE + 1; hipLaunchKernelGGL(mega_fwd, dim3(grid), dim3(512), LDS_BYTES, stream, a); }
#endif
    for (int rep = 0; rep < PROBE_REPS; ++rep) { a.ph_lo = PROBE_PHASE; a.ph_hi = PROBE_HI; a.bar_region = 1 + rep; hipLaunchKernelGGL(mega_fwd, dim3(grid), dim3(512), LDS_BYTES, stream, a); }
#endif
#else
    for (int p = 0; p < N_PHASES; ++p) { a.ph_lo = p; a.ph_hi = p + 1; hipLaunchKernelGGL(mega_fwd, dim3(grid), dim3(512), LDS_BYTES, stream, a); }
#endif
}
```

```cpp
#include <hip/hip_runtime.h>
#include <cstdio>
#include <cstdint>

#ifndef MK_ONE_LAUNCH
#define MK_ONE_LAUNCH 1
#endif
#ifndef PROBE_QTR0
#define PROBE_QTR0 0u
#endif
#ifndef PROBE_HI
#define PROBE_HI (PROBE_PHASE + 1)
#endif
#ifndef SCAN_CHUNKED
#define SCAN_CHUNKED 1
#endif
#ifndef SCAN_FORCE_DIRECT
#define SCAN_FORCE_DIRECT 0
#endif
#ifndef DBG_SCAN
#define DBG_SCAN 0
#define DBG_DIR 0
#define DBG_MODE 0
#define DBG_CHUNK 0
#endif
#ifndef DBG_NOA
#define DBG_NOA 0
#define DBG_NOB 0
#endif
#ifndef DBG_D
#define DBG_D 0
#endif
#ifndef DBG_TI
#define DBG_TI 0
#endif
#ifndef CS_LOCKSTEP
#define CS_LOCKSTEP 0
#endif

#define GAS __attribute__((address_space(1)))
#define LAS __attribute__((address_space(3)))
typedef unsigned short bf16_t;
typedef short bf16x8 __attribute__((ext_vector_type(8)));
typedef short s16x4 __attribute__((ext_vector_type(4)));
typedef float f32x4 __attribute__((ext_vector_type(4)));
typedef float f32x16 __attribute__((ext_vector_type(16)));
typedef unsigned u32x4 __attribute__((ext_vector_type(4)));
typedef unsigned u32x2 __attribute__((ext_vector_type(2)));

constexpr int NB = 8, SEQ = 4096, T = NB * SEQ, D = 1024, CL = 256, TC = NB * CL, ROWS = T + TC;
constexpr int NH = 8, HD = 64, NKV = 2, RD = 512;
constexpr int NE = 32, TOPK = 4, DE = 1024;
constexpr int PROJ_SRC = 4736;
constexpr int ZP = 4864;
constexpr int ZC_Q = 0, ZC_K = 512, ZC_V = 640, ZC_R = 768, ZC_RK = 1280, ZC_RV = 1792, ZC_LORA = 2304, ZC_G = 2816;
constexpr int NTILE_N = ZP / 256;
constexpr float RMS_EPS = 1e-6f, GN_EPS = 64e-5f;
constexpr float F8_WSCALE = 32.0f, F8_ASCALE = 4.0f, F8_HSCALE = 8.0f;

constexpr size_t MiB = 1u << 20;
constexpr size_t WS_CTL = 0, CTL_BYTES = 1 * MiB;
constexpr size_t WS_WIN = 1 * MiB;
constexpr size_t WS_WUPA = 11 * MiB, WS_WUPR = 12 * MiB;
constexpr size_t WS_WOUT = 13 * MiB;
constexpr size_t WS_LORA = 15 * MiB;
constexpr size_t WS_MISC = 15 * MiB + 512 * 1024;
constexpr size_t WS_WGU = 16 * MiB;
constexpr size_t WS_WDN = 144 * MiB;
constexpr size_t WS_HX = 208 * MiB;
constexpr size_t WS_YF = 208 * MiB, WS_YB = 240 * MiB;
constexpr size_t WS_HF = 208 * MiB;
constexpr size_t WS_Z = 276 * MiB;
constexpr size_t WS_SLOT_TOK = 272 * MiB;
constexpr size_t WS_FEAT = 599 * MiB;
constexpr size_t FEAT_STRIDE = 34 * MiB;
constexpr size_t WS_MERGED = 769 * MiB;
constexpr size_t WS_MIX = 599 * MiB;
constexpr size_t WS_QR = 939 * MiB;
constexpr size_t WS_RWK = 939 * MiB;
constexpr size_t WS_KA = 971 * MiB;
constexpr size_t WS_VT = 980 * MiB;
constexpr size_t WS_ATT = 990 * MiB;
constexpr size_t WS_SLOT_GATE = 276 * MiB;
constexpr size_t WS_TOKK = 280 * MiB;
constexpr size_t WS_H = 281 * MiB;
constexpr int MAXTILES = 544, MAXSLOT = MAXTILES * 256;
constexpr size_t WS_YBUF = 553 * MiB;
constexpr size_t WS_END = 1024 * MiB;
static_assert(WS_YBUF + (size_t)MAXSLOT * 1024 * 2 <= WS_QR, "ws map");
static_assert(WS_H + (size_t)MAXSLOT * 1024 * 2 <= WS_YBUF, "ws map");
static_assert(WS_Z + (size_t)ROWS * ZP * 2 <= WS_FEAT, "ws map");
static_assert(WS_FEAT + 10 * FEAT_STRIDE <= WS_QR, "ws map");
static_assert(WS_ATT + (size_t)T * 512 * 2 <= WS_END, "ws map");
static_assert(WS_VT + 9 * MiB <= WS_ATT && WS_KA + (size_t)ROWS * 128 * 2 <= WS_VT, "ws map");
enum { F_R = 0, F_V, F_A, F_KF, F_KB, F_BF, F_BB, F_WF, F_WB, F_G };
constexpr int CW_BAR = 4096;
constexpr int CW_CNT = 8192;
constexpr int CW_QATT = 8320, CW_QTR = 8384;
constexpr int CW_MOD = 16384;
static_assert((CW_MOD + 9 * 6144) * 4 <= (int)CTL_BYTES, "ctl");

constexpr int RING_BYTES = 131072;
constexpr int MISC_OFF = RING_BYTES + 320;
constexpr int LDS_BYTES = 147456;

#define LDS_WAIT() asm volatile("s_waitcnt lgkmcnt(0)" ::: "memory")
#define VM_WAIT() asm volatile("s_waitcnt vmcnt(0)" ::: "memory")
__device__ __forceinline__ float bf2f(unsigned b) { return __uint_as_float(b << 16); }
__device__ __forceinline__ unsigned f2bf(float f) { unsigned u = __float_as_uint(f); return (u + 0x7fffu + ((u >> 16) & 1u)) >> 16; }
__device__ __forceinline__ unsigned pk2(float lo, float hi) { return f2bf(lo) | (f2bf(hi) << 16); }
__device__ __forceinline__ float lo16(unsigned w) { return __uint_as_float(w << 16); }
__device__ __forceinline__ float hi16(unsigned w) { return __uint_as_float(w & 0xffff0000u); }
__device__ __forceinline__ float sigmoidf_(float x) { return __builtin_amdgcn_rcpf(1.0f + __expf(-x)); }
__device__ __forceinline__ float wave_sum(float v) {
#pragma unroll
    for (int o = 1; o < 64; o <<= 1) v += __shfl_xor(v, o);
    return v;
}

#define XB_TMO      128
#define XB_XCNT(j)  (256  + 64 * (j))
#define XB_XSUB(j)  (1280 + 64 * (j))
#define XB_XGEN(j)  (2304 + 64 * (j))
#define XB_TOP      3328
#define XB_TOPGEN   3392
#define XCD_BAR_WORDS 3456
#define XB_SPIN_CAP (1u << 22)
__device__ __forceinline__ unsigned xb_ld(unsigned* p)              { return __hip_atomic_load(p, __ATOMIC_RELAXED, __HIP_MEMORY_SCOPE_AGENT); }
__device__ __forceinline__ unsigned xb_add(unsigned* p, unsigned v) { return __hip_atomic_fetch_add(p, v, __ATOMIC_RELAXED, __HIP_MEMORY_SCOPE_AGENT); }
__device__ __forceinline__ unsigned xb_xcc_id() { return (unsigned)__builtin_amdgcn_s_getreg((3 << 11) | 20) & 0xFu; }
#define XB_SPIN(cond, bar) do { unsigned _sp = 0; while (cond) { __builtin_amdgcn_s_sleep(1); \
    if ((++_sp & 255u) == 0u) { if (xb_ld(&(bar)[XB_TMO])) break; if (_sp > XB_SPIN_CAP) { atomicAdd(&(bar)[XB_TMO], 1u); break; } } } } while (0)
struct XcdBarrier { unsigned* bar; unsigned x; volatile LAS unsigned* st; };
__device__ __forceinline__ XcdBarrier xcd_barrier_post(unsigned* bar, volatile LAS unsigned* st) {
    XcdBarrier b; b.bar = bar; b.x = xb_xcc_id(); b.st = st;
    if (threadIdx.x == 0) (void)xb_add(&bar[XB_XCNT(b.x)], 1u);
    return b;
}
__device__ __forceinline__ void xcd_barrier_complete(unsigned* bar, unsigned x, unsigned& nloc, unsigned& nx) {
    const unsigned G = gridDim.x * gridDim.y * gridDim.z;
    unsigned sum, cnt, mine, sp = 0u;
    for (;;) {
        sum = 0u; cnt = 0u; mine = 0u;
#pragma unroll
        for (unsigned j = 0; j < 16; ++j) { const unsigned c = xb_ld(&bar[XB_XCNT(j)]); sum += c; cnt += (c > 0u) ? 1u : 0u; mine = (j == x) ? c : mine; }
        if (sum == G) break;
        __builtin_amdgcn_s_sleep(1);
        if ((++sp & 255u) == 0u) { if (xb_ld(&bar[XB_TMO])) break; if (sp > XB_SPIN_CAP) { atomicAdd(&bar[XB_TMO], 1u); break; } }
    }
    nloc = mine > 0u ? mine : 1u; nx = cnt > 0u ? cnt : 1u;
}
__device__ __forceinline__ void xcd_barrier(const XcdBarrier& b) {
    asm volatile("s_waitcnt vmcnt(0)" ::: "memory");
    __syncthreads();
    if (threadIdx.x == 0) {
        unsigned* bar = b.bar;
        __builtin_amdgcn_s_waitcnt(0);
        unsigned nloc = b.st[0], nx = b.st[1];
        if (nloc == 0u) { xcd_barrier_complete(bar, b.x, nloc, nx); b.st[0] = nloc; b.st[1] = nx; }
        const unsigned old = xb_add(&bar[XB_XSUB(b.x)], 1u);
        const unsigned gen = old / nloc;
        if (old + 1u == (gen + 1u) * nloc) {
            __builtin_amdgcn_fence(__ATOMIC_RELEASE, "agent");
            asm volatile("s_waitcnt vmcnt(0)" ::: "memory");
            const unsigned og = xb_add(&bar[XB_TOP], 1u);
            const unsigned tg = og / nx;
            if (og + 1u == (tg + 1u) * nx) xb_add(&bar[XB_TOPGEN], 1u);
            else XB_SPIN(xb_ld(&bar[XB_TOPGEN]) == tg, bar);
            __builtin_amdgcn_fence(__ATOMIC_ACQUIRE, "agent");
            xb_add(&bar[XB_XGEN(b.x)], 1u);
            asm volatile("s_waitcnt vmcnt(0)" ::: "memory");
        } else {
            XB_SPIN(xb_ld(&bar[XB_XGEN(b.x)]) == gen, bar);
            __builtin_amdgcn_fence(__ATOMIC_ACQUIRE, "agent");
            asm volatile("s_waitcnt vmcnt(0)" ::: "memory");
        }
    }
    __syncthreads();
}

namespace pg8 {
constexpr int BM = 256, BK = 64, HALF = 128, HTB = HALF * BK * 2, STAGE_BYTES = 8 * HTB;
__host__ __device__ __forceinline__ int lds_byte(int r, int c) { const int st = (r >> 4) * 2 + (c >> 5), rr = r & 15, cc = c & 31, ob = rr * 64 + cc * 2; return st * 1024 + (ob ^ (((ob >> 9) & 1) << 5)); }
__host__ __device__ __forceinline__ void stage_rc(int b, int& R, int& C) { const int st = b / 1024, sb = b % 1024, swz = sb ^ (((sb >> 9) & 1) << 5); R = (st >> 1) * 16 + swz / 64; C = (st & 1) * 32 + (swz % 64) / 2; }
__host__ __device__ __forceinline__ int perm32(int rho) { const int n = rho >> 4, i = rho & 15; return 8 * (i >> 2) + 4 * n + (i & 3); }

struct GUnit { const char* B; int pm, pn, e, lrow0; };

typedef int i32x8 __attribute__((ext_vector_type(8)));
template <int K, class Epi, class Sched, bool F8 = false>
__device__ __forceinline__ void gemm_phase(LAS unsigned char* lds, const char* Aroot, const Sched& S, const Epi& E) {
    const int tid = threadIdx.x, wid = __builtin_amdgcn_readfirstlane(tid >> 6), lane = tid & 63, wr = wid >> 2, wc = wid & 3, fr = lane & 15, fq = lane >> 4;
    constexpr int EB = F8 ? 1 : 2;
    constexpr int nt = K * EB / (BK * 2);
    int Rr[2], Cc[2]; unsigned voffB[2];
#pragma unroll
    for (int i = 0; i < 2; ++i) { int R, C; stage_rc(tid * 16 + i * 8192, R, C); const int Rb = Epi::PERM ? ((R & ~31) + perm32(R & 31)) : R;
        Rr[i] = R; Cc[i] = C; voffB[i] = (unsigned)(Rb * K * EB + C * 2); }
    constexpr size_t kstep = (size_t)(BK * 2);
    constexpr size_t hstep = (size_t)HALF * K * EB;
    const unsigned ldsw = (unsigned)wid * 1024u;
    const int aoff = lds_byte(wr * 64 + fr, fq * 8), boff = lds_byte(wc * 32 + fr, fq * 8);
#define PG8_SA(b, h) (((b) * 2 + (h)) * HTB)
#define PG8_SB(b, h) ((4 + (b) * 2 + (h)) * HTB)
#define PG8_STAGEB(bufoff, gbase) do { _Pragma("unroll") for (int _i = 0; _i < 2; ++_i) \
        __builtin_amdgcn_global_load_lds((const unsigned*)((const char*)(gbase) + voffB[_i]), (LAS unsigned*)(lds + (bufoff) + ldsw + _i * 8192), 16, 0, 0); } while (0)
#define PG8_STAGEA(bufoff, base, o0, o1, kb) do { \
        __builtin_amdgcn_global_load_lds((const unsigned*)((base) + (size_t)(kb) + (size_t)(o0)), (LAS unsigned*)(lds + (bufoff) + ldsw), 16, 0, 0); \
        __builtin_amdgcn_global_load_lds((const unsigned*)((base) + (size_t)(kb) + (size_t)(o1)), (LAS unsigned*)(lds + (bufoff) + ldsw + 8192), 16, 0, 0); } while (0)
#define PG8_LD8(dst, off) do { const u32x4 _p0 = *(const LAS u32x4*)(lds + (off)), _p1 = *(const LAS u32x4*)(lds + (off) + 1024); dst = (i32x8){(int)_p0.x, (int)_p0.y, (int)_p0.z, (int)_p0.w, (int)_p1.x, (int)_p1.y, (int)_p1.z, (int)_p1.w}; } while (0)
#define PG8_LDA(dst, b, h) do { if constexpr (F8) { _Pragma("unroll") for (int m = 0; m < 4; ++m) PG8_LD8(dst##8[m], PG8_SA(b, h) + aoff + m * 2048); } \
        else { _Pragma("unroll") for (int m = 0; m < 4; ++m) _Pragma("unroll") for (int k = 0; k < 2; ++k) dst[m][k] = *(const LAS bf16x8*)(lds + PG8_SA(b, h) + aoff + m * 2048 + k * 1024); } } while (0)
#define PG8_LDB(dst, b, h) do { if constexpr (F8) { _Pragma("unroll") for (int n = 0; n < 2; ++n) PG8_LD8(dst##8[n], PG8_SB(b, h) + boff + n * 2048); } \
        else { _Pragma("unroll") for (int n = 0; n < 2; ++n) _Pragma("unroll") for (int k = 0; k < 2; ++k) dst[n][k] = *(const LAS bf16x8*)(lds + PG8_SB(b, h) + boff + n * 2048 + k * 1024); } } while (0)
#define PG8_MMA(ai, bj, At, Bt) do { __builtin_amdgcn_s_setprio(1); _Pragma("unroll") for (int m = 0; m < 4; ++m) _Pragma("unroll") for (int n = 0; n < 2; ++n) { \
        if constexpr (F8) asm volatile("v_mfma_scale_f32_16x16x128_f8f6f4 %0, %1, %2, %0, %3, %3 op_sel_hi:[0,0,0]" : "+v"(acc[ai][bj][m][n]) : "v"(Bt##8[n]), "v"(At##8[m]), "v"(f8scale)); \
        else { _Pragma("unroll") for (int k = 0; k < 2; ++k) acc[ai][bj][m][n] = __builtin_amdgcn_mfma_f32_16x16x32_bf16(Bt[n][k], At[m][k], acc[ai][bj][m][n], 0, 0, 0); } } \
        __builtin_amdgcn_s_setprio(0); } while (0)
#define PG8_WAIT_V(n) asm volatile("s_waitcnt vmcnt(" #n ")" ::: "memory")
#define PG8_WAIT_L(n) asm volatile("s_waitcnt lgkmcnt(" #n ")" ::: "memory")
#define PG8_BAR __builtin_amdgcn_s_barrier()
#define PG8_SCHED __builtin_amdgcn_sched_barrier(0)
    GUnit cur, nxt; int ui = 0;
    if (!S.next(0, cur)) return;
    f32x4 acc[2][2][4][2];
#pragma unroll
    for (int a = 0; a < 2; ++a)
#pragma unroll
        for (int b = 0; b < 2; ++b)
#pragma unroll
            for (int m = 0; m < 4; ++m)
#pragma unroll
                for (int n = 0; n < 2; ++n) acc[a][b][m][n] = (f32x4){0.f, 0.f, 0.f, 0.f};
    bf16x8 At[4][2], B0[2][2], B1[2][2];
    const int f8scale = 0x7f7f7f7f;
    i32x8 At8[4], B08[2], B18[2];
    unsigned c00, c01, c10, c11;
    const char* cA = Aroot;
    if constexpr (Sched::GATHER) {
        c00 = S.arow(cur, Rr[0]) * (unsigned)(K * EB) + (unsigned)Cc[0] * 2u; c01 = S.arow(cur, Rr[1]) * (unsigned)(K * EB) + (unsigned)Cc[1] * 2u;
        c10 = S.arow(cur, HALF + Rr[0]) * (unsigned)(K * EB) + (unsigned)Cc[0] * 2u; c11 = S.arow(cur, HALF + Rr[1]) * (unsigned)(K * EB) + (unsigned)Cc[1] * 2u;
    } else {
        c00 = (unsigned)(Rr[0] * K * EB + Cc[0] * 2); c01 = (unsigned)(Rr[1] * K * EB + Cc[1] * 2); c10 = c00 + (unsigned)(HALF * K * EB); c11 = c01 + (unsigned)(HALF * K * EB);
        cA = Aroot + (size_t)S.arow(cur, 0) * (size_t)(K * EB);
    }
    const char* cB = cur.B;
    PG8_STAGEB(PG8_SB(0, 0), cB); PG8_STAGEA(PG8_SA(0, 0), cA, c00, c01, 0); PG8_STAGEB(PG8_SB(0, 1), cB + hstep); PG8_STAGEA(PG8_SA(0, 1), cA, c10, c11, 0);
    if (wr == 1) PG8_BAR;
    PG8_WAIT_V(4); PG8_BAR;
    PG8_STAGEB(PG8_SB(1, 0), cB + kstep); PG8_STAGEA(PG8_SA(1, 0), cA, c00, c01, kstep); PG8_STAGEB(PG8_SB(1, 1), cB + hstep + kstep);
    PG8_WAIT_V(6); PG8_BAR;
    for (;;) {
        const bool has_next = S.next(ui + 1, nxt);
        unsigned n00 = c00, n01 = c01, n10 = c10, n11 = c11; const char* nB = cB; const char* nA = cA;
        LAS u32x4* noff_lds = (LAS u32x4*)(lds + STAGE_BYTES + 2048) + tid;
        if (has_next) {
            if constexpr (Sched::GATHER) {
                int tz = tid; asm volatile("" : "+v"(tz));
                int R0, C0, R1, C1; stage_rc(tz * 16, R0, C0); stage_rc(tz * 16 + 8192, R1, C1);
                u32x4 nn;
                nn.x = S.arow(nxt, R0) * (unsigned)(K * EB) + (unsigned)C0 * 2u; nn.y = S.arow(nxt, R1) * (unsigned)(K * EB) + (unsigned)C1 * 2u;
                nn.z = S.arow(nxt, HALF + R0) * (unsigned)(K * EB) + (unsigned)C0 * 2u; nn.w = S.arow(nxt, HALF + R1) * (unsigned)(K * EB) + (unsigned)C1 * 2u;
                *((LAS u32x4*)(lds + STAGE_BYTES + 2048) + tz) = nn;
            } else nA = Aroot + (size_t)S.arow(nxt, 0) * (size_t)(K * EB);
            nB = nxt.B;
        } else if constexpr (Sched::GATHER) { *noff_lds = (u32x4){c00, c01, c10, c11}; }
        for (int t = 0; t < nt; t += 2) {
            const bool last = (t == nt - 2);
            const size_t k1 = (size_t)(t + 1) * kstep;
            const size_t k2 = last ? 0 : (size_t)(t + 2) * kstep, k3 = k2 + kstep;
            if constexpr (Sched::GATHER) { if (last) { const u32x4 nn = *noff_lds; n00 = nn.x; n01 = nn.y; n10 = nn.z; n11 = nn.w; } }
            const unsigned a00 = last ? n00 : c00, a01 = last ? n01 : c01, a10 = last ? n10 : c10, a11 = last ? n11 : c11; const char* a2 = last ? nA : cA;
            const char* b2 = last ? nB : cB + (size_t)(t + 2) * kstep; const char* b3 = b2 + kstep;
            PG8_LDB(B0, 0, 0); PG8_SCHED; PG8_LDA(At, 0, 0); PG8_STAGEA(PG8_SA(1, 1), cA, c10, c11, k1);
            PG8_WAIT_L(8); PG8_BAR; PG8_WAIT_L(0); PG8_MMA(0, 0, At, B0); PG8_BAR; PG8_SCHED;
            PG8_LDB(B1, 0, 1); PG8_STAGEB(PG8_SB(0, 0), b2);
            PG8_BAR; PG8_WAIT_L(0); PG8_MMA(0, 1, At, B1); PG8_BAR;
            PG8_LDA(At, 0, 1); PG8_STAGEA(PG8_SA(0, 0), a2, a00, a01, k2);
            PG8_BAR; PG8_WAIT_L(0); PG8_MMA(1, 0, At, B0); PG8_BAR; PG8_SCHED;
            PG8_STAGEB(PG8_SB(0, 1), b2 + hstep);
            PG8_WAIT_V(6); PG8_BAR; PG8_MMA(1, 1, At, B1); PG8_BAR;
            PG8_LDB(B0, 1, 0); PG8_SCHED; PG8_LDA(At, 1, 0); PG8_STAGEA(PG8_SA(0, 1), a2, a10, a11, k2);
            PG8_WAIT_L(8); PG8_BAR; PG8_WAIT_L(0); PG8_MMA(0, 0, At, B0); PG8_BAR; PG8_SCHED;
            PG8_LDB(B1, 1, 1); PG8_STAGEB(PG8_SB(1, 0), b3);
            PG8_BAR; PG8_WAIT_L(0); PG8_MMA(0, 1, At, B1); PG8_BAR;
            PG8_LDA(At, 1, 1); PG8_STAGEA(PG8_SA(1, 0), a2, a00, a01, k3);
            PG8_BAR; PG8_WAIT_L(0); PG8_MMA(1, 0, At, B0); PG8_BAR; PG8_SCHED;
            PG8_STAGEB(PG8_SB(1, 1), b3 + hstep);
            PG8_WAIT_V(6); PG8_BAR; PG8_MMA(1, 1, At, B1); PG8_BAR;
        }
        if constexpr (F8) asm volatile("s_nop 15\n\ts_nop 15" ::: "memory");
        E(acc, cur, wr, wc, fr, fq);
        if (!has_next) break;
#pragma unroll
        for (int a = 0; a < 2; ++a)
#pragma unroll
            for (int b = 0; b < 2; ++b)
#pragma unroll
                for (int m = 0; m < 4; ++m)
#pragma unroll
                    for (int n = 0; n < 2; ++n) acc[a][b][m][n] = (f32x4){0.f, 0.f, 0.f, 0.f};
        cur = nxt; cB = nB; cA = nA; c00 = n00; c01 = n01; c10 = n10; c11 = n11; ++ui;
    }
    PG8_WAIT_V(0);
    if (wr == 0) PG8_BAR;
    PG8_BAR;
#undef PG8_SA
#undef PG8_SB
#undef PG8_STAGEA
#undef PG8_STAGEB
#undef PG8_LDA
#undef PG8_LDB
#undef PG8_MMA
#undef PG8_LD8
#undef PG8_WAIT_V
#undef PG8_WAIT_L
#undef PG8_BAR
#undef PG8_SCHED
}
}
using pg8::GUnit;

struct Args { const float* in[38]; float* out; unsigned char* ws; int ph_lo, ph_hi, bar_region, pad; };
enum { I_X = 0, I_C, I_CTX, I_CCTX, I_WADA, I_BADA, I_GPREMIX, I_GPOSTMIX, I_GPREFFN, I_GPOSTFFN, I_WIN, I_BIN, I_MUP, I_MUN, I_SINKS, I_W0F, I_W0B, I_W2F, I_W2B,
       I_A0F, I_A0B, I_A2F, I_A2B, I_G2, I_KK, I_KA, I_RK, I_LNW, I_LNB, I_WUPA, I_WUPR, I_WOUT, I_WROUTER, I_BROUTER, I_WGU, I_BGU, I_WDN, I_BDN };

__device__ __forceinline__ unsigned pk4_fp8(float a, float b, float c, float d) { int w = 0; w = __builtin_amdgcn_cvt_pk_fp8_f32(a, b, w, false); w = __builtin_amdgcn_cvt_pk_fp8_f32(c, d, w, true); return (unsigned)w; }
typedef float f32x2_t __attribute__((ext_vector_type(2)));
typedef __bf16 bf16x2_t __attribute__((ext_vector_type(2)));
__device__ __forceinline__ unsigned cvt_pk_bf16_asm(float lo, float hi) { unsigned r; asm volatile("v_cvt_pk_bf16_f32 %0, %1, %2" : "=v"(r) : "v"(lo), "v"(hi)); return r; }
__device__ __forceinline__ unsigned cvt_pk_bf16(float lo, float hi) { const f32x2_t v = {lo, hi}; const bf16x2_t b = __builtin_convertvector(v, bf16x2_t); return __builtin_bit_cast(unsigned, b); }

__device__ __forceinline__ void tile_order(int L, int nM, int nN, int& pm, int& pn) {
    const int nwg = nM * nN; int wgid = L;
    { const int q = nwg / 8, r = nwg % 8, xcd = wgid % 8, off = wgid / 8; wgid = (xcd < r ? xcd * (q + 1) : r * (q + 1) + (xcd - r) * q) + off; }
    const int nig = 8 * nN, gid = wgid / nig, fm = gid * 8, gsz = (nM - fm) < 8 ? (nM - fm) : 8;
    pm = fm + ((wgid % nig) % gsz); pn = (wgid % nig) / gsz;
}

struct SchedProj {           static constexpr bool GATHER = false;
    const char* Bt; int G, c;
    __device__ __forceinline__ bool next(int i, GUnit& u) const {
        const int L = i * G + c; constexpr int NXU = 128 * NTILE_N;
        if (L >= NXU + 72) return false;
        int pm, pn;
        if (L < NXU) tile_order(L, 128, NTILE_N, pm, pn); else { const int l2 = L - NXU; pm = 128 + l2 / 9; pn = 2 + l2 % 9; }
        u.pm = pm; u.pn = pn; u.e = 0; u.lrow0 = 0; u.B = Bt + (size_t)pn * 256 * D * 2; return true;
    }
    __device__ __forceinline__ unsigned arow(const GUnit& u, int r) const { return (unsigned)(u.pm * 256 + r); }
};
template <int K> struct SchedDense {
    static constexpr bool GATHER = false;
    const char* Bt; int G, c;
    __device__ __forceinline__ bool next(int i, GUnit& u) const {
        const int L = i * G + c; if (L >= 128 * 4) return false;
        int pm, pn; tile_order(L, 128, 4, pm, pn);
        u.pm = pm; u.pn = pn; u.e = 0; u.lrow0 = 0; u.B = Bt + (size_t)pn * 256 * K * 2; return true;
    }
    __device__ __forceinline__ unsigned arow(const GUnit& u, int r) const { return (unsigned)(u.pm * 256 + r); }
};
template <int NPN, bool GATHER_, int EB = 2> struct SchedMoe {
    static constexpr bool GATHER = GATHER_;
    const char* Bt; int G, c; const LAS int* tstart; const int* cnt; const int* slot_tok;
    __device__ __forceinline__ bool next(int i, GUnit& u) const {
        const int L = i * G + c; const int TT = __builtin_amdgcn_readfirstlane(tstart[NE]);
        if (L >= TT * NPN) return false;
        const int rt = L / NPN, pn = L % NPN; int e = 0;
#pragma unroll
        for (int j = 1; j < NE; ++j) e += (tstart[j] <= rt) ? 1 : 0;
        e = __builtin_amdgcn_readfirstlane(e);
        u.pm = rt; u.pn = pn; u.e = e; u.lrow0 = __builtin_amdgcn_readfirstlane((rt - tstart[e]) * 256);
        u.B = Bt + ((size_t)e * (NPN * 256) + (size_t)pn * 256) * DE * EB; return true;
    }
    __device__ __forceinline__ unsigned arow(const GUnit& u, int r) const {
        if (GATHER) { const int lr = u.lrow0 + r; const int n = cnt[u.e]; return (lr < n) ? (unsigned)slot_tok[u.e * T + lr] : 0u; }
        return (unsigned)(u.pm * 256 + r);
    }
};

struct EpiZ {
    static constexpr bool PERM = true;
    bf16_t* Z; const float* bias;
    __device__ __forceinline__ void operator()(const f32x4 (&acc)[2][2][4][2], const GUnit& u, int wr, int wc, int fr, int fq) const {
        const int row0 = u.pm * 256 + wr * 64 + fr, col0 = u.pn * 256 + wc * 32 + 8 * fq;
        f32x4 bv[2][2];
#pragma unroll
        for (int bj = 0; bj < 2; ++bj)
#pragma unroll
            for (int n = 0; n < 2; ++n) bv[bj][n] = *(const f32x4*)(bias + col0 + bj * 128 + 4 * n);
#pragma unroll
        for (int ai = 0; ai < 2; ++ai)
#pragma unroll
            for (int m = 0; m < 4; ++m) { bf16_t* rowp = Z + (size_t)(row0 + ai * 128 + m * 16) * ZP + col0;
#pragma unroll
                for (int bj = 0; bj < 2; ++bj) { const f32x4 v0 = acc[ai][bj][m][0] + bv[bj][0], v1 = acc[ai][bj][m][1] + bv[bj][1];
                    u32x4 w; w.x = cvt_pk_bf16(v0[0], v0[1]); w.y = cvt_pk_bf16(v0[2], v0[3]); w.z = cvt_pk_bf16(v1[0], v1[1]); w.w = cvt_pk_bf16(v1[2], v1[3]);
                    *(u32x4*)(rowp + bj * 128) = w; } }
    }
};
template <bool SECOND> struct EpiUp {
    static constexpr bool PERM = true;
    bf16_t* O; const bf16_t* Z;
    __device__ __forceinline__ void operator()(const f32x4 (&acc)[2][2][4][2], const GUnit& u, int wr, int wc, int fr, int fq) const {
        const int row0 = u.pm * 256 + wr * 64 + fr, col0 = u.pn * 256 + wc * 32 + 8 * fq;
#pragma unroll
        for (int ai = 0; ai < 2; ++ai)
#pragma unroll
            for (int m = 0; m < 4; ++m) { const size_t row = (size_t)(row0 + ai * 128 + m * 16);
#pragma unroll
                for (int bj = 0; bj < 2; ++bj) {
                    const u32x4 g = *(const u32x4*)(Z + row * ZP + ZC_G + (SECOND ? 1024 : 0) + col0 + bj * 128);
                    const f32x4 a0 = acc[ai][bj][m][0], a1 = acc[ai][bj][m][1];
                    float o[8];
                    o[0] = sigmoidf_(lo16(g.x)) * a0[0]; o[1] = sigmoidf_(hi16(g.x)) * a0[1]; o[2] = sigmoidf_(lo16(g.y)) * a0[2]; o[3] = sigmoidf_(hi16(g.y)) * a0[3];
                    o[4] = sigmoidf_(lo16(g.z)) * a1[0]; o[5] = sigmoidf_(hi16(g.z)) * a1[1]; o[6] = sigmoidf_(lo16(g.w)) * a1[2]; o[7] = sigmoidf_(hi16(g.w)) * a1[3];
                    bf16_t* op = O + row * 1024 + col0 + bj * 128;
                    if (SECOND) { const u32x4 p = *(const u32x4*)op;
                        o[0] += lo16(p.x); o[1] += hi16(p.x); o[2] += lo16(p.y); o[3] += hi16(p.y); o[4] += lo16(p.z); o[5] += hi16(p.z); o[6] += lo16(p.w); o[7] += hi16(p.w); }
                    u32x4 w; w.x = cvt_pk_bf16(o[0], o[1]); w.y = cvt_pk_bf16(o[2], o[3]); w.z = cvt_pk_bf16(o[4], o[5]); w.w = cvt_pk_bf16(o[6], o[7]);
                    *(u32x4*)op = w; } }
    }
};
struct EpiMix {
    static constexpr bool PERM = false;
    float* C;
    __device__ __forceinline__ void operator()(const f32x4 (&acc)[2][2][4][2], const GUnit& u, int wr, int wc, int fr, int fq) const {
        const int row0 = u.pm * 256 + wr * 64 + fr, col0 = u.pn * 256 + wc * 32 + 4 * fq;
#pragma unroll
        for (int ai = 0; ai < 2; ++ai)
#pragma unroll
            for (int m = 0; m < 4; ++m) { float* rowp = C + (size_t)(row0 + ai * 128 + m * 16) * 1024 + col0;
#pragma unroll
                for (int bj = 0; bj < 2; ++bj)
#pragma unroll
                    for (int n = 0; n < 2; ++n) *(f32x4*)(rowp + bj * 128 + n * 16) = acc[ai][bj][m][n]; }
    }
};
__device__ __forceinline__ float swiglu1(float g, float up) {
    g = fminf(g, 7.0f); up = fminf(fmaxf(up, -7.0f), 7.0f);
    return (up + 1.0f) * (g * sigmoidf_(1.702f * g));
}
struct EpiMoe1 {
    static constexpr bool PERM = true;
    bf16_t* H; const float* bgu;
    __device__ __forceinline__ void operator()(const f32x4 (&acc)[2][2][4][2], const GUnit& u, int wr, int wc, int fr, int fq) const {
        const int row0 = u.pm * 256 + wr * 64 + fr, col0 = u.pn * 256 + wc * 32 + 8 * fq;
        const float* b = bgu + (size_t)u.e * 2048 + col0;
        constexpr float sc = 1.0f / (F8_WSCALE * F8_ASCALE);
#pragma unroll
        for (int bj = 0; bj < 2; ++bj) {
            const f32x4 b0 = *(const f32x4*)(b + bj * 128), b1 = *(const f32x4*)(b + bj * 128 + 4);
#pragma unroll
            for (int ai = 0; ai < 2; ++ai)
#pragma unroll
                for (int m = 0; m < 4; ++m) {
                    const f32x4 v0 = acc[ai][bj][m][0] * sc + b0, v1 = acc[ai][bj][m][1] * sc + b1;
                    *(unsigned*)((unsigned char*)H + (size_t)(row0 + ai * 128 + m * 16) * 1024 + (col0 >> 1) + bj * 64) =
                        pk4_fp8(swiglu1(v0[0], v0[1]) * F8_HSCALE, swiglu1(v0[2], v0[3]) * F8_HSCALE, swiglu1(v1[0], v1[1]) * F8_HSCALE, swiglu1(v1[2], v1[3]) * F8_HSCALE);
                }
        }
    }
};
struct EpiMoe2 {
    static constexpr bool PERM = true;
    bf16_t* Y; const float* bdn; const float* slot_gate; const int* cnt;
    __device__ __forceinline__ void operator()(const f32x4 (&acc)[2][2][4][2], const GUnit& u, int wr, int wc, int fr, int fq) const {
        const int r0 = wr * 64 + fr, col0 = u.pn * 256 + wc * 32 + 8 * fq;
        const float* b = bdn + (size_t)u.e * 1024 + col0; const int n_e = cnt[u.e];
        f32x4 bv[2][2];
#pragma unroll
        for (int bj = 0; bj < 2; ++bj)
#pragma unroll
            for (int n = 0; n < 2; ++n) bv[bj][n] = *(const f32x4*)(b + bj * 128 + 4 * n);
#pragma unroll
        for (int ai = 0; ai < 2; ++ai)
#pragma unroll
            for (int m = 0; m < 4; ++m) { const int r = r0 + ai * 128 + m * 16; const int lr = u.lrow0 + r;
                const float gt = (lr < n_e) ? slot_gate[(size_t)u.e * T + lr] : 0.0f;
                bf16_t* rowp = Y + (size_t)(u.pm * 256 + r) * 1024 + col0;
#pragma unroll
                for (int bj = 0; bj < 2; ++bj) { const f32x4 v0 = (acc[ai][bj][m][0] * (1.0f / (F8_WSCALE * F8_HSCALE)) + bv[bj][0]) * gt, v1 = (acc[ai][bj][m][1] * (1.0f / (F8_WSCALE * F8_HSCALE)) + bv[bj][1]) * gt;
                    u32x4 w; w.x = cvt_pk_bf16(v0[0], v0[1]); w.y = cvt_pk_bf16(v0[2], v0[3]); w.z = cvt_pk_bf16(v1[0], v1[1]); w.w = cvt_pk_bf16(v1[2], v1[3]);
                    *(u32x4*)(rowp + bj * 128) = w; } }
    }
};

__device__ __forceinline__ void p0_transpose_item(const float* W, int K, int N, bf16_t* WT, int row_off, LAS float* scr, int item, int lane) {
    const int nblk = N / 32, kb = item / nblk, nb = item % nblk, k0 = 64 * kb, n0 = 32 * nb;
#pragma unroll 8
    for (int i = 0; i < 32; ++i) { const int kk = 2 * i + (lane >> 5); scr[kk * 33 + (lane & 31)] = W[(size_t)(k0 + kk) * N + n0 + (lane & 31)]; }
    LDS_WAIT(); asm volatile("" ::: "memory");
    const int c = lane & 7;
#pragma unroll
    for (int j = 0; j < 4; ++j) { const int n = (lane >> 3) + 8 * j; const LAS float* s = scr + (8 * c) * 33 + n;
        u32x4 o; o.x = pk2(s[0 * 33], s[1 * 33]); o.y = pk2(s[2 * 33], s[3 * 33]); o.z = pk2(s[4 * 33], s[5 * 33]); o.w = pk2(s[6 * 33], s[7 * 33]);
        *(u32x4*)(WT + (size_t)(row_off + n0 + n) * K + k0 + 8 * c) = o; }
    LDS_WAIT(); asm volatile("" ::: "memory");
}
__device__ __forceinline__ void p0_prologue(const Args& a, LAS unsigned char* lds, int tid, int lane, int wave, int G) {
    unsigned char* ws = a.ws;
    {
        float* MOD = (float*)(ws + WS_CTL) + CW_MOD;
        LAS float* sl = (LAS float*)lds;
        LAS float* red = sl + 9 * 1024;
        if (blockIdx.x < 96) {
            for (int i = tid; i < 9 * 1024; i += 512) { const int r = i >> 10, k = i & 1023; const float v = (r < 8) ? a.in[I_C][r * D + k] : a.in[I_CCTX][k]; sl[i] = v * sigmoidf_(v); }
            __syncthreads();
            for (int it = blockIdx.x; it < 96; it += G) {
                const int n = it * 64 + lane; float acc[9];
#pragma unroll
                for (int r = 0; r < 9; ++r) acc[r] = 0.f;
                const float* w = a.in[I_WADA] + (size_t)(wave * 128) * 6144 + n;
#pragma unroll 8
                for (int kk = 0; kk < 128; ++kk) { const float wv = w[(size_t)kk * 6144];
#pragma unroll
                    for (int r = 0; r < 9; ++r) acc[r] += sl[r * 1024 + wave * 128 + kk] * wv; }
#pragma unroll
                for (int r = 0; r < 9; ++r) red[(wave * 9 + r) * 64 + lane] = acc[r];
                __syncthreads();
                for (int i = tid; i < 9 * 64; i += 512) { const int r = i >> 6, c = i & 63; float s = a.in[I_BADA][it * 64 + c];
#pragma unroll
                    for (int w8 = 0; w8 < 8; ++w8) s += red[(w8 * 9 + r) * 64 + c];
                    MOD[r * 6144 + it * 64 + c] = s; }
                __syncthreads();
            }
        }
        __syncthreads();
    }
    {
        float* misc = (float*)(ws + WS_MISC);
        const int gt = blockIdx.x * 512 + tid, NGT = G * 512;
        for (int n = gt; n < ZP; n += NGT) misc[n] = (n < 2688) ? a.in[I_BIN][n] : ((n < 2816) ? 0.f : a.in[I_BIN][n - 128]);
        for (int n = gt; n < 1024; n += NGT) { const int p = n >> 4, i = n & 15; const float inv = powf(10000.0f, -(float)i / 16.0f); float s, c; sincosf((float)p * inv, &s, &c); misc[ZP + n] = c; misc[ZP + 1024 + n] = s; }
        u32x4* zr = (u32x4*)((bf16_t*)(ws + WS_WIN) + (size_t)2688 * D);
        for (int n = gt; n < 128 * D / 8; n += NGT) zr[n] = (u32x4){0u, 0u, 0u, 0u};
    }
    {
        LAS float* scr = (LAS float*)(lds + wave * 8704);
        const int gw = blockIdx.x * 8 + wave, NGW = G * 8;
        constexpr int J_IN = 16 * (PROJ_SRC / 32), J_UP = 8 * 32, J_OUT = 16 * 32, J_L = 16, J_G2 = 32, J_GU1 = 16 * 64, J_DN1 = 16 * 32;
        constexpr int NITEMS = J_IN + 2 * J_UP + J_OUT + 4 * J_L + J_G2;
        bf16_t* lora = (bf16_t*)(ws + WS_LORA);
        for (int it = gw; it < NITEMS; it += NGW) {
            int r = it;
            if (r < J_IN) { const int nb = r % (PROJ_SRC / 32); p0_transpose_item(a.in[I_WIN], D, PROJ_SRC, (bf16_t*)(ws + WS_WIN), (nb * 32 >= 2688) ? 128 : 0, scr, r, lane); continue; } r -= J_IN;
            if (r < J_UP) { p0_transpose_item(a.in[I_WUPA], 512, D, (bf16_t*)(ws + WS_WUPA), 0, scr, r, lane); continue; } r -= J_UP;
            if (r < J_UP) { p0_transpose_item(a.in[I_WUPR], 512, D, (bf16_t*)(ws + WS_WUPR), 0, scr, r, lane); continue; } r -= J_UP;
            if (r < J_OUT) { p0_transpose_item(a.in[I_WOUT], D, D, (bf16_t*)(ws + WS_WOUT), 0, scr, r, lane); continue; } r -= J_OUT;
            if (r < J_L) { p0_transpose_item(a.in[I_W2F], 64, 512, lora, 0, scr, r, lane); continue; } r -= J_L;
            if (r < J_L) { p0_transpose_item(a.in[I_W2B], 64, 512, lora + 32768, 0, scr, r, lane); continue; } r -= J_L;
            if (r < J_L) { p0_transpose_item(a.in[I_A2F], 64, 512, lora + 2 * 32768, 0, scr, r, lane); continue; } r -= J_L;
            if (r < J_L) { p0_transpose_item(a.in[I_A2B], 64, 512, lora + 3 * 32768, 0, scr, r, lane); continue; } r -= J_L;
            p0_transpose_item(a.in[I_G2], 128, 512, lora + 4 * 32768, 0, scr, r, lane);
        }
    }
}

__device__ __forceinline__ void p0_transpose_item_f8(const float* W, int K, int N, unsigned char* WT, LAS float* scr, int item, int lane, float sc) {
    const int nblk = N / 32, kb = item / nblk, nb = item % nblk, k0 = 64 * kb, n0 = 32 * nb;
#pragma unroll 8
    for (int i = 0; i < 32; ++i) { const int kk = 2 * i + (lane >> 5); scr[kk * 33 + (lane & 31)] = W[(size_t)(k0 + kk) * N + n0 + (lane & 31)] * sc; }
    LDS_WAIT(); asm volatile("" ::: "memory");
    const int c = lane & 7;
#pragma unroll
    for (int j = 0; j < 4; ++j) { const int n = (lane >> 3) + 8 * j; const LAS float* s = scr + (8 * c) * 33 + n;
        u32x2 o; o.x = pk4_fp8(s[0 * 33], s[1 * 33], s[2 * 33], s[3 * 33]); o.y = pk4_fp8(s[4 * 33], s[5 * 33], s[6 * 33], s[7 * 33]);
        *(u32x2*)(WT + (size_t)(n0 + n) * K + k0 + 8 * c) = o; }
    LDS_WAIT(); asm volatile("" ::: "memory");
}
__device__ __forceinline__ int queue_pull(unsigned* q, LAS unsigned char* lds, int tid) {
    volatile LAS int* w = (volatile LAS int*)(lds + RING_BYTES + 256);
    __syncthreads();
    if (tid == 0) *w = (int)__hip_atomic_fetch_add(q, 1u, __ATOMIC_RELAXED, __HIP_MEMORY_SCOPE_AGENT);
    __syncthreads();
    return *w;
}
__device__ __forceinline__ void moe_weight_copies(const Args& a, LAS unsigned char* lds, int tid, int lane, int wave) {
    unsigned char* ws = a.ws;
    LAS float* scr = (LAS float*)(lds + wave * 8704);
    constexpr int J_GU1 = 16 * 64, J_DN1 = 16 * 32, NCHUNK = (NE * J_GU1 + NE * J_DN1) / 128;
    unsigned* q = (unsigned*)(ws + WS_CTL) + CW_QTR;
    for (;;) {
        const int ch = queue_pull(q, lds, tid);
        if (ch >= NCHUNK) break;
#pragma unroll 1
        for (int k = 0; k < 16; ++k) {
            int r = ch * 128 + wave * 16 + k;
            if (r < NE * J_GU1) { const int e = r / J_GU1; p0_transpose_item_f8(a.in[I_WGU] + (size_t)e * D * 2048, D, 2048, (unsigned char*)(ws + WS_WGU) + (size_t)e * 2048 * D, scr, r % J_GU1, lane, F8_WSCALE); }
            else { r -= NE * J_GU1; const int e = r / J_DN1; p0_transpose_item_f8(a.in[I_WDN] + (size_t)e * DE * D, DE, D, (unsigned char*)(ws + WS_WDN) + (size_t)e * D * DE, scr, r % J_DN1, lane, F8_WSCALE); }
        }
    }
}

__device__ __forceinline__ void p1_norm(const Args& a, int lane, int wave, int G) {
    const float* MOD = (const float*)(a.ws + WS_CTL) + CW_MOD;
    bf16_t* HX = (bf16_t*)(a.ws + WS_HX);
    const int gw = blockIdx.x * 8 + wave, NGW = G * 8;
    for (int m = gw; m < ROWS; m += NGW) {
        const float* xrow = (m < T) ? a.in[I_X] + (size_t)m * D : a.in[I_CTX] + (size_t)(m - T) * D;
        const int r = (m < T) ? (m >> 12) : 8;
        const f32x4* xr = (const f32x4*)xrow + lane;
        f32x4 v[4]; float s = 0.f;
#pragma unroll
        for (int j = 0; j < 4; ++j) { v[j] = xr[64 * j]; s += (v[j].x * v[j].x + v[j].y * v[j].y) + (v[j].z * v[j].z + v[j].w * v[j].w); }
        const float rstd = 1.0f / sqrtf(wave_sum(s) * (1.f / D) + RMS_EPS);
        unsigned long long* o8 = (unsigned long long*)(HX + (size_t)m * D) + lane;
#pragma unroll
        for (int j = 0; j < 4; ++j) {
            const f32x4 g = ((const f32x4*)a.in[I_GPREMIX])[64 * j + lane], sh = ((const f32x4*)(MOD + r * 6144))[64 * j + lane], sc = ((const f32x4*)(MOD + r * 6144 + 1024))[64 * j + lane];
            const f32x4 h = (v[j] * rstd * g) * (sc + 1.0f) + sh;
            o8[64 * j] = (unsigned long long)pk2(h.x, h.y) | ((unsigned long long)pk2(h.z, h.w) << 32);
        }
    }
}

constexpr size_t WS_ACT = WS_HX;
__device__ __forceinline__ void p3a_pointwise(const Args& a, int tid, int G) {
    unsigned char* ws = a.ws;
    const bf16_t* Z = (const bf16_t*)(ws + WS_Z);
    bf16_t* FB = (bf16_t*)(ws + WS_FEAT); bf16_t* ACT = (bf16_t*)(ws + WS_ACT);
    const float* rc = (const float*)(ws + WS_MISC) + ZP; const float* rs = rc + 1024;
    const int cv = tid % 240, rg = tid / 240;
    float mp[8], mn[8];
    if (tid < 480) {
#pragma unroll
        for (int j = 0; j < 8; ++j) { mp[j] = a.in[I_MUP][8 * cv + j]; mn[j] = a.in[I_MUN][8 * cv + j]; }
    }
    for (int unit = blockIdx.x; unit < ROWS / 16; unit += G) {
        const int row0 = unit * 16;
        const bool isx = row0 < T;
        const int slen = isx ? SEQ : CL;
        const int pos0 = isx ? (row0 & (SEQ - 1)) : ((row0 - T) & (CL - 1));
        if (tid < 480) {
            const int r0 = row0 + 8 * rg, p0 = pos0 + 8 * rg;
            const bf16_t* zp = Z + (size_t)r0 * ZP + ZC_R + 8 * cv;
            u32x4 prv = (u32x4){0u, 0u, 0u, 0u};
            if (p0 > 0) prv = *(const u32x4*)(zp - ZP);
            u32x4 cur = *(const u32x4*)zp;
#pragma unroll
            for (int i = 0; i < 8; ++i) {
                u32x4 nxt = (u32x4){0u, 0u, 0u, 0u};
                if (p0 + i < slen - 1) nxt = *(const u32x4*)(zp + (size_t)(i + 1) * ZP);
                float o[8];
#pragma unroll
                for (int j = 0; j < 4; ++j) {
                    const float c0 = lo16(cur[j]), c1 = hi16(cur[j]);
                    o[2 * j] = c0 + mp[2 * j] * (lo16(prv[j]) - c0) + mn[2 * j] * (lo16(nxt[j]) - c0);
                    o[2 * j + 1] = c1 + mp[2 * j + 1] * (hi16(prv[j]) - c1) + mn[2 * j + 1] * (hi16(nxt[j]) - c1);
                }
                bf16_t* op;
                if (cv < 64) op = FB + (size_t)F_R * (FEAT_STRIDE / 2) + (size_t)(r0 + i) * RD + 8 * cv;
                else if (cv < 128) op = FB + (size_t)F_A * (FEAT_STRIDE / 2) + (size_t)(r0 + i) * RD + 8 * (cv - 64);
                else if (cv < 192) op = FB + (size_t)F_V * (FEAT_STRIDE / 2) + (size_t)(r0 + i) * RD + 8 * (cv - 128);
                else {
                    op = ACT + (size_t)(r0 + i) * 384 + 8 * (cv - 192);
                    if (cv < 208) {
#pragma unroll
                        for (int j = 0; j < 8; ++j) o[j] = 1.0f - 2.0f * __builtin_amdgcn_rcpf(__expf(2.0f * o[j]) + 1.0f);
                    } else if (cv >= 224) {
#pragma unroll
                        for (int j = 0; j < 8; ++j) o[j] = sigmoidf_(o[j]);
                    }
                }
                u32x4 w; w.x = pk2(o[0], o[1]); w.y = pk2(o[2], o[3]); w.z = pk2(o[4], o[5]); w.w = pk2(o[6], o[7]);
                *(u32x4*)op = w;
                prv = cur; cur = nxt;
            }
        }
        {
            bf16_t* QR = (bf16_t*)(ws + WS_QR); bf16_t* KA = (bf16_t*)(ws + WS_KA); bf16_t* VT = (bf16_t*)(ws + WS_VT);
#pragma unroll 1
            for (int idx = tid; idx < 16 * 40; idx += 512) {
                const int tk = idx / 40, j = idx % 40; const int row = row0 + tk, pos = pos0 + tk;
                const int hh = j >> 2, part = (j >> 1) & 1, sub = j & 1;
                const bool isq = hh < 8;
                if (isq && !isx) continue;
                const int zc = isq ? (ZC_Q + hh * 64) : (ZC_K + (hh - 8) * 64);
                const bf16_t* zp = Z + (size_t)row * ZP + zc + part * 32 + sub * 8;
                const u32x4 t1 = *(const u32x4*)zp, t2 = *(const u32x4*)(zp + 16);
                float x1[8], x2[8], o1[8], o2[8];
#pragma unroll
                for (int q = 0; q < 4; ++q) { x1[2 * q] = lo16(t1[q]); x1[2 * q + 1] = hi16(t1[q]); x2[2 * q] = lo16(t2[q]); x2[2 * q + 1] = hi16(t2[q]); }
                if (isx) {
                    const int p = part ? (pos & 63) : (pos >> 6);
                    const float sc = isq ? (0.125f * 1.44269504089f) : 1.0f;
                    const f32x4 cA = *(const f32x4*)(rc + p * 16 + sub * 8), cB = *(const f32x4*)(rc + p * 16 + sub * 8 + 4), sA = *(const f32x4*)(rs + p * 16 + sub * 8), sB = *(const f32x4*)(rs + p * 16 + sub * 8 + 4);
#pragma unroll
                    for (int q = 0; q < 8; ++q) { const float c = q < 4 ? cA[q & 3] : cB[q & 3], s = q < 4 ? sA[q & 3] : sB[q & 3];
                        o1[q] = (x1[q] * c - x2[q] * s) * sc; o2[q] = (x2[q] * c + x1[q] * s) * sc; }
                } else {
#pragma unroll
                    for (int q = 0; q < 8; ++q) { o1[q] = x1[q]; o2[q] = x2[q]; }
                }
                u32x4 w1, w2;
#pragma unroll
                for (int q = 0; q < 4; ++q) { w1[q] = pk2(o1[2 * q], o1[2 * q + 1]); w2[q] = pk2(o2[2 * q], o2[2 * q + 1]); }
                bf16_t* op = isq ? (QR + (size_t)row * 512 + hh * 64 + part * 32 + sub * 8) : (KA + (size_t)row * 128 + (hh - 8) * 64 + part * 32 + sub * 8);
                *(u32x4*)op = w1; *(u32x4*)(op + 16) = w2;
            }
            if (tid < 256) {
                const int cidx = tid & 127, tg = tid >> 7; const int g = cidx >> 6, d = cidx & 63;
                unsigned short vv[8];
#pragma unroll
                for (int q = 0; q < 8; ++q) vv[q] = Z[(size_t)(row0 + 8 * tg + q) * ZP + ZC_V + cidx];
                u32x4 w; w.x = vv[0] | ((unsigned)vv[1] << 16); w.y = vv[2] | ((unsigned)vv[3] << 16); w.z = vv[4] | ((unsigned)vv[5] << 16); w.w = vv[6] | ((unsigned)vv[7] << 16);
                bf16_t* op;
                if (isx) { const int b = row0 >> 12; op = VT + ((size_t)(b * 2 + g) * 64 + d) * SEQ + pos0 + 8 * tg; }
                else { const int b = (row0 - T) >> 8; op = VT + (size_t)NB * 2 * 64 * SEQ + ((size_t)(b * 2 + g) * 64 + d) * CL + pos0 + 8 * tg; }
                *(u32x4*)op = w;
            }
        }
    }
}

__device__ __forceinline__ void p3b_features(const Args& a, LAS unsigned char* lds, int tid, int lane, int wave, int G) {
    unsigned char* ws = a.ws;
    const bf16_t* lora = (const bf16_t*)(ws + WS_LORA);
    const bf16_t* ACT = (const bf16_t*)(ws + WS_ACT);
    bf16_t* FB = (bf16_t*)(ws + WS_FEAT);
    const int h = blockIdx.x & 7;
    constexpr int P64 = 72, P128 = 136;
    LAS bf16_t* WL = (LAS bf16_t*)lds;
    LAS bf16_t* WG2 = WL + 4 * 64 * P64;
    __syncthreads();
    for (int i = tid; i < 4 * 64 * 8; i += 512) { const int m = i >> 9, r = (i >> 3) & 63, c = i & 7; const int ch = 16 * ((r >> 2) & 3) + 4 * (r >> 4) + (r & 3);
        *(LAS u32x4*)(WL + (m * 64 + r) * P64 + 8 * c) = *(const u32x4*)(lora + (size_t)m * 32768 + (size_t)(h * 64 + ch) * 64 + 8 * c); }
    for (int i = tid; i < 64 * 16; i += 512) { const int r = i >> 4, c = i & 15; const int ch = 16 * ((r >> 2) & 3) + 4 * (r >> 4) + (r & 3);
        *(LAS u32x4*)(WG2 + r * P128 + 8 * c) = *(const u32x4*)(lora + (size_t)4 * 32768 + (size_t)(h * 64 + ch) * 128 + 8 * c); }
    __syncthreads();
    const int tk = lane & 15, cg = lane >> 4;
    f32x4 w0f[4], w0b[4], a0f[4], a0b[4], kkw[4], kaw[4];
#pragma unroll
    for (int cs = 0; cs < 4; ++cs) { const int c = h * 64 + 16 * cg + 4 * cs;
        w0f[cs] = *(const f32x4*)(a.in[I_W0F] + c); w0b[cs] = *(const f32x4*)(a.in[I_W0B] + c); a0f[cs] = *(const f32x4*)(a.in[I_A0F] + c); a0b[cs] = *(const f32x4*)(a.in[I_A0B] + c);
        kkw[cs] = *(const f32x4*)(a.in[I_KK] + c); kaw[cs] = *(const f32x4*)(a.in[I_KA] + c); }
    for (int tt = blockIdx.x >> 3; tt < ROWS / 128; tt += (G >> 3)) {
        const int row = tt * 128 + 16 * wave + tk;
        bf16x8 bfr[12];
        const bf16_t* ap = ACT + (size_t)row * 384 + 8 * cg;
#pragma unroll
        for (int kb = 0; kb < 12; ++kb) bfr[kb] = *(const bf16x8*)(ap + 32 * kb);
        bf16_t* frow = FB + (size_t)row * RD + h * 64 + 16 * cg;
        u32x2 kraw[4];
#pragma unroll
        for (int cs = 0; cs < 4; ++cs) kraw[cs] = *(const u32x2*)(frow + (size_t)F_A * (FEAT_STRIDE / 2) + 4 * cs);
        auto store16 = [&](int arr, const f32x4 (&v)[4]) {
            u32x4 w0, w1;
            w0.x = cvt_pk_bf16_asm(v[0][0], v[0][1]); w0.y = cvt_pk_bf16_asm(v[0][2], v[0][3]); w0.z = cvt_pk_bf16_asm(v[1][0], v[1][1]); w0.w = cvt_pk_bf16_asm(v[1][2], v[1][3]);
            w1.x = cvt_pk_bf16_asm(v[2][0], v[2][1]); w1.y = cvt_pk_bf16_asm(v[2][2], v[2][3]); w1.z = cvt_pk_bf16_asm(v[3][0], v[3][1]); w1.w = cvt_pk_bf16_asm(v[3][2], v[3][3]);
            u32x4* p = (u32x4*)(frow + (size_t)arr * (FEAT_STRIDE / 2)); p[0] = w0; p[1] = w1;
        };
        auto lora_mm = [&](int m, int kb0, f32x4 (&acc)[4]) {
#pragma unroll
            for (int cs = 0; cs < 4; ++cs) acc[cs] = (f32x4){0.f, 0.f, 0.f, 0.f};
            const int nkb = (m == 4) ? 4 : 2;
#pragma unroll
            for (int kb = 0; kb < 4; ++kb) if (kb < nkb) {
#pragma unroll
                for (int cs = 0; cs < 4; ++cs) {
                    const bf16x8 afr = (m == 4) ? *(const LAS bf16x8*)(WG2 + (16 * cs + tk) * P128 + 32 * kb + 8 * cg) : *(const LAS bf16x8*)(WL + (m * 64 + 16 * cs + tk) * P64 + 32 * kb + 8 * cg);
                    acc[cs] = __builtin_amdgcn_mfma_f32_16x16x32_bf16(afr, bfr[kb0 + kb], acc[cs], 0, 0, 0);
                }
            }
        };
        f32x4 acc[4];
        lora_mm(0, 0, acc);
#pragma unroll
        for (int cs = 0; cs < 4; ++cs)
#pragma unroll
            for (int j = 0; j < 4; ++j) acc[cs][j] = SCAN_CHUNKED ? (-0.60653065971f * sigmoidf_(acc[cs][j] + w0f[cs][j])) : (__expf(-0.60653065971f * sigmoidf_(acc[cs][j] + w0f[cs][j])) - 1.0f);
        store16(F_WF, acc);
        lora_mm(1, 2, acc);
#pragma unroll
        for (int cs = 0; cs < 4; ++cs)
#pragma unroll
            for (int j = 0; j < 4; ++j) acc[cs][j] = SCAN_CHUNKED ? (-0.60653065971f * sigmoidf_(acc[cs][j] + w0b[cs][j])) : (__expf(-0.60653065971f * sigmoidf_(acc[cs][j] + w0b[cs][j])) - 1.0f);
        store16(F_WB, acc);
        lora_mm(4, 8, acc);
        asm volatile("s_nop 7\n\ts_nop 7" ::: "memory");
        store16(F_G, acc);
        f32x4 iclf[4], iclb[4];
        lora_mm(2, 4, iclf);
        lora_mm(3, 6, iclb);
#pragma unroll
        for (int cs = 0; cs < 4; ++cs)
#pragma unroll
            for (int j = 0; j < 4; ++j) { iclf[cs][j] = sigmoidf_(iclf[cs][j] + a0f[cs][j]); iclb[cs][j] = sigmoidf_(iclb[cs][j] + a0b[cs][j]); }
        f32x4 kv[4]; float nrm = 0.f;
#pragma unroll
        for (int cs = 0; cs < 4; ++cs) {
            kv[cs] = (f32x4){lo16(kraw[cs].x), hi16(kraw[cs].x), lo16(kraw[cs].y), hi16(kraw[cs].y)};
            const f32x4 kk = kv[cs] * kkw[cs];
            nrm += (kk[0] * kk[0] + kk[1] * kk[1]) + (kk[2] * kk[2] + kk[3] * kk[3]);
        }
        nrm += __shfl_xor(nrm, 16); nrm += __shfl_xor(nrm, 32);
        const float inv = 1.0f / fmaxf(sqrtf(nrm), 1e-12f);
        f32x4 oa[4], obf[4], obb[4], okf[4], okb[4];
#pragma unroll
        for (int cs = 0; cs < 4; ++cs) {
            const f32x4 kkn = kv[cs] * kkw[cs] * inv;
            oa[cs] = -kkn; obf[cs] = kkn * iclf[cs]; obb[cs] = kkn * iclb[cs];
            okf[cs] = kv[cs] * ((iclf[cs] - 1.0f) * kaw[cs] + 1.0f); okb[cs] = kv[cs] * ((iclb[cs] - 1.0f) * kaw[cs] + 1.0f);
        }
        store16(F_A, oa); store16(F_BF, obf); store16(F_BB, obb); store16(F_KF, okf); store16(F_KB, okb);
    }
}

__device__ __forceinline__ void p4_attention(const Args& a, LAS unsigned char* lds, int tid, int lane, int wave, int G) {
    unsigned char* ws = a.ws;
    const bf16_t* QR = (const bf16_t*)(ws + WS_QR); const bf16_t* KA = (const bf16_t*)(ws + WS_KA); const bf16_t* VT = (const bf16_t*)(ws + WS_VT);
    bf16_t* ATT = (bf16_t*)(ws + WS_ATT);
    constexpr int KP = 72;
    LAS bf16_t* Ks0 = (LAS bf16_t*)lds;
    const int qi = lane & 31, hf = lane >> 5;
    unsigned* qatt = (unsigned*)(ws + WS_CTL) + CW_QATT;
    for (int it = 0;; ++it) {
        int upull = 0; if ((it & 1) == 0) { upull = queue_pull(qatt, lds, tid); *(volatile LAS int*)(lds + RING_BYTES + 260) = upull; } else upull = *(volatile LAS int*)(lds + RING_BYTES + 260);
        const int unit = 2 * upull + (it & 1);
        if (unit >= NB * NKV * (SEQ / 64)) break;
        const int qb = unit & 63, g = (unit >> 6) & 1, b = unit >> 7;
        const int q0 = qb * 64;
        const int head = g * 4 + (wave >> 1), qloc = 32 * (wave & 1) + qi;
        const size_t qrow = (size_t)b * SEQ + q0 + qloc;
        bf16x8 qf[4];
#pragma unroll
        for (int s = 0; s < 4; ++s) qf[s] = *(const bf16x8*)(QR + qrow * 512 + head * 64 + 16 * s + 8 * hf);
        float m = a.in[I_SINKS][head] * 1.44269504089f, lsum = hf ? 0.f : 1.f;
        f32x16 O0, O1;
#pragma unroll
        for (int r = 0; r < 16; ++r) { O0[r] = 0.f; O1[r] = 0.f; }
        const int rr = tid >> 3, ch = tid & 7;
        auto tile_ok = [&](int kt) -> bool { const int kp = q0 - 128 + 64 * kt; return kt >= 5 || (kp >= 0 && kp < SEQ); };
        u32x4 kreg, vreg;
        auto fetch_tile = [&](int kt) {
            const int kp0 = q0 - 128 + 64 * kt;
            const bf16_t* kp = (kt < 5) ? KA + ((size_t)b * SEQ + kp0 + rr) * 128 + g * 64 + 8 * ch
                                        : KA + ((size_t)T + b * CL + 64 * (kt - 5) + rr) * 128 + g * 64 + 8 * ch;
            const bf16_t* vp = (kt < 5) ? VT + ((size_t)(b * 2 + g) * 64 + rr) * SEQ + kp0 + 8 * ch
                                        : VT + (size_t)NB * 2 * 64 * SEQ + ((size_t)(b * 2 + g) * 64 + rr) * CL + 64 * (kt - 5) + 8 * ch;
            kreg = *(const u32x4*)kp; vreg = *(const u32x4*)vp;
        };
        int kt = 0; while (!tile_ok(kt)) ++kt;
        fetch_tile(kt);
        int par = 0;
        __syncthreads();
        for (; kt < 9; ) {
            LAS bf16_t* Ks = Ks0 + par * (2 * 64 * KP); LAS bf16_t* Vs = Ks + 64 * KP;
            *(LAS u32x4*)(Ks + rr * KP + 8 * ch) = kreg; *(LAS u32x4*)(Vs + rr * KP + 8 * ch) = vreg;
            __syncthreads();
            int ktn = kt + 1; while (ktn < 9 && !tile_ok(ktn)) ++ktn;
            if (ktn < 9) fetch_tile(ktn);
            f32x16 X0, X1;
#pragma unroll
            for (int r = 0; r < 16; ++r) { X0[r] = 0.f; X1[r] = 0.f; }
#pragma unroll
            for (int s = 0; s < 4; ++s) {
                const bf16x8 k0 = *(const LAS bf16x8*)(Ks + qi * KP + 16 * s + 8 * hf), k1 = *(const LAS bf16x8*)(Ks + (32 + qi) * KP + 16 * s + 8 * hf);
                X0 = __builtin_amdgcn_mfma_f32_32x32x16_bf16(k0, qf[s], X0, 0, 0, 0);
                X1 = __builtin_amdgcn_mfma_f32_32x32x16_bf16(k1, qf[s], X1, 0, 0, 0);
            }
            if (kt == 0 || kt == 4) {
#pragma unroll
                for (int r = 0; r < 16; ++r) { const int k0i = (r & 3) + 8 * (r >> 2) + 4 * hf, k1i = 32 + k0i;
                    const bool v0 = (kt == 0) ? (k0i >= qloc) : (k0i <= qloc), v1 = (kt == 0) ? (k1i >= qloc) : (k1i <= qloc);
                    X0[r] = v0 ? X0[r] : -1e30f; X1[r] = v1 ? X1[r] : -1e30f; }
            }
            float mx0 = X0[0], mx1 = X1[0];
#pragma unroll
            for (int r = 1; r < 16; ++r) { mx0 = __builtin_fmaxf(mx0, X0[r]); mx1 = __builtin_fmaxf(mx1, X1[r]); }
            float mx = __builtin_fmaxf(mx0, mx1);
            mx = __builtin_fmaxf(mx, __shfl_xor(mx, 32));
            const float mn = __builtin_fmaxf(m, mx);
            if (__any(mn > m)) {
                const float alpha = __builtin_amdgcn_exp2f(m - mn);
                lsum *= alpha;
#pragma unroll
                for (int r = 0; r < 16; ++r) { O0[r] *= alpha; O1[r] *= alpha; }
                m = mn;
            }
            float ps0 = 0.f, ps1 = 0.f;
#pragma unroll
            for (int r = 0; r < 16; ++r) { X0[r] = __builtin_amdgcn_exp2f(X0[r] - m); X1[r] = __builtin_amdgcn_exp2f(X1[r] - m); ps0 += X0[r]; ps1 += X1[r]; }
            lsum += ps0 + ps1;
#pragma unroll
            for (int kg = 0; kg < 2; ++kg)
#pragma unroll
                for (int s2 = 0; s2 < 2; ++s2) {
                    bf16x8 pf;
#pragma unroll
                    for (int j = 0; j < 4; ++j) { const float p0 = kg ? X1[8 * s2 + 2 * j] : X0[8 * s2 + 2 * j], p1 = kg ? X1[8 * s2 + 2 * j + 1] : X0[8 * s2 + 2 * j + 1];
                        const unsigned w = cvt_pk_bf16(p0, p1); pf[2 * j] = (short)(w & 0xffff); pf[2 * j + 1] = (short)(w >> 16); }
                    const int kb = 32 * kg + 16 * s2 + 4 * hf;
#pragma unroll
                    for (int dg = 0; dg < 2; ++dg) {
                        const LAS bf16_t* vr = Vs + (32 * dg + qi) * KP + kb;
                        const s16x4 va = *(const LAS s16x4*)vr, vb = *(const LAS s16x4*)(vr + 8);
                        bf16x8 vf; vf[0] = va[0]; vf[1] = va[1]; vf[2] = va[2]; vf[3] = va[3]; vf[4] = vb[0]; vf[5] = vb[1]; vf[6] = vb[2]; vf[7] = vb[3];
                        if (dg == 0) O0 = __builtin_amdgcn_mfma_f32_32x32x16_bf16(vf, pf, O0, 0, 0, 0);
                        else O1 = __builtin_amdgcn_mfma_f32_32x32x16_bf16(vf, pf, O1, 0, 0, 0);
                    }
                }
            kt = ktn; par ^= 1;
        }
        const float ltot = lsum + __shfl_xor(lsum, 32);
        const float inv = 1.0f / ltot;
        bf16_t* op = ATT + qrow * 512 + head * 64;
#pragma unroll
        for (int dg = 0; dg < 2; ++dg)
#pragma unroll
            for (int rq = 0; rq < 4; ++rq) {
                const int d0 = 32 * dg + 8 * rq + 4 * hf;
                u32x2 w;
                if (dg == 0) { w.x = cvt_pk_bf16(O0[4 * rq] * inv, O0[4 * rq + 1] * inv); w.y = cvt_pk_bf16(O0[4 * rq + 2] * inv, O0[4 * rq + 3] * inv); }
                else { w.x = cvt_pk_bf16(O1[4 * rq] * inv, O1[4 * rq + 1] * inv); w.y = cvt_pk_bf16(O1[4 * rq + 2] * inv, O1[4 * rq + 3] * inv); }
                *(u32x2*)(op + d0) = w;
            }
    }
}

template <int CTRL> __device__ __forceinline__ float dpp_add(float x) {
    return x + __builtin_bit_cast(float, __builtin_amdgcn_update_dpp(0, __builtin_bit_cast(int, x), CTRL, 0xf, 0xf, false));
}
__device__ __forceinline__ float row16_sum(float x) { x = dpp_add<0x128>(x); x = dpp_add<0x124>(x); x = dpp_add<0x122>(x); x = dpp_add<0x121>(x); return x; }
template <int VAR> __device__ __forceinline__ void p4_scan(const Args& a, LAS unsigned char* lds, int tid, int lane, int wave, int G) {
    unsigned char* ws = a.ws;
    const bf16_t* FB = (const bf16_t*)(ws + WS_FEAT);
    constexpr int TS = 32, NBLK = (CL + SEQ) / TS;
    constexpr int OPF = TS * 5 * 64;
    LAS float* OPS = (LAS float*)lds;
    LAS float* VB = OPS + 2 * OPF;
    LAS float* YBUF = VB + 2 * TS * 32;
    const int rl = 4 * wave + (lane >> 4), cg = lane & 15;
    for (int unit = blockIdx.x; unit < NB * NH * 4; unit += G) {
        const int half = unit & 1, dir = (unit >> 1) & 1, h = (unit >> 2) & 7, b = unit >> 5;
        const size_t astr = FEAT_STRIDE / 2;
        const bf16_t* arrp[5] = { FB + (size_t)(dir ? F_WB : F_WF) * astr, FB + (size_t)F_A * astr, FB + (size_t)(dir ? F_BB : F_BF) * astr, FB + (size_t)(dir ? F_KB : F_KF) * astr, FB + (size_t)F_R * astr };
        const bf16_t* vp = FB + (size_t)F_V * astr;
        bf16_t* Y = (bf16_t*)(ws + (dir ? WS_YB : WS_YF));
        auto row_of = [&](int s) -> int { return (s < CL) ? (T + b * CL + (dir ? (CL - 1 - s) : s)) : (b * SEQ + (dir ? (SEQ - 1 - (s - CL)) : (s - CL))); };
        u32x2 pre[6];
        auto fetch = [&](int blk) {
#pragma unroll
            for (int it = 0; it < 6; ++it) { const int q = tid + 512 * it; pre[it] = (u32x2){0u, 0u};
                if (q < TS * 88) { const int st = q / 88, rem = q % 88; const int row = row_of(blk * TS + st);
                    if (rem < 80) { const int ar = rem >> 4, ci = rem & 15; const bf16_t* p = (ar == 0 ? arrp[0] : ar == 1 ? arrp[1] : ar == 2 ? arrp[2] : ar == 3 ? arrp[3] : arrp[4]);
                        pre[it] = *(const u32x2*)(p + (size_t)row * RD + h * 64 + 4 * ci); }
                    else { const int ci = rem - 80; pre[it] = *(const u32x2*)(vp + (size_t)row * RD + h * 64 + half * 32 + 4 * ci); } } }
        };
        auto commit = [&](int buf) {
#pragma unroll
            for (int it = 0; it < 6; ++it) { const int q = tid + 512 * it;
                if (q < TS * 88) { const int st = q / 88, rem = q % 88;
                    f32x4 v = (f32x4){lo16(pre[it].x), hi16(pre[it].x), lo16(pre[it].y), hi16(pre[it].y)};
                    if (SCAN_CHUNKED && rem < 16) { v[0] = __expf(v[0]) - 1.0f; v[1] = __expf(v[1]) - 1.0f; v[2] = __expf(v[2]) - 1.0f; v[3] = __expf(v[3]) - 1.0f; }
                    if (rem < 80) *(LAS f32x4*)(OPS + buf * OPF + st * 320 + rem * 4) = v;
                    else *(LAS f32x4*)(VB + buf * TS * 32 + st * 32 + (rem - 80) * 4) = v; } }
        };
        __syncthreads();
        fetch(0); commit(0);
        __syncthreads();
        f32x4 S = (f32x4){0.f, 0.f, 0.f, 0.f};
        for (int blk = 0; blk < NBLK; ++blk) {
            const int buf = blk & 1;
            if (blk + 1 < NBLK) fetch(blk + 1);
            const LAS float* ob = OPS + buf * OPF + 4 * cg; const LAS float* vb = VB + buf * TS * 32 + rl; LAS float* yb = YBUF + buf * TS * 32 + rl;
            float ykeep = 0.f;
            f32x4 qw[3], qa[3], qb[3], qk[3], qr[3]; float qv[3];
#define SCAN_LOAD(st_, sl_) do { qw[sl_] = *(const LAS f32x4*)(ob + (st_) * 320); qa[sl_] = *(const LAS f32x4*)(ob + (st_) * 320 + 64); qb[sl_] = *(const LAS f32x4*)(ob + (st_) * 320 + 128); \
                qk[sl_] = *(const LAS f32x4*)(ob + (st_) * 320 + 192); qr[sl_] = *(const LAS f32x4*)(ob + (st_) * 320 + 256); qv[sl_] = vb[(st_) * 32]; } while (0)
            SCAN_LOAD(0, 0); SCAN_LOAD(1, 1);
#pragma unroll
            for (int st = 0; st < TS; ++st) {
                if (st + 2 < TS && (VAR != 2 || st < 1)) SCAN_LOAD(st + 2, (st + 2) % 3);
                const f32x4 ow = qw[st % 3], av = DBG_NOA ? (f32x4){0.f, 0.f, 0.f, 0.f} : qa[st % 3], bv = DBG_NOB ? (f32x4){0.f, 0.f, 0.f, 0.f} : qb[st % 3], kv = qk[st % 3], rv = qr[st % 3]; const float vi = qv[st % 3];
                float sa = fmaf(S[3], av[3], fmaf(S[2], av[2], fmaf(S[1], av[1], S[0] * av[0])));
                const f32x4 S1 = S + S * ow + kv * vi;
                if (VAR != 1) sa = row16_sum(sa);
                S = S1 + bv * sa;
                float y = fmaf(S[3], rv[3], fmaf(S[2], rv[2], fmaf(S[1], rv[1], S[0] * rv[0])));
                if (VAR != 1) y = row16_sum(y);
                ykeep = (cg == (st & 15)) ? y : ykeep;
                if ((st & 15) == 15) yb[((st & ~15) + cg) * 32] = ykeep;
            }
#undef SCAN_LOAD
            if (blk + 1 < NBLK) commit(buf ^ 1);
            __syncthreads();
            if (blk >= CL / TS) {
                const int st = tid >> 4, pr = tid & 15;
                const int row = row_of(blk * TS + st);
                const float y0 = YBUF[buf * TS * 32 + st * 32 + 2 * pr], y1 = YBUF[buf * TS * 32 + st * 32 + 2 * pr + 1];
                *(unsigned*)(Y + (size_t)row * RD + h * 64 + half * 32 + 2 * pr) = pk2(y0, y1);
            }
        }
    }
}

constexpr int CS_SLOT = 16384, CS_AT = 0, CS_RT = 2304, CS_BH = 4608, CS_KH = 6912, CS_VV = 9216, CS_AAK = 11520, CS_TT = 12800, CS_ARK = 14080, CS_GC = 15360;
constexpr int CS_SCR = 4 * CS_SLOT, CS_SCR_BYTES = 6144, CS_BT = 0, CS_KT = 2304, CS_NN = 4608, CS_FLAGS = CS_SCR + 4 * CS_SCR_BYTES;
typedef short v4i16_t __attribute__((ext_vector_type(4)));
__device__ __forceinline__ bf16x8 pack8(f32x4 x, f32x4 y) {
    u32x4 w; w.x = cvt_pk_bf16(x[0], x[1]); w.y = cvt_pk_bf16(x[2], x[3]); w.z = cvt_pk_bf16(y[0], y[1]); w.w = cvt_pk_bf16(y[2], y[3]);
    return __builtin_bit_cast(bf16x8, w);
}
__device__ __forceinline__ bf16x8 join8(s16x4 x, s16x4 y) { bf16x8 r; r[0] = x[0]; r[1] = x[1]; r[2] = x[2]; r[3] = x[3]; r[4] = y[0]; r[5] = y[1]; r[6] = y[2]; r[7] = y[3]; return r; }
__device__ __forceinline__ s16x4 lds_tr4(const LAS unsigned char* p) { return __builtin_bit_cast(s16x4, __builtin_amdgcn_ds_read_tr16_b64_v4i16((LAS v4i16_t*)p)); }
template <int CTRL> __device__ __forceinline__ float dpp_shr_add(float x) {
    return x + __builtin_bit_cast(float, __builtin_amdgcn_update_dpp(0, __builtin_bit_cast(int, x), CTRL, 0xf, 0xf, true));
}
template <bool TEST> __device__ __forceinline__ void p4_scan_chunked(const Args& a, LAS unsigned char* lds, int tid, int lane, int wave, int G) {
    unsigned char* ws = a.ws;
    const bf16_t* FB = (const bf16_t*)(ws + WS_FEAT);
    const size_t astr = FEAT_STRIDE / 2;
    constexpr int NCH = (CL + SEQ) / 16;
    volatile LAS unsigned* flags = (volatile LAS unsigned*)(lds + CS_FLAGS);
    for (int unit = blockIdx.x; unit < NB * NH * 2; unit += G) {
        const int dir = unit & 1, h = (unit >> 1) & 7, b = unit >> 4;
        __syncthreads();
        for (int i = tid; i < (CS_FLAGS + 64) / 16; i += 512) *(LAS u32x4*)(lds + 16 * i) = (u32x4){0u, 0u, 0u, 0u};
        __syncthreads();
        auto row_of = [&](int s) -> int { return (s < CL) ? (T + b * CL + (dir ? (CL - 1 - s) : s)) : (b * SEQ + (dir ? (SEQ - 1 - (s - CL)) : (s - CL))); };
        if (wave < 4) {
            const int il = lane & 15, g = lane >> 4, ich = 16 * wave + il;
            bf16_t* Y = (bf16_t*)(ws + (dir ? WS_YB : WS_YF));
            f32x4 ST[4];
#pragma unroll
            for (int jt = 0; jt < 4; ++jt) ST[jt] = (f32x4){0.f, 0.f, 0.f, 0.f};
            const f32x4 zero4 = (f32x4){0.f, 0.f, 0.f, 0.f}; const s16x4 z16 = (s16x4){0, 0, 0, 0};
            const int troff = (4 * g + (il >> 2)) * 144 + 8 * (il & 3);
            for (int c = 0; c < NCH; ++c) {
                const int slot = c & 3; LAS unsigned char* sb = lds + slot * CS_SLOT;
                while (flags[slot] != (unsigned)(c + 1)) __builtin_amdgcn_s_sleep(1);
                __builtin_amdgcn_fence(__ATOMIC_ACQUIRE, "workgroup");
                const bf16x8 sf0 = pack8(ST[0], ST[1]), sf1 = pack8(ST[2], ST[3]);
                const LAS unsigned char* atp = sb + CS_AT + il * 144 + 8 * g;
                const bf16x8 a0 = join8(*(const LAS s16x4*)(atp), *(const LAS s16x4*)(atp + 32)), a1 = join8(*(const LAS s16x4*)(atp + 64), *(const LAS s16x4*)(atp + 96));
                const LAS unsigned char* rtp = sb + CS_RT + il * 144 + 8 * g;
                const bf16x8 r0 = join8(*(const LAS s16x4*)(rtp), *(const LAS s16x4*)(rtp + 32)), r1 = join8(*(const LAS s16x4*)(rtp + 64), *(const LAS s16x4*)(rtp + 96));
                const bf16x8 aak = *(const LAS bf16x8*)(sb + CS_AAK + il * 80 + 16 * g);
                const bf16x8 ttf = *(const LAS bf16x8*)(sb + CS_TT + il * 80 + 16 * g);
                const bf16x8 ark = *(const LAS bf16x8*)(sb + CS_ARK + il * 80 + 16 * g);
                const s16x4 vv = lds_tr4(sb + CS_VV + troff + 32 * wave);
                f32x4 zw1 = zero4, zyy = zero4, zuu = zero4; asm volatile("" : "+v"(zw1), "+v"(zyy), "+v"(zuu));
                f32x4 w1 = __builtin_amdgcn_mfma_f32_16x16x32_bf16(a0, sf0, zw1, 0, 0, 0);
                w1 = __builtin_amdgcn_mfma_f32_16x16x32_bf16(a1, sf1, w1, 0, 0, 0);
                w1 = __builtin_amdgcn_mfma_f32_16x16x32_bf16(aak, join8(vv, z16), w1, 0, 0, 0);
                f32x4 yy = __builtin_amdgcn_mfma_f32_16x16x32_bf16(r0, sf0, zyy, 0, 0, 0);
                yy = __builtin_amdgcn_mfma_f32_16x16x32_bf16(r1, sf1, yy, 0, 0, 0);
                const bf16x8 w1f = pack8(w1, zero4);
                const f32x4 uu = __builtin_amdgcn_mfma_f32_16x16x32_bf16(ttf, w1f, zuu, 0, 0, 0);
                bf16x8 uv; { u32x4 w; w.x = cvt_pk_bf16(uu[0], uu[1]); w.y = cvt_pk_bf16(uu[2], uu[3]); const u32x2 v2 = __builtin_bit_cast(u32x2, vv); w.z = v2.x; w.w = v2.y; uv = __builtin_bit_cast(bf16x8, w); }
#pragma unroll
                for (int jt = 0; jt < 4; ++jt) {
                    const f32x4 gc = *(const LAS f32x4*)(sb + CS_GC + (16 * jt + 4 * g) * 4);
                    const bf16x8 bk = join8(lds_tr4(sb + CS_BH + troff + 32 * jt), lds_tr4(sb + CS_KH + troff + 32 * jt));
                    ST[jt] = __builtin_amdgcn_mfma_f32_16x16x32_bf16(bk, uv, ST[jt] * gc, 0, 0, 0);
                }
                yy = __builtin_amdgcn_mfma_f32_16x16x32_bf16(ark, uv, yy, 0, 0, 0);
                asm volatile("s_waitcnt lgkmcnt(0)" ::: "memory");
                if (lane == 0) __hip_atomic_fetch_add((LAS unsigned*)(lds + CS_FLAGS) + 4 + slot, 1u, __ATOMIC_RELEASE, __HIP_MEMORY_SCOPE_WORKGROUP);
                if (c >= CL / 16) {
#pragma unroll
                    for (int rg = 0; rg < 4; ++rg) { const int row = row_of(16 * c + 4 * g + rg); Y[(size_t)row * RD + h * 64 + ich] = (bf16_t)f2bf(yy[rg]); }
                }
            }
        } else {
            const int p = wave - 4, jg = lane >> 4, t = lane & 15;
            LAS unsigned char* scr = lds + CS_SCR + p * CS_SCR_BYTES;
            u32x4 raw[6][2];
            auto load_raw = [&](int c) {
                const size_t ro = (size_t)row_of(16 * c + t) * RD + h * 64 + 16 * jg;
#pragma unroll
                for (int hf = 0; hf < 2; ++hf) {
                    raw[0][hf] = *(const u32x4*)(FB + (size_t)(dir ? F_WB : F_WF) * astr + ro + 8 * hf); raw[1][hf] = *(const u32x4*)(FB + (size_t)F_A * astr + ro + 8 * hf);
                    raw[2][hf] = *(const u32x4*)(FB + (size_t)(dir ? F_BB : F_BF) * astr + ro + 8 * hf); raw[3][hf] = *(const u32x4*)(FB + (size_t)(dir ? F_KB : F_KF) * astr + ro + 8 * hf);
                    raw[4][hf] = *(const u32x4*)(FB + (size_t)F_R * astr + ro + 8 * hf); raw[5][hf] = *(const u32x4*)(FB + (size_t)F_V * astr + ro + 8 * hf); }
            };
            load_raw(p);
            const int tn = lane & 15, gq = lane >> 4;
            for (int c = p; c < NCH; c += 4) {
                const int slot = c & 3; LAS unsigned char* sb = lds + slot * CS_SLOT;
                float cs[16], lwv[16];
#pragma unroll
                for (int q = 0; q < 8; ++q) { const unsigned w = raw[0][q >> 2][q & 3]; lwv[2 * q] = lo16(w); lwv[2 * q + 1] = hi16(w); }
#pragma unroll
                for (int q = 0; q < 16; ++q) { float x = lwv[q]; x = dpp_shr_add<0x111>(x); x = dpp_shr_add<0x112>(x); x = dpp_shr_add<0x114>(x); x = dpp_shr_add<0x118>(x); cs[q] = x; }
                float Gc[16], Gi[16], Gp[16], G15[16];
#pragma unroll
                for (int q = 0; q < 16; ++q) { Gc[q] = __expf(cs[q]); Gi[q] = __expf(-cs[q]); Gp[q] = __expf(cs[q] - lwv[q]); G15[q] = __shfl(Gc[q], (lane & 48) | 15); }
                while (flags[4 + slot] != (unsigned)(4 * (c >> 2))) __builtin_amdgcn_s_sleep(1);
                __builtin_amdgcn_fence(__ATOMIC_ACQUIRE, "workgroup");
                {
                    u32x4 wa[2], wr[2], wb[2], wk[2], wbh[2], wkh[2];
#pragma unroll
                    for (int q = 0; q < 8; ++q) {
                        const unsigned ua = raw[1][q >> 2][q & 3], ub = raw[2][q >> 2][q & 3], uk = raw[3][q >> 2][q & 3], ur = raw[4][q >> 2][q & 3];
                        const float a0 = lo16(ua) * Gp[2 * q], a1 = hi16(ua) * Gp[2 * q + 1], r0 = lo16(ur) * Gc[2 * q], r1 = hi16(ur) * Gc[2 * q + 1];
                        const float b0 = lo16(ub) * Gi[2 * q], b1 = hi16(ub) * Gi[2 * q + 1], k0 = lo16(uk) * Gi[2 * q], k1 = hi16(uk) * Gi[2 * q + 1];
                        wa[q >> 2][q & 3] = cvt_pk_bf16(a0, a1); wr[q >> 2][q & 3] = cvt_pk_bf16(r0, r1); wb[q >> 2][q & 3] = cvt_pk_bf16(b0, b1); wk[q >> 2][q & 3] = cvt_pk_bf16(k0, k1);
                        wbh[q >> 2][q & 3] = cvt_pk_bf16(b0 * G15[2 * q], b1 * G15[2 * q + 1]); wkh[q >> 2][q & 3] = cvt_pk_bf16(k0 * G15[2 * q], k1 * G15[2 * q + 1]);
                    }
                    const int ro = t * 144 + 32 * jg;
#pragma unroll
                    for (int hf = 0; hf < 2; ++hf) {
                        *(LAS u32x4*)(sb + CS_AT + ro + 16 * hf) = wa[hf]; *(LAS u32x4*)(sb + CS_RT + ro + 16 * hf) = wr[hf];
                        *(LAS u32x4*)(scr + CS_BT + ro + 16 * hf) = wb[hf]; *(LAS u32x4*)(scr + CS_KT + ro + 16 * hf) = wk[hf];
                        *(LAS u32x4*)(sb + CS_BH + ro + 16 * hf) = wbh[hf]; *(LAS u32x4*)(sb + CS_KH + ro + 16 * hf) = wkh[hf];
                        *(LAS u32x4*)(sb + CS_VV + ro + 16 * hf) = raw[5][hf];
                    }
                    if (t == 15) {
#pragma unroll
                        for (int q = 0; q < 4; ++q) *(LAS f32x4*)(sb + CS_GC + (16 * jg + 4 * q) * 4) = (f32x4){Gc[4 * q], Gc[4 * q + 1], Gc[4 * q + 2], Gc[4 * q + 3]};
                    }
                }
                if (c + 4 < NCH) load_raw(c + 4);
                asm volatile("s_waitcnt lgkmcnt(0)" ::: "memory");
                f32x4 m0 = (f32x4){0.f, 0.f, 0.f, 0.f}, m1 = m0, m3 = m0, m4 = m0;
                asm volatile("" : "+v"(m0), "+v"(m1), "+v"(m3), "+v"(m4));
#pragma unroll
                for (int ks = 0; ks < 2; ++ks) {
                    const bf16x8 xa = *(const LAS bf16x8*)(sb + CS_AT + tn * 144 + 64 * ks + 16 * gq), xr = *(const LAS bf16x8*)(sb + CS_RT + tn * 144 + 64 * ks + 16 * gq);
                    const bf16x8 yb = *(const LAS bf16x8*)(scr + CS_BT + tn * 144 + 64 * ks + 16 * gq), yk = *(const LAS bf16x8*)(scr + CS_KT + tn * 144 + 64 * ks + 16 * gq);
                    m0 = __builtin_amdgcn_mfma_f32_16x16x32_bf16(yb, xa, m0, 0, 0, 0);
                    m1 = __builtin_amdgcn_mfma_f32_16x16x32_bf16(yk, xa, m1, 0, 0, 0);
                    m3 = __builtin_amdgcn_mfma_f32_16x16x32_bf16(yb, xr, m3, 0, 0, 0);
                    m4 = __builtin_amdgcn_mfma_f32_16x16x32_bf16(yk, xr, m4, 0, 0, 0);
                }
                {
                    f32x4 n0, q1, q3, q4;
#pragma unroll
                    for (int rg = 0; rg < 4; ++rg) { const int s = 4 * gq + rg; const bool lt = s < tn, le = s <= tn;
                        n0[rg] = lt ? m0[rg] : 0.f; q1[rg] = lt ? m1[rg] : 0.f; q3[rg] = le ? m3[rg] : 0.f; q4[rg] = le ? m4[rg] : 0.f;
                        *(LAS float*)(scr + CS_NN + (s * 16 + tn) * 4) = n0[rg]; }
                    u32x2 w1; w1.x = cvt_pk_bf16(q1[0], q1[1]); w1.y = cvt_pk_bf16(q1[2], q1[3]);
                    *(LAS u32x2*)(sb + CS_AAK + tn * 80 + 16 * gq) = w1;
                    u32x4 w3; w3.x = cvt_pk_bf16(q3[0], q3[1]); w3.y = cvt_pk_bf16(q3[2], q3[3]); w3.z = cvt_pk_bf16(q4[0], q4[1]); w3.w = cvt_pk_bf16(q4[2], q4[3]);
                    *(LAS u32x4*)(sb + CS_ARK + tn * 80 + 16 * gq) = w3;
                }
                asm volatile("s_waitcnt lgkmcnt(0)" ::: "memory");
                float Tc[16];
#pragma unroll
                for (int s = 0; s < 16; ++s) Tc[s] = (s == tn) ? 1.0f : 0.0f;
                {
                    const LAS f32x4* NR = (const LAS f32x4*)(scr + CS_NN);
                    f32x4 cq[4], nq[4];
#pragma unroll
                    for (int k = 0; k < 4; ++k) { cq[k] = NR[4 * 14 + k]; nq[k] = cq[k]; }
#pragma unroll
                    for (int s = 14; s >= 0; --s) {
                        if (s > 0) {
#pragma unroll
                            for (int k = 0; k < 4; ++k) if (4 * k + 3 > s - 1) nq[k] = NR[4 * (s - 1) + k];
                        }
                        float acc0 = 0.f, acc1 = 0.f;
#pragma unroll
                        for (int q = s + 1; q < 16; ++q) { if (q & 1) acc1 += Tc[q] * cq[q >> 2][q & 3]; else acc0 += Tc[q] * cq[q >> 2][q & 3]; }
                        Tc[s] = (s < tn) ? (acc0 + acc1) : Tc[s];
#pragma unroll
                        for (int k = 0; k < 4; ++k) cq[k] = nq[k];
                    }
                }
                if (lane < 16) {
#pragma unroll
                    for (int g4 = 0; g4 < 4; ++g4) { u32x2 w; w.x = cvt_pk_bf16(Tc[4 * g4], Tc[4 * g4 + 1]); w.y = cvt_pk_bf16(Tc[4 * g4 + 2], Tc[4 * g4 + 3]); *(LAS u32x2*)(sb + CS_TT + tn * 80 + 16 * g4) = w; }
                }
                __builtin_amdgcn_fence(__ATOMIC_RELEASE, "workgroup");
                asm volatile("s_waitcnt lgkmcnt(0)" ::: "memory");
                if (lane == 0) flags[slot] = (unsigned)(c + 1);
            }
        }
    }
}

__device__ __forceinline__ void p5_rwkv_out(const Args& a, int lane, int wave, int G) {
    unsigned char* ws = a.ws;
    const bf16_t* FB = (const bf16_t*)(ws + WS_FEAT); const size_t astr = FEAT_STRIDE / 2;
    const bf16_t* YF = (const bf16_t*)(ws + WS_YF); const bf16_t* YBk = (const bf16_t*)(ws + WS_YB);
    bf16_t* RWK = (bf16_t*)(ws + WS_RWK);
    const int gw = blockIdx.x * 8 + wave, NGW = G * 8;
    const int c0 = 8 * lane;
    float lnw[8], lnb[8], rk[8];
#pragma unroll
    for (int j = 0; j < 8; ++j) { lnw[j] = a.in[I_LNW][c0 + j]; lnb[j] = a.in[I_LNB][c0 + j]; rk[j] = a.in[I_RK][c0 + j]; }
    auto ld8 = [&](const bf16_t* p, float (&o)[8]) { const u32x4 w = *(const u32x4*)p;
#pragma unroll
        for (int j = 0; j < 4; ++j) { o[2 * j] = lo16(w[j]); o[2 * j + 1] = hi16(w[j]); } };
    for (int m = gw; m < T; m += NGW) {
        const size_t o = (size_t)m * RD + c0;
        float yf[8], yb[8], r[8], kf[8], kb[8], v[8], g[8];
        ld8(YF + o, yf); ld8(YBk + o, yb); ld8(FB + F_R * astr + o, r); ld8(FB + F_KF * astr + o, kf); ld8(FB + F_KB * astr + o, kb); ld8(FB + F_V * astr + o, v); ld8(FB + F_G * astr + o, g);
        float s = 0.f, bs = 0.f;
#pragma unroll
        for (int j = 0; j < 8; ++j) { yf[j] += yb[j]; s += yf[j]; bs += r[j] * (kf[j] + kb[j]) * rk[j]; }
        s += __shfl_xor(s, 1); s += __shfl_xor(s, 2); s += __shfl_xor(s, 4);
        bs += __shfl_xor(bs, 1); bs += __shfl_xor(bs, 2); bs += __shfl_xor(bs, 4);
        const float mean = s * (1.f / 64.f); float q = 0.f;
#pragma unroll
        for (int j = 0; j < 8; ++j) { yf[j] -= mean; q += yf[j] * yf[j]; }
        q += __shfl_xor(q, 1); q += __shfl_xor(q, 2); q += __shfl_xor(q, 4);
        const float rstd = 1.0f / sqrtf(q * (1.f / 64.f) + GN_EPS);
        float out[8];
#pragma unroll
        for (int j = 0; j < 8; ++j) out[j] = (yf[j] * rstd * lnw[j] + lnb[j] + bs * v[j]) * g[j];
        u32x4 w; w.x = pk2(out[0], out[1]); w.y = pk2(out[2], out[3]); w.z = pk2(out[4], out[5]); w.w = pk2(out[6], out[7]);
        *(u32x4*)(RWK + o) = w;
    }
}

template <bool PROBE> __device__ __forceinline__ void p9_postmix_router(const Args& a, LAS unsigned char* lds, int tid, int lane, int wave, int G) {
    unsigned char* ws = a.ws;
    const float* MOD = (const float*)(ws + WS_CTL) + CW_MOD;
    const float* MIX = (const float*)(ws + WS_MIX);
    bf16_t* HF = (bf16_t*)(ws + (PROBE ? WS_H + 160 * MiB : WS_HF));
    int* cnt = (int*)(ws + WS_CTL) + (PROBE ? 12000 : CW_CNT);
    int* slot_tok = (int*)(ws + (PROBE ? WS_H + 240 * MiB : WS_SLOT_TOK)); float* slot_gate = (float*)(ws + (PROBE ? WS_H + 248 * MiB : WS_SLOT_GATE)); unsigned* tokk = (unsigned*)(ws + (PROBE ? WS_H + 256 * MiB : WS_TOKK));
    constexpr int HP = 1028;
    LAS float* HL = (LAS float*)lds;
    LAS float* PART = HL + 16 * HP;
    LAS int* SEL_E = (LAS int*)(lds + 90112); LAS float* SEL_G = (LAS float*)(lds + 90112 + 2048); LAS int* SEL_M = (LAS int*)(lds + 90112 + 4096);
    LAS int* HIST = (LAS int*)(lds + 90112 + 6144); LAS int* BASE = HIST + 32;
    int nsel = 0;
    const int ti = lane & 15, kq = lane >> 4;
    float wb0[32], wb1[32];
    {
        const float* wr = a.in[I_WROUTER];
#pragma unroll
        for (int ks = 0; ks < 32; ++ks) { const int k = 128 * wave + 4 * ks + kq; wb0[ks] = wr[k * NE + ti]; wb1[ks] = wr[k * NE + 16 + ti]; }
    }
    const float brt = a.in[I_BROUTER][lane & 31];
    for (int unit = blockIdx.x; unit < T / 16; unit += G) {
        const int tok0 = unit * 16;
        __syncthreads();
        {
            const int m0 = tok0 + 2 * wave; const int b = m0 >> 12;
            f32x4 v[2][4]; float s[2] = {0.f, 0.f};
#pragma unroll
            for (int tt = 0; tt < 2; ++tt) { const f32x4* mr = (const f32x4*)(MIX + (size_t)(m0 + tt) * D) + lane;
#pragma unroll
                for (int j = 0; j < 4; ++j) { v[tt][j] = mr[64 * j]; s[tt] += (v[tt][j].x * v[tt][j].x + v[tt][j].y * v[tt][j].y) + (v[tt][j].z * v[tt][j].z + v[tt][j].w * v[tt][j].w); } }
            f32x4 xv[2][4];
#pragma unroll
            for (int tt = 0; tt < 2; ++tt) { const f32x4* xr = (const f32x4*)(a.in[I_X] + (size_t)(m0 + tt) * D) + lane;
#pragma unroll
                for (int j = 0; j < 4; ++j) xv[tt][j] = xr[64 * j]; }
#pragma unroll
            for (int o = 1; o < 64; o <<= 1) { s[0] += __shfl_xor(s[0], o); s[1] += __shfl_xor(s[1], o); }
            float s2[2] = {0.f, 0.f};
#pragma unroll
            for (int j = 0; j < 4; ++j) {
                const f32x4 g = ((const f32x4*)a.in[I_GPOSTMIX])[64 * j + lane], gt = ((const f32x4*)(MOD + b * 6144 + 2048))[64 * j + lane];
#pragma unroll
                for (int tt = 0; tt < 2; ++tt) {
                    const float rstd = __builtin_amdgcn_rsqf(s[tt] * (1.f / D) + RMS_EPS);
                    v[tt][j] = xv[tt][j] + gt * (v[tt][j] * rstd * g);
                    ((f32x4*)((PROBE ? (float*)(ws + WS_H) : a.out) + (size_t)(m0 + tt) * D))[64 * j + lane] = v[tt][j];
                    s2[tt] += (v[tt][j].x * v[tt][j].x + v[tt][j].y * v[tt][j].y) + (v[tt][j].z * v[tt][j].z + v[tt][j].w * v[tt][j].w);
                }
            }
#pragma unroll
            for (int o = 1; o < 64; o <<= 1) { s2[0] += __shfl_xor(s2[0], o); s2[1] += __shfl_xor(s2[1], o); }
#pragma unroll
            for (int j = 0; j < 4; ++j) {
                const f32x4 g = ((const f32x4*)a.in[I_GPREFFN])[64 * j + lane], sh = ((const f32x4*)(MOD + b * 6144 + 3072))[64 * j + lane], sc = ((const f32x4*)(MOD + b * 6144 + 4096))[64 * j + lane];
#pragma unroll
                for (int tt = 0; tt < 2; ++tt) {
                    const float rstd2 = __builtin_amdgcn_rsqf(s2[tt] * (1.f / D) + RMS_EPS);
                    const f32x4 hv = (v[tt][j] * rstd2 * g) * (sc + 1.0f) + sh;
                    ((unsigned*)((unsigned char*)HF + (size_t)(m0 + tt) * D))[64 * j + lane] = pk4_fp8(hv.x * F8_ASCALE, hv.y * F8_ASCALE, hv.z * F8_ASCALE, hv.w * F8_ASCALE);
                    *(LAS f32x4*)(HL + (2 * wave + tt) * HP + 256 * j + 4 * lane) = hv;
                }
            }
        }
        __syncthreads();
        {
            f32x4 acc0 = (f32x4){0.f, 0.f, 0.f, 0.f}, acc1 = acc0;
#pragma unroll
            for (int ks = 0; ks < 32; ++ks) {
                const float av = HL[ti * HP + 128 * wave + 4 * ks + kq];
                acc0 = __builtin_amdgcn_mfma_f32_16x16x4f32(av, wb0[ks], acc0, 0, 0, 0);
                acc1 = __builtin_amdgcn_mfma_f32_16x16x4f32(av, wb1[ks], acc1, 0, 0, 0);
            }
#pragma unroll
            for (int r = 0; r < 4; ++r) { PART[(wave * 16 + 4 * kq + r) * 32 + ti] = acc0[r]; PART[(wave * 16 + 4 * kq + r) * 32 + 16 + ti] = acc1[r]; }
        }
        __syncthreads();
        {
            const int tl = 2 * wave + (lane >> 5); const int m = tok0 + tl;
            const int e = lane & 31;
            float lg = brt;
#pragma unroll
            for (int w = 0; w < 8; ++w) lg += PART[(w * 16 + tl) * 32 + e];
            float tv[4]; int ti4[4];
#pragma unroll
            for (int k = 0; k < 4; ++k) {
                float bv = lg; int bi = e;
#pragma unroll
                for (int o = 1; o < 32; o <<= 1) { const float ov = __shfl_xor(bv, o); const int oi = __shfl_xor(bi, o); if (ov > bv || (ov == bv && oi < bi)) { bv = ov; bi = oi; } }
                tv[k] = bv; ti4[k] = bi;
                if (e == bi) lg = -3.0e38f;
            }
            const float e1 = __expf(tv[1] - tv[0]), e2 = __expf(tv[2] - tv[0]), e3 = __expf(tv[3] - tv[0]);
            const float inv = 1.0f / (1.0f + e1 + e2 + e3);
            if (e < 4) {
                const int ek = e == 0 ? ti4[0] : e == 1 ? ti4[1] : e == 2 ? ti4[2] : ti4[3];
                const float gk = (e == 0 ? 1.0f : e == 1 ? e1 : e == 2 ? e2 : e3) * inv;
                const int si = nsel * 64 + tl * 4 + e;
                SEL_E[si] = ek; SEL_G[si] = gk; SEL_M[si] = m;
            }
        }
        ++nsel;
    }
    __syncthreads();
    if (tid < 32) HIST[tid] = 0;
    __syncthreads();
    int my_e = 0, my_lr = 0; const bool have = tid < nsel * 64;
    if (have) { my_e = SEL_E[tid]; my_lr = __hip_atomic_fetch_add(HIST + my_e, 1, __ATOMIC_RELAXED, __HIP_MEMORY_SCOPE_WORKGROUP); }
    __syncthreads();
    if (tid < 32) { const int n = HIST[tid]; BASE[tid] = n ? atomicAdd(cnt + tid, n) : 0; }
    __syncthreads();
    if (have) { const int rank = BASE[my_e] + my_lr; const int m = SEL_M[tid];
        slot_tok[my_e * T + rank] = m; slot_gate[(size_t)my_e * T + rank] = SEL_G[tid];
        tokk[m * 4 + (tid & 3)] = ((unsigned)my_e << 20) | (unsigned)rank; }
}

__device__ __forceinline__ void moe_table(const Args& a, LAS int* tstart, int tid) {
    const int* cnt = (const int*)(a.ws + WS_CTL) + CW_CNT;
    __syncthreads();
    if (tid == 0) { int acc = 0; for (int e = 0; e < NE; ++e) { tstart[e] = acc; acc += (__hip_atomic_load(cnt + e, __ATOMIC_RELAXED, __HIP_MEMORY_SCOPE_AGENT) + 255) >> 8; } tstart[NE] = acc; }
    __syncthreads();
}

template <bool PROBE> __device__ __forceinline__ void p12_combine(const Args& a, LAS int* tstart, int lane, int wave, int G) {
    unsigned char* ws = a.ws;
    const float* MOD = (const float*)(ws + WS_CTL) + CW_MOD;
    const bf16_t* YB = (const bf16_t*)(ws + WS_YBUF); const unsigned* tokk = (const unsigned*)(ws + WS_TOKK);
    const int gw = blockIdx.x * 8 + wave, NGW = G * 8;
    for (int m0 = gw; m0 < T; m0 += 2 * NGW) {
        const int m1 = (m0 + NGW < T) ? m0 + NGW : m0;
        const u32x4 tk0 = *(const u32x4*)(tokk + m0 * 4), tk1 = *(const u32x4*)(tokk + m1 * 4);
        unsigned long long yr[2][4][4]; f32x4 xr[2][4];
#pragma unroll
        for (int r = 0; r < 2; ++r) {
            const int m = r ? m1 : m0;
#pragma unroll
            for (int k = 0; k < 4; ++k) {
                const unsigned tk = r ? tk1[k] : tk0[k]; const int e = (int)(tk >> 20), rank = (int)(tk & 0xfffffu);
                const unsigned long long* yp = (const unsigned long long*)(YB + ((size_t)tstart[e] * 256 + rank) * D) + lane;
#pragma unroll
                for (int j = 0; j < 4; ++j) yr[r][k][j] = yp[64 * j];
            }
#pragma unroll
            for (int j = 0; j < 4; ++j) xr[r][j] = ((const f32x4*)(a.out + (size_t)m * D))[64 * j + lane];
        }
#pragma unroll
        for (int r = 0; r < 2; ++r) {
            const int m = r ? m1 : m0; const int b = m >> 12;
            f32x4 y[4]; float s = 0.f;
#pragma unroll
            for (int j = 0; j < 4; ++j) { y[j] = (f32x4){0.f, 0.f, 0.f, 0.f};
#pragma unroll
                for (int k = 0; k < 4; ++k) { const unsigned lo = (unsigned)yr[r][k][j], hi = (unsigned)(yr[r][k][j] >> 32); y[j] += (f32x4){lo16(lo), hi16(lo), lo16(hi), hi16(hi)}; }
                s += (y[j][0] * y[j][0] + y[j][1] * y[j][1]) + (y[j][2] * y[j][2] + y[j][3] * y[j][3]); }
            const float rstd = __builtin_amdgcn_rsqf(wave_sum(s) * (1.f / D) + RMS_EPS);
            if (r == 0 || m1 != m0) {
#pragma unroll
                for (int j = 0; j < 4; ++j) {
                    const f32x4 g = ((const f32x4*)a.in[I_GPOSTFFN])[64 * j + lane], gt = ((const f32x4*)(MOD + b * 6144 + 5120))[64 * j + lane];
                    ((f32x4*)((PROBE ? (float*)(ws + WS_H) : a.out) + (size_t)m * D))[64 * j + lane] = xr[r][j] + gt * (y[j] * rstd * g);
                }
            }
        }
    }
}

constexpr int N_PHASES = 13;
__global__ void __launch_bounds__(512, 2) mega_fwd(Args args) {
    extern __shared__ __attribute__((aligned(16))) unsigned char lds_raw[];
    LAS unsigned char* lds = (LAS unsigned char*)lds_raw;
    const int tid = threadIdx.x, lane = tid & 63, wave = __builtin_amdgcn_readfirstlane(tid >> 6);
    const int G = gridDim.x;
    volatile LAS unsigned* MISC = (volatile LAS unsigned*)(lds + MISC_OFF);
    LAS int* tstart = (LAS int*)(lds + RING_BYTES);
    for (int u = tid; u < (LDS_BYTES - RING_BYTES) / 4; u += 512) ((LAS unsigned*)(lds + RING_BYTES))[u] = 0u;
    __syncthreads();
    unsigned char* ws = args.ws;
    const int lo = args.ph_lo, hi = args.ph_hi;
    unsigned* barw = (unsigned*)(ws + WS_CTL) + (args.bar_region ? (131072 + (args.bar_region - 1) * 4096) : CW_BAR);
    XcdBarrier bar; bar.bar = barw; bar.x = 0; bar.st = nullptr;
    if (hi - lo > 1) bar = xcd_barrier_post(barw, MISC + 8);
#ifndef PH_MASK
#define PH_MASK 0x1FFF
#endif
#define IN(k) (((PH_MASK >> (k)) & 1) && lo <= (k) && (k) < hi)
#define SEAM(k) do { if (IN(k) && IN((k) + 1)) xcd_barrier(bar); } while (0)

    if (IN(0)) { p0_prologue(args, lds, tid, lane, wave, G); SEAM(0); }
    if (IN(1)) { p1_norm(args, lane, wave, G); SEAM(1); }
    if (IN(2)) {
        SchedProj S{(const char*)(ws + WS_WIN), G, (int)blockIdx.x};
        EpiZ E{(bf16_t*)(ws + WS_Z), (const float*)(ws + WS_MISC)};
        pg8::gemm_phase<1024, EpiZ, SchedProj>(lds, (const char*)(ws + WS_HX), S, E);
        SEAM(2);
    }
    if (IN(3)) { p3a_pointwise(args, tid, G); if (IN(4)) xcd_barrier(bar); p3b_features(args, lds, tid, lane, wave, G); SEAM(3); }
    if (IN(5)) { if (SCAN_CHUNKED && !SCAN_FORCE_DIRECT) p4_scan_chunked<false>(args, lds, tid, lane, wave, G); else p4_scan<0>(args, lds, tid, lane, wave, G);
        p4_attention(args, lds, tid, lane, wave, G);
        moe_weight_copies(args, lds, tid, lane, wave);
        SEAM(5); }
#if DBG_SCAN
    if (IN(6) && blockIdx.x == 0) {
        const bf16_t* Yt = (const bf16_t*)(ws + (DBG_DIR ? WS_YB : WS_YF)); const bf16_t* Y2 = (const bf16_t*)(ws + 272 * MiB);
        LAS float* red = (LAS float*)lds; float* dbg = (float*)(ws + WS_CTL) + 12288;
        int first = -1; float worst = 0.f;
        for (int ci = 0; ci < 256; ++ci) {
            float e2 = 0.f, r2 = 0.f;
            for (int i = tid; i < 16 * 512; i += 512) { const int cc = DBG_DIR ? (255 - ci) : ci; const size_t o = (size_t)(cc * 16) * 512 + i; const float yt = bf2f(Yt[o]), y2 = bf2f(Y2[o]); e2 += (yt - y2) * (yt - y2); r2 += yt * yt; }
            e2 = wave_sum(e2); r2 = wave_sum(r2);
            __syncthreads(); if (lane == 0) { red[wave] = e2; red[8 + wave] = r2; } __syncthreads();
            float E = 0.f, R = 0.f; for (int w8 = 0; w8 < 8; ++w8) { E += red[w8]; R += red[8 + w8]; }
            const float rel = sqrtf(E / fmaxf(R, 1e-20f));
            if (first < 0 && !(rel < 0.03f)) first = ci;
            if (ci == DBG_CHUNK) { worst = rel;
                if (DBG_MODE == 2) { float z = 0.f; for (int i = tid; i < 16 * 512; i += 512) { const int cc = DBG_DIR ? (255 - ci) : ci; z += ((Y2[(size_t)(cc * 16) * 512 + i] & 0x7fff) > 0x7f80) ? 1.f : 0.f; }
                    z = wave_sum(z); __syncthreads(); if (lane == 0) red[16 + wave] = z; __syncthreads(); float Z = 0.f; for (int w8 = 0; w8 < 8; ++w8) Z += red[16 + w8]; worst = Z / 8192.f; } }
        }
        if (tid == 0) dbg[0] = DBG_MODE ? worst : ((first < 0) ? 0.f : (float)(first + 1) / 256.f);
    }
#endif
    if (IN(6)) {
        p5_rwkv_out(args, lane, wave, G);
        SchedDense<512> S{(const char*)(ws + WS_WUPA), G, (int)blockIdx.x};
        EpiUp<false> E{(bf16_t*)(ws + WS_MERGED), (const bf16_t*)(ws + WS_Z)};
        pg8::gemm_phase<512, EpiUp<false>, SchedDense<512>>(lds, (const char*)(ws + WS_ATT), S, E);
        SEAM(6);
    }
    if (IN(7)) {
        SchedDense<512> S{(const char*)(ws + WS_WUPR), G, (int)blockIdx.x};
        EpiUp<true> E{(bf16_t*)(ws + WS_MERGED), (const bf16_t*)(ws + WS_Z)};
        pg8::gemm_phase<512, EpiUp<true>, SchedDense<512>>(lds, (const char*)(ws + WS_RWK), S, E);
        SEAM(7);
    }
    if (IN(8)) {
        SchedDense<1024> S{(const char*)(ws + WS_WOUT), G, (int)blockIdx.x};
        EpiMix E{(float*)(ws + WS_MIX)};
        pg8::gemm_phase<1024, EpiMix, SchedDense<1024>>(lds, (const char*)(ws + WS_MERGED), S, E);
        SEAM(8);
    }
    if (IN(9)) { p9_postmix_router<false>(args, lds, tid, lane, wave, G); SEAM(9); }
    if (IN(10)) {
        moe_table(args, tstart, tid);
        SchedMoe<8, true, 1> S{(const char*)(ws + WS_WGU), G, (int)blockIdx.x, tstart, (const int*)(ws + WS_CTL) + CW_CNT, (const int*)(ws + WS_SLOT_TOK)};
        EpiMoe1 E{(bf16_t*)(ws + WS_H), args.in[I_BGU]};
        pg8::gemm_phase<1024, EpiMoe1, SchedMoe<8, true, 1>, true>(lds, (const char*)(ws + WS_HF), S, E);
        SEAM(10);
    }
    if (IN(11)) {
        moe_table(args, tstart, tid);
        SchedMoe<4, false, 1> S{(const char*)(ws + WS_WDN), G, (int)blockIdx.x, tstart, (const int*)(ws + WS_CTL) + CW_CNT, (const int*)(ws + WS_SLOT_TOK)};
        EpiMoe2 E{(bf16_t*)(ws + WS_YBUF), args.in[I_BDN], (const float*)(ws + WS_SLOT_GATE), (const int*)(ws + WS_CTL) + CW_CNT};
        pg8::gemm_phase<1024, EpiMoe2, SchedMoe<4, false, 1>, true>(lds, (const char*)(ws + WS_H), S, E);
        SEAM(11);
    }
    if (IN(12)) { moe_table(args, tstart, tid); p12_combine<false>(args, tstart, lane, wave, G); }
#ifdef PROBE_PHASE
    if (lo == 15 && blockIdx.x == 0 && tid < 32) { unsigned* ctl = (unsigned*)(ws + WS_CTL); if (tid == 0) { ctl[CW_QATT] = 0u; ctl[CW_QTR] = PROBE_QTR0; } ctl[CW_CNT + tid] = 0u; }
    if (lo == 16) p9_postmix_router<true>(args, lds, tid, lane, wave, G);
    if (lo == 17) { moe_table(args, tstart, tid); p12_combine<true>(args, tstart, lane, wave, G); }
    if (lo == 18) p4_attention(args, lds, tid, lane, wave, G);
    if (lo == 13) p3a_pointwise(args, tid, G);
    if (lo == 14) p3b_features(args, lds, tid, lane, wave, G);
#endif
#undef IN
#undef SEAM
}

extern "C" void kernel_launch(void* const* d_in, const int* in_sizes, int n_in, void* d_out, int out_size, void* d_ws, size_t ws_size, hipStream_t stream) {
    static int grid = 0;
    if (grid == 0) {
        if (n_in != 38 || out_size != T * D || ws_size < WS_END) { fprintf(stderr, "kernel_launch: unexpected problem shape (n_in %d, out %d, ws %zu)\n", n_in, out_size, ws_size); grid = -1; return; }
        int dev = 0, cus = 0, per_cu = 0;
        if (hipGetDevice(&dev) != hipSuccess || hipDeviceGetAttribute(&cus, hipDeviceAttributeMultiprocessorCount, dev) != hipSuccess) { grid = -1; return; }
        if (hipFuncSetAttribute((const void*)mega_fwd, hipFuncAttributeMaxDynamicSharedMemorySize, LDS_BYTES) != hipSuccess) { fprintf(stderr, "kernel_launch: hipFuncSetAttribute failed\n"); grid = -1; return; }
        if (hipOccupancyMaxActiveBlocksPerMultiprocessor(&per_cu, (const void*)mega_fwd, 512, LDS_BYTES) != hipSuccess || per_cu < 1) fprintf(stderr, "kernel_launch: occupancy query says %d\n", per_cu);
        (void)hipGetLastError();
        grid = cus;
    }
    if (grid < 0) return;
    (void)hipMemsetAsync((char*)d_ws + WS_CTL, 0, CTL_BYTES, stream);
    Args a{};
    for (int i = 0; i < 38; ++i) a.in[i] = (const float*)d_in[i];
    a.out = (float*)d_out; a.ws = (unsigned char*)d_ws;
#if MK_ONE_LAUNCH
    a.ph_lo = 0; a.ph_hi = N_PHASES;
    hipLaunchKernelGGL(mega_fwd, dim3(grid), dim3(512), LDS_BYTES, stream, a);
#ifdef PROBE_PHASE
#ifdef PROBE_PRE
    { a.ph_lo = PROBE_PRE; a.ph_hi = PROBE_PRE + 1; hipLaunchKernelGGL(mega_fwd, dim3(grid), dim3(512), LDS_BYTES, stream, a); }
#endif
    for (int rep = 0; rep < PROBE_REPS; ++rep) { a.ph_lo = PROBE_PHASE; a.ph_hi = PROBE_HI; a.bar_region = 1 + rep; hipLaunchKernelGGL(mega_fwd, dim3(grid), dim3(512), LDS_BYTES, stream, a); }
#endif
#else
    for (int p = 0; p < N_PHASES; ++p) { a.ph_lo = p; a.ph_hi = p + 1; hipLaunchKernelGGL(mega_fwd, dim3(grid), dim3(512), LDS_BYTES, stream, a); }
#endif
}
```

```cpp
#include <hip/hip_runtime.h>
#include <cstdio>
#include <cstdint>

#ifndef MK_ONE_LAUNCH
#define MK_ONE_LAUNCH 1
#endif
#ifndef PROBE_QTR0
#define PROBE_QTR0 0u
#endif
#ifndef PROBE_HI
#define PROBE_HI (PROBE_PHASE + 1)
#endif
#ifndef SCAN_CHUNKED
#define SCAN_CHUNKED 1
#endif
#ifndef SCAN_FORCE_DIRECT
#define SCAN_FORCE_DIRECT 0
#endif
#ifndef DBG_SCAN
#define DBG_SCAN 0
#define DBG_DIR 0
#define DBG_MODE 0
#define DBG_CHUNK 0
#endif
#ifndef DBG_NOA
#define DBG_NOA 0
#define DBG_NOB 0
#endif
#ifndef DBG_D
#define DBG_D 0
#endif
#ifndef DBG_TI
#define DBG_TI 0
#endif
#ifndef CS_LOCKSTEP
#define CS_LOCKSTEP 0
#endif

#define GAS __attribute__((address_space(1)))
#define LAS __attribute__((address_space(3)))
typedef unsigned short bf16_t;
typedef short bf16x8 __attribute__((ext_vector_type(8)));
typedef short s16x4 __attribute__((ext_vector_type(4)));
typedef float f32x4 __attribute__((ext_vector_type(4)));
typedef float f32x16 __attribute__((ext_vector_type(16)));
typedef unsigned u32x4 __attribute__((ext_vector_type(4)));
typedef unsigned u32x2 __attribute__((ext_vector_type(2)));

constexpr int NB = 8, SEQ = 4096, T = NB * SEQ, D = 1024, CL = 256, TC = NB * CL, ROWS = T + TC;
constexpr int NH = 8, HD = 64, NKV = 2, RD = 512;
constexpr int NE = 32, TOPK = 4, DE = 1024;
constexpr int PROJ_SRC = 4736;
constexpr int ZP = 4864;
constexpr int ZC_Q = 0, ZC_K = 512, ZC_V = 640, ZC_R = 768, ZC_RK = 1280, ZC_RV = 1792, ZC_LORA = 2304, ZC_G = 2816;
constexpr int NTILE_N = ZP / 256;
constexpr float RMS_EPS = 1e-6f, GN_EPS = 64e-5f;
constexpr float F8_WSCALE = 32.0f, F8_ASCALE = 4.0f, F8_HSCALE = 8.0f, F8_YSCALE = 32.0f;

constexpr size_t MiB = 1u << 20;
constexpr size_t WS_CTL = 0, CTL_BYTES = 1 * MiB;
constexpr size_t WS_WIN = 1 * MiB;
constexpr size_t WS_WUPA = 11 * MiB, WS_WUPR = 12 * MiB;
constexpr size_t WS_WOUT = 13 * MiB;
constexpr size_t WS_LORA = 15 * MiB;
constexpr size_t WS_MISC = 15 * MiB + 512 * 1024;
constexpr size_t WS_WGU = 16 * MiB;
constexpr size_t WS_WDN = 144 * MiB;
constexpr size_t WS_HX = 208 * MiB;
constexpr size_t WS_YF = 208 * MiB, WS_YB = 240 * MiB;
constexpr size_t WS_HF = 208 * MiB;
constexpr size_t WS_Z = 276 * MiB;
constexpr size_t WS_SLOT_TOK = 272 * MiB;
constexpr size_t WS_FEAT = 599 * MiB;
constexpr size_t FEAT_STRIDE = 34 * MiB;
constexpr size_t WS_MERGED = 769 * MiB;
constexpr size_t WS_MIX = 599 * MiB;
constexpr size_t WS_QR = 939 * MiB;
constexpr size_t WS_RWK = 939 * MiB;
constexpr size_t WS_KA = 971 * MiB;
constexpr size_t WS_VT = 980 * MiB;
constexpr size_t WS_ATT = 990 * MiB;
constexpr size_t WS_SLOT_GATE = 276 * MiB;
constexpr size_t WS_TOKK = 280 * MiB;
constexpr size_t WS_H = 281 * MiB;
constexpr int MAXTILES = 544, MAXSLOT = MAXTILES * 256;
constexpr size_t WS_YBUF = 553 * MiB;
constexpr size_t WS_END = 1024 * MiB;
static_assert(WS_YBUF + (size_t)MAXSLOT * 1024 * 2 <= WS_QR, "ws map");
static_assert(WS_H + (size_t)MAXSLOT * 1024 * 2 <= WS_YBUF, "ws map");
static_assert(WS_Z + (size_t)ROWS * ZP * 2 <= WS_FEAT, "ws map");
static_assert(WS_FEAT + 10 * FEAT_STRIDE <= WS_QR, "ws map");
static_assert(WS_ATT + (size_t)T * 512 * 2 <= WS_END, "ws map");
static_assert(WS_VT + 9 * MiB <= WS_ATT && WS_KA + (size_t)ROWS * 128 * 2 <= WS_VT, "ws map");
enum { F_R = 0, F_V, F_A, F_KF, F_KB, F_BF, F_BB, F_WF, F_WB, F_G };
constexpr int CW_BAR = 4096;
constexpr int CW_CNT = 8192;
constexpr int CW_QATT = 8320, CW_QTR = 8384;
constexpr int CW_MOD = 16384;
static_assert((CW_MOD + 9 * 6144) * 4 <= (int)CTL_BYTES, "ctl");

constexpr int RING_BYTES = 131072;
constexpr int MISC_OFF = RING_BYTES + 320;
constexpr int LDS_BYTES = 147456;

#define LDS_WAIT() asm volatile("s_waitcnt lgkmcnt(0)" ::: "memory")
#define VM_WAIT() asm volatile("s_waitcnt vmcnt(0)" ::: "memory")
__device__ __forceinline__ float bf2f(unsigned b) { return __uint_as_float(b << 16); }
__device__ __forceinline__ unsigned f2bf(float f) { unsigned u = __float_as_uint(f); return (u + 0x7fffu + ((u >> 16) & 1u)) >> 16; }
__device__ __forceinline__ unsigned pk2(float lo, float hi) { return f2bf(lo) | (f2bf(hi) << 16); }
__device__ __forceinline__ float lo16(unsigned w) { return __uint_as_float(w << 16); }
__device__ __forceinline__ float hi16(unsigned w) { return __uint_as_float(w & 0xffff0000u); }
__device__ __forceinline__ float sigmoidf_(float x) { return __builtin_amdgcn_rcpf(1.0f + __expf(-x)); }
__device__ __forceinline__ float wave_sum(float v) {
#pragma unroll
    for (int o = 1; o < 64; o <<= 1) v += __shfl_xor(v, o);
    return v;
}

#define XB_TMO      128
#define XB_XCNT(j)  (256  + 64 * (j))
#define XB_XSUB(j)  (1280 + 64 * (j))
#define XB_XGEN(j)  (2304 + 64 * (j))
#define XB_TOP      3328
#define XB_TOPGEN   3392
#define XCD_BAR_WORDS 3456
#define XB_SPIN_CAP (1u << 22)
__device__ __forceinline__ unsigned xb_ld(unsigned* p)              { return __hip_atomic_load(p, __ATOMIC_RELAXED, __HIP_MEMORY_SCOPE_AGENT); }
__device__ __forceinline__ unsigned xb_add(unsigned* p, unsigned v) { return __hip_atomic_fetch_add(p, v, __ATOMIC_RELAXED, __HIP_MEMORY_SCOPE_AGENT); }
__device__ __forceinline__ unsigned xb_xcc_id() { return (unsigned)__builtin_amdgcn_s_getreg((3 << 11) | 20) & 0xFu; }
#define XB_SPIN(cond, bar) do { unsigned _sp = 0; while (cond) { __builtin_amdgcn_s_sleep(1); \
    if ((++_sp & 255u) == 0u) { if (xb_ld(&(bar)[XB_TMO])) break; if (_sp > XB_SPIN_CAP) { atomicAdd(&(bar)[XB_TMO], 1u); break; } } } } while (0)
struct XcdBarrier { unsigned* bar; unsigned x; volatile LAS unsigned* st; };
__device__ __forceinline__ XcdBarrier xcd_barrier_post(unsigned* bar, volatile LAS unsigned* st) {
    XcdBarrier b; b.bar = bar; b.x = xb_xcc_id(); b.st = st;
    if (threadIdx.x == 0) (void)xb_add(&bar[XB_XCNT(b.x)], 1u);
    return b;
}
__device__ __forceinline__ void xcd_barrier_complete(unsigned* bar, unsigned x, unsigned& nloc, unsigned& nx) {
    const unsigned G = gridDim.x * gridDim.y * gridDim.z;
    unsigned sum, cnt, mine, sp = 0u;
    for (;;) {
        sum = 0u; cnt = 0u; mine = 0u;
#pragma unroll
        for (unsigned j = 0; j < 16; ++j) { const unsigned c = xb_ld(&bar[XB_XCNT(j)]); sum += c; cnt += (c > 0u) ? 1u : 0u; mine = (j == x) ? c : mine; }
        if (sum == G) break;
        __builtin_amdgcn_s_sleep(1);
        if ((++sp & 255u) == 0u) { if (xb_ld(&bar[XB_TMO])) break; if (sp > XB_SPIN_CAP) { atomicAdd(&bar[XB_TMO], 1u); break; } }
    }
    nloc = mine > 0u ? mine : 1u; nx = cnt > 0u ? cnt : 1u;
}
__device__ __forceinline__ void xcd_barrier(const XcdBarrier& b) {
    asm volatile("s_waitcnt vmcnt(0)" ::: "memory");
    __syncthreads();
    if (threadIdx.x == 0) {
        unsigned* bar = b.bar;
        __builtin_amdgcn_s_waitcnt(0);
        unsigned nloc = b.st[0], nx = b.st[1];
        if (nloc == 0u) { xcd_barrier_complete(bar, b.x, nloc, nx); b.st[0] = nloc; b.st[1] = nx; }
        const unsigned old = xb_add(&bar[XB_XSUB(b.x)], 1u);
        const unsigned gen = old / nloc;
        if (old + 1u == (gen + 1u) * nloc) {
            __builtin_amdgcn_fence(__ATOMIC_RELEASE, "agent");
            asm volatile("s_waitcnt vmcnt(0)" ::: "memory");
            const unsigned og = xb_add(&bar[XB_TOP], 1u);
            const unsigned tg = og / nx;
            if (og + 1u == (tg + 1u) * nx) xb_add(&bar[XB_TOPGEN], 1u);
            else XB_SPIN(xb_ld(&bar[XB_TOPGEN]) == tg, bar);
            __builtin_amdgcn_fence(__ATOMIC_ACQUIRE, "agent");
            xb_add(&bar[XB_XGEN(b.x)], 1u);
            asm volatile("s_waitcnt vmcnt(0)" ::: "memory");
        } else {
            XB_SPIN(xb_ld(&bar[XB_XGEN(b.x)]) == gen, bar);
            __builtin_amdgcn_fence(__ATOMIC_ACQUIRE, "agent");
            asm volatile("s_waitcnt vmcnt(0)" ::: "memory");
        }
    }
    __syncthreads();
}

namespace pg8 {
constexpr int BM = 256, BK = 64, HALF = 128, HTB = HALF * BK * 2, STAGE_BYTES = 8 * HTB;
__host__ __device__ __forceinline__ int lds_byte(int r, int c) { const int st = (r >> 4) * 2 + (c >> 5), rr = r & 15, cc = c & 31, ob = rr * 64 + cc * 2; return st * 1024 + (ob ^ (((ob >> 9) & 1) << 5)); }
__host__ __device__ __forceinline__ void stage_rc(int b, int& R, int& C) { const int st = b / 1024, sb = b % 1024, swz = sb ^ (((sb >> 9) & 1) << 5); R = (st >> 1) * 16 + swz / 64; C = (st & 1) * 32 + (swz % 64) / 2; }
__host__ __device__ __forceinline__ int perm32(int rho) { const int n = rho >> 4, i = rho & 15; return 8 * (i >> 2) + 4 * n + (i & 3); }

struct GUnit { const char* B; int pm, pn, e, lrow0; };

typedef int i32x8 __attribute__((ext_vector_type(8)));
template <int K, class Epi, class Sched, bool F8 = false>
__device__ __forceinline__ void gemm_phase(LAS unsigned char* lds, const char* Aroot, const Sched& S, const Epi& E) {
    const int tid = threadIdx.x, wid = __builtin_amdgcn_readfirstlane(tid >> 6), lane = tid & 63, wr = wid >> 2, wc = wid & 3, fr = lane & 15, fq = lane >> 4;
    constexpr int EB = F8 ? 1 : 2;
    constexpr int nt = K * EB / (BK * 2);
    int Rr[2], Cc[2]; unsigned voffB[2];
#pragma unroll
    for (int i = 0; i < 2; ++i) { int R, C; stage_rc(tid * 16 + i * 8192, R, C); const int Rb = Epi::PERM ? ((R & ~31) + perm32(R & 31)) : R;
        Rr[i] = R; Cc[i] = C; voffB[i] = (unsigned)(Rb * K * EB + C * 2); }
    constexpr size_t kstep = (size_t)(BK * 2);
    constexpr size_t hstep = (size_t)HALF * K * EB;
    const unsigned ldsw = (unsigned)wid * 1024u;
    const int aoff = lds_byte(wr * 64 + fr, fq * 8), boff = lds_byte(wc * 32 + fr, fq * 8);
#define PG8_SA(b, h) (((b) * 2 + (h)) * HTB)
#define PG8_SB(b, h) ((4 + (b) * 2 + (h)) * HTB)
#define PG8_STAGEB(bufoff, gbase) do { _Pragma("unroll") for (int _i = 0; _i < 2; ++_i) \
        __builtin_amdgcn_global_load_lds((const unsigned*)((const char*)(gbase) + voffB[_i]), (LAS unsigned*)(lds + (bufoff) + ldsw + _i * 8192), 16, 0, 0); } while (0)
#define PG8_STAGEA(bufoff, base, o0, o1, kb) do { \
        __builtin_amdgcn_global_load_lds((const unsigned*)((base) + (size_t)(kb) + (size_t)(o0)), (LAS unsigned*)(lds + (bufoff) + ldsw), 16, 0, 0); \
        __builtin_amdgcn_global_load_lds((const unsigned*)((base) + (size_t)(kb) + (size_t)(o1)), (LAS unsigned*)(lds + (bufoff) + ldsw + 8192), 16, 0, 0); } while (0)
#define PG8_LD8(dst, off) do { const u32x4 _p0 = *(const LAS u32x4*)(lds + (off)), _p1 = *(const LAS u32x4*)(lds + (off) + 1024); dst = (i32x8){(int)_p0.x, (int)_p0.y, (int)_p0.z, (int)_p0.w, (int)_p1.x, (int)_p1.y, (int)_p1.z, (int)_p1.w}; } while (0)
#define PG8_LDA(dst, b, h) do { if constexpr (F8) { _Pragma("unroll") for (int m = 0; m < 4; ++m) PG8_LD8(dst##8[m], PG8_SA(b, h) + aoff + m * 2048); } \
        else { _Pragma("unroll") for (int m = 0; m < 4; ++m) _Pragma("unroll") for (int k = 0; k < 2; ++k) dst[m][k] = *(const LAS bf16x8*)(lds + PG8_SA(b, h) + aoff + m * 2048 + k * 1024); } } while (0)
#define PG8_LDB(dst, b, h) do { if constexpr (F8) { _Pragma("unroll") for (int n = 0; n < 2; ++n) PG8_LD8(dst##8[n], PG8_SB(b, h) + boff + n * 2048); } \
        else { _Pragma("unroll") for (int n = 0; n < 2; ++n) _Pragma("unroll") for (int k = 0; k < 2; ++k) dst[n][k] = *(const LAS bf16x8*)(lds + PG8_SB(b, h) + boff + n * 2048 + k * 1024); } } while (0)
#define PG8_MMA(ai, bj, At, Bt) do { __builtin_amdgcn_s_setprio(1); _Pragma("unroll") for (int m = 0; m < 4; ++m) _Pragma("unroll") for (int n = 0; n < 2; ++n) { \
        if constexpr (F8) asm volatile("v_mfma_scale_f32_16x16x128_f8f6f4 %0, %1, %2, %0, %3, %3 op_sel_hi:[0,0,0]" : "+v"(acc[ai][bj][m][n]) : "v"(Bt##8[n]), "v"(At##8[m]), "v"(f8scale)); \
        else { _Pragma("unroll") for (int k = 0; k < 2; ++k) acc[ai][bj][m][n] = __builtin_amdgcn_mfma_f32_16x16x32_bf16(Bt[n][k], At[m][k], acc[ai][bj][m][n], 0, 0, 0); } } \
        __builtin_amdgcn_s_setprio(0); } while (0)
#define PG8_WAIT_V(n) asm volatile("s_waitcnt vmcnt(" #n ")" ::: "memory")
#define PG8_WAIT_L(n) asm volatile("s_waitcnt lgkmcnt(" #n ")" ::: "memory")
#define PG8_BAR __builtin_amdgcn_s_barrier()
#define PG8_SCHED __builtin_amdgcn_sched_barrier(0)
    GUnit cur, nxt; int ui = 0;
    if (!S.next(0, cur)) return;
    f32x4 acc[2][2][4][2];
#pragma unroll
    for (int a = 0; a < 2; ++a)
#pragma unroll
        for (int b = 0; b < 2; ++b)
#pragma unroll
            for (int m = 0; m < 4; ++m)
#pragma unroll
                for (int n = 0; n < 2; ++n) acc[a][b][m][n] = (f32x4){0.f, 0.f, 0.f, 0.f};
    bf16x8 At[4][2], B0[2][2], B1[2][2];
    const int f8scale = 0x7f7f7f7f;
    i32x8 At8[4], B08[2], B18[2];
    unsigned c00, c01, c10, c11;
    const char* cA = Aroot;
    if constexpr (Sched::GATHER) {
        c00 = S.arow(cur, Rr[0]) * (unsigned)(K * EB) + (unsigned)Cc[0] * 2u; c01 = S.arow(cur, Rr[1]) * (unsigned)(K * EB) + (unsigned)Cc[1] * 2u;
        c10 = S.arow(cur, HALF + Rr[0]) * (unsigned)(K * EB) + (unsigned)Cc[0] * 2u; c11 = S.arow(cur, HALF + Rr[1]) * (unsigned)(K * EB) + (unsigned)Cc[1] * 2u;
    } else {
        c00 = (unsigned)(Rr[0] * K * EB + Cc[0] * 2); c01 = (unsigned)(Rr[1] * K * EB + Cc[1] * 2); c10 = c00 + (unsigned)(HALF * K * EB); c11 = c01 + (unsigned)(HALF * K * EB);
        cA = Aroot + (size_t)S.arow(cur, 0) * (size_t)(K * EB);
    }
    const char* cB = cur.B;
    PG8_STAGEB(PG8_SB(0, 0), cB); PG8_STAGEA(PG8_SA(0, 0), cA, c00, c01, 0); PG8_STAGEB(PG8_SB(0, 1), cB + hstep); PG8_STAGEA(PG8_SA(0, 1), cA, c10, c11, 0);
    if (wr == 1) PG8_BAR;
    PG8_WAIT_V(4); PG8_BAR;
    PG8_STAGEB(PG8_SB(1, 0), cB + kstep); PG8_STAGEA(PG8_SA(1, 0), cA, c00, c01, kstep); PG8_STAGEB(PG8_SB(1, 1), cB + hstep + kstep);
    PG8_WAIT_V(6); PG8_BAR;
    for (;;) {
        const bool has_next = S.next(ui + 1, nxt);
        unsigned n00 = c00, n01 = c01, n10 = c10, n11 = c11; const char* nB = cB; const char* nA = cA;
        LAS u32x4* noff_lds = (LAS u32x4*)(lds + STAGE_BYTES + 2048) + tid;
        if (has_next) {
            if constexpr (Sched::GATHER) {
                int tz = tid; asm volatile("" : "+v"(tz));
                int R0, C0, R1, C1; stage_rc(tz * 16, R0, C0); stage_rc(tz * 16 + 8192, R1, C1);
                u32x4 nn;
                nn.x = S.arow(nxt, R0) * (unsigned)(K * EB) + (unsigned)C0 * 2u; nn.y = S.arow(nxt, R1) * (unsigned)(K * EB) + (unsigned)C1 * 2u;
                nn.z = S.arow(nxt, HALF + R0) * (unsigned)(K * EB) + (unsigned)C0 * 2u; nn.w = S.arow(nxt, HALF + R1) * (unsigned)(K * EB) + (unsigned)C1 * 2u;
                *((LAS u32x4*)(lds + STAGE_BYTES + 2048) + tz) = nn;
            } else nA = Aroot + (size_t)S.arow(nxt, 0) * (size_t)(K * EB);
            nB = nxt.B;
        } else if constexpr (Sched::GATHER) { *noff_lds = (u32x4){c00, c01, c10, c11}; }
        for (int t = 0; t < nt; t += 2) {
            const bool last = (t == nt - 2);
            const size_t k1 = (size_t)(t + 1) * kstep;
            const size_t k2 = last ? 0 : (size_t)(t + 2) * kstep, k3 = k2 + kstep;
            if constexpr (Sched::GATHER) { if (last) { const u32x4 nn = *noff_lds; n00 = nn.x; n01 = nn.y; n10 = nn.z; n11 = nn.w; } }
            const unsigned a00 = last ? n00 : c00, a01 = last ? n01 : c01, a10 = last ? n10 : c10, a11 = last ? n11 : c11; const char* a2 = last ? nA : cA;
            const char* b2 = last ? nB : cB + (size_t)(t + 2) * kstep; const char* b3 = b2 + kstep;
            PG8_LDB(B0, 0, 0); PG8_SCHED; PG8_LDA(At, 0, 0); PG8_STAGEA(PG8_SA(1, 1), cA, c10, c11, k1);
            PG8_WAIT_L(8); PG8_BAR; PG8_WAIT_L(0); PG8_MMA(0, 0, At, B0); PG8_BAR; PG8_SCHED;
            PG8_LDB(B1, 0, 1); PG8_STAGEB(PG8_SB(0, 0), b2);
            PG8_BAR; PG8_WAIT_L(0); PG8_MMA(0, 1, At, B1); PG8_BAR;
            PG8_LDA(At, 0, 1); PG8_STAGEA(PG8_SA(0, 0), a2, a00, a01, k2);
            PG8_BAR; PG8_WAIT_L(0); PG8_MMA(1, 0, At, B0); PG8_BAR; PG8_SCHED;
            PG8_STAGEB(PG8_SB(0, 1), b2 + hstep);
            PG8_WAIT_V(6); PG8_BAR; PG8_MMA(1, 1, At, B1); PG8_BAR;
            PG8_LDB(B0, 1, 0); PG8_SCHED; PG8_LDA(At, 1, 0); PG8_STAGEA(PG8_SA(0, 1), a2, a10, a11, k2);
            PG8_WAIT_L(8); PG8_BAR; PG8_WAIT_L(0); PG8_MMA(0, 0, At, B0); PG8_BAR; PG8_SCHED;
            PG8_LDB(B1, 1, 1); PG8_STAGEB(PG8_SB(1, 0), b3);
            PG8_BAR; PG8_WAIT_L(0); PG8_MMA(0, 1, At, B1); PG8_BAR;
            PG8_LDA(At, 1, 1); PG8_STAGEA(PG8_SA(1, 0), a2, a00, a01, k3);
            PG8_BAR; PG8_WAIT_L(0); PG8_MMA(1, 0, At, B0); PG8_BAR; PG8_SCHED;
            PG8_STAGEB(PG8_SB(1, 1), b3 + hstep);
            PG8_WAIT_V(6); PG8_BAR; PG8_MMA(1, 1, At, B1); PG8_BAR;
        }
        if (wr == 0) PG8_BAR;
        if constexpr (F8) asm volatile("s_nop 15\n\ts_nop 15" ::: "memory");
        E(acc, cur, wr, wc, fr, fq);
        if (!has_next) break;
#pragma unroll
        for (int a = 0; a < 2; ++a)
#pragma unroll
            for (int b = 0; b < 2; ++b)
#pragma unroll
                for (int m = 0; m < 4; ++m)
#pragma unroll
                    for (int n = 0; n < 2; ++n) acc[a][b][m][n] = (f32x4){0.f, 0.f, 0.f, 0.f};
        cur = nxt; cB = nB; cA = nA; c00 = n00; c01 = n01; c10 = n10; c11 = n11; ++ui;
        if (wr == 1) PG8_BAR;
    }
    PG8_WAIT_V(0);
    PG8_BAR;
#undef PG8_SA
#undef PG8_SB
#undef PG8_STAGEA
#undef PG8_STAGEB
#undef PG8_LDA
#undef PG8_LDB
#undef PG8_MMA
#undef PG8_LD8
#undef PG8_WAIT_V
#undef PG8_WAIT_L
#undef PG8_BAR
#undef PG8_SCHED
}
}
using pg8::GUnit;

struct Args { const float* in[38]; float* out; unsigned char* ws; int ph_lo, ph_hi, bar_region, pad; };
enum { I_X = 0, I_C, I_CTX, I_CCTX, I_WADA, I_BADA, I_GPREMIX, I_GPOSTMIX, I_GPREFFN, I_GPOSTFFN, I_WIN, I_BIN, I_MUP, I_MUN, I_SINKS, I_W0F, I_W0B, I_W2F, I_W2B,
       I_A0F, I_A0B, I_A2F, I_A2B, I_G2, I_KK, I_KA, I_RK, I_LNW, I_LNB, I_WUPA, I_WUPR, I_WOUT, I_WROUTER, I_BROUTER, I_WGU, I_BGU, I_WDN, I_BDN };

__device__ __forceinline__ unsigned pk4_fp8(float a, float b, float c, float d) { int w = 0; w = __builtin_amdgcn_cvt_pk_fp8_f32(a, b, w, false); w = __builtin_amdgcn_cvt_pk_fp8_f32(c, d, w, true); return (unsigned)w; }
typedef float f32x2_t __attribute__((ext_vector_type(2)));
typedef __bf16 bf16x2_t __attribute__((ext_vector_type(2)));
__device__ __forceinline__ unsigned cvt_pk_bf16_asm(float lo, float hi) { unsigned r; asm volatile("v_cvt_pk_bf16_f32 %0, %1, %2" : "=v"(r) : "v"(lo), "v"(hi)); return r; }
__device__ __forceinline__ unsigned cvt_pk_bf16(float lo, float hi) { const f32x2_t v = {lo, hi}; const bf16x2_t b = __builtin_convertvector(v, bf16x2_t); return __builtin_bit_cast(unsigned, b); }

__device__ __forceinline__ void tile_order(int L, int nM, int nN, int& pm, int& pn) {
    const int nwg = nM * nN; int wgid = L;
    { const int q = nwg / 8, r = nwg % 8, xcd = wgid % 8, off = wgid / 8; wgid = (xcd < r ? xcd * (q + 1) : r * (q + 1) + (xcd - r) * q) + off; }
    const int nig = 8 * nN, gid = wgid / nig, fm = gid * 8, gsz = (nM - fm) < 8 ? (nM - fm) : 8;
    pm = fm + ((wgid % nig) % gsz); pn = (wgid % nig) / gsz;
}

struct SchedProj {           static constexpr bool GATHER = false;
    const char* Bt; int G, c;
    __device__ __forceinline__ bool next(int i, GUnit& u) const {
        const int L = i * G + c; constexpr int NXU = 128 * NTILE_N;
        if (L >= NXU + 72) return false;
        int pm, pn;
        if (L < NXU) tile_order(L, 128, NTILE_N, pm, pn); else { const int l2 = L - NXU; pm = 128 + l2 / 9; pn = 2 + l2 % 9; }
        u.pm = pm; u.pn = pn; u.e = 0; u.lrow0 = 0; u.B = Bt + (size_t)pn * 256 * D * 2; return true;
    }
    __device__ __forceinline__ unsigned arow(const GUnit& u, int r) const { return (unsigned)(u.pm * 256 + r); }
};
template <int K> struct SchedDense {
    static constexpr bool GATHER = false;
    const char* Bt; int G, c;
    __device__ __forceinline__ bool next(int i, GUnit& u) const {
        const int L = i * G + c; if (L >= 128 * 4) return false;
        int pm, pn; tile_order(L, 128, 4, pm, pn);
        u.pm = pm; u.pn = pn; u.e = 0; u.lrow0 = 0; u.B = Bt + (size_t)pn * 256 * K * 2; return true;
    }
    __device__ __forceinline__ unsigned arow(const GUnit& u, int r) const { return (unsigned)(u.pm * 256 + r); }
};
template <int NPN, bool GATHER_, int EB = 2> struct SchedMoe {
    static constexpr bool GATHER = GATHER_;
    const char* Bt; int G, c; const LAS int* tstart; const int* cnt; const int* slot_tok;
    __device__ __forceinline__ bool next(int i, GUnit& u) const {
        const int L = i * G + c; const int TT = __builtin_amdgcn_readfirstlane(tstart[NE]);
        if (L >= TT * NPN) return false;
        const int rt = L / NPN, pn = L % NPN; int e = 0;
#pragma unroll
        for (int j = 1; j < NE; ++j) e += (tstart[j] <= rt) ? 1 : 0;
        e = __builtin_amdgcn_readfirstlane(e);
        u.pm = rt; u.pn = pn; u.e = e; u.lrow0 = __builtin_amdgcn_readfirstlane((rt - tstart[e]) * 256);
        u.B = Bt + ((size_t)e * (NPN * 256) + (size_t)pn * 256) * DE * EB; return true;
    }
    __device__ __forceinline__ unsigned arow(const GUnit& u, int r) const {
        if (GATHER) { const int lr = u.lrow0 + r; const int n = cnt[u.e]; const unsigned tok = (unsigned)slot_tok[u.e * T + (lr < T ? lr : T - 1)]; return (lr < n) ? tok : 0u; }
        return (unsigned)(u.pm * 256 + r);
    }
};

struct EpiZ {
    static constexpr bool PERM = true;
    bf16_t* Z; const float* bias;
    __device__ __forceinline__ void operator()(const f32x4 (&acc)[2][2][4][2], const GUnit& u, int wr, int wc, int fr, int fq) const {
        const int row0 = u.pm * 256 + wr * 64 + fr, col0 = u.pn * 256 + wc * 32 + 8 * fq;
        f32x4 bv[2][2];
#pragma unroll
        for (int bj = 0; bj < 2; ++bj)
#pragma unroll
            for (int n = 0; n < 2; ++n) bv[bj][n] = *(const f32x4*)(bias + col0 + bj * 128 + 4 * n);
#pragma unroll
        for (int ai = 0; ai < 2; ++ai)
#pragma unroll
            for (int m = 0; m < 4; ++m) { bf16_t* rowp = Z + (size_t)(row0 + ai * 128 + m * 16) * ZP + col0;
#pragma unroll
                for (int bj = 0; bj < 2; ++bj) { const f32x4 v0 = acc[ai][bj][m][0] + bv[bj][0], v1 = acc[ai][bj][m][1] + bv[bj][1];
                    u32x4 w; w.x = cvt_pk_bf16(v0[0], v0[1]); w.y = cvt_pk_bf16(v0[2], v0[3]); w.z = cvt_pk_bf16(v1[0], v1[1]); w.w = cvt_pk_bf16(v1[2], v1[3]);
                    *(u32x4*)(rowp + bj * 128) = w; } }
    }
};
template <bool SECOND> struct EpiUp {
    static constexpr bool PERM = true;
    bf16_t* O; const bf16_t* Z;
    __device__ __forceinline__ void operator()(const f32x4 (&acc)[2][2][4][2], const GUnit& u, int wr, int wc, int fr, int fq) const {
        const int row0 = u.pm * 256 + wr * 64 + fr, col0 = u.pn * 256 + wc * 32 + 8 * fq;
#pragma unroll
        for (int ai = 0; ai < 2; ++ai)
#pragma unroll
            for (int m = 0; m < 4; ++m) { const size_t row = (size_t)(row0 + ai * 128 + m * 16);
#pragma unroll
                for (int bj = 0; bj < 2; ++bj) {
                    const u32x4 g = *(const u32x4*)(Z + row * ZP + ZC_G + (SECOND ? 1024 : 0) + col0 + bj * 128);
                    const f32x4 a0 = acc[ai][bj][m][0], a1 = acc[ai][bj][m][1];
                    float o[8];
                    o[0] = sigmoidf_(lo16(g.x)) * a0[0]; o[1] = sigmoidf_(hi16(g.x)) * a0[1]; o[2] = sigmoidf_(lo16(g.y)) * a0[2]; o[3] = sigmoidf_(hi16(g.y)) * a0[3];
                    o[4] = sigmoidf_(lo16(g.z)) * a1[0]; o[5] = sigmoidf_(hi16(g.z)) * a1[1]; o[6] = sigmoidf_(lo16(g.w)) * a1[2]; o[7] = sigmoidf_(hi16(g.w)) * a1[3];
                    bf16_t* op = O + row * 1024 + col0 + bj * 128;
                    if (SECOND) { const u32x4 p = *(const u32x4*)op;
                        o[0] += lo16(p.x); o[1] += hi16(p.x); o[2] += lo16(p.y); o[3] += hi16(p.y); o[4] += lo16(p.z); o[5] += hi16(p.z); o[6] += lo16(p.w); o[7] += hi16(p.w); }
                    u32x4 w; w.x = cvt_pk_bf16(o[0], o[1]); w.y = cvt_pk_bf16(o[2], o[3]); w.z = cvt_pk_bf16(o[4], o[5]); w.w = cvt_pk_bf16(o[6], o[7]);
                    *(u32x4*)op = w; } }
    }
};
struct EpiMix {
    static constexpr bool PERM = false;
    float* C;
    __device__ __forceinline__ void operator()(const f32x4 (&acc)[2][2][4][2], const GUnit& u, int wr, int wc, int fr, int fq) const {
        const int row0 = u.pm * 256 + wr * 64 + fr, col0 = u.pn * 256 + wc * 32 + 4 * fq;
#pragma unroll
        for (int ai = 0; ai < 2; ++ai)
#pragma unroll
            for (int m = 0; m < 4; ++m) { float* rowp = C + (size_t)(row0 + ai * 128 + m * 16) * 1024 + col0;
#pragma unroll
                for (int bj = 0; bj < 2; ++bj)
#pragma unroll
                    for (int n = 0; n < 2; ++n) *(f32x4*)(rowp + bj * 128 + n * 16) = acc[ai][bj][m][n]; }
    }
};
__device__ __forceinline__ float swiglu1(float g, float up) {
    g = fminf(g, 7.0f); up = fminf(fmaxf(up, -7.0f), 7.0f);
    return (up + 1.0f) * (g * sigmoidf_(1.702f * g));
}
struct EpiMoe1 {
    static constexpr bool PERM = true;
    bf16_t* H; const float* bgu;
    __device__ __forceinline__ void operator()(const f32x4 (&acc)[2][2][4][2], const GUnit& u, int wr, int wc, int fr, int fq) const {
        const int row0 = u.pm * 256 + wr * 64 + fr, col0 = u.pn * 256 + wc * 32 + 8 * fq;
        const float* b = bgu + (size_t)u.e * 2048 + col0;
        constexpr float sc = 1.0f / (F8_WSCALE * F8_ASCALE);
#pragma unroll
        for (int bj = 0; bj < 2; ++bj) {
            const f32x4 b0 = *(const f32x4*)(b + bj * 128), b1 = *(const f32x4*)(b + bj * 128 + 4);
#pragma unroll
            for (int ai = 0; ai < 2; ++ai)
#pragma unroll
                for (int m = 0; m < 4; ++m) {
                    const f32x4 v0 = acc[ai][bj][m][0] * sc + b0, v1 = acc[ai][bj][m][1] * sc + b1;
                    *(unsigned*)((unsigned char*)H + (size_t)(row0 + ai * 128 + m * 16) * 1024 + (col0 >> 1) + bj * 64) =
                        pk4_fp8(swiglu1(v0[0], v0[1]) * F8_HSCALE, swiglu1(v0[2], v0[3]) * F8_HSCALE, swiglu1(v1[0], v1[1]) * F8_HSCALE, swiglu1(v1[2], v1[3]) * F8_HSCALE);
                }
        }
    }
};
struct EpiMoe2 {
    static constexpr bool PERM = true;
    unsigned char* Y; const float* bdn; const float* slot_gate; const int* cnt;
    __device__ __forceinline__ void operator()(const f32x4 (&acc)[2][2][4][2], const GUnit& u, int wr, int wc, int fr, int fq) const {
        const int r0 = wr * 64 + fr, col0 = u.pn * 256 + wc * 32 + 8 * fq;
        const float* b = bdn + (size_t)u.e * 1024 + col0; const int n_e = cnt[u.e];
        constexpr float sc = 1.0f / (F8_WSCALE * F8_HSCALE);
        f32x4 bv[2][2];
#pragma unroll
        for (int bj = 0; bj < 2; ++bj)
#pragma unroll
            for (int n = 0; n < 2; ++n) bv[bj][n] = *(const f32x4*)(b + bj * 128 + 4 * n);
#pragma unroll
        for (int ai = 0; ai < 2; ++ai)
#pragma unroll
            for (int m = 0; m < 4; ++m) { const int r = r0 + ai * 128 + m * 16; const int lr = u.lrow0 + r;
                const float gt = ((lr < n_e) ? slot_gate[(size_t)u.e * T + lr] : 0.0f) * F8_YSCALE;
                unsigned char* rowp = Y + (size_t)(u.pm * 256 + r) * 1024 + col0;
#pragma unroll
                for (int bj = 0; bj < 2; ++bj) { const f32x4 v0 = (acc[ai][bj][m][0] * sc + bv[bj][0]) * gt, v1 = (acc[ai][bj][m][1] * sc + bv[bj][1]) * gt;
                    u32x2 w; w.x = pk4_fp8(v0[0], v0[1], v0[2], v0[3]); w.y = pk4_fp8(v1[0], v1[1], v1[2], v1[3]);
                    *(u32x2*)(rowp + bj * 128) = w; } }
    }
};

__device__ __forceinline__ void p0_transpose_item(const float* W, int K, int N, bf16_t* WT, int row_off, LAS float* scr, int item, int lane) {
    const int nblk = N / 32, kb = item / nblk, nb = item % nblk, k0 = 64 * kb, n0 = 32 * nb;
#pragma unroll 8
    for (int i = 0; i < 32; ++i) { const int kk = 2 * i + (lane >> 5); scr[kk * 33 + (lane & 31)] = W[(size_t)(k0 + kk) * N + n0 + (lane & 31)]; }
    LDS_WAIT(); asm volatile("" ::: "memory");
    const int c = lane & 7;
#pragma unroll
    for (int j = 0; j < 4; ++j) { const int n = (lane >> 3) + 8 * j; const LAS float* s = scr + (8 * c) * 33 + n;
        u32x4 o; o.x = pk2(s[0 * 33], s[1 * 33]); o.y = pk2(s[2 * 33], s[3 * 33]); o.z = pk2(s[4 * 33], s[5 * 33]); o.w = pk2(s[6 * 33], s[7 * 33]);
        *(u32x4*)(WT + (size_t)(row_off + n0 + n) * K + k0 + 8 * c) = o; }
    LDS_WAIT(); asm volatile("" ::: "memory");
}
__device__ __forceinline__ void p0_prologue(const Args& a, LAS unsigned char* lds, int tid, int lane, int wave, int G) {
    unsigned char* ws = a.ws;
    {
        float* MOD = (float*)(ws + WS_CTL) + CW_MOD;
        LAS float* sl = (LAS float*)lds;
        LAS float* red = sl + 9 * 1024;
        if (blockIdx.x < 96) {
            for (int i = tid; i < 9 * 1024; i += 512) { const int r = i >> 10, k = i & 1023; const float v = (r < 8) ? a.in[I_C][r * D + k] : a.in[I_CCTX][k]; sl[i] = v * sigmoidf_(v); }
            __syncthreads();
            for (int it = blockIdx.x; it < 96; it += G) {
                const int n = it * 64 + lane; float acc[9];
#pragma unroll
                for (int r = 0; r < 9; ++r) acc[r] = 0.f;
                const float* w = a.in[I_WADA] + (size_t)(wave * 128) * 6144 + n;
#pragma unroll 8
                for (int kk = 0; kk < 128; ++kk) { const float wv = w[(size_t)kk * 6144];
#pragma unroll
                    for (int r = 0; r < 9; ++r) acc[r] += sl[r * 1024 + wave * 128 + kk] * wv; }
#pragma unroll
                for (int r = 0; r < 9; ++r) red[(wave * 9 + r) * 64 + lane] = acc[r];
                __syncthreads();
                for (int i = tid; i < 9 * 64; i += 512) { const int r = i >> 6, c = i & 63; float s = a.in[I_BADA][it * 64 + c];
#pragma unroll
                    for (int w8 = 0; w8 < 8; ++w8) s += red[(w8 * 9 + r) * 64 + c];
                    MOD[r * 6144 + it * 64 + c] = s; }
                __syncthreads();
            }
        }
        __syncthreads();
    }
    {
        float* misc = (float*)(ws + WS_MISC);
        const int gt = blockIdx.x * 512 + tid, NGT = G * 512;
        for (int n = gt; n < ZP; n += NGT) misc[n] = (n < 2688) ? a.in[I_BIN][n] : ((n < 2816) ? 0.f : a.in[I_BIN][n - 128]);
        for (int n = gt; n < 1024; n += NGT) { const int p = n >> 4, i = n & 15; const float inv = powf(10000.0f, -(float)i / 16.0f); float s, c; sincosf((float)p * inv, &s, &c); misc[ZP + n] = c; misc[ZP + 1024 + n] = s; }
        u32x4* zr = (u32x4*)((bf16_t*)(ws + WS_WIN) + (size_t)2688 * D);
        for (int n = gt; n < 128 * D / 8; n += NGT) zr[n] = (u32x4){0u, 0u, 0u, 0u};
    }
    {
        LAS float* scr = (LAS float*)(lds + wave * 8704);
        const int gw = blockIdx.x * 8 + wave, NGW = G * 8;
        constexpr int J_IN = 16 * (PROJ_SRC / 32), J_UP = 8 * 32, J_OUT = 16 * 32, J_L = 16, J_G2 = 32, J_GU1 = 16 * 64, J_DN1 = 16 * 32;
        constexpr int NITEMS = J_IN + 2 * J_UP + J_OUT + 4 * J_L + J_G2;
        bf16_t* lora = (bf16_t*)(ws + WS_LORA);
        for (int it = gw; it < NITEMS; it += NGW) {
            int r = it;
            if (r < J_IN) { const int nb = r % (PROJ_SRC / 32); p0_transpose_item(a.in[I_WIN], D, PROJ_SRC, (bf16_t*)(ws + WS_WIN), (nb * 32 >= 2688) ? 128 : 0, scr, r, lane); continue; } r -= J_IN;
            if (r < J_UP) { p0_transpose_item(a.in[I_WUPA], 512, D, (bf16_t*)(ws + WS_WUPA), 0, scr, r, lane); continue; } r -= J_UP;
            if (r < J_UP) { p0_transpose_item(a.in[I_WUPR], 512, D, (bf16_t*)(ws + WS_WUPR), 0, scr, r, lane); continue; } r -= J_UP;
            if (r < J_OUT) { p0_transpose_item(a.in[I_WOUT], D, D, (bf16_t*)(ws + WS_WOUT), 0, scr, r, lane); continue; } r -= J_OUT;
            if (r < J_L) { p0_transpose_item(a.in[I_W2F], 64, 512, lora, 0, scr, r, lane); continue; } r -= J_L;
            if (r < J_L) { p0_transpose_item(a.in[I_W2B], 64, 512, lora + 32768, 0, scr, r, lane); continue; } r -= J_L;
            if (r < J_L) { p0_transpose_item(a.in[I_A2F], 64, 512, lora + 2 * 32768, 0, scr, r, lane); continue; } r -= J_L;
            if (r < J_L) { p0_transpose_item(a.in[I_A2B], 64, 512, lora + 3 * 32768, 0, scr, r, lane); continue; } r -= J_L;
            p0_transpose_item(a.in[I_G2], 128, 512, lora + 4 * 32768, 0, scr, r, lane);
        }
    }
}

__device__ __forceinline__ void p0_transpose_item_f8(const float* W, int K, int N, unsigned char* WT, LAS float* scr, int item, int lane, float sc) {
    const int nblk = N / 32, kb = item / nblk, nb = item % nblk, k0 = 64 * kb, n0 = 32 * nb;
#pragma unroll 8
    for (int i = 0; i < 32; ++i) { const int kk = 2 * i + (lane >> 5); scr[kk * 33 + (lane & 31)] = W[(size_t)(k0 + kk) * N + n0 + (lane & 31)] * sc; }
    LDS_WAIT(); asm volatile("" ::: "memory");
    const int c = lane & 7;
#pragma unroll
    for (int j = 0; j < 4; ++j) { const int n = (lane >> 3) + 8 * j; const LAS float* s = scr + (8 * c) * 33 + n;
        u32x2 o; o.x = pk4_fp8(s[0 * 33], s[1 * 33], s[2 * 33], s[3 * 33]); o.y = pk4_fp8(s[4 * 33], s[5 * 33], s[6 * 33], s[7 * 33]);
        *(u32x2*)(WT + (size_t)(n0 + n) * K + k0 + 8 * c) = o; }
    LDS_WAIT(); asm volatile("" ::: "memory");
}
__device__ __forceinline__ int queue_pull(unsigned* q, LAS unsigned char* lds, int tid) {
    volatile LAS int* w = (volatile LAS int*)(lds + RING_BYTES + 256);
    __syncthreads();
    if (tid == 0) *w = (int)__hip_atomic_fetch_add(q, 1u, __ATOMIC_RELAXED, __HIP_MEMORY_SCOPE_AGENT);
    __syncthreads();
    return *w;
}
__device__ __forceinline__ void moe_weight_copies(const Args& a, LAS unsigned char* lds, int tid, int lane, int wave) {
    unsigned char* ws = a.ws;
    LAS float* scr = (LAS float*)(lds + wave * 8704);
    constexpr int J_GU1 = 16 * 64, J_DN1 = 16 * 32, NCHUNK = (NE * J_GU1 + NE * J_DN1) / 128;
    unsigned* q = (unsigned*)(ws + WS_CTL) + CW_QTR;
    for (;;) {
        const int ch = queue_pull(q, lds, tid);
        if (ch >= NCHUNK) break;
#pragma unroll 1
        for (int k = 0; k < 16; ++k) {
            int r = ch * 128 + wave * 16 + k;
            if (r < NE * J_GU1) { const int e = r / J_GU1; p0_transpose_item_f8(a.in[I_WGU] + (size_t)e * D * 2048, D, 2048, (unsigned char*)(ws + WS_WGU) + (size_t)e * 2048 * D, scr, r % J_GU1, lane, F8_WSCALE); }
            else { r -= NE * J_GU1; const int e = r / J_DN1; p0_transpose_item_f8(a.in[I_WDN] + (size_t)e * DE * D, DE, D, (unsigned char*)(ws + WS_WDN) + (size_t)e * D * DE, scr, r % J_DN1, lane, F8_WSCALE); }
        }
    }
}

__device__ __forceinline__ void p1_norm(const Args& a, int lane, int wave, int G) {
    const float* MOD = (const float*)(a.ws + WS_CTL) + CW_MOD;
    bf16_t* HX = (bf16_t*)(a.ws + WS_HX);
    const int gw = blockIdx.x * 8 + wave, NGW = G * 8;
    for (int m = gw; m < ROWS; m += NGW) {
        const float* xrow = (m < T) ? a.in[I_X] + (size_t)m * D : a.in[I_CTX] + (size_t)(m - T) * D;
        const int r = (m < T) ? (m >> 12) : 8;
        const f32x4* xr = (const f32x4*)xrow + lane;
        f32x4 v[4]; float s = 0.f;
#pragma unroll
        for (int j = 0; j < 4; ++j) { v[j] = xr[64 * j]; s += (v[j].x * v[j].x + v[j].y * v[j].y) + (v[j].z * v[j].z + v[j].w * v[j].w); }
        const float rstd = 1.0f / sqrtf(wave_sum(s) * (1.f / D) + RMS_EPS);
        unsigned long long* o8 = (unsigned long long*)(HX + (size_t)m * D) + lane;
#pragma unroll
        for (int j = 0; j < 4; ++j) {
            const f32x4 g = ((const f32x4*)a.in[I_GPREMIX])[64 * j + lane], sh = ((const f32x4*)(MOD + r * 6144))[64 * j + lane], sc = ((const f32x4*)(MOD + r * 6144 + 1024))[64 * j + lane];
            const f32x4 h = (v[j] * rstd * g) * (sc + 1.0f) + sh;
            o8[64 * j] = (unsigned long long)pk2(h.x, h.y) | ((unsigned long long)pk2(h.z, h.w) << 32);
        }
    }
}

constexpr size_t WS_ACT = WS_HX;
__device__ __forceinline__ void p3a_pointwise(const Args& a, int tid, int G) {
    unsigned char* ws = a.ws;
    const bf16_t* Z = (const bf16_t*)(ws + WS_Z);
    bf16_t* FB = (bf16_t*)(ws + WS_FEAT); bf16_t* ACT = (bf16_t*)(ws + WS_ACT);
    const float* rc = (const float*)(ws + WS_MISC) + ZP; const float* rs = rc + 1024;
    const int cv = tid % 240, rg = tid / 240;
    float mp[8], mn[8];
    if (tid < 480) {
#pragma unroll
        for (int j = 0; j < 8; ++j) { mp[j] = a.in[I_MUP][8 * cv + j]; mn[j] = a.in[I_MUN][8 * cv + j]; }
    }
    for (int unit = blockIdx.x; unit < ROWS / 16; unit += G) {
        const int row0 = unit * 16;
        const bool isx = row0 < T;
        const int slen = isx ? SEQ : CL;
        const int pos0 = isx ? (row0 & (SEQ - 1)) : ((row0 - T) & (CL - 1));
        if (tid < 480) {
            const int r0 = row0 + 8 * rg, p0 = pos0 + 8 * rg;
            const bf16_t* zp = Z + (size_t)r0 * ZP + ZC_R + 8 * cv;
            u32x4 prv = (u32x4){0u, 0u, 0u, 0u};
            if (p0 > 0) prv = *(const u32x4*)(zp - ZP);
            u32x4 cur = *(const u32x4*)zp;
#pragma unroll
            for (int i = 0; i < 8; ++i) {
                u32x4 nxt = (u32x4){0u, 0u, 0u, 0u};
                if (p0 + i < slen - 1) nxt = *(const u32x4*)(zp + (size_t)(i + 1) * ZP);
                float o[8];
#pragma unroll
                for (int j = 0; j < 4; ++j) {
                    const float c0 = lo16(cur[j]), c1 = hi16(cur[j]);
                    o[2 * j] = c0 + mp[2 * j] * (lo16(prv[j]) - c0) + mn[2 * j] * (lo16(nxt[j]) - c0);
                    o[2 * j + 1] = c1 + mp[2 * j + 1] * (hi16(prv[j]) - c1) + mn[2 * j + 1] * (hi16(nxt[j]) - c1);
                }
                bf16_t* op;
                if (cv < 64) op = FB + (size_t)F_R * (FEAT_STRIDE / 2) + (size_t)(r0 + i) * RD + 8 * cv;
                else if (cv < 128) op = FB + (size_t)F_A * (FEAT_STRIDE / 2) + (size_t)(r0 + i) * RD + 8 * (cv - 64);
                else if (cv < 192) op = FB + (size_t)F_V * (FEAT_STRIDE / 2) + (size_t)(r0 + i) * RD + 8 * (cv - 128);
                else {
                    op = ACT + (size_t)(r0 + i) * 384 + 8 * (cv - 192);
                    if (cv < 208) {
#pragma unroll
                        for (int j = 0; j < 8; ++j) o[j] = 1.0f - 2.0f * __builtin_amdgcn_rcpf(__expf(2.0f * o[j]) + 1.0f);
                    } else if (cv >= 224) {
#pragma unroll
                        for (int j = 0; j < 8; ++j) o[j] = sigmoidf_(o[j]);
                    }
                }
                u32x4 w; w.x = pk2(o[0], o[1]); w.y = pk2(o[2], o[3]); w.z = pk2(o[4], o[5]); w.w = pk2(o[6], o[7]);
                *(u32x4*)op = w;
                prv = cur; cur = nxt;
            }
        }
        {
            bf16_t* QR = (bf16_t*)(ws + WS_QR); bf16_t* KA = (bf16_t*)(ws + WS_KA); bf16_t* VT = (bf16_t*)(ws + WS_VT);
#pragma unroll 1
            for (int idx = tid; idx < 16 * 40; idx += 512) {
                const int tk = idx / 40, j = idx % 40; const int row = row0 + tk, pos = pos0 + tk;
                const int hh = j >> 2, part = (j >> 1) & 1, sub = j & 1;
                const bool isq = hh < 8;
                if (isq && !isx) continue;
                const int zc = isq ? (ZC_Q + hh * 64) : (ZC_K + (hh - 8) * 64);
                const bf16_t* zp = Z + (size_t)row * ZP + zc + part * 32 + sub * 8;
                const u32x4 t1 = *(const u32x4*)zp, t2 = *(const u32x4*)(zp + 16);
                float x1[8], x2[8], o1[8], o2[8];
#pragma unroll
                for (int q = 0; q < 4; ++q) { x1[2 * q] = lo16(t1[q]); x1[2 * q + 1] = hi16(t1[q]); x2[2 * q] = lo16(t2[q]); x2[2 * q + 1] = hi16(t2[q]); }
                if (isx) {
                    const int p = part ? (pos & 63) : (pos >> 6);
                    const float sc = isq ? (0.125f * 1.44269504089f) : 1.0f;
                    const f32x4 cA = *(const f32x4*)(rc + p * 16 + sub * 8), cB = *(const f32x4*)(rc + p * 16 + sub * 8 + 4), sA = *(const f32x4*)(rs + p * 16 + sub * 8), sB = *(const f32x4*)(rs + p * 16 + sub * 8 + 4);
#pragma unroll
                    for (int q = 0; q < 8; ++q) { const float c = q < 4 ? cA[q & 3] : cB[q & 3], s = q < 4 ? sA[q & 3] : sB[q & 3];
                        o1[q] = (x1[q] * c - x2[q] * s) * sc; o2[q] = (x2[q] * c + x1[q] * s) * sc; }
                } else {
#pragma unroll
                    for (int q = 0; q < 8; ++q) { o1[q] = x1[q]; o2[q] = x2[q]; }
                }
                u32x4 w1, w2;
#pragma unroll
                for (int q = 0; q < 4; ++q) { w1[q] = pk2(o1[2 * q], o1[2 * q + 1]); w2[q] = pk2(o2[2 * q], o2[2 * q + 1]); }
                bf16_t* op = isq ? (QR + (size_t)row * 512 + hh * 64 + part * 32 + sub * 8) : (KA + (size_t)row * 128 + (hh - 8) * 64 + part * 32 + sub * 8);
                *(u32x4*)op = w1; *(u32x4*)(op + 16) = w2;
            }
            if (tid < 256) {
                const int cidx = tid & 127, tg = tid >> 7; const int g = cidx >> 6, d = cidx & 63;
                unsigned short vv[8];
#pragma unroll
                for (int q = 0; q < 8; ++q) vv[q] = Z[(size_t)(row0 + 8 * tg + q) * ZP + ZC_V + cidx];
                u32x4 w; w.x = vv[0] | ((unsigned)vv[1] << 16); w.y = vv[2] | ((unsigned)vv[3] << 16); w.z = vv[4] | ((unsigned)vv[5] << 16); w.w = vv[6] | ((unsigned)vv[7] << 16);
                bf16_t* op;
                if (isx) { const int b = row0 >> 12; op = VT + ((size_t)(b * 2 + g) * 64 + d) * SEQ + pos0 + 8 * tg; }
                else { const int b = (row0 - T) >> 8; op = VT + (size_t)NB * 2 * 64 * SEQ + ((size_t)(b * 2 + g) * 64 + d) * CL + pos0 + 8 * tg; }
                *(u32x4*)op = w;
            }
        }
    }
}

__device__ __forceinline__ void p3b_features(const Args& a, LAS unsigned char* lds, int tid, int lane, int wave, int G) {
    unsigned char* ws = a.ws;
    const bf16_t* lora = (const bf16_t*)(ws + WS_LORA);
    const bf16_t* ACT = (const bf16_t*)(ws + WS_ACT);
    bf16_t* FB = (bf16_t*)(ws + WS_FEAT);
    const int h = blockIdx.x & 7;
    constexpr int P64 = 72, P128 = 136;
    LAS bf16_t* WL = (LAS bf16_t*)lds;
    LAS bf16_t* WG2 = WL + 4 * 64 * P64;
    __syncthreads();
    for (int i = tid; i < 4 * 64 * 8; i += 512) { const int m = i >> 9, r = (i >> 3) & 63, c = i & 7; const int ch = 16 * ((r >> 2) & 3) + 4 * (r >> 4) + (r & 3);
        *(LAS u32x4*)(WL + (m * 64 + r) * P64 + 8 * c) = *(const u32x4*)(lora + (size_t)m * 32768 + (size_t)(h * 64 + ch) * 64 + 8 * c); }
    for (int i = tid; i < 64 * 16; i += 512) { const int r = i >> 4, c = i & 15; const int ch = 16 * ((r >> 2) & 3) + 4 * (r >> 4) + (r & 3);
        *(LAS u32x4*)(WG2 + r * P128 + 8 * c) = *(const u32x4*)(lora + (size_t)4 * 32768 + (size_t)(h * 64 + ch) * 128 + 8 * c); }
    __syncthreads();
    const int tk = lane & 15, cg = lane >> 4;
    f32x4 w0f[4], w0b[4], a0f[4], a0b[4], kkw[4], kaw[4];
#pragma unroll
    for (int cs = 0; cs < 4; ++cs) { const int c = h * 64 + 16 * cg + 4 * cs;
        w0f[cs] = *(const f32x4*)(a.in[I_W0F] + c); w0b[cs] = *(const f32x4*)(a.in[I_W0B] + c); a0f[cs] = *(const f32x4*)(a.in[I_A0F] + c); a0b[cs] = *(const f32x4*)(a.in[I_A0B] + c);
        kkw[cs] = *(const f32x4*)(a.in[I_KK] + c); kaw[cs] = *(const f32x4*)(a.in[I_KA] + c); }
    for (int tt = blockIdx.x >> 3; tt < ROWS / 128; tt += (G >> 3)) {
        const int row = tt * 128 + 16 * wave + tk;
        bf16x8 bfr[12];
        const bf16_t* ap = ACT + (size_t)row * 384 + 8 * cg;
#pragma unroll
        for (int kb = 0; kb < 12; ++kb) bfr[kb] = *(const bf16x8*)(ap + 32 * kb);
        bf16_t* frow = FB + (size_t)row * RD + h * 64 + 16 * cg;
        u32x2 kraw[4];
#pragma unroll
        for (int cs = 0; cs < 4; ++cs) kraw[cs] = *(const u32x2*)(frow + (size_t)F_A * (FEAT_STRIDE / 2) + 4 * cs);
        auto store16 = [&](int arr, const f32x4 (&v)[4]) {
            u32x4 w0, w1;
            w0.x = cvt_pk_bf16_asm(v[0][0], v[0][1]); w0.y = cvt_pk_bf16_asm(v[0][2], v[0][3]); w0.z = cvt_pk_bf16_asm(v[1][0], v[1][1]); w0.w = cvt_pk_bf16_asm(v[1][2], v[1][3]);
            w1.x = cvt_pk_bf16_asm(v[2][0], v[2][1]); w1.y = cvt_pk_bf16_asm(v[2][2], v[2][3]); w1.z = cvt_pk_bf16_asm(v[3][0], v[3][1]); w1.w = cvt_pk_bf16_asm(v[3][2], v[3][3]);
            u32x4* p = (u32x4*)(frow + (size_t)arr * (FEAT_STRIDE / 2)); p[0] = w0; p[1] = w1;
        };
        auto lora_mm = [&](int m, int kb0, f32x4 (&acc)[4]) {
#pragma unroll
            for (int cs = 0; cs < 4; ++cs) acc[cs] = (f32x4){0.f, 0.f, 0.f, 0.f};
            const int nkb = (m == 4) ? 4 : 2;
#pragma unroll
            for (int kb = 0; kb < 4; ++kb) if (kb < nkb) {
#pragma unroll
                for (int cs = 0; cs < 4; ++cs) {
                    const bf16x8 afr = (m == 4) ? *(const LAS bf16x8*)(WG2 + (16 * cs + tk) * P128 + 32 * kb + 8 * cg) : *(const LAS bf16x8*)(WL + (m * 64 + 16 * cs + tk) * P64 + 32 * kb + 8 * cg);
                    acc[cs] = __builtin_amdgcn_mfma_f32_16x16x32_bf16(afr, bfr[kb0 + kb], acc[cs], 0, 0, 0);
                }
            }
        };
        f32x4 acc[4];
        lora_mm(0, 0, acc);
#pragma unroll
        for (int cs = 0; cs < 4; ++cs)
#pragma unroll
            for (int j = 0; j < 4; ++j) acc[cs][j] = SCAN_CHUNKED ? (-0.60653065971f * sigmoidf_(acc[cs][j] + w0f[cs][j])) : (__expf(-0.60653065971f * sigmoidf_(acc[cs][j] + w0f[cs][j])) - 1.0f);
        store16(F_WF, acc);
        lora_mm(1, 2, acc);
#pragma unroll
        for (int cs = 0; cs < 4; ++cs)
#pragma unroll
            for (int j = 0; j < 4; ++j) acc[cs][j] = SCAN_CHUNKED ? (-0.60653065971f * sigmoidf_(acc[cs][j] + w0b[cs][j])) : (__expf(-0.60653065971f * sigmoidf_(acc[cs][j] + w0b[cs][j])) - 1.0f);
        store16(F_WB, acc);
        lora_mm(4, 8, acc);
        asm volatile("s_nop 7\n\ts_nop 7" ::: "memory");
        store16(F_G, acc);
        f32x4 iclf[4], iclb[4];
        lora_mm(2, 4, iclf);
        lora_mm(3, 6, iclb);
#pragma unroll
        for (int cs = 0; cs < 4; ++cs)
#pragma unroll
            for (int j = 0; j < 4; ++j) { iclf[cs][j] = sigmoidf_(iclf[cs][j] + a0f[cs][j]); iclb[cs][j] = sigmoidf_(iclb[cs][j] + a0b[cs][j]); }
        f32x4 kv[4]; float nrm = 0.f;
#pragma unroll
        for (int cs = 0; cs < 4; ++cs) {
            kv[cs] = (f32x4){lo16(kraw[cs].x), hi16(kraw[cs].x), lo16(kraw[cs].y), hi16(kraw[cs].y)};
            const f32x4 kk = kv[cs] * kkw[cs];
            nrm += (kk[0] * kk[0] + kk[1] * kk[1]) + (kk[2] * kk[2] + kk[3] * kk[3]);
        }
        nrm += __shfl_xor(nrm, 16); nrm += __shfl_xor(nrm, 32);
        const float inv = 1.0f / fmaxf(sqrtf(nrm), 1e-12f);
        f32x4 oa[4], obf[4], obb[4], okf[4], okb[4];
#pragma unroll
        for (int cs = 0; cs < 4; ++cs) {
            const f32x4 kkn = kv[cs] * kkw[cs] * inv;
            oa[cs] = -kkn; obf[cs] = kkn * iclf[cs]; obb[cs] = kkn * iclb[cs];
            okf[cs] = kv[cs] * ((iclf[cs] - 1.0f) * kaw[cs] + 1.0f); okb[cs] = kv[cs] * ((iclb[cs] - 1.0f) * kaw[cs] + 1.0f);
        }
        store16(F_A, oa); store16(F_BF, obf); store16(F_BB, obb); store16(F_KF, okf); store16(F_KB, okb);
    }
}

__device__ __forceinline__ void p4_attention(const Args& a, LAS unsigned char* lds, int tid, int lane, int wave, int G) {
    unsigned char* ws = a.ws;
    const bf16_t* QR = (const bf16_t*)(ws + WS_QR); const bf16_t* KA = (const bf16_t*)(ws + WS_KA); const bf16_t* VT = (const bf16_t*)(ws + WS_VT);
    bf16_t* ATT = (bf16_t*)(ws + WS_ATT);
    constexpr int KP = 72;
    LAS bf16_t* Ks0 = (LAS bf16_t*)lds;
    const int qi = lane & 31, hf = lane >> 5;
    unsigned* qatt = (unsigned*)(ws + WS_CTL) + CW_QATT;
    for (int it = 0;; ++it) {
        int upull = 0; if ((it & 1) == 0) { upull = queue_pull(qatt, lds, tid); *(volatile LAS int*)(lds + RING_BYTES + 260) = upull; } else upull = *(volatile LAS int*)(lds + RING_BYTES + 260);
        const int unit = 2 * upull + (it & 1);
        if (unit >= NB * NKV * (SEQ / 64)) break;
        const int qb = unit & 63, g = (unit >> 6) & 1, b = unit >> 7;
        const int q0 = qb * 64;
        const int head = g * 4 + (wave >> 1), qloc = 32 * (wave & 1) + qi;
        const size_t qrow = (size_t)b * SEQ + q0 + qloc;
        bf16x8 qf[4];
#pragma unroll
        for (int s = 0; s < 4; ++s) qf[s] = *(const bf16x8*)(QR + qrow * 512 + head * 64 + 16 * s + 8 * hf);
        float m = a.in[I_SINKS][head] * 1.44269504089f, lsum = hf ? 0.f : 1.f;
        f32x16 O0, O1;
#pragma unroll
        for (int r = 0; r < 16; ++r) { O0[r] = 0.f; O1[r] = 0.f; }
        const int rr = tid >> 3, ch = tid & 7;
        auto tile_ok = [&](int kt) -> bool { const int kp = q0 - 128 + 64 * kt; return kt >= 5 || (kp >= 0 && kp < SEQ); };
        u32x4 kreg, vreg;
        auto fetch_tile = [&](int kt) {
            const int kp0 = q0 - 128 + 64 * kt;
            const bf16_t* kp = (kt < 5) ? KA + ((size_t)b * SEQ + kp0 + rr) * 128 + g * 64 + 8 * ch
                                        : KA + ((size_t)T + b * CL + 64 * (kt - 5) + rr) * 128 + g * 64 + 8 * ch;
            const bf16_t* vp = (kt < 5) ? VT + ((size_t)(b * 2 + g) * 64 + rr) * SEQ + kp0 + 8 * ch
                                        : VT + (size_t)NB * 2 * 64 * SEQ + ((size_t)(b * 2 + g) * 64 + rr) * CL + 64 * (kt - 5) + 8 * ch;
            kreg = *(const u32x4*)kp; vreg = *(const u32x4*)vp;
        };
        int kt = 0; while (!tile_ok(kt)) ++kt;
        fetch_tile(kt);
        int par = 0;
        __syncthreads();
        for (; kt < 9; ) {
            LAS bf16_t* Ks = Ks0 + par * (2 * 64 * KP); LAS bf16_t* Vs = Ks + 64 * KP;
            *(LAS u32x4*)(Ks + rr * KP + 8 * ch) = kreg; *(LAS u32x4*)(Vs + rr * KP + 8 * ch) = vreg;
            __syncthreads();
            int ktn = kt + 1; while (ktn < 9 && !tile_ok(ktn)) ++ktn;
            if (ktn < 9) fetch_tile(ktn);
            f32x16 X0, X1;
#pragma unroll
            for (int r = 0; r < 16; ++r) { X0[r] = 0.f; X1[r] = 0.f; }
#pragma unroll
            for (int s = 0; s < 4; ++s) {
                const bf16x8 k0 = *(const LAS bf16x8*)(Ks + qi * KP + 16 * s + 8 * hf), k1 = *(const LAS bf16x8*)(Ks + (32 + qi) * KP + 16 * s + 8 * hf);
                X0 = __builtin_amdgcn_mfma_f32_32x32x16_bf16(k0, qf[s], X0, 0, 0, 0);
                X1 = __builtin_amdgcn_mfma_f32_32x32x16_bf16(k1, qf[s], X1, 0, 0, 0);
            }
            if (kt == 0 || kt == 4) {
#pragma unroll
                for (int r = 0; r < 16; ++r) { const int k0i = (r & 3) + 8 * (r >> 2) + 4 * hf, k1i = 32 + k0i;
                    const bool v0 = (kt == 0) ? (k0i >= qloc) : (k0i <= qloc), v1 = (kt == 0) ? (k1i >= qloc) : (k1i <= qloc);
                    X0[r] = v0 ? X0[r] : -1e30f; X1[r] = v1 ? X1[r] : -1e30f; }
            }
            float mx0 = X0[0], mx1 = X1[0];
#pragma unroll
            for (int r = 1; r < 16; ++r) { mx0 = __builtin_fmaxf(mx0, X0[r]); mx1 = __builtin_fmaxf(mx1, X1[r]); }
            float mx = __builtin_fmaxf(mx0, mx1);
            mx = __builtin_fmaxf(mx, __shfl_xor(mx, 32));
            const float mn = __builtin_fmaxf(m, mx);
            if (__any(mn > m)) {
                const float alpha = __builtin_amdgcn_exp2f(m - mn);
                lsum *= alpha;
#pragma unroll
                for (int r = 0; r < 16; ++r) { O0[r] *= alpha; O1[r] *= alpha; }
                m = mn;
            }
            float ps0 = 0.f, ps1 = 0.f;
#pragma unroll
            for (int r = 0; r < 16; ++r) { X0[r] = __builtin_amdgcn_exp2f(X0[r] - m); X1[r] = __builtin_amdgcn_exp2f(X1[r] - m); ps0 += X0[r]; ps1 += X1[r]; }
            lsum += ps0 + ps1;
#pragma unroll
            for (int kg = 0; kg < 2; ++kg)
#pragma unroll
                for (int s2 = 0; s2 < 2; ++s2) {
                    bf16x8 pf;
#pragma unroll
                    for (int j = 0; j < 4; ++j) { const float p0 = kg ? X1[8 * s2 + 2 * j] : X0[8 * s2 + 2 * j], p1 = kg ? X1[8 * s2 + 2 * j + 1] : X0[8 * s2 + 2 * j + 1];
                        const unsigned w = cvt_pk_bf16(p0, p1); pf[2 * j] = (short)(w & 0xffff); pf[2 * j + 1] = (short)(w >> 16); }
                    const int kb = 32 * kg + 16 * s2 + 4 * hf;
#pragma unroll
                    for (int dg = 0; dg < 2; ++dg) {
                        const LAS bf16_t* vr = Vs + (32 * dg + qi) * KP + kb;
                        const s16x4 va = *(const LAS s16x4*)vr, vb = *(const LAS s16x4*)(vr + 8);
                        bf16x8 vf; vf[0] = va[0]; vf[1] = va[1]; vf[2] = va[2]; vf[3] = va[3]; vf[4] = vb[0]; vf[5] = vb[1]; vf[6] = vb[2]; vf[7] = vb[3];
                        if (dg == 0) O0 = __builtin_amdgcn_mfma_f32_32x32x16_bf16(vf, pf, O0, 0, 0, 0);
                        else O1 = __builtin_amdgcn_mfma_f32_32x32x16_bf16(vf, pf, O1, 0, 0, 0);
                    }
                }
            kt = ktn; par ^= 1;
        }
        const float ltot = lsum + __shfl_xor(lsum, 32);
        const float inv = 1.0f / ltot;
        bf16_t* op = ATT + qrow * 512 + head * 64;
#pragma unroll
        for (int dg = 0; dg < 2; ++dg)
#pragma unroll
            for (int rq = 0; rq < 4; ++rq) {
                const int d0 = 32 * dg + 8 * rq + 4 * hf;
                u32x2 w;
                if (dg == 0) { w.x = cvt_pk_bf16(O0[4 * rq] * inv, O0[4 * rq + 1] * inv); w.y = cvt_pk_bf16(O0[4 * rq + 2] * inv, O0[4 * rq + 3] * inv); }
                else { w.x = cvt_pk_bf16(O1[4 * rq] * inv, O1[4 * rq + 1] * inv); w.y = cvt_pk_bf16(O1[4 * rq + 2] * inv, O1[4 * rq + 3] * inv); }
                *(u32x2*)(op + d0) = w;
            }
    }
}

template <int CTRL> __device__ __forceinline__ float dpp_add(float x) {
    return x + __builtin_bit_cast(float, __builtin_amdgcn_update_dpp(0, __builtin_bit_cast(int, x), CTRL, 0xf, 0xf, false));
}
__device__ __forceinline__ float row16_sum(float x) { x = dpp_add<0x128>(x); x = dpp_add<0x124>(x); x = dpp_add<0x122>(x); x = dpp_add<0x121>(x); return x; }
template <int VAR> __device__ __forceinline__ void p4_scan(const Args& a, LAS unsigned char* lds, int tid, int lane, int wave, int G) {
    unsigned char* ws = a.ws;
    const bf16_t* FB = (const bf16_t*)(ws + WS_FEAT);
    constexpr int TS = 32, NBLK = (CL + SEQ) / TS;
    constexpr int OPF = TS * 5 * 64;
    LAS float* OPS = (LAS float*)lds;
    LAS float* VB = OPS + 2 * OPF;
    LAS float* YBUF = VB + 2 * TS * 32;
    const int rl = 4 * wave + (lane >> 4), cg = lane & 15;
    for (int unit = blockIdx.x; unit < NB * NH * 4; unit += G) {
        const int half = unit & 1, dir = (unit >> 1) & 1, h = (unit >> 2) & 7, b = unit >> 5;
        const size_t astr = FEAT_STRIDE / 2;
        const bf16_t* arrp[5] = { FB + (size_t)(dir ? F_WB : F_WF) * astr, FB + (size_t)F_A * astr, FB + (size_t)(dir ? F_BB : F_BF) * astr, FB + (size_t)(dir ? F_KB : F_KF) * astr, FB + (size_t)F_R * astr };
        const bf16_t* vp = FB + (size_t)F_V * astr;
        bf16_t* Y = (bf16_t*)(ws + (dir ? WS_YB : WS_YF));
        auto row_of = [&](int s) -> int { return (s < CL) ? (T + b * CL + (dir ? (CL - 1 - s) : s)) : (b * SEQ + (dir ? (SEQ - 1 - (s - CL)) : (s - CL))); };
        u32x2 pre[6];
        auto fetch = [&](int blk) {
#pragma unroll
            for (int it = 0; it < 6; ++it) { const int q = tid + 512 * it; pre[it] = (u32x2){0u, 0u};
                if (q < TS * 88) { const int st = q / 88, rem = q % 88; const int row = row_of(blk * TS + st);
                    if (rem < 80) { const int ar = rem >> 4, ci = rem & 15; const bf16_t* p = (ar == 0 ? arrp[0] : ar == 1 ? arrp[1] : ar == 2 ? arrp[2] : ar == 3 ? arrp[3] : arrp[4]);
                        pre[it] = *(const u32x2*)(p + (size_t)row * RD + h * 64 + 4 * ci); }
                    else { const int ci = rem - 80; pre[it] = *(const u32x2*)(vp + (size_t)row * RD + h * 64 + half * 32 + 4 * ci); } } }
        };
        auto commit = [&](int buf) {
#pragma unroll
            for (int it = 0; it < 6; ++it) { const int q = tid + 512 * it;
                if (q < TS * 88) { const int st = q / 88, rem = q % 88;
                    f32x4 v = (f32x4){lo16(pre[it].x), hi16(pre[it].x), lo16(pre[it].y), hi16(pre[it].y)};
                    if (SCAN_CHUNKED && rem < 16) { v[0] = __expf(v[0]) - 1.0f; v[1] = __expf(v[1]) - 1.0f; v[2] = __expf(v[2]) - 1.0f; v[3] = __expf(v[3]) - 1.0f; }
                    if (rem < 80) *(LAS f32x4*)(OPS + buf * OPF + st * 320 + rem * 4) = v;
                    else *(LAS f32x4*)(VB + buf * TS * 32 + st * 32 + (rem - 80) * 4) = v; } }
        };
        __syncthreads();
        fetch(0); commit(0);
        __syncthreads();
        f32x4 S = (f32x4){0.f, 0.f, 0.f, 0.f};
        for (int blk = 0; blk < NBLK; ++blk) {
            const int buf = blk & 1;
            if (blk + 1 < NBLK) fetch(blk + 1);
            const LAS float* ob = OPS + buf * OPF + 4 * cg; const LAS float* vb = VB + buf * TS * 32 + rl; LAS float* yb = YBUF + buf * TS * 32 + rl;
            float ykeep = 0.f;
            f32x4 qw[3], qa[3], qb[3], qk[3], qr[3]; float qv[3];
#define SCAN_LOAD(st_, sl_) do { qw[sl_] = *(const LAS f32x4*)(ob + (st_) * 320); qa[sl_] = *(const LAS f32x4*)(ob + (st_) * 320 + 64); qb[sl_] = *(const LAS f32x4*)(ob + (st_) * 320 + 128); \
                qk[sl_] = *(const LAS f32x4*)(ob + (st_) * 320 + 192); qr[sl_] = *(const LAS f32x4*)(ob + (st_) * 320 + 256); qv[sl_] = vb[(st_) * 32]; } while (0)
            SCAN_LOAD(0, 0); SCAN_LOAD(1, 1);
#pragma unroll
            for (int st = 0; st < TS; ++st) {
                if (st + 2 < TS && (VAR != 2 || st < 1)) SCAN_LOAD(st + 2, (st + 2) % 3);
                const f32x4 ow = qw[st % 3], av = DBG_NOA ? (f32x4){0.f, 0.f, 0.f, 0.f} : qa[st % 3], bv = DBG_NOB ? (f32x4){0.f, 0.f, 0.f, 0.f} : qb[st % 3], kv = qk[st % 3], rv = qr[st % 3]; const float vi = qv[st % 3];
                float sa = fmaf(S[3], av[3], fmaf(S[2], av[2], fmaf(S[1], av[1], S[0] * av[0])));
                const f32x4 S1 = S + S * ow + kv * vi;
                if (VAR != 1) sa = row16_sum(sa);
                S = S1 + bv * sa;
                float y = fmaf(S[3], rv[3], fmaf(S[2], rv[2], fmaf(S[1], rv[1], S[0] * rv[0])));
                if (VAR != 1) y = row16_sum(y);
                ykeep = (cg == (st & 15)) ? y : ykeep;
                if ((st & 15) == 15) yb[((st & ~15) + cg) * 32] = ykeep;
            }
#undef SCAN_LOAD
            if (blk + 1 < NBLK) commit(buf ^ 1);
            __syncthreads();
            if (blk >= CL / TS) {
                const int st = tid >> 4, pr = tid & 15;
                const int row = row_of(blk * TS + st);
                const float y0 = YBUF[buf * TS * 32 + st * 32 + 2 * pr], y1 = YBUF[buf * TS * 32 + st * 32 + 2 * pr + 1];
                *(unsigned*)(Y + (size_t)row * RD + h * 64 + half * 32 + 2 * pr) = pk2(y0, y1);
            }
        }
    }
}

constexpr int CS_SLOT = 16384, CS_AT = 0, CS_RT = 2304, CS_BH = 4608, CS_KH = 6912, CS_VV = 9216, CS_AAK = 11520, CS_TT = 12800, CS_ARK = 14080, CS_GC = 15360;
constexpr int CS_SCR = 4 * CS_SLOT, CS_SCR_BYTES = 6144, CS_BT = 0, CS_KT = 2304, CS_NN = 4608, CS_FLAGS = CS_SCR + 4 * CS_SCR_BYTES;
typedef short v4i16_t __attribute__((ext_vector_type(4)));
__device__ __forceinline__ bf16x8 pack8(f32x4 x, f32x4 y) {
    u32x4 w; w.x = cvt_pk_bf16(x[0], x[1]); w.y = cvt_pk_bf16(x[2], x[3]); w.z = cvt_pk_bf16(y[0], y[1]); w.w = cvt_pk_bf16(y[2], y[3]);
    return __builtin_bit_cast(bf16x8, w);
}
__device__ __forceinline__ bf16x8 join8(s16x4 x, s16x4 y) { bf16x8 r; r[0] = x[0]; r[1] = x[1]; r[2] = x[2]; r[3] = x[3]; r[4] = y[0]; r[5] = y[1]; r[6] = y[2]; r[7] = y[3]; return r; }
__device__ __forceinline__ s16x4 lds_tr4(const LAS unsigned char* p) { return __builtin_bit_cast(s16x4, __builtin_amdgcn_ds_read_tr16_b64_v4i16((LAS v4i16_t*)p)); }
template <int CTRL> __device__ __forceinline__ float dpp_shr_add(float x) {
    return x + __builtin_bit_cast(float, __builtin_amdgcn_update_dpp(0, __builtin_bit_cast(int, x), CTRL, 0xf, 0xf, true));
}
template <bool TEST> __device__ __forceinline__ void p4_scan_chunked(const Args& a, LAS unsigned char* lds, int tid, int lane, int wave, int G) {
    unsigned char* ws = a.ws;
    const bf16_t* FB = (const bf16_t*)(ws + WS_FEAT);
    const size_t astr = FEAT_STRIDE / 2;
    constexpr int NCH = (CL + SEQ) / 16;
    volatile LAS unsigned* flags = (volatile LAS unsigned*)(lds + CS_FLAGS);
    for (int unit = blockIdx.x; unit < NB * NH * 2; unit += G) {
        const int dir = unit & 1, h = (unit >> 1) & 7, b = unit >> 4;
        __syncthreads();
        for (int i = tid; i < (CS_FLAGS + 64) / 16; i += 512) *(LAS u32x4*)(lds + 16 * i) = (u32x4){0u, 0u, 0u, 0u};
        __syncthreads();
        auto row_of = [&](int s) -> int { return (s < CL) ? (T + b * CL + (dir ? (CL - 1 - s) : s)) : (b * SEQ + (dir ? (SEQ - 1 - (s - CL)) : (s - CL))); };
        if (wave < 4) {
            const int il = lane & 15, g = lane >> 4, ich = 16 * wave + il;
            bf16_t* Y = (bf16_t*)(ws + (dir ? WS_YB : WS_YF));
            f32x4 ST[4];
#pragma unroll
            for (int jt = 0; jt < 4; ++jt) ST[jt] = (f32x4){0.f, 0.f, 0.f, 0.f};
            const f32x4 zero4 = (f32x4){0.f, 0.f, 0.f, 0.f}; const s16x4 z16 = (s16x4){0, 0, 0, 0};
            const int troff = (4 * g + (il >> 2)) * 144 + 8 * (il & 3);
            for (int c = 0; c < NCH; ++c) {
                const int slot = c & 3; LAS unsigned char* sb = lds + slot * CS_SLOT;
                while (flags[slot] != (unsigned)(c + 1)) __builtin_amdgcn_s_sleep(1);
                __builtin_amdgcn_fence(__ATOMIC_ACQUIRE, "workgroup");
                const bf16x8 sf0 = pack8(ST[0], ST[1]), sf1 = pack8(ST[2], ST[3]);
                const LAS unsigned char* atp = sb + CS_AT + il * 144 + 8 * g;
                const bf16x8 a0 = join8(*(const LAS s16x4*)(atp), *(const LAS s16x4*)(atp + 32)), a1 = join8(*(const LAS s16x4*)(atp + 64), *(const LAS s16x4*)(atp + 96));
                const LAS unsigned char* rtp = sb + CS_RT + il * 144 + 8 * g;
                const bf16x8 r0 = join8(*(const LAS s16x4*)(rtp), *(const LAS s16x4*)(rtp + 32)), r1 = join8(*(const LAS s16x4*)(rtp + 64), *(const LAS s16x4*)(rtp + 96));
                const bf16x8 aak = *(const LAS bf16x8*)(sb + CS_AAK + il * 80 + 16 * g);
                const bf16x8 ttf = *(const LAS bf16x8*)(sb + CS_TT + il * 80 + 16 * g);
                const bf16x8 ark = *(const LAS bf16x8*)(sb + CS_ARK + il * 80 + 16 * g);
                const s16x4 vv = lds_tr4(sb + CS_VV + troff + 32 * wave);
                f32x4 zw1 = zero4, zyy = zero4, zuu = zero4; asm volatile("" : "+v"(zw1), "+v"(zyy), "+v"(zuu));
                f32x4 w1 = __builtin_amdgcn_mfma_f32_16x16x32_bf16(a0, sf0, zw1, 0, 0, 0);
                w1 = __builtin_amdgcn_mfma_f32_16x16x32_bf16(a1, sf1, w1, 0, 0, 0);
                w1 = __builtin_amdgcn_mfma_f32_16x16x32_bf16(aak, join8(vv, z16), w1, 0, 0, 0);
                f32x4 yy = __builtin_amdgcn_mfma_f32_16x16x32_bf16(r0, sf0, zyy, 0, 0, 0);
                yy = __builtin_amdgcn_mfma_f32_16x16x32_bf16(r1, sf1, yy, 0, 0, 0);
                const bf16x8 w1f = pack8(w1, zero4);
                const f32x4 uu = __builtin_amdgcn_mfma_f32_16x16x32_bf16(ttf, w1f, zuu, 0, 0, 0);
                bf16x8 uv; { u32x4 w; w.x = cvt_pk_bf16(uu[0], uu[1]); w.y = cvt_pk_bf16(uu[2], uu[3]); const u32x2 v2 = __builtin_bit_cast(u32x2, vv); w.z = v2.x; w.w = v2.y; uv = __builtin_bit_cast(bf16x8, w); }
#pragma unroll
                for (int jt = 0; jt < 4; ++jt) {
                    const f32x4 gc = *(const LAS f32x4*)(sb + CS_GC + (16 * jt + 4 * g) * 4);
                    const bf16x8 bk = join8(lds_tr4(sb + CS_BH + troff + 32 * jt), lds_tr4(sb + CS_KH + troff + 32 * jt));
                    ST[jt] = __builtin_amdgcn_mfma_f32_16x16x32_bf16(bk, uv, ST[jt] * gc, 0, 0, 0);
                }
                yy = __builtin_amdgcn_mfma_f32_16x16x32_bf16(ark, uv, yy, 0, 0, 0);
                asm volatile("s_waitcnt lgkmcnt(0)" ::: "memory");
                if (lane == 0) __hip_atomic_fetch_add((LAS unsigned*)(lds + CS_FLAGS) + 4 + slot, 1u, __ATOMIC_RELEASE, __HIP_MEMORY_SCOPE_WORKGROUP);
                if (c >= CL / 16) {
#pragma unroll
                    for (int rg = 0; rg < 4; ++rg) { const int row = row_of(16 * c + 4 * g + rg); Y[(size_t)row * RD + h * 64 + ich] = (bf16_t)f2bf(yy[rg]); }
                }
            }
        } else {
            const int p = wave - 4, jg = lane >> 4, t = lane & 15;
            LAS unsigned char* scr = lds + CS_SCR + p * CS_SCR_BYTES;
            u32x4 raw[6][2];
            auto load_raw = [&](int c) {
                const size_t ro = (size_t)row_of(16 * c + t) * RD + h * 64 + 16 * jg;
#pragma unroll
                for (int hf = 0; hf < 2; ++hf) {
                    raw[0][hf] = *(const u32x4*)(FB + (size_t)(dir ? F_WB : F_WF) * astr + ro + 8 * hf); raw[1][hf] = *(const u32x4*)(FB + (size_t)F_A * astr + ro + 8 * hf);
                    raw[2][hf] = *(const u32x4*)(FB + (size_t)(dir ? F_BB : F_BF) * astr + ro + 8 * hf); raw[3][hf] = *(const u32x4*)(FB + (size_t)(dir ? F_KB : F_KF) * astr + ro + 8 * hf);
                    raw[4][hf] = *(const u32x4*)(FB + (size_t)F_R * astr + ro + 8 * hf); raw[5][hf] = *(const u32x4*)(FB + (size_t)F_V * astr + ro + 8 * hf); }
            };
            load_raw(p);
            const int tn = lane & 15, gq = lane >> 4;
            for (int c = p; c < NCH; c += 4) {
                const int slot = c & 3; LAS unsigned char* sb = lds + slot * CS_SLOT;
                float cs[16], lwv[16];
#pragma unroll
                for (int q = 0; q < 8; ++q) { const unsigned w = raw[0][q >> 2][q & 3]; lwv[2 * q] = lo16(w); lwv[2 * q + 1] = hi16(w); }
#pragma unroll
                for (int q = 0; q < 16; ++q) { float x = lwv[q]; x = dpp_shr_add<0x111>(x); x = dpp_shr_add<0x112>(x); x = dpp_shr_add<0x114>(x); x = dpp_shr_add<0x118>(x); cs[q] = x; }
                float Gc[16], Gi[16], Gp[16], G15[16];
#pragma unroll
                for (int q = 0; q < 16; ++q) { Gc[q] = __expf(cs[q]); Gi[q] = __expf(-cs[q]); Gp[q] = __expf(cs[q] - lwv[q]); G15[q] = __shfl(Gc[q], (lane & 48) | 15); }
                while (flags[4 + slot] != (unsigned)(4 * (c >> 2))) __builtin_amdgcn_s_sleep(1);
                __builtin_amdgcn_fence(__ATOMIC_ACQUIRE, "workgroup");
                {
                    u32x4 wa[2], wr[2], wb[2], wk[2], wbh[2], wkh[2];
#pragma unroll
                    for (int q = 0; q < 8; ++q) {
                        const unsigned ua = raw[1][q >> 2][q & 3], ub = raw[2][q >> 2][q & 3], uk = raw[3][q >> 2][q & 3], ur = raw[4][q >> 2][q & 3];
                        const float a0 = lo16(ua) * Gp[2 * q], a1 = hi16(ua) * Gp[2 * q + 1], r0 = lo16(ur) * Gc[2 * q], r1 = hi16(ur) * Gc[2 * q + 1];
                        const float b0 = lo16(ub) * Gi[2 * q], b1 = hi16(ub) * Gi[2 * q + 1], k0 = lo16(uk) * Gi[2 * q], k1 = hi16(uk) * Gi[2 * q + 1];
                        wa[q >> 2][q & 3] = cvt_pk_bf16(a0, a1); wr[q >> 2][q & 3] = cvt_pk_bf16(r0, r1); wb[q >> 2][q & 3] = cvt_pk_bf16(b0, b1); wk[q >> 2][q & 3] = cvt_pk_bf16(k0, k1);
                        wbh[q >> 2][q & 3] = cvt_pk_bf16(b0 * G15[2 * q], b1 * G15[2 * q + 1]); wkh[q >> 2][q & 3] = cvt_pk_bf16(k0 * G15[2 * q], k1 * G15[2 * q + 1]);
                    }
                    const int ro = t * 144 + 32 * jg;
#pragma unroll
                    for (int hf = 0; hf < 2; ++hf) {
                        *(LAS u32x4*)(sb + CS_AT + ro + 16 * hf) = wa[hf]; *(LAS u32x4*)(sb + CS_RT + ro + 16 * hf) = wr[hf];
                        *(LAS u32x4*)(scr + CS_BT + ro + 16 * hf) = wb[hf]; *(LAS u32x4*)(scr + CS_KT + ro + 16 * hf) = wk[hf];
                        *(LAS u32x4*)(sb + CS_BH + ro + 16 * hf) = wbh[hf]; *(LAS u32x4*)(sb + CS_KH + ro + 16 * hf) = wkh[hf];
                        *(LAS u32x4*)(sb + CS_VV + ro + 16 * hf) = raw[5][hf];
                    }
                    if (t == 15) {
#pragma unroll
                        for (int q = 0; q < 4; ++q) *(LAS f32x4*)(sb + CS_GC + (16 * jg + 4 * q) * 4) = (f32x4){Gc[4 * q], Gc[4 * q + 1], Gc[4 * q + 2], Gc[4 * q + 3]};
                    }
                }
                if (c + 4 < NCH) load_raw(c + 4);
                asm volatile("s_waitcnt lgkmcnt(0)" ::: "memory");
                f32x4 m0 = (f32x4){0.f, 0.f, 0.f, 0.f}, m1 = m0, m3 = m0, m4 = m0;
                asm volatile("" : "+v"(m0), "+v"(m1), "+v"(m3), "+v"(m4));
#pragma unroll
                for (int ks = 0; ks < 2; ++ks) {
                    const bf16x8 xa = *(const LAS bf16x8*)(sb + CS_AT + tn * 144 + 64 * ks + 16 * gq), xr = *(const LAS bf16x8*)(sb + CS_RT + tn * 144 + 64 * ks + 16 * gq);
                    const bf16x8 yb = *(const LAS bf16x8*)(scr + CS_BT + tn * 144 + 64 * ks + 16 * gq), yk = *(const LAS bf16x8*)(scr + CS_KT + tn * 144 + 64 * ks + 16 * gq);
                    m0 = __builtin_amdgcn_mfma_f32_16x16x32_bf16(yb, xa, m0, 0, 0, 0);
                    m1 = __builtin_amdgcn_mfma_f32_16x16x32_bf16(yk, xa, m1, 0, 0, 0);
                    m3 = __builtin_amdgcn_mfma_f32_16x16x32_bf16(yb, xr, m3, 0, 0, 0);
                    m4 = __builtin_amdgcn_mfma_f32_16x16x32_bf16(yk, xr, m4, 0, 0, 0);
                }
                {
                    f32x4 n0, q1, q3, q4;
#pragma unroll
                    for (int rg = 0; rg < 4; ++rg) { const int s = 4 * gq + rg; const bool lt = s < tn, le = s <= tn;
                        n0[rg] = lt ? m0[rg] : 0.f; q1[rg] = lt ? m1[rg] : 0.f; q3[rg] = le ? m3[rg] : 0.f; q4[rg] = le ? m4[rg] : 0.f;
                        *(LAS float*)(scr + CS_NN + (s * 16 + tn) * 4) = n0[rg]; }
                    u32x2 w1; w1.x = cvt_pk_bf16(q1[0], q1[1]); w1.y = cvt_pk_bf16(q1[2], q1[3]);
                    *(LAS u32x2*)(sb + CS_AAK + tn * 80 + 16 * gq) = w1;
                    u32x4 w3; w3.x = cvt_pk_bf16(q3[0], q3[1]); w3.y = cvt_pk_bf16(q3[2], q3[3]); w3.z = cvt_pk_bf16(q4[0], q4[1]); w3.w = cvt_pk_bf16(q4[2], q4[3]);
                    *(LAS u32x4*)(sb + CS_ARK + tn * 80 + 16 * gq) = w3;
                }
                asm volatile("s_waitcnt lgkmcnt(0)" ::: "memory");
                float Tc[16];
#pragma unroll
                for (int s = 0; s < 16; ++s) Tc[s] = (s == tn) ? 1.0f : 0.0f;
                {
                    const LAS f32x4* NR = (const LAS f32x4*)(scr + CS_NN);
                    f32x4 cq[4], nq[4];
#pragma unroll
                    for (int k = 0; k < 4; ++k) { cq[k] = NR[4 * 14 + k]; nq[k] = cq[k]; }
#pragma unroll
                    for (int s = 14; s >= 0; --s) {
                        if (s > 0) {
#pragma unroll
                            for (int k = 0; k < 4; ++k) if (4 * k + 3 > s - 1) nq[k] = NR[4 * (s - 1) + k];
                        }
                        float acc0 = 0.f, acc1 = 0.f;
#pragma unroll
                        for (int q = s + 1; q < 16; ++q) { if (q & 1) acc1 += Tc[q] * cq[q >> 2][q & 3]; else acc0 += Tc[q] * cq[q >> 2][q & 3]; }
                        Tc[s] = (s < tn) ? (acc0 + acc1) : Tc[s];
#pragma unroll
                        for (int k = 0; k < 4; ++k) cq[k] = nq[k];
                    }
                }
                if (lane < 16) {
#pragma unroll
                    for (int g4 = 0; g4 < 4; ++g4) { u32x2 w; w.x = cvt_pk_bf16(Tc[4 * g4], Tc[4 * g4 + 1]); w.y = cvt_pk_bf16(Tc[4 * g4 + 2], Tc[4 * g4 + 3]); *(LAS u32x2*)(sb + CS_TT + tn * 80 + 16 * g4) = w; }
                }
                __builtin_amdgcn_fence(__ATOMIC_RELEASE, "workgroup");
                asm volatile("s_waitcnt lgkmcnt(0)" ::: "memory");
                if (lane == 0) flags[slot] = (unsigned)(c + 1);
            }
        }
    }
}

__device__ __forceinline__ void p5_rwkv_out(const Args& a, int lane, int wave, int G) {
    unsigned char* ws = a.ws;
    const bf16_t* FB = (const bf16_t*)(ws + WS_FEAT); const size_t astr = FEAT_STRIDE / 2;
    const bf16_t* YF = (const bf16_t*)(ws + WS_YF); const bf16_t* YBk = (const bf16_t*)(ws + WS_YB);
    bf16_t* RWK = (bf16_t*)(ws + WS_RWK);
    const int gw = blockIdx.x * 8 + wave, NGW = G * 8;
    const int c0 = 8 * lane;
    float lnw[8], lnb[8], rk[8];
#pragma unroll
    for (int j = 0; j < 8; ++j) { lnw[j] = a.in[I_LNW][c0 + j]; lnb[j] = a.in[I_LNB][c0 + j]; rk[j] = a.in[I_RK][c0 + j]; }
    auto ld8 = [&](const bf16_t* p, float (&o)[8]) { const u32x4 w = *(const u32x4*)p;
#pragma unroll
        for (int j = 0; j < 4; ++j) { o[2 * j] = lo16(w[j]); o[2 * j + 1] = hi16(w[j]); } };
    for (int m = gw; m < T; m += NGW) {
        const size_t o = (size_t)m * RD + c0;
        float yf[8], yb[8], r[8], kf[8], kb[8], v[8], g[8];
        ld8(YF + o, yf); ld8(YBk + o, yb); ld8(FB + F_R * astr + o, r); ld8(FB + F_KF * astr + o, kf); ld8(FB + F_KB * astr + o, kb); ld8(FB + F_V * astr + o, v); ld8(FB + F_G * astr + o, g);
        float s = 0.f, bs = 0.f;
#pragma unroll
        for (int j = 0; j < 8; ++j) { yf[j] += yb[j]; s += yf[j]; bs += r[j] * (kf[j] + kb[j]) * rk[j]; }
        s += __shfl_xor(s, 1); s += __shfl_xor(s, 2); s += __shfl_xor(s, 4);
        bs += __shfl_xor(bs, 1); bs += __shfl_xor(bs, 2); bs += __shfl_xor(bs, 4);
        const float mean = s * (1.f / 64.f); float q = 0.f;
#pragma unroll
        for (int j = 0; j < 8; ++j) { yf[j] -= mean; q += yf[j] * yf[j]; }
        q += __shfl_xor(q, 1); q += __shfl_xor(q, 2); q += __shfl_xor(q, 4);
        const float rstd = 1.0f / sqrtf(q * (1.f / 64.f) + GN_EPS);
        float out[8];
#pragma unroll
        for (int j = 0; j < 8; ++j) out[j] = (yf[j] * rstd * lnw[j] + lnb[j] + bs * v[j]) * g[j];
        u32x4 w; w.x = pk2(out[0], out[1]); w.y = pk2(out[2], out[3]); w.z = pk2(out[4], out[5]); w.w = pk2(out[6], out[7]);
        *(u32x4*)(RWK + o) = w;
    }
}

template <bool PROBE> __device__ __forceinline__ void p9_postmix_router(const Args& a, LAS unsigned char* lds, int tid, int lane, int wave, int G) {
    unsigned char* ws = a.ws;
    const float* MOD = (const float*)(ws + WS_CTL) + CW_MOD;
    const float* MIX = (const float*)(ws + WS_MIX);
    bf16_t* HF = (bf16_t*)(ws + (PROBE ? WS_H + 160 * MiB : WS_HF));
    int* cnt = (int*)(ws + WS_CTL) + (PROBE ? 12000 : CW_CNT);
    int* slot_tok = (int*)(ws + (PROBE ? WS_H + 240 * MiB : WS_SLOT_TOK)); float* slot_gate = (float*)(ws + (PROBE ? WS_H + 248 * MiB : WS_SLOT_GATE)); unsigned* tokk = (unsigned*)(ws + (PROBE ? WS_H + 256 * MiB : WS_TOKK));
    constexpr int HP = 1028;
    LAS float* HL = (LAS float*)lds;
    LAS float* PART = HL + 16 * HP;
    LAS int* SEL_E = (LAS int*)(lds + 90112); LAS float* SEL_G = (LAS float*)(lds + 90112 + 2048); LAS int* SEL_M = (LAS int*)(lds + 90112 + 4096);
    LAS int* HIST = (LAS int*)(lds + 90112 + 6144); LAS int* BASE = HIST + 32;
    int nsel = 0;
    const int ti = lane & 15, kq = lane >> 4;
    float wb0[32], wb1[32];
    {
        const float* wr = a.in[I_WROUTER];
#pragma unroll
        for (int ks = 0; ks < 32; ++ks) { const int k = 128 * wave + 4 * ks + kq; wb0[ks] = wr[k * NE + ti]; wb1[ks] = wr[k * NE + 16 + ti]; }
    }
    const float brt = a.in[I_BROUTER][lane & 31];
    for (int unit = blockIdx.x; unit < T / 16; unit += G) {
        const int tok0 = unit * 16;
        __syncthreads();
        {
            const int m0 = tok0 + 2 * wave; const int b = m0 >> 12;
            f32x4 v[2][4]; float s[2] = {0.f, 0.f};
#pragma unroll
            for (int tt = 0; tt < 2; ++tt) { const f32x4* mr = (const f32x4*)(MIX + (size_t)(m0 + tt) * D) + lane;
#pragma unroll
                for (int j = 0; j < 4; ++j) { v[tt][j] = mr[64 * j]; s[tt] += (v[tt][j].x * v[tt][j].x + v[tt][j].y * v[tt][j].y) + (v[tt][j].z * v[tt][j].z + v[tt][j].w * v[tt][j].w); } }
            f32x4 xv[2][4];
#pragma unroll
            for (int tt = 0; tt < 2; ++tt) { const f32x4* xr = (const f32x4*)(a.in[I_X] + (size_t)(m0 + tt) * D) + lane;
#pragma unroll
                for (int j = 0; j < 4; ++j) xv[tt][j] = xr[64 * j]; }
#pragma unroll
            for (int o = 1; o < 64; o <<= 1) { s[0] += __shfl_xor(s[0], o); s[1] += __shfl_xor(s[1], o); }
            float s2[2] = {0.f, 0.f};
#pragma unroll
            for (int j = 0; j < 4; ++j) {
                const f32x4 g = ((const f32x4*)a.in[I_GPOSTMIX])[64 * j + lane], gt = ((const f32x4*)(MOD + b * 6144 + 2048))[64 * j + lane];
#pragma unroll
                for (int tt = 0; tt < 2; ++tt) {
                    const float rstd = __builtin_amdgcn_rsqf(s[tt] * (1.f / D) + RMS_EPS);
                    v[tt][j] = xv[tt][j] + gt * (v[tt][j] * rstd * g);
                    ((f32x4*)((PROBE ? (float*)(ws + WS_H) : a.out) + (size_t)(m0 + tt) * D))[64 * j + lane] = v[tt][j];
                    s2[tt] += (v[tt][j].x * v[tt][j].x + v[tt][j].y * v[tt][j].y) + (v[tt][j].z * v[tt][j].z + v[tt][j].w * v[tt][j].w);
                }
            }
#pragma unroll
            for (int o = 1; o < 64; o <<= 1) { s2[0] += __shfl_xor(s2[0], o); s2[1] += __shfl_xor(s2[1], o); }
#pragma unroll
            for (int j = 0; j < 4; ++j) {
                const f32x4 g = ((const f32x4*)a.in[I_GPREFFN])[64 * j + lane], sh = ((const f32x4*)(MOD + b * 6144 + 3072))[64 * j + lane], sc = ((const f32x4*)(MOD + b * 6144 + 4096))[64 * j + lane];
#pragma unroll
                for (int tt = 0; tt < 2; ++tt) {
                    const float rstd2 = __builtin_amdgcn_rsqf(s2[tt] * (1.f / D) + RMS_EPS);
                    const f32x4 hv = (v[tt][j] * rstd2 * g) * (sc + 1.0f) + sh;
                    ((unsigned*)((unsigned char*)HF + (size_t)(m0 + tt) * D))[64 * j + lane] = pk4_fp8(hv.x * F8_ASCALE, hv.y * F8_ASCALE, hv.z * F8_ASCALE, hv.w * F8_ASCALE);
                    *(LAS f32x4*)(HL + (2 * wave + tt) * HP + 256 * j + 4 * lane) = hv;
                }
            }
        }
        __syncthreads();
        {
            f32x4 acc0 = (f32x4){0.f, 0.f, 0.f, 0.f}, acc1 = acc0;
#pragma unroll
            for (int ks = 0; ks < 32; ++ks) {
                const float av = HL[ti * HP + 128 * wave + 4 * ks + kq];
                acc0 = __builtin_amdgcn_mfma_f32_16x16x4f32(av, wb0[ks], acc0, 0, 0, 0);
                acc1 = __builtin_amdgcn_mfma_f32_16x16x4f32(av, wb1[ks], acc1, 0, 0, 0);
            }
#pragma unroll
            for (int r = 0; r < 4; ++r) { PART[(wave * 16 + 4 * kq + r) * 32 + ti] = acc0[r]; PART[(wave * 16 + 4 * kq + r) * 32 + 16 + ti] = acc1[r]; }
        }
        __syncthreads();
        {
            const int tl = 2 * wave + (lane >> 5); const int m = tok0 + tl;
            const int e = lane & 31;
            float lg = brt;
#pragma unroll
            for (int w = 0; w < 8; ++w) lg += PART[(w * 16 + tl) * 32 + e];
            float tv[4]; int ti4[4];
#pragma unroll
            for (int k = 0; k < 4; ++k) {
                float bv = lg; int bi = e;
#pragma unroll
                for (int o = 1; o < 32; o <<= 1) { const float ov = __shfl_xor(bv, o); const int oi = __shfl_xor(bi, o); if (ov > bv || (ov == bv && oi < bi)) { bv = ov; bi = oi; } }
                tv[k] = bv; ti4[k] = bi;
                if (e == bi) lg = -3.0e38f;
            }
            const float e1 = __expf(tv[1] - tv[0]), e2 = __expf(tv[2] - tv[0]), e3 = __expf(tv[3] - tv[0]);
            const float inv = 1.0f / (1.0f + e1 + e2 + e3);
            if (e < 4) {
                const int ek = e == 0 ? ti4[0] : e == 1 ? ti4[1] : e == 2 ? ti4[2] : ti4[3];
                const float gk = (e == 0 ? 1.0f : e == 1 ? e1 : e == 2 ? e2 : e3) * inv;
                const int si = nsel * 64 + tl * 4 + e;
                SEL_E[si] = ek; SEL_G[si] = gk; SEL_M[si] = m;
            }
        }
        ++nsel;
    }
    __syncthreads();
    if (tid < 32) HIST[tid] = 0;
    __syncthreads();
    int my_e = 0, my_lr = 0; const bool have = tid < nsel * 64;
    if (have) { my_e = SEL_E[tid]; my_lr = __hip_atomic_fetch_add(HIST + my_e, 1, __ATOMIC_RELAXED, __HIP_MEMORY_SCOPE_WORKGROUP); }
    __syncthreads();
    if (tid < 32) { const int n = HIST[tid]; BASE[tid] = n ? atomicAdd(cnt + tid, n) : 0; }
    __syncthreads();
    if (have) { const int rank = BASE[my_e] + my_lr; const int m = SEL_M[tid];
        slot_tok[my_e * T + rank] = m; slot_gate[(size_t)my_e * T + rank] = SEL_G[tid];
        tokk[m * 4 + (tid & 3)] = ((unsigned)my_e << 20) | (unsigned)rank; }
}

__device__ __forceinline__ void moe_table(const Args& a, LAS int* tstart, int tid) {
    const int* cnt = (const int*)(a.ws + WS_CTL) + CW_CNT;
    __syncthreads();
    if (tid == 0) { int acc = 0; for (int e = 0; e < NE; ++e) { tstart[e] = acc; acc += (__hip_atomic_load(cnt + e, __ATOMIC_RELAXED, __HIP_MEMORY_SCOPE_AGENT) + 255) >> 8; } tstart[NE] = acc; }
    __syncthreads();
}

__device__ __forceinline__ void p12_combine(const Args& a, LAS int* tstart, int lane, int wave, int G) {
    unsigned char* ws = a.ws;
    const float* MOD = (const float*)(ws + WS_CTL) + CW_MOD;
    const unsigned char* YB = (const unsigned char*)(ws + WS_YBUF); const unsigned* tokk = (const unsigned*)(ws + WS_TOKK);
    const int gw = blockIdx.x * 8 + wave, NGW = G * 8;
    for (int m = gw; m < T; m += NGW) {
        const int b = m >> 12;
        const u32x4 tk4 = *(const u32x4*)(tokk + m * 4);
        unsigned yw[4][4];
#pragma unroll
        for (int k = 0; k < 4; ++k) {
            const unsigned tk = tk4[k]; const int e = (int)(tk >> 20), rank = (int)(tk & 0xfffffu);
            const unsigned* yr = (const unsigned*)(YB + ((size_t)tstart[e] * 256 + rank) * D) + lane;
#pragma unroll
            for (int j = 0; j < 4; ++j) yw[k][j] = yr[64 * j];
        }
        f32x4 xr[4];
#pragma unroll
        for (int j = 0; j < 4; ++j) xr[j] = ((const f32x4*)(a.out + (size_t)m * D))[64 * j + lane];
        f32x4 y[4]; float s = 0.f;
#pragma unroll
        for (int j = 0; j < 4; ++j) { y[j] = (f32x4){0.f, 0.f, 0.f, 0.f};
#pragma unroll
            for (int k = 0; k < 4; ++k) { const f32x2_t lo = __builtin_amdgcn_cvt_pk_f32_fp8((int)yw[k][j], false), hi = __builtin_amdgcn_cvt_pk_f32_fp8((int)yw[k][j], true); y[j] += (f32x4){lo.x, lo.y, hi.x, hi.y}; }
            s += (y[j][0] * y[j][0] + y[j][1] * y[j][1]) + (y[j][2] * y[j][2] + y[j][3] * y[j][3]); }
        const float rstd = __builtin_amdgcn_rsqf(wave_sum(s) * (1.f / D) + RMS_EPS * F8_YSCALE * F8_YSCALE);
#pragma unroll
        for (int j = 0; j < 4; ++j) {
            const f32x4 g = ((const f32x4*)a.in[I_GPOSTFFN])[64 * j + lane], gt = ((const f32x4*)(MOD + b * 6144 + 5120))[64 * j + lane];
            ((f32x4*)(a.out + (size_t)m * D))[64 * j + lane] = xr[j] + gt * (y[j] * rstd * g);
        }
    }
}

constexpr int N_PHASES = 13;
__global__ void __launch_bounds__(512, 2) mega_fwd(Args args) {
    extern __shared__ __attribute__((aligned(16))) unsigned char lds_raw[];
    LAS unsigned char* lds = (LAS unsigned char*)lds_raw;
    const int tid = threadIdx.x, lane = tid & 63, wave = __builtin_amdgcn_readfirstlane(tid >> 6);
    const int G = gridDim.x;
    volatile LAS unsigned* MISC = (volatile LAS unsigned*)(lds + MISC_OFF);
    LAS int* tstart = (LAS int*)(lds + RING_BYTES);
    for (int u = tid; u < (LDS_BYTES - RING_BYTES) / 4; u += 512) ((LAS unsigned*)(lds + RING_BYTES))[u] = 0u;
    __syncthreads();
    unsigned char* ws = args.ws;
    const int lo = args.ph_lo, hi = args.ph_hi;
    unsigned* barw = (unsigned*)(ws + WS_CTL) + (args.bar_region ? (131072 + (args.bar_region - 1) * 4096) : CW_BAR);
    XcdBarrier bar; bar.bar = barw; bar.x = 0; bar.st = nullptr;
    if (hi - lo > 1) bar = xcd_barrier_post(barw, MISC + 8);
#ifndef PH_MASK
#define PH_MASK 0x1FFF
#endif
#define IN(k) (((PH_MASK >> (k)) & 1) && lo <= (k) && (k) < hi)
#define SEAM(k) do { if (IN(k) && IN((k) + 1)) xcd_barrier(bar); } while (0)

    if (IN(0)) { p0_prologue(args, lds, tid, lane, wave, G); SEAM(0); }
    if (IN(1)) { p1_norm(args, lane, wave, G); SEAM(1); }
    if (IN(2)) {
        SchedProj S{(const char*)(ws + WS_WIN), G, (int)blockIdx.x};
        EpiZ E{(bf16_t*)(ws + WS_Z), (const float*)(ws + WS_MISC)};
        pg8::gemm_phase<1024, EpiZ, SchedProj>(lds, (const char*)(ws + WS_HX), S, E);
        SEAM(2);
    }
    if (IN(3)) { p3a_pointwise(args, tid, G); if (IN(4)) xcd_barrier(bar); p3b_features(args, lds, tid, lane, wave, G); SEAM(3); }
    if (IN(5)) { if (SCAN_CHUNKED && !SCAN_FORCE_DIRECT) p4_scan_chunked<false>(args, lds, tid, lane, wave, G); else p4_scan<0>(args, lds, tid, lane, wave, G);
        p4_attention(args, lds, tid, lane, wave, G);
        moe_weight_copies(args, lds, tid, lane, wave);
        SEAM(5); }
#if DBG_SCAN
    if (IN(6) && blockIdx.x == 0) {
        const bf16_t* Yt = (const bf16_t*)(ws + (DBG_DIR ? WS_YB : WS_YF)); const bf16_t* Y2 = (const bf16_t*)(ws + 272 * MiB);
        LAS float* red = (LAS float*)lds; float* dbg = (float*)(ws + WS_CTL) + 12288;
        int first = -1; float worst = 0.f;
        for (int ci = 0; ci < 256; ++ci) {
            float e2 = 0.f, r2 = 0.f;
            for (int i = tid; i < 16 * 512; i += 512) { const int cc = DBG_DIR ? (255 - ci) : ci; const size_t o = (size_t)(cc * 16) * 512 + i; const float yt = bf2f(Yt[o]), y2 = bf2f(Y2[o]); e2 += (yt - y2) * (yt - y2); r2 += yt * yt; }
            e2 = wave_sum(e2); r2 = wave_sum(r2);
            __syncthreads(); if (lane == 0) { red[wave] = e2; red[8 + wave] = r2; } __syncthreads();
            float E = 0.f, R = 0.f; for (int w8 = 0; w8 < 8; ++w8) { E += red[w8]; R += red[8 + w8]; }
            const float rel = sqrtf(E / fmaxf(R, 1e-20f));
            if (first < 0 && !(rel < 0.03f)) first = ci;
            if (ci == DBG_CHUNK) { worst = rel;
                if (DBG_MODE == 2) { float z = 0.f; for (int i = tid; i < 16 * 512; i += 512) { const int cc = DBG_DIR ? (255 - ci) : ci; z += ((Y2[(size_t)(cc * 16) * 512 + i] & 0x7fff) > 0x7f80) ? 1.f : 0.f; }
                    z = wave_sum(z); __syncthreads(); if (lane == 0) red[16 + wave] = z; __syncthreads(); float Z = 0.f; for (int w8 = 0; w8 < 8; ++w8) Z += red[16 + w8]; worst = Z / 8192.f; } }
        }
        if (tid == 0) dbg[0] = DBG_MODE ? worst : ((first < 0) ? 0.f : (float)(first + 1) / 256.f);
    }
#endif
    if (IN(6)) {
        p5_rwkv_out(args, lane, wave, G);
        SchedDense<512> S{(const char*)(ws + WS_WUPA), G, (int)blockIdx.x};
        EpiUp<false> E{(bf16_t*)(ws + WS_MERGED), (const bf16_t*)(ws + WS_Z)};
        pg8::gemm_phase<512, EpiUp<false>, SchedDense<512>>(lds, (const char*)(ws + WS_ATT), S, E);
        SEAM(6);
    }
    if (IN(7)) {
        SchedDense<512> S{(const char*)(ws + WS_WUPR), G, (int)blockIdx.x};
        EpiUp<true> E{(bf16_t*)(ws + WS_MERGED), (const bf16_t*)(ws + WS_Z)};
        pg8::gemm_phase<512, EpiUp<true>, SchedDense<512>>(lds, (const char*)(ws + WS_RWK), S, E);
        SEAM(7);
    }
    if (IN(8)) {
        SchedDense<1024> S{(const char*)(ws + WS_WOUT), G, (int)blockIdx.x};
        EpiMix E{(float*)(ws + WS_MIX)};
        pg8::gemm_phase<1024, EpiMix, SchedDense<1024>>(lds, (const char*)(ws + WS_MERGED), S, E);
        SEAM(8);
    }
    if (IN(9)) { p9_postmix_router<false>(args, lds, tid, lane, wave, G); SEAM(9); }
    if (IN(10)) {
        moe_table(args, tstart, tid);
        SchedMoe<8, true, 1> S{(const char*)(ws + WS_WGU), G, (int)blockIdx.x, tstart, (const int*)(ws + WS_CTL) + CW_CNT, (const int*)(ws + WS_SLOT_TOK)};
        EpiMoe1 E{(bf16_t*)(ws + WS_H), args.in[I_BGU]};
        pg8::gemm_phase<1024, EpiMoe1, SchedMoe<8, true, 1>, true>(lds, (const char*)(ws + WS_HF), S, E);
        SEAM(10);
    }
    if (IN(11)) {
        moe_table(args, tstart, tid);
        SchedMoe<4, false, 1> S{(const char*)(ws + WS_WDN), G, (int)blockIdx.x, tstart, (const int*)(ws + WS_CTL) + CW_CNT, (const int*)(ws + WS_SLOT_TOK)};
        EpiMoe2 E{(unsigned char*)(ws + WS_YBUF), args.in[I_BDN], (const float*)(ws + WS_SLOT_GATE), (const int*)(ws + WS_CTL) + CW_CNT};
        pg8::gemm_phase<1024, EpiMoe2, SchedMoe<4, false, 1>, true>(lds, (const char*)(ws + WS_H), S, E);
        SEAM(11);
    }
    if (IN(12)) { moe_table(args, tstart, tid); p12_combine(args, tstart, lane, wave, G); }
#ifdef PROBE_PHASE
    if (lo == 15 && blockIdx.x == 0 && tid < 32) { unsigned* ctl = (unsigned*)(ws + WS_CTL); if (tid == 0) { ctl[CW_QATT] = 0u; ctl[CW_QTR] = PROBE_QTR0; } ctl[CW_CNT + tid] = 0u; }
    if (lo == 16) p9_postmix_router<true>(args, lds, tid, lane, wave, G);
    if (lo == 18) p4_attention(args, lds, tid, lane, wave, G);
    if (lo == 13) p3a_pointwise(args, tid, G);
    if (lo == 14) p3b_features(args, lds, tid, lane, wave, G);
#endif
#undef IN
#undef SEAM
}

extern "C" void kernel_launch(void* const* d_in, const int* in_sizes, int n_in, void* d_out, int out_size, void* d_ws, size_t ws_size, hipStream_t stream) {
    static int grid = 0;
    if (grid == 0) {
        if (n_in != 38 || out_size != T * D || ws_size < WS_END) { fprintf(stderr, "kernel_launch: unexpected problem shape (n_in %d, out %d, ws %zu)\n", n_in, out_size, ws_size); grid = -1; return; }
        int dev = 0, cus = 0, per_cu = 0;
        if (hipGetDevice(&dev) != hipSuccess || hipDeviceGetAttribute(&cus, hipDeviceAttributeMultiprocessorCount, dev) != hipSuccess) { grid = -1; return; }
        if (hipFuncSetAttribute((const void*)mega_fwd, hipFuncAttributeMaxDynamicSharedMemorySize, LDS_BYTES) != hipSuccess) { fprintf(stderr, "kernel_launch: hipFuncSetAttribute failed\n"); grid = -1; return; }
        if (hipOccupancyMaxActiveBlocksPerMultiprocessor(&per_cu, (const void*)mega_fwd, 512, LDS_BYTES) != hipSuccess || per_cu < 1) fprintf(stderr, "kernel_launch: occupancy query says %d\n", per_cu);
        (void)hipGetLastError();
        grid = cus;
    }
    if (grid < 0) return;
    (void)hipMemsetAsync((char*)d_ws + WS_CTL, 0, CTL_BYTES, stream);
    Args a{};
    for (int i = 0; i < 38; ++i) a.in[i] = (const float*)d_in[i];
    a.out = (float*)d_out; a.ws = (unsigned char*)d_ws;
#if MK_ONE_LAUNCH
    a.ph_lo = 0; a.ph_hi = N_PHASES;
    hipLaunchKernelGGL(mega_fwd, dim3(grid), dim3(512), LDS_BYTES, stream, a);
#ifdef PROBE_PHASE
#ifdef PROBE_PRE
    { a.ph_lo = PROBE_PRE; a.ph_hi = PROBE_PRE + 1; hipLaunchKernelGGL(mega_fwd, dim3(grid), dim3(512), LDS_BYTES, stream, a); }
#endif
    for (int rep = 0; rep < PROBE_REPS; ++rep) { a.ph_lo = PROBE_PHASE; a.ph_hi = PROBE_HI; a.bar_region = 1 + rep; hipLaunchKernelGGL(mega_fwd, dim3(grid), dim3(512), LDS_BYTES, stream, a); }
#endif
#else
    for (int p = 0; p < N_PHASES; ++p) { a.ph_lo = p; a.ph_hi = p + 1; hipLaunchKernelGGL(mega_fwd, dim3(grid), dim3(512), LDS_BYTES, stream, a); }
#endif
}
```

```cpp
#include <hip/hip_runtime.h>
#include <cstdio>
#include <cstdint>

#ifndef MK_ONE_LAUNCH
#define MK_ONE_LAUNCH 1
#endif
#ifndef PROBE_QTR0
#define PROBE_QTR0 0u
#endif
#ifndef PROBE_HI
#define PROBE_HI (PROBE_PHASE + 1)
#endif
#ifndef SCAN_CHUNKED
#define SCAN_CHUNKED 1
#endif
#ifndef SCAN_FORCE_DIRECT
#define SCAN_FORCE_DIRECT 0
#endif
#ifndef DBG_SCAN
#define DBG_SCAN 0
#define DBG_DIR 0
#define DBG_MODE 0
#define DBG_CHUNK 0
#endif
#ifndef DBG_NOA
#define DBG_NOA 0
#define DBG_NOB 0
#endif
#ifndef DBG_D
#define DBG_D 0
#endif
#ifndef DBG_TI
#define DBG_TI 0
#endif
#ifndef CS_LOCKSTEP
#define CS_LOCKSTEP 0
#endif

#define GAS __attribute__((address_space(1)))
#define LAS __attribute__((address_space(3)))
typedef unsigned short bf16_t;
typedef short bf16x8 __attribute__((ext_vector_type(8)));
typedef short s16x4 __attribute__((ext_vector_type(4)));
typedef float f32x4 __attribute__((ext_vector_type(4)));
typedef float f32x16 __attribute__((ext_vector_type(16)));
typedef unsigned u32x4 __attribute__((ext_vector_type(4)));
typedef unsigned u32x2 __attribute__((ext_vector_type(2)));

constexpr int NB = 8, SEQ = 4096, T = NB * SEQ, D = 1024, CL = 256, TC = NB * CL, ROWS = T + TC;
constexpr int NH = 8, HD = 64, NKV = 2, RD = 512;
constexpr int NE = 32, TOPK = 4, DE = 1024;
constexpr int PROJ_SRC = 4736;
constexpr int ZP = 4864;
constexpr int ZC_Q = 0, ZC_K = 512, ZC_V = 640, ZC_R = 768, ZC_RK = 1280, ZC_RV = 1792, ZC_LORA = 2304, ZC_G = 2816;
constexpr int NTILE_N = ZP / 256;
constexpr float RMS_EPS = 1e-6f, GN_EPS = 64e-5f;
constexpr float F8_WSCALE = 32.0f, F8_ASCALE = 4.0f, F8_HSCALE = 8.0f, F8_YSCALE = 32.0f;

constexpr size_t MiB = 1u << 20;
constexpr size_t WS_CTL = 0, CTL_BYTES = 1 * MiB;
constexpr size_t WS_WIN = 1 * MiB;
constexpr size_t WS_WUPA = 11 * MiB, WS_WUPR = 12 * MiB;
constexpr size_t WS_WOUT = 13 * MiB;
constexpr size_t WS_LORA = 15 * MiB;
constexpr size_t WS_MISC = 15 * MiB + 512 * 1024;
constexpr size_t WS_WGU = 16 * MiB;
constexpr size_t WS_WDN = 144 * MiB;
constexpr size_t WS_HX = 208 * MiB;
constexpr size_t WS_YF = 208 * MiB, WS_YB = 240 * MiB;
constexpr size_t WS_HF = 208 * MiB;
constexpr size_t WS_Z = 276 * MiB;
constexpr size_t WS_SLOT_TOK = 272 * MiB;
constexpr size_t WS_FEAT = 599 * MiB;
constexpr size_t FEAT_STRIDE = 34 * MiB;
constexpr size_t WS_MERGED = 769 * MiB;
constexpr size_t WS_MIX = 599 * MiB;
constexpr size_t WS_QR = 939 * MiB;
constexpr size_t WS_RWK = 939 * MiB;
constexpr size_t WS_KA = 971 * MiB;
constexpr size_t WS_VT = 980 * MiB;
constexpr size_t WS_ATT = 990 * MiB;
constexpr size_t WS_SLOT_GATE = 276 * MiB;
constexpr size_t WS_TOKK = 280 * MiB;
constexpr size_t WS_H = 281 * MiB;
constexpr int MAXTILES = 544, MAXSLOT = MAXTILES * 256;
constexpr size_t WS_YBUF = 553 * MiB;
constexpr size_t WS_END = 1024 * MiB;
static_assert(WS_YBUF + (size_t)MAXSLOT * 1024 * 2 <= WS_QR, "ws map");
static_assert(WS_H + (size_t)MAXSLOT * 1024 * 2 <= WS_YBUF, "ws map");
static_assert(WS_Z + (size_t)ROWS * ZP * 2 <= WS_FEAT, "ws map");
static_assert(WS_FEAT + 10 * FEAT_STRIDE <= WS_QR, "ws map");
static_assert(WS_ATT + (size_t)T * 512 * 2 <= WS_END, "ws map");
static_assert(WS_VT + 9 * MiB <= WS_ATT && WS_KA + (size_t)ROWS * 128 * 2 <= WS_VT, "ws map");
enum { F_R = 0, F_V, F_A, F_KF, F_KB, F_BF, F_BB, F_WF, F_WB, F_G };
constexpr int CW_BAR = 4096;
constexpr int CW_CNT = 8192;
constexpr int CW_QATT = 8320, CW_QTR = 8384;
constexpr int CW_MOD = 16384;
static_assert((CW_MOD + 9 * 6144) * 4 <= (int)CTL_BYTES, "ctl");

constexpr int RING_BYTES = 131072;
constexpr int MISC_OFF = RING_BYTES + 320;
constexpr int LDS_BYTES = 147456;

#define LDS_WAIT() asm volatile("s_waitcnt lgkmcnt(0)" ::: "memory")
#define VM_WAIT() asm volatile("s_waitcnt vmcnt(0)" ::: "memory")
__device__ __forceinline__ float bf2f(unsigned b) { return __uint_as_float(b << 16); }
__device__ __forceinline__ unsigned f2bf(float f) { unsigned u = __float_as_uint(f); return (u + 0x7fffu + ((u >> 16) & 1u)) >> 16; }
__device__ __forceinline__ unsigned pk2(float lo, float hi) { return f2bf(lo) | (f2bf(hi) << 16); }
__device__ __forceinline__ float lo16(unsigned w) { return __uint_as_float(w << 16); }
__device__ __forceinline__ float hi16(unsigned w) { return __uint_as_float(w & 0xffff0000u); }
__device__ __forceinline__ float sigmoidf_(float x) { return __builtin_amdgcn_rcpf(1.0f + __expf(-x)); }
__device__ __forceinline__ float wave_sum(float v) {
#pragma unroll
    for (int o = 1; o < 64; o <<= 1) v += __shfl_xor(v, o);
    return v;
}

#define XB_TMO      128
#define XB_XCNT(j)  (256  + 64 * (j))
#define XB_XSUB(j)  (1280 + 64 * (j))
#define XB_XGEN(j)  (2304 + 64 * (j))
#define XB_TOP      3328
#define XB_TOPGEN   3392
#define XCD_BAR_WORDS 3456
#define XB_SPIN_CAP (1u << 22)
__device__ __forceinline__ unsigned xb_ld(unsigned* p)              { return __hip_atomic_load(p, __ATOMIC_RELAXED, __HIP_MEMORY_SCOPE_AGENT); }
__device__ __forceinline__ unsigned xb_add(unsigned* p, unsigned v) { return __hip_atomic_fetch_add(p, v, __ATOMIC_RELAXED, __HIP_MEMORY_SCOPE_AGENT); }
__device__ __forceinline__ unsigned xb_xcc_id() { return (unsigned)__builtin_amdgcn_s_getreg((3 << 11) | 20) & 0xFu; }
#define XB_SPIN(cond, bar) do { unsigned _sp = 0; while (cond) { __builtin_amdgcn_s_sleep(1); \
    if ((++_sp & 255u) == 0u) { if (xb_ld(&(bar)[XB_TMO])) break; if (_sp > XB_SPIN_CAP) { atomicAdd(&(bar)[XB_TMO], 1u); break; } } } } while (0)
struct XcdBarrier { unsigned* bar; unsigned x; volatile LAS unsigned* st; };
__device__ __forceinline__ XcdBarrier xcd_barrier_post(unsigned* bar, volatile LAS unsigned* st) {
    XcdBarrier b; b.bar = bar; b.x = xb_xcc_id(); b.st = st;
    if (threadIdx.x == 0) (void)xb_add(&bar[XB_XCNT(b.x)], 1u);
    return b;
}
__device__ __forceinline__ void xcd_barrier_complete(unsigned* bar, unsigned x, unsigned& nloc, unsigned& nx) {
    const unsigned G = gridDim.x * gridDim.y * gridDim.z;
    unsigned sum, cnt, mine, sp = 0u;
    for (;;) {
        sum = 0u; cnt = 0u; mine = 0u;
#pragma unroll
        for (unsigned j = 0; j < 16; ++j) { const unsigned c = xb_ld(&bar[XB_XCNT(j)]); sum += c; cnt += (c > 0u) ? 1u : 0u; mine = (j == x) ? c : mine; }
        if (sum == G) break;
        __builtin_amdgcn_s_sleep(1);
        if ((++sp & 255u) == 0u) { if (xb_ld(&bar[XB_TMO])) break; if (sp > XB_SPIN_CAP) { atomicAdd(&bar[XB_TMO], 1u); break; } }
    }
    nloc = mine > 0u ? mine : 1u; nx = cnt > 0u ? cnt : 1u;
}
__device__ __forceinline__ void xcd_barrier(const XcdBarrier& b) {
    asm volatile("s_waitcnt vmcnt(0)" ::: "memory");
    __syncthreads();
    if (threadIdx.x == 0) {
        unsigned* bar = b.bar;
        __builtin_amdgcn_s_waitcnt(0);
        unsigned nloc = b.st[0], nx = b.st[1];
        if (nloc == 0u) { xcd_barrier_complete(bar, b.x, nloc, nx); b.st[0] = nloc; b.st[1] = nx; }
        const unsigned old = xb_add(&bar[XB_XSUB(b.x)], 1u);
        const unsigned gen = old / nloc;
        if (old + 1u == (gen + 1u) * nloc) {
            __builtin_amdgcn_fence(__ATOMIC_RELEASE, "agent");
            asm volatile("s_waitcnt vmcnt(0)" ::: "memory");
            const unsigned og = xb_add(&bar[XB_TOP], 1u);
            const unsigned tg = og / nx;
            if (og + 1u == (tg + 1u) * nx) xb_add(&bar[XB_TOPGEN], 1u);
            else XB_SPIN(xb_ld(&bar[XB_TOPGEN]) == tg, bar);
            __builtin_amdgcn_fence(__ATOMIC_ACQUIRE, "agent");
            xb_add(&bar[XB_XGEN(b.x)], 1u);
            asm volatile("s_waitcnt vmcnt(0)" ::: "memory");
        } else {
            XB_SPIN(xb_ld(&bar[XB_XGEN(b.x)]) == gen, bar);
            __builtin_amdgcn_fence(__ATOMIC_ACQUIRE, "agent");
            asm volatile("s_waitcnt vmcnt(0)" ::: "memory");
        }
    }
    __syncthreads();
}

namespace pg8 {
constexpr int BM = 256, BK = 64, HALF = 128, HTB = HALF * BK * 2, STAGE_BYTES = 8 * HTB;
__host__ __device__ __forceinline__ int lds_byte(int r, int c) { const int st = (r >> 4) * 2 + (c >> 5), rr = r & 15, cc = c & 31, ob = rr * 64 + cc * 2; return st * 1024 + (ob ^ (((ob >> 9) & 1) << 5)); }
__host__ __device__ __forceinline__ void stage_rc(int b, int& R, int& C) { const int st = b / 1024, sb = b % 1024, swz = sb ^ (((sb >> 9) & 1) << 5); R = (st >> 1) * 16 + swz / 64; C = (st & 1) * 32 + (swz % 64) / 2; }
__host__ __device__ __forceinline__ int perm32(int rho) { const int n = rho >> 4, i = rho & 15; return 8 * (i >> 2) + 4 * n + (i & 3); }

struct GUnit { const char* B; int pm, pn, e, lrow0; };

typedef int i32x8 __attribute__((ext_vector_type(8)));
template <int K, class Epi, class Sched, bool F8 = false>
__device__ __forceinline__ void gemm_phase(LAS unsigned char* lds, const char* Aroot, const Sched& S, const Epi& E) {
    const int tid = threadIdx.x, wid = __builtin_amdgcn_readfirstlane(tid >> 6), lane = tid & 63, wr = wid >> 2, wc = wid & 3, fr = lane & 15, fq = lane >> 4;
    constexpr int EB = F8 ? 1 : 2;
    constexpr int nt = K * EB / (BK * 2);
    int Rr[2], Cc[2]; unsigned voffB[2];
#pragma unroll
    for (int i = 0; i < 2; ++i) { int R, C; stage_rc(tid * 16 + i * 8192, R, C); const int Rb = Epi::PERM ? ((R & ~31) + perm32(R & 31)) : R;
        Rr[i] = R; Cc[i] = C; voffB[i] = (unsigned)(Rb * K * EB + C * 2); }
    constexpr size_t kstep = (size_t)(BK * 2);
    constexpr size_t hstep = (size_t)HALF * K * EB;
    const unsigned ldsw = (unsigned)wid * 1024u;
    const int aoff = lds_byte(wr * 64 + fr, fq * 8), boff = lds_byte(wc * 32 + fr, fq * 8);
#define PG8_SA(b, h) (((b) * 2 + (h)) * HTB)
#define PG8_SB(b, h) ((4 + (b) * 2 + (h)) * HTB)
#define PG8_STAGEB(bufoff, gbase) do { _Pragma("unroll") for (int _i = 0; _i < 2; ++_i) \
        __builtin_amdgcn_global_load_lds((const unsigned*)((const char*)(gbase) + voffB[_i]), (LAS unsigned*)(lds + (bufoff) + ldsw + _i * 8192), 16, 0, 0); } while (0)
#define PG8_STAGEA(bufoff, base, o0, o1, kb) do { unsigned _o0 = (o0), _o1 = (o1); asm volatile("" : "+v"(_o0), "+v"(_o1));     \
        const char* _gb = (base) + (size_t)(kb); \
        __builtin_amdgcn_global_load_lds((const unsigned*)(_gb + _o0), (LAS unsigned*)(lds + (bufoff) + ldsw), 16, 0, 0); \
        __builtin_amdgcn_global_load_lds((const unsigned*)(_gb + _o1), (LAS unsigned*)(lds + (bufoff) + ldsw + 8192), 16, 0, 0); } while (0)
#define PG8_LD8(dst, off) do { const u32x4 _p0 = *(const LAS u32x4*)(lds + (off)), _p1 = *(const LAS u32x4*)(lds + (off) + 1024); dst = (i32x8){(int)_p0.x, (int)_p0.y, (int)_p0.z, (int)_p0.w, (int)_p1.x, (int)_p1.y, (int)_p1.z, (int)_p1.w}; } while (0)
#define PG8_LDA(dst, b, h) do { if constexpr (F8) { _Pragma("unroll") for (int m = 0; m < 4; ++m) PG8_LD8(dst##8[m], PG8_SA(b, h) + aoff + m * 2048); } \
        else { _Pragma("unroll") for (int m = 0; m < 4; ++m) _Pragma("unroll") for (int k = 0; k < 2; ++k) dst[m][k] = *(const LAS bf16x8*)(lds + PG8_SA(b, h) + aoff + m * 2048 + k * 1024); } } while (0)
#define PG8_LDB(dst, b, h) do { if constexpr (F8) { _Pragma("unroll") for (int n = 0; n < 2; ++n) PG8_LD8(dst##8[n], PG8_SB(b, h) + boff + n * 2048); } \
        else { _Pragma("unroll") for (int n = 0; n < 2; ++n) _Pragma("unroll") for (int k = 0; k < 2; ++k) dst[n][k] = *(const LAS bf16x8*)(lds + PG8_SB(b, h) + boff + n * 2048 + k * 1024); } } while (0)
#define PG8_MMA(ai, bj, At, Bt) do { __builtin_amdgcn_s_setprio(1); _Pragma("unroll") for (int m = 0; m < 4; ++m) _Pragma("unroll") for (int n = 0; n < 2; ++n) { \
        if constexpr (F8) asm volatile("v_mfma_scale_f32_16x16x128_f8f6f4 %0, %1, %2, %0, %3, %3 op_sel_hi:[0,0,0]" : "+v"(acc[ai][bj][m][n]) : "v"(Bt##8[n]), "v"(At##8[m]), "v"(f8scale)); \
        else { _Pragma("unroll") for (int k = 0; k < 2; ++k) acc[ai][bj][m][n] = __builtin_amdgcn_mfma_f32_16x16x32_bf16(Bt[n][k], At[m][k], acc[ai][bj][m][n], 0, 0, 0); } } \
        __builtin_amdgcn_s_setprio(0); } while (0)
#define PG8_WAIT_V(n) asm volatile("s_waitcnt vmcnt(" #n ")" ::: "memory")
#define PG8_WAIT_L(n) asm volatile("s_waitcnt lgkmcnt(" #n ")" ::: "memory")
#define PG8_BAR __builtin_amdgcn_s_barrier()
#define PG8_SCHED __builtin_amdgcn_sched_barrier(0)
    GUnit cur, nxt; int ui = 0;
    if (!S.next(0, cur)) return;
    f32x4 acc[2][2][4][2];
#pragma unroll
    for (int a = 0; a < 2; ++a)
#pragma unroll
        for (int b = 0; b < 2; ++b)
#pragma unroll
            for (int m = 0; m < 4; ++m)
#pragma unroll
                for (int n = 0; n < 2; ++n) acc[a][b][m][n] = (f32x4){0.f, 0.f, 0.f, 0.f};
    bf16x8 At[4][2], B0[2][2], B1[2][2];
    const int f8scale = 0x7f7f7f7f;
    i32x8 At8[4], B08[2], B18[2];
    unsigned c00, c01, c10, c11;
    const char* cA = Aroot;
    if constexpr (Sched::GATHER) {
        c00 = S.arow(cur, Rr[0]) * (unsigned)(K * EB) + (unsigned)Cc[0] * 2u; c01 = S.arow(cur, Rr[1]) * (unsigned)(K * EB) + (unsigned)Cc[1] * 2u;
        c10 = S.arow(cur, HALF + Rr[0]) * (unsigned)(K * EB) + (unsigned)Cc[0] * 2u; c11 = S.arow(cur, HALF + Rr[1]) * (unsigned)(K * EB) + (unsigned)Cc[1] * 2u;
    } else {
        c00 = (unsigned)(Rr[0] * K * EB + Cc[0] * 2); c01 = (unsigned)(Rr[1] * K * EB + Cc[1] * 2); c10 = c00 + (unsigned)(HALF * K * EB); c11 = c01 + (unsigned)(HALF * K * EB);
        cA = Aroot + (size_t)S.arow(cur, 0) * (size_t)(K * EB);
    }
    const char* cB = cur.B;
    PG8_STAGEB(PG8_SB(0, 0), cB); PG8_STAGEA(PG8_SA(0, 0), cA, c00, c01, 0); PG8_STAGEB(PG8_SB(0, 1), cB + hstep); PG8_STAGEA(PG8_SA(0, 1), cA, c10, c11, 0);
    if (wr == 1) PG8_BAR;
    PG8_WAIT_V(4); PG8_BAR;
    PG8_STAGEB(PG8_SB(1, 0), cB + kstep); PG8_STAGEA(PG8_SA(1, 0), cA, c00, c01, kstep); PG8_STAGEB(PG8_SB(1, 1), cB + hstep + kstep);
    PG8_WAIT_V(6); PG8_BAR;
    for (;;) {
        const bool has_next = S.next(ui + 1, nxt);
        unsigned n00 = c00, n01 = c01, n10 = c10, n11 = c11; const char* nB = cB; const char* nA = cA;
        LAS u32x4* noff_lds = (LAS u32x4*)(lds + STAGE_BYTES + 2048) + tid;
        if (has_next) {
            if constexpr (Sched::GATHER) {
                int tz = tid; asm volatile("" : "+v"(tz));
                int R0, C0, R1, C1; stage_rc(tz * 16, R0, C0); stage_rc(tz * 16 + 8192, R1, C1);
                u32x4 nn;
                nn.x = S.arow(nxt, R0) * (unsigned)(K * EB) + (unsigned)C0 * 2u; nn.y = S.arow(nxt, R1) * (unsigned)(K * EB) + (unsigned)C1 * 2u;
                nn.z = S.arow(nxt, HALF + R0) * (unsigned)(K * EB) + (unsigned)C0 * 2u; nn.w = S.arow(nxt, HALF + R1) * (unsigned)(K * EB) + (unsigned)C1 * 2u;
                *((LAS u32x4*)(lds + STAGE_BYTES + 2048) + tz) = nn;
            } else nA = Aroot + (size_t)S.arow(nxt, 0) * (size_t)(K * EB);
            nB = nxt.B;
        } else if constexpr (Sched::GATHER) { *noff_lds = (u32x4){c00, c01, c10, c11}; }
        for (int t = 0; t < nt; t += 2) {
            const bool last = (t == nt - 2);
            const size_t k1 = (size_t)(t + 1) * kstep;
            const size_t k2 = last ? 0 : (size_t)(t + 2) * kstep, k3 = k2 + kstep;
            if constexpr (Sched::GATHER) { if (last) { const u32x4 nn = *noff_lds; n00 = nn.x; n01 = nn.y; n10 = nn.z; n11 = nn.w; } }
            const unsigned a00 = last ? n00 : c00, a01 = last ? n01 : c01, a10 = last ? n10 : c10, a11 = last ? n11 : c11; const char* a2 = last ? nA : cA;
            const char* b2 = last ? nB : cB + (size_t)(t + 2) * kstep; const char* b3 = b2 + kstep;
            PG8_LDB(B0, 0, 0); PG8_SCHED; PG8_LDA(At, 0, 0); PG8_STAGEA(PG8_SA(1, 1), cA, c10, c11, k1);
            PG8_WAIT_L(8); PG8_BAR; PG8_WAIT_L(0); PG8_MMA(0, 0, At, B0); PG8_BAR; PG8_SCHED;
            PG8_LDB(B1, 0, 1); PG8_STAGEB(PG8_SB(0, 0), b2);
            PG8_BAR; PG8_WAIT_L(0); PG8_MMA(0, 1, At, B1); PG8_BAR;
            PG8_LDA(At, 0, 1); PG8_STAGEA(PG8_SA(0, 0), a2, a00, a01, k2);
            PG8_BAR; PG8_WAIT_L(0); PG8_MMA(1, 0, At, B0); PG8_BAR; PG8_SCHED;
            PG8_STAGEB(PG8_SB(0, 1), b2 + hstep);
            PG8_WAIT_V(6); PG8_BAR; PG8_MMA(1, 1, At, B1); PG8_BAR;
            PG8_LDB(B0, 1, 0); PG8_SCHED; PG8_LDA(At, 1, 0); PG8_STAGEA(PG8_SA(0, 1), a2, a10, a11, k2);
            PG8_WAIT_L(8); PG8_BAR; PG8_WAIT_L(0); PG8_MMA(0, 0, At, B0); PG8_BAR; PG8_SCHED;
            PG8_LDB(B1, 1, 1); PG8_STAGEB(PG8_SB(1, 0), b3);
            PG8_BAR; PG8_WAIT_L(0); PG8_MMA(0, 1, At, B1); PG8_BAR;
            PG8_LDA(At, 1, 1); PG8_STAGEA(PG8_SA(1, 0), a2, a00, a01, k3);
            PG8_BAR; PG8_WAIT_L(0); PG8_MMA(1, 0, At, B0); PG8_BAR; PG8_SCHED;
            PG8_STAGEB(PG8_SB(1, 1), b3 + hstep);
            PG8_WAIT_V(6); PG8_BAR; PG8_MMA(1, 1, At, B1); PG8_BAR;
        }
        if (wr == 0) PG8_BAR;
        if constexpr (F8) asm volatile("s_nop 15\n\ts_nop 15" ::: "memory");
        E(acc, cur, wr, wc, fr, fq);
        if (!has_next) break;
#pragma unroll
        for (int a = 0; a < 2; ++a)
#pragma unroll
            for (int b = 0; b < 2; ++b)
#pragma unroll
                for (int m = 0; m < 4; ++m)
#pragma unroll
                    for (int n = 0; n < 2; ++n) acc[a][b][m][n] = (f32x4){0.f, 0.f, 0.f, 0.f};
        cur = nxt; cB = nB; cA = nA; c00 = n00; c01 = n01; c10 = n10; c11 = n11; ++ui;
        if (wr == 1) PG8_BAR;
    }
    PG8_WAIT_V(0);
    PG8_BAR;
#undef PG8_SA
#undef PG8_SB
#undef PG8_STAGEA
#undef PG8_STAGEB
#undef PG8_LDA
#undef PG8_LDB
#undef PG8_MMA
#undef PG8_LD8
#undef PG8_WAIT_V
#undef PG8_WAIT_L
#undef PG8_BAR
#undef PG8_SCHED
}
}
using pg8::GUnit;

struct Args { const float* in[38]; float* out; unsigned char* ws; int ph_lo, ph_hi, bar_region, pad; };
enum { I_X = 0, I_C, I_CTX, I_CCTX, I_WADA, I_BADA, I_GPREMIX, I_GPOSTMIX, I_GPREFFN, I_GPOSTFFN, I_WIN, I_BIN, I_MUP, I_MUN, I_SINKS, I_W0F, I_W0B, I_W2F, I_W2B,
       I_A0F, I_A0B, I_A2F, I_A2B, I_G2, I_KK, I_KA, I_RK, I_LNW, I_LNB, I_WUPA, I_WUPR, I_WOUT, I_WROUTER, I_BROUTER, I_WGU, I_BGU, I_WDN, I_BDN };

__device__ __forceinline__ unsigned pk4_fp8(float a, float b, float c, float d) { int w = 0; w = __builtin_amdgcn_cvt_pk_fp8_f32(a, b, w, false); w = __builtin_amdgcn_cvt_pk_fp8_f32(c, d, w, true); return (unsigned)w; }
typedef float f32x2_t __attribute__((ext_vector_type(2)));
typedef __bf16 bf16x2_t __attribute__((ext_vector_type(2)));
__device__ __forceinline__ unsigned cvt_pk_bf16_asm(float lo, float hi) { unsigned r; asm volatile("v_cvt_pk_bf16_f32 %0, %1, %2" : "=v"(r) : "v"(lo), "v"(hi)); return r; }
__device__ __forceinline__ unsigned cvt_pk_bf16(float lo, float hi) { const f32x2_t v = {lo, hi}; const bf16x2_t b = __builtin_convertvector(v, bf16x2_t); return __builtin_bit_cast(unsigned, b); }

__device__ __forceinline__ void tile_order(int L, int nM, int nN, int& pm, int& pn) {
    const int nwg = nM * nN; int wgid = L;
    { const int q = nwg / 8, r = nwg % 8, xcd = wgid % 8, off = wgid / 8; wgid = (xcd < r ? xcd * (q + 1) : r * (q + 1) + (xcd - r) * q) + off; }
    const int nig = 8 * nN, gid = wgid / nig, fm = gid * 8, gsz = (nM - fm) < 8 ? (nM - fm) : 8;
    pm = fm + ((wgid % nig) % gsz); pn = (wgid % nig) / gsz;
}

struct SchedProj {           static constexpr bool GATHER = false;
    const char* Bt; int G, c;
    __device__ __forceinline__ bool next(int i, GUnit& u) const {
        const int L = i * G + c; constexpr int NXU = 128 * NTILE_N;
        if (L >= NXU + 72) return false;
        int pm, pn;
        if (L < NXU) tile_order(L, 128, NTILE_N, pm, pn); else { const int l2 = L - NXU; pm = 128 + l2 / 9; pn = 2 + l2 % 9; }
        u.pm = pm; u.pn = pn; u.e = 0; u.lrow0 = 0; u.B = Bt + (size_t)pn * 256 * D * 2; return true;
    }
    __device__ __forceinline__ unsigned arow(const GUnit& u, int r) const { return (unsigned)(u.pm * 256 + r); }
};
template <int K> struct SchedDense {
    static constexpr bool GATHER = false;
    const char* Bt; int G, c;
    __device__ __forceinline__ bool next(int i, GUnit& u) const {
        const int L = i * G + c; if (L >= 128 * 4) return false;
        int pm, pn; tile_order(L, 128, 4, pm, pn);
        u.pm = pm; u.pn = pn; u.e = 0; u.lrow0 = 0; u.B = Bt + (size_t)pn * 256 * K * 2; return true;
    }
    __device__ __forceinline__ unsigned arow(const GUnit& u, int r) const { return (unsigned)(u.pm * 256 + r); }
};
template <int NPN, bool GATHER_, int EB = 2> struct SchedMoe {
    static constexpr bool GATHER = GATHER_;
    const char* Bt; int G, c; const LAS int* tstart; const int* cnt; const int* slot_tok;
    __device__ __forceinline__ bool next(int i, GUnit& u) const {
        const int L = i * G + c; const int TT = __builtin_amdgcn_readfirstlane(tstart[NE]);
        if (L >= TT * NPN) return false;
        const int rt = L / NPN, pn = L % NPN; int e = 0;
#pragma unroll
        for (int j = 1; j < NE; ++j) e += (tstart[j] <= rt) ? 1 : 0;
        e = __builtin_amdgcn_readfirstlane(e);
        u.pm = rt; u.pn = pn; u.e = e; u.lrow0 = __builtin_amdgcn_readfirstlane((rt - tstart[e]) * 256);
        u.B = Bt + ((size_t)e * (NPN * 256) + (size_t)pn * 256) * DE * EB; return true;
    }
    __device__ __forceinline__ unsigned arow(const GUnit& u, int r) const {
        if (GATHER) { const int lr = u.lrow0 + r; const int n = cnt[u.e]; const unsigned tok = (unsigned)slot_tok[u.e * T + (lr < T ? lr : T - 1)]; return (lr < n) ? tok : 0u; }
        return (unsigned)(u.pm * 256 + r);
    }
};

struct EpiZ {
    static constexpr bool PERM = true;
    bf16_t* Z; const float* bias;
    __device__ __forceinline__ void operator()(const f32x4 (&acc)[2][2][4][2], const GUnit& u, int wr, int wc, int fr, int fq) const {
        const int row0 = u.pm * 256 + wr * 64 + fr, col0 = u.pn * 256 + wc * 32 + 8 * fq;
        f32x4 bv[2][2];
#pragma unroll
        for (int bj = 0; bj < 2; ++bj)
#pragma unroll
            for (int n = 0; n < 2; ++n) bv[bj][n] = *(const f32x4*)(bias + col0 + bj * 128 + 4 * n);
#pragma unroll
        for (int ai = 0; ai < 2; ++ai)
#pragma unroll
            for (int m = 0; m < 4; ++m) { bf16_t* rowp = Z + (size_t)(row0 + ai * 128 + m * 16) * ZP + col0;
#pragma unroll
                for (int bj = 0; bj < 2; ++bj) { const f32x4 v0 = acc[ai][bj][m][0] + bv[bj][0], v1 = acc[ai][bj][m][1] + bv[bj][1];
                    u32x4 w; w.x = cvt_pk_bf16(v0[0], v0[1]); w.y = cvt_pk_bf16(v0[2], v0[3]); w.z = cvt_pk_bf16(v1[0], v1[1]); w.w = cvt_pk_bf16(v1[2], v1[3]);
                    *(u32x4*)(rowp + bj * 128) = w; } }
    }
};
template <bool SECOND> struct EpiUp {
    static constexpr bool PERM = true;
    bf16_t* O; const bf16_t* Z;
    __device__ __forceinline__ void operator()(const f32x4 (&acc)[2][2][4][2], const GUnit& u, int wr, int wc, int fr, int fq) const {
        const int row0 = u.pm * 256 + wr * 64 + fr, col0 = u.pn * 256 + wc * 32 + 8 * fq;
#pragma unroll
        for (int ai = 0; ai < 2; ++ai)
#pragma unroll
            for (int m = 0; m < 4; ++m) { const size_t row = (size_t)(row0 + ai * 128 + m * 16);
#pragma unroll
                for (int bj = 0; bj < 2; ++bj) {
                    const u32x4 g = *(const u32x4*)(Z + row * ZP + ZC_G + (SECOND ? 1024 : 0) + col0 + bj * 128);
                    const f32x4 a0 = acc[ai][bj][m][0], a1 = acc[ai][bj][m][1];
                    float o[8];
                    o[0] = sigmoidf_(lo16(g.x)) * a0[0]; o[1] = sigmoidf_(hi16(g.x)) * a0[1]; o[2] = sigmoidf_(lo16(g.y)) * a0[2]; o[3] = sigmoidf_(hi16(g.y)) * a0[3];
                    o[4] = sigmoidf_(lo16(g.z)) * a1[0]; o[5] = sigmoidf_(hi16(g.z)) * a1[1]; o[6] = sigmoidf_(lo16(g.w)) * a1[2]; o[7] = sigmoidf_(hi16(g.w)) * a1[3];
                    bf16_t* op = O + row * 1024 + col0 + bj * 128;
                    if (SECOND) { const u32x4 p = *(const u32x4*)op;
                        o[0] += lo16(p.x); o[1] += hi16(p.x); o[2] += lo16(p.y); o[3] += hi16(p.y); o[4] += lo16(p.z); o[5] += hi16(p.z); o[6] += lo16(p.w); o[7] += hi16(p.w); }
                    u32x4 w; w.x = cvt_pk_bf16(o[0], o[1]); w.y = cvt_pk_bf16(o[2], o[3]); w.z = cvt_pk_bf16(o[4], o[5]); w.w = cvt_pk_bf16(o[6], o[7]);
                    *(u32x4*)op = w; } }
    }
};
struct EpiMix {
    static constexpr bool PERM = true;
    bf16_t* C;
    __device__ __forceinline__ void operator()(const f32x4 (&acc)[2][2][4][2], const GUnit& u, int wr, int wc, int fr, int fq) const {
        const int row0 = u.pm * 256 + wr * 64 + fr, col0 = u.pn * 256 + wc * 32 + 8 * fq;
#pragma unroll
        for (int ai = 0; ai < 2; ++ai)
#pragma unroll
            for (int m = 0; m < 4; ++m) { bf16_t* rowp = C + (size_t)(row0 + ai * 128 + m * 16) * 1024 + col0;
#pragma unroll
                for (int bj = 0; bj < 2; ++bj) { const f32x4 v0 = acc[ai][bj][m][0], v1 = acc[ai][bj][m][1];
                    u32x4 w; w.x = cvt_pk_bf16(v0[0], v0[1]); w.y = cvt_pk_bf16(v0[2], v0[3]); w.z = cvt_pk_bf16(v1[0], v1[1]); w.w = cvt_pk_bf16(v1[2], v1[3]);
                    *(u32x4*)(rowp + bj * 128) = w; } }
    }
};
__device__ __forceinline__ float swiglu1(float g, float up) {
    g = fminf(g, 7.0f); up = fminf(fmaxf(up, -7.0f), 7.0f);
    return (up + 1.0f) * (g * sigmoidf_(1.702f * g));
}
struct EpiMoe1 {
    static constexpr bool PERM = true;
    bf16_t* H; const float* bgu;
    __device__ __forceinline__ void operator()(const f32x4 (&acc)[2][2][4][2], const GUnit& u, int wr, int wc, int fr, int fq) const {
        const int row0 = u.pm * 256 + wr * 64 + fr, col0 = u.pn * 256 + wc * 32 + 8 * fq;
        const float* b = bgu + (size_t)u.e * 2048 + col0;
        constexpr float sc = 1.0f / (F8_WSCALE * F8_ASCALE);
#pragma unroll
        for (int bj = 0; bj < 2; ++bj) {
            const f32x4 b0 = *(const f32x4*)(b + bj * 128), b1 = *(const f32x4*)(b + bj * 128 + 4);
#pragma unroll
            for (int ai = 0; ai < 2; ++ai)
#pragma unroll
                for (int m = 0; m < 4; ++m) {
                    const f32x4 v0 = acc[ai][bj][m][0] * sc + b0, v1 = acc[ai][bj][m][1] * sc + b1;
                    *(unsigned*)((unsigned char*)H + (size_t)(row0 + ai * 128 + m * 16) * 1024 + (col0 >> 1) + bj * 64) =
                        pk4_fp8(swiglu1(v0[0], v0[1]) * F8_HSCALE, swiglu1(v0[2], v0[3]) * F8_HSCALE, swiglu1(v1[0], v1[1]) * F8_HSCALE, swiglu1(v1[2], v1[3]) * F8_HSCALE);
                }
        }
    }
};
struct EpiMoe2 {
    static constexpr bool PERM = true;
    unsigned char* Y; const float* bdn; const float* slot_gate; const int* cnt;
    __device__ __forceinline__ void operator()(const f32x4 (&acc)[2][2][4][2], const GUnit& u, int wr, int wc, int fr, int fq) const {
        const int r0 = wr * 64 + fr, col0 = u.pn * 256 + wc * 32 + 8 * fq;
        const float* b = bdn + (size_t)u.e * 1024 + col0; const int n_e = cnt[u.e];
        constexpr float sc = 1.0f / (F8_WSCALE * F8_HSCALE);
        f32x4 bv[2][2];
#pragma unroll
        for (int bj = 0; bj < 2; ++bj)
#pragma unroll
            for (int n = 0; n < 2; ++n) bv[bj][n] = *(const f32x4*)(b + bj * 128 + 4 * n);
#pragma unroll
        for (int ai = 0; ai < 2; ++ai)
#pragma unroll
            for (int m = 0; m < 4; ++m) { const int r = r0 + ai * 128 + m * 16; const int lr = u.lrow0 + r;
                const float gt = ((lr < n_e) ? slot_gate[(size_t)u.e * T + lr] : 0.0f) * F8_YSCALE;
                unsigned char* rowp = Y + (size_t)(u.pm * 256 + r) * 1024 + col0;
#pragma unroll
                for (int bj = 0; bj < 2; ++bj) { const f32x4 v0 = (acc[ai][bj][m][0] * sc + bv[bj][0]) * gt, v1 = (acc[ai][bj][m][1] * sc + bv[bj][1]) * gt;
                    u32x2 w; w.x = pk4_fp8(v0[0], v0[1], v0[2], v0[3]); w.y = pk4_fp8(v1[0], v1[1], v1[2], v1[3]);
                    *(u32x2*)(rowp + bj * 128) = w; } }
    }
};

__device__ __forceinline__ void p0_transpose_item(const float* W, int K, int N, bf16_t* WT, int row_off, LAS float* scr, int item, int lane) {
    const int nblk = N / 32, kb = item / nblk, nb = item % nblk, k0 = 64 * kb, n0 = 32 * nb;
#pragma unroll 8
    for (int i = 0; i < 32; ++i) { const int kk = 2 * i + (lane >> 5); scr[kk * 33 + (lane & 31)] = W[(size_t)(k0 + kk) * N + n0 + (lane & 31)]; }
    LDS_WAIT(); asm volatile("" ::: "memory");
    const int c = lane & 7;
#pragma unroll
    for (int j = 0; j < 4; ++j) { const int n = (lane >> 3) + 8 * j; const LAS float* s = scr + (8 * c) * 33 + n;
        u32x4 o; o.x = pk2(s[0 * 33], s[1 * 33]); o.y = pk2(s[2 * 33], s[3 * 33]); o.z = pk2(s[4 * 33], s[5 * 33]); o.w = pk2(s[6 * 33], s[7 * 33]);
        *(u32x4*)(WT + (size_t)(row_off + n0 + n) * K + k0 + 8 * c) = o; }
    LDS_WAIT(); asm volatile("" ::: "memory");
}
__device__ __forceinline__ void p0_prologue(const Args& a, LAS unsigned char* lds, int tid, int lane, int wave, int G) {
    unsigned char* ws = a.ws;
    {
        float* MOD = (float*)(ws + WS_CTL) + CW_MOD;
        LAS float* sl = (LAS float*)lds;
        LAS float* red = sl + 9 * 1024;
        if (blockIdx.x < 96) {
            for (int i = tid; i < 9 * 1024; i += 512) { const int r = i >> 10, k = i & 1023; const float v = (r < 8) ? a.in[I_C][r * D + k] : a.in[I_CCTX][k]; sl[i] = v * sigmoidf_(v); }
            __syncthreads();
            for (int it = blockIdx.x; it < 96; it += G) {
                const int n = it * 64 + lane; float acc[9];
#pragma unroll
                for (int r = 0; r < 9; ++r) acc[r] = 0.f;
                const float* w = a.in[I_WADA] + (size_t)(wave * 128) * 6144 + n;
#pragma unroll 8
                for (int kk = 0; kk < 128; ++kk) { const float wv = w[(size_t)kk * 6144];
#pragma unroll
                    for (int r = 0; r < 9; ++r) acc[r] += sl[r * 1024 + wave * 128 + kk] * wv; }
#pragma unroll
                for (int r = 0; r < 9; ++r) red[(wave * 9 + r) * 64 + lane] = acc[r];
                __syncthreads();
                for (int i = tid; i < 9 * 64; i += 512) { const int r = i >> 6, c = i & 63; float s = a.in[I_BADA][it * 64 + c];
#pragma unroll
                    for (int w8 = 0; w8 < 8; ++w8) s += red[(w8 * 9 + r) * 64 + c];
                    MOD[r * 6144 + it * 64 + c] = s; }
                __syncthreads();
            }
        }
        __syncthreads();
    }
    {
        float* misc = (float*)(ws + WS_MISC);
        const int gt = blockIdx.x * 512 + tid, NGT = G * 512;
        for (int n = gt; n < ZP; n += NGT) misc[n] = (n < 2688) ? a.in[I_BIN][n] : ((n < 2816) ? 0.f : a.in[I_BIN][n - 128]);
        for (int n = gt; n < 1024; n += NGT) { const int p = n >> 4, i = n & 15; const float inv = powf(10000.0f, -(float)i / 16.0f); float s, c; sincosf((float)p * inv, &s, &c); misc[ZP + n] = c; misc[ZP + 1024 + n] = s; }
        u32x4* zr = (u32x4*)((bf16_t*)(ws + WS_WIN) + (size_t)2688 * D);
        for (int n = gt; n < 128 * D / 8; n += NGT) zr[n] = (u32x4){0u, 0u, 0u, 0u};
    }
    {
        LAS float* scr = (LAS float*)(lds + wave * 8704);
        const int gw = blockIdx.x * 8 + wave, NGW = G * 8;
        constexpr int J_IN = 16 * (PROJ_SRC / 32), J_UP = 8 * 32, J_OUT = 16 * 32, J_L = 16, J_G2 = 32, J_GU1 = 16 * 64, J_DN1 = 16 * 32;
        constexpr int NITEMS = J_IN + 2 * J_UP + J_OUT + 4 * J_L + J_G2;
        bf16_t* lora = (bf16_t*)(ws + WS_LORA);
        for (int it = gw; it < NITEMS; it += NGW) {
            int r = it;
            if (r < J_IN) { const int nb = r % (PROJ_SRC / 32); p0_transpose_item(a.in[I_WIN], D, PROJ_SRC, (bf16_t*)(ws + WS_WIN), (nb * 32 >= 2688) ? 128 : 0, scr, r, lane); continue; } r -= J_IN;
            if (r < J_UP) { p0_transpose_item(a.in[I_WUPA], 512, D, (bf16_t*)(ws + WS_WUPA), 0, scr, r, lane); continue; } r -= J_UP;
            if (r < J_UP) { p0_transpose_item(a.in[I_WUPR], 512, D, (bf16_t*)(ws + WS_WUPR), 0, scr, r, lane); continue; } r -= J_UP;
            if (r < J_OUT) { p0_transpose_item(a.in[I_WOUT], D, D, (bf16_t*)(ws + WS_WOUT), 0, scr, r, lane); continue; } r -= J_OUT;
            if (r < J_L) { p0_transpose_item(a.in[I_W2F], 64, 512, lora, 0, scr, r, lane); continue; } r -= J_L;
            if (r < J_L) { p0_transpose_item(a.in[I_W2B], 64, 512, lora + 32768, 0, scr, r, lane); continue; } r -= J_L;
            if (r < J_L) { p0_transpose_item(a.in[I_A2F], 64, 512, lora + 2 * 32768, 0, scr, r, lane); continue; } r -= J_L;
            if (r < J_L) { p0_transpose_item(a.in[I_A2B], 64, 512, lora + 3 * 32768, 0, scr, r, lane); continue; } r -= J_L;
            p0_transpose_item(a.in[I_G2], 128, 512, lora + 4 * 32768, 0, scr, r, lane);
        }
    }
}

__device__ __forceinline__ void p0_transpose_item_f8(const float* W, int K, int N, unsigned char* WT, LAS float* scr, int item, int lane, float sc) {
    const int nblk = N / 32, kb = item / nblk, nb = item % nblk, k0 = 64 * kb, n0 = 32 * nb;
#pragma unroll 8
    for (int i = 0; i < 32; ++i) { const int kk = 2 * i + (lane >> 5); scr[kk * 33 + (lane & 31)] = W[(size_t)(k0 + kk) * N + n0 + (lane & 31)] * sc; }
    LDS_WAIT(); asm volatile("" ::: "memory");
    const int c = lane & 7;
#pragma unroll
    for (int j = 0; j < 4; ++j) { const int n = (lane >> 3) + 8 * j; const LAS float* s = scr + (8 * c) * 33 + n;
        u32x2 o; o.x = pk4_fp8(s[0 * 33], s[1 * 33], s[2 * 33], s[3 * 33]); o.y = pk4_fp8(s[4 * 33], s[5 * 33], s[6 * 33], s[7 * 33]);
        *(u32x2*)(WT + (size_t)(n0 + n) * K + k0 + 8 * c) = o; }
    LDS_WAIT(); asm volatile("" ::: "memory");
}
__device__ __forceinline__ int queue_pull(unsigned* q, LAS unsigned char* lds, int tid) {
    volatile LAS int* w = (volatile LAS int*)(lds + RING_BYTES + 256);
    __syncthreads();
    if (tid == 0) *w = (int)__hip_atomic_fetch_add(q, 1u, __ATOMIC_RELAXED, __HIP_MEMORY_SCOPE_AGENT);
    __syncthreads();
    return *w;
}
__device__ __forceinline__ void moe_weight_copies(const Args& a, LAS unsigned char* lds, int tid, int lane, int wave) {
    unsigned char* ws = a.ws;
    LAS float* scr = (LAS float*)(lds + wave * 8704);
    constexpr int J_GU1 = 16 * 64, J_DN1 = 16 * 32, NCHUNK = (NE * J_GU1 + NE * J_DN1) / 128;
    unsigned* q = (unsigned*)(ws + WS_CTL) + CW_QTR;
    for (;;) {
        const int ch = queue_pull(q, lds, tid);
        if (ch >= NCHUNK) break;
#pragma unroll 1
        for (int k = 0; k < 16; ++k) {
            int r = ch * 128 + wave * 16 + k;
            if (r < NE * J_GU1) { const int e = r / J_GU1; p0_transpose_item_f8(a.in[I_WGU] + (size_t)e * D * 2048, D, 2048, (unsigned char*)(ws + WS_WGU) + (size_t)e * 2048 * D, scr, r % J_GU1, lane, F8_WSCALE); }
            else { r -= NE * J_GU1; const int e = r / J_DN1; p0_transpose_item_f8(a.in[I_WDN] + (size_t)e * DE * D, DE, D, (unsigned char*)(ws + WS_WDN) + (size_t)e * D * DE, scr, r % J_DN1, lane, F8_WSCALE); }
        }
    }
}

__device__ __forceinline__ void p1_norm(const Args& a, int lane, int wave, int G) {
    const float* MOD = (const float*)(a.ws + WS_CTL) + CW_MOD;
    bf16_t* HX = (bf16_t*)(a.ws + WS_HX);
    const int gw = blockIdx.x * 8 + wave, NGW = G * 8;
    for (int m = gw; m < ROWS; m += NGW) {
        const float* xrow = (m < T) ? a.in[I_X] + (size_t)m * D : a.in[I_CTX] + (size_t)(m - T) * D;
        const int r = (m < T) ? (m >> 12) : 8;
        const f32x4* xr = (const f32x4*)xrow + lane;
        f32x4 v[4]; float s = 0.f;
#pragma unroll
        for (int j = 0; j < 4; ++j) { v[j] = xr[64 * j]; s += (v[j].x * v[j].x + v[j].y * v[j].y) + (v[j].z * v[j].z + v[j].w * v[j].w); }
        const float rstd = 1.0f / sqrtf(wave_sum(s) * (1.f / D) + RMS_EPS);
        unsigned long long* o8 = (unsigned long long*)(HX + (size_t)m * D) + lane;
#pragma unroll
        for (int j = 0; j < 4; ++j) {
            const f32x4 g = ((const f32x4*)a.in[I_GPREMIX])[64 * j + lane], sh = ((const f32x4*)(MOD + r * 6144))[64 * j + lane], sc = ((const f32x4*)(MOD + r * 6144 + 1024))[64 * j + lane];
            const f32x4 h = (v[j] * rstd * g) * (sc + 1.0f) + sh;
            o8[64 * j] = (unsigned long long)pk2(h.x, h.y) | ((unsigned long long)pk2(h.z, h.w) << 32);
        }
    }
}

constexpr size_t WS_ACT = WS_HX;
__device__ __forceinline__ void p3a_pointwise(const Args& a, int tid, int G) {
    unsigned char* ws = a.ws;
    const bf16_t* Z = (const bf16_t*)(ws + WS_Z);
    bf16_t* FB = (bf16_t*)(ws + WS_FEAT); bf16_t* ACT = (bf16_t*)(ws + WS_ACT);
    const float* rc = (const float*)(ws + WS_MISC) + ZP; const float* rs = rc + 1024;
    const int cv = tid % 240, rg = tid / 240;
    float mp[8], mn[8];
    if (tid < 480) {
#pragma unroll
        for (int j = 0; j < 8; ++j) { mp[j] = a.in[I_MUP][8 * cv + j]; mn[j] = a.in[I_MUN][8 * cv + j]; }
    }
    for (int unit = blockIdx.x; unit < ROWS / 16; unit += G) {
        const int row0 = unit * 16;
        const bool isx = row0 < T;
        const int slen = isx ? SEQ : CL;
        const int pos0 = isx ? (row0 & (SEQ - 1)) : ((row0 - T) & (CL - 1));
        if (tid < 480) {
            const int r0 = row0 + 8 * rg, p0 = pos0 + 8 * rg;
            const bf16_t* zp = Z + (size_t)r0 * ZP + ZC_R + 8 * cv;
            u32x4 prv = (u32x4){0u, 0u, 0u, 0u};
            if (p0 > 0) prv = *(const u32x4*)(zp - ZP);
            u32x4 cur = *(const u32x4*)zp;
#pragma unroll
            for (int i = 0; i < 8; ++i) {
                u32x4 nxt = (u32x4){0u, 0u, 0u, 0u};
                if (p0 + i < slen - 1) nxt = *(const u32x4*)(zp + (size_t)(i + 1) * ZP);
                float o[8];
#pragma unroll
                for (int j = 0; j < 4; ++j) {
                    const float c0 = lo16(cur[j]), c1 = hi16(cur[j]);
                    o[2 * j] = c0 + mp[2 * j] * (lo16(prv[j]) - c0) + mn[2 * j] * (lo16(nxt[j]) - c0);
                    o[2 * j + 1] = c1 + mp[2 * j + 1] * (hi16(prv[j]) - c1) + mn[2 * j + 1] * (hi16(nxt[j]) - c1);
                }
                bf16_t* op;
                if (cv < 64) op = FB + (size_t)F_R * (FEAT_STRIDE / 2) + (size_t)(r0 + i) * RD + 8 * cv;
                else if (cv < 128) op = FB + (size_t)F_A * (FEAT_STRIDE / 2) + (size_t)(r0 + i) * RD + 8 * (cv - 64);
                else if (cv < 192) op = FB + (size_t)F_V * (FEAT_STRIDE / 2) + (size_t)(r0 + i) * RD + 8 * (cv - 128);
                else {
                    op = ACT + (size_t)(r0 + i) * 384 + 8 * (cv - 192);
                    if (cv < 208) {
#pragma unroll
                        for (int j = 0; j < 8; ++j) o[j] = 1.0f - 2.0f * __builtin_amdgcn_rcpf(__expf(2.0f * o[j]) + 1.0f);
                    } else if (cv >= 224) {
#pragma unroll
                        for (int j = 0; j < 8; ++j) o[j] = sigmoidf_(o[j]);
                    }
                }
                u32x4 w; w.x = pk2(o[0], o[1]); w.y = pk2(o[2], o[3]); w.z = pk2(o[4], o[5]); w.w = pk2(o[6], o[7]);
                *(u32x4*)op = w;
                prv = cur; cur = nxt;
            }
        }
        {
            bf16_t* QR = (bf16_t*)(ws + WS_QR); bf16_t* KA = (bf16_t*)(ws + WS_KA); bf16_t* VT = (bf16_t*)(ws + WS_VT);
#pragma unroll 1
            for (int idx = tid; idx < 16 * 40; idx += 512) {
                const int tk = idx / 40, j = idx % 40; const int row = row0 + tk, pos = pos0 + tk;
                const int hh = j >> 2, part = (j >> 1) & 1, sub = j & 1;
                const bool isq = hh < 8;
                if (isq && !isx) continue;
                const int zc = isq ? (ZC_Q + hh * 64) : (ZC_K + (hh - 8) * 64);
                const bf16_t* zp = Z + (size_t)row * ZP + zc + part * 32 + sub * 8;
                const u32x4 t1 = *(const u32x4*)zp, t2 = *(const u32x4*)(zp + 16);
                float x1[8], x2[8], o1[8], o2[8];
#pragma unroll
                for (int q = 0; q < 4; ++q) { x1[2 * q] = lo16(t1[q]); x1[2 * q + 1] = hi16(t1[q]); x2[2 * q] = lo16(t2[q]); x2[2 * q + 1] = hi16(t2[q]); }
                if (isx) {
                    const int p = part ? (pos & 63) : (pos >> 6);
                    const float sc = isq ? (0.125f * 1.44269504089f) : 1.0f;
                    const f32x4 cA = *(const f32x4*)(rc + p * 16 + sub * 8), cB = *(const f32x4*)(rc + p * 16 + sub * 8 + 4), sA = *(const f32x4*)(rs + p * 16 + sub * 8), sB = *(const f32x4*)(rs + p * 16 + sub * 8 + 4);
#pragma unroll
                    for (int q = 0; q < 8; ++q) { const float c = q < 4 ? cA[q & 3] : cB[q & 3], s = q < 4 ? sA[q & 3] : sB[q & 3];
                        o1[q] = (x1[q] * c - x2[q] * s) * sc; o2[q] = (x2[q] * c + x1[q] * s) * sc; }
                } else {
#pragma unroll
                    for (int q = 0; q < 8; ++q) { o1[q] = x1[q]; o2[q] = x2[q]; }
                }
                u32x4 w1, w2;
#pragma unroll
                for (int q = 0; q < 4; ++q) { w1[q] = pk2(o1[2 * q], o1[2 * q + 1]); w2[q] = pk2(o2[2 * q], o2[2 * q + 1]); }
                bf16_t* op = isq ? (QR + (size_t)row * 512 + hh * 64 + part * 32 + sub * 8) : (KA + (size_t)row * 128 + (hh - 8) * 64 + part * 32 + sub * 8);
                *(u32x4*)op = w1; *(u32x4*)(op + 16) = w2;
            }
            if (tid < 256) {
                const int cidx = tid & 127, tg = tid >> 7; const int g = cidx >> 6, d = cidx & 63;
                unsigned short vv[8];
#pragma unroll
                for (int q = 0; q < 8; ++q) vv[q] = Z[(size_t)(row0 + 8 * tg + q) * ZP + ZC_V + cidx];
                u32x4 w; w.x = vv[0] | ((unsigned)vv[1] << 16); w.y = vv[2] | ((unsigned)vv[3] << 16); w.z = vv[4] | ((unsigned)vv[5] << 16); w.w = vv[6] | ((unsigned)vv[7] << 16);
                bf16_t* op;
                if (isx) { const int b = row0 >> 12; op = VT + ((size_t)(b * 2 + g) * 64 + d) * SEQ + pos0 + 8 * tg; }
                else { const int b = (row0 - T) >> 8; op = VT + (size_t)NB * 2 * 64 * SEQ + ((size_t)(b * 2 + g) * 64 + d) * CL + pos0 + 8 * tg; }
                *(u32x4*)op = w;
            }
        }
    }
}

__device__ __forceinline__ void p3b_features(const Args& a, LAS unsigned char* lds, int tid, int lane, int wave, int G) {
    unsigned char* ws = a.ws;
    const bf16_t* lora = (const bf16_t*)(ws + WS_LORA);
    const bf16_t* ACT = (const bf16_t*)(ws + WS_ACT);
    bf16_t* FB = (bf16_t*)(ws + WS_FEAT);
    const int h = blockIdx.x & 7;
    constexpr int P64 = 72, P128 = 136;
    LAS bf16_t* WL = (LAS bf16_t*)lds;
    LAS bf16_t* WG2 = WL + 4 * 64 * P64;
    __syncthreads();
    for (int i = tid; i < 4 * 64 * 8; i += 512) { const int m = i >> 9, r = (i >> 3) & 63, c = i & 7; const int ch = 16 * ((r >> 2) & 3) + 4 * (r >> 4) + (r & 3);
        *(LAS u32x4*)(WL + (m * 64 + r) * P64 + 8 * c) = *(const u32x4*)(lora + (size_t)m * 32768 + (size_t)(h * 64 + ch) * 64 + 8 * c); }
    for (int i = tid; i < 64 * 16; i += 512) { const int r = i >> 4, c = i & 15; const int ch = 16 * ((r >> 2) & 3) + 4 * (r >> 4) + (r & 3);
        *(LAS u32x4*)(WG2 + r * P128 + 8 * c) = *(const u32x4*)(lora + (size_t)4 * 32768 + (size_t)(h * 64 + ch) * 128 + 8 * c); }
    __syncthreads();
    const int tk = lane & 15, cg = lane >> 4;
    f32x4 w0f[4], w0b[4], a0f[4], a0b[4], kkw[4], kaw[4];
#pragma unroll
    for (int cs = 0; cs < 4; ++cs) { const int c = h * 64 + 16 * cg + 4 * cs;
        w0f[cs] = *(const f32x4*)(a.in[I_W0F] + c); w0b[cs] = *(const f32x4*)(a.in[I_W0B] + c); a0f[cs] = *(const f32x4*)(a.in[I_A0F] + c); a0b[cs] = *(const f32x4*)(a.in[I_A0B] + c);
        kkw[cs] = *(const f32x4*)(a.in[I_KK] + c); kaw[cs] = *(const f32x4*)(a.in[I_KA] + c); }
    for (int tt = blockIdx.x >> 3; tt < ROWS / 128; tt += (G >> 3)) {
        const int row = tt * 128 + 16 * wave + tk;
        bf16x8 bfr[12];
        const bf16_t* ap = ACT + (size_t)row * 384 + 8 * cg;
#pragma unroll
        for (int kb = 0; kb < 12; ++kb) bfr[kb] = *(const bf16x8*)(ap + 32 * kb);
        bf16_t* frow = FB + (size_t)row * RD + h * 64 + 16 * cg;
        u32x2 kraw[4];
#pragma unroll
        for (int cs = 0; cs < 4; ++cs) kraw[cs] = *(const u32x2*)(frow + (size_t)F_A * (FEAT_STRIDE / 2) + 4 * cs);
        auto store16 = [&](int arr, const f32x4 (&v)[4]) {
            u32x4 w0, w1;
            w0.x = cvt_pk_bf16_asm(v[0][0], v[0][1]); w0.y = cvt_pk_bf16_asm(v[0][2], v[0][3]); w0.z = cvt_pk_bf16_asm(v[1][0], v[1][1]); w0.w = cvt_pk_bf16_asm(v[1][2], v[1][3]);
            w1.x = cvt_pk_bf16_asm(v[2][0], v[2][1]); w1.y = cvt_pk_bf16_asm(v[2][2], v[2][3]); w1.z = cvt_pk_bf16_asm(v[3][0], v[3][1]); w1.w = cvt_pk_bf16_asm(v[3][2], v[3][3]);
            u32x4* p = (u32x4*)(frow + (size_t)arr * (FEAT_STRIDE / 2)); p[0] = w0; p[1] = w1;
        };
        auto lora_mm = [&](int m, int kb0, f32x4 (&acc)[4]) {
#pragma unroll
            for (int cs = 0; cs < 4; ++cs) acc[cs] = (f32x4){0.f, 0.f, 0.f, 0.f};
            const int nkb = (m == 4) ? 4 : 2;
#pragma unroll
            for (int kb = 0; kb < 4; ++kb) if (kb < nkb) {
#pragma unroll
                for (int cs = 0; cs < 4; ++cs) {
                    const bf16x8 afr = (m == 4) ? *(const LAS bf16x8*)(WG2 + (16 * cs + tk) * P128 + 32 * kb + 8 * cg) : *(const LAS bf16x8*)(WL + (m * 64 + 16 * cs + tk) * P64 + 32 * kb + 8 * cg);
                    acc[cs] = __builtin_amdgcn_mfma_f32_16x16x32_bf16(afr, bfr[kb0 + kb], acc[cs], 0, 0, 0);
                }
            }
        };
        f32x4 acc[4];
        lora_mm(0, 0, acc);
#pragma unroll
        for (int cs = 0; cs < 4; ++cs)
#pragma unroll
            for (int j = 0; j < 4; ++j) acc[cs][j] = SCAN_CHUNKED ? (-0.60653065971f * sigmoidf_(acc[cs][j] + w0f[cs][j])) : (__expf(-0.60653065971f * sigmoidf_(acc[cs][j] + w0f[cs][j])) - 1.0f);
        store16(F_WF, acc);
        lora_mm(1, 2, acc);
#pragma unroll
        for (int cs = 0; cs < 4; ++cs)
#pragma unroll
            for (int j = 0; j < 4; ++j) acc[cs][j] = SCAN_CHUNKED ? (-0.60653065971f * sigmoidf_(acc[cs][j] + w0b[cs][j])) : (__expf(-0.60653065971f * sigmoidf_(acc[cs][j] + w0b[cs][j])) - 1.0f);
        store16(F_WB, acc);
        lora_mm(4, 8, acc);
        asm volatile("s_nop 7\n\ts_nop 7" ::: "memory");
        store16(F_G, acc);
        f32x4 iclf[4], iclb[4];
        lora_mm(2, 4, iclf);
        lora_mm(3, 6, iclb);
#pragma unroll
        for (int cs = 0; cs < 4; ++cs)
#pragma unroll
            for (int j = 0; j < 4; ++j) { iclf[cs][j] = sigmoidf_(iclf[cs][j] + a0f[cs][j]); iclb[cs][j] = sigmoidf_(iclb[cs][j] + a0b[cs][j]); }
        f32x4 kv[4]; float nrm = 0.f;
#pragma unroll
        for (int cs = 0; cs < 4; ++cs) {
            kv[cs] = (f32x4){lo16(kraw[cs].x), hi16(kraw[cs].x), lo16(kraw[cs].y), hi16(kraw[cs].y)};
            const f32x4 kk = kv[cs] * kkw[cs];
            nrm += (kk[0] * kk[0] + kk[1] * kk[1]) + (kk[2] * kk[2] + kk[3] * kk[3]);
        }
        nrm += __shfl_xor(nrm, 16); nrm += __shfl_xor(nrm, 32);
        const float inv = 1.0f / fmaxf(sqrtf(nrm), 1e-12f);
        f32x4 oa[4], obf[4], obb[4], okf[4], okb[4];
#pragma unroll
        for (int cs = 0; cs < 4; ++cs) {
            const f32x4 kkn = kv[cs] * kkw[cs] * inv;
            oa[cs] = -kkn; obf[cs] = kkn * iclf[cs]; obb[cs] = kkn * iclb[cs];
            okf[cs] = kv[cs] * ((iclf[cs] - 1.0f) * kaw[cs] + 1.0f); okb[cs] = kv[cs] * ((iclb[cs] - 1.0f) * kaw[cs] + 1.0f);
        }
        store16(F_A, oa); store16(F_BF, obf); store16(F_BB, obb); store16(F_KF, okf); store16(F_KB, okb);
    }
}

__device__ __forceinline__ void p4_attention(const Args& a, LAS unsigned char* lds, int tid, int lane, int wave, int G) {
    unsigned char* ws = a.ws;
    const bf16_t* QR = (const bf16_t*)(ws + WS_QR); const bf16_t* KA = (const bf16_t*)(ws + WS_KA); const bf16_t* VT = (const bf16_t*)(ws + WS_VT);
    bf16_t* ATT = (bf16_t*)(ws + WS_ATT);
    constexpr int KP = 72;
    LAS bf16_t* Ks0 = (LAS bf16_t*)lds;
    const int qi = lane & 31, hf = lane >> 5;
    unsigned* qatt = (unsigned*)(ws + WS_CTL) + CW_QATT;
    for (int it = 0;; ++it) {
        int upull = 0; if ((it & 1) == 0) { upull = queue_pull(qatt, lds, tid); *(volatile LAS int*)(lds + RING_BYTES + 260) = upull; } else upull = *(volatile LAS int*)(lds + RING_BYTES + 260);
        const int unit = 2 * upull + (it & 1);
        if (unit >= NB * NKV * (SEQ / 64)) break;
        const int qb = unit & 63, g = (unit >> 6) & 1, b = unit >> 7;
        const int q0 = qb * 64;
        const int head = g * 4 + (wave >> 1), qloc = 32 * (wave & 1) + qi;
        const size_t qrow = (size_t)b * SEQ + q0 + qloc;
        bf16x8 qf[4];
#pragma unroll
        for (int s = 0; s < 4; ++s) qf[s] = *(const bf16x8*)(QR + qrow * 512 + head * 64 + 16 * s + 8 * hf);
        float m = a.in[I_SINKS][head] * 1.44269504089f, lsum = hf ? 0.f : 1.f;
        f32x16 O0, O1;
#pragma unroll
        for (int r = 0; r < 16; ++r) { O0[r] = 0.f; O1[r] = 0.f; }
        const int rr = tid >> 3, ch = tid & 7;
        auto tile_ok = [&](int kt) -> bool { const int kp = q0 - 128 + 64 * kt; return kt >= 5 || (kp >= 0 && kp < SEQ); };
        u32x4 kreg, vreg;
        auto fetch_tile = [&](int kt) {
            const int kp0 = q0 - 128 + 64 * kt;
            const bf16_t* kp = (kt < 5) ? KA + ((size_t)b * SEQ + kp0 + rr) * 128 + g * 64 + 8 * ch
                                        : KA + ((size_t)T + b * CL + 64 * (kt - 5) + rr) * 128 + g * 64 + 8 * ch;
            const bf16_t* vp = (kt < 5) ? VT + ((size_t)(b * 2 + g) * 64 + rr) * SEQ + kp0 + 8 * ch
                                        : VT + (size_t)NB * 2 * 64 * SEQ + ((size_t)(b * 2 + g) * 64 + rr) * CL + 64 * (kt - 5) + 8 * ch;
            kreg = *(const u32x4*)kp; vreg = *(const u32x4*)vp;
        };
        int kt = 0; while (!tile_ok(kt)) ++kt;
        fetch_tile(kt);
        int par = 0;
        __syncthreads();
        for (; kt < 9; ) {
            LAS bf16_t* Ks = Ks0 + par * (2 * 64 * KP); LAS bf16_t* Vs = Ks + 64 * KP;
            *(LAS u32x4*)(Ks + rr * KP + 8 * ch) = kreg; *(LAS u32x4*)(Vs + rr * KP + 8 * ch) = vreg;
            __syncthreads();
            int ktn = kt + 1; while (ktn < 9 && !tile_ok(ktn)) ++ktn;
            if (ktn < 9) fetch_tile(ktn);
            f32x16 X0, X1;
#pragma unroll
            for (int r = 0; r < 16; ++r) { X0[r] = 0.f; X1[r] = 0.f; }
#pragma unroll
            for (int s = 0; s < 4; ++s) {
                const bf16x8 k0 = *(const LAS bf16x8*)(Ks + qi * KP + 16 * s + 8 * hf), k1 = *(const LAS bf16x8*)(Ks + (32 + qi) * KP + 16 * s + 8 * hf);
                X0 = __builtin_amdgcn_mfma_f32_32x32x16_bf16(k0, qf[s], X0, 0, 0, 0);
                X1 = __builtin_amdgcn_mfma_f32_32x32x16_bf16(k1, qf[s], X1, 0, 0, 0);
            }
            if (kt == 0 || kt == 4) {
#pragma unroll
                for (int r = 0; r < 16; ++r) { const int k0i = (r & 3) + 8 * (r >> 2) + 4 * hf, k1i = 32 + k0i;
                    const bool v0 = (kt == 0) ? (k0i >= qloc) : (k0i <= qloc), v1 = (kt == 0) ? (k1i >= qloc) : (k1i <= qloc);
                    X0[r] = v0 ? X0[r] : -1e30f; X1[r] = v1 ? X1[r] : -1e30f; }
            }
            float mx0 = X0[0], mx1 = X1[0];
#pragma unroll
            for (int r = 1; r < 16; ++r) { mx0 = __builtin_fmaxf(mx0, X0[r]); mx1 = __builtin_fmaxf(mx1, X1[r]); }
            float mx = __builtin_fmaxf(mx0, mx1);
            mx = __builtin_fmaxf(mx, __shfl_xor(mx, 32));
            const float mn = __builtin_fmaxf(m, mx);
            if (__any(mn > m)) {
                const float alpha = __builtin_amdgcn_exp2f(m - mn);
                lsum *= alpha;
#pragma unroll
                for (int r = 0; r < 16; ++r) { O0[r] *= alpha; O1[r] *= alpha; }
                m = mn;
            }
            float ps0 = 0.f, ps1 = 0.f;
#pragma unroll
            for (int r = 0; r < 16; ++r) { X0[r] = __builtin_amdgcn_exp2f(X0[r] - m); X1[r] = __builtin_amdgcn_exp2f(X1[r] - m); ps0 += X0[r]; ps1 += X1[r]; }
            lsum += ps0 + ps1;
#pragma unroll
            for (int kg = 0; kg < 2; ++kg)
#pragma unroll
                for (int s2 = 0; s2 < 2; ++s2) {
                    bf16x8 pf;
#pragma unroll
                    for (int j = 0; j < 4; ++j) { const float p0 = kg ? X1[8 * s2 + 2 * j] : X0[8 * s2 + 2 * j], p1 = kg ? X1[8 * s2 + 2 * j + 1] : X0[8 * s2 + 2 * j + 1];
                        const unsigned w = cvt_pk_bf16(p0, p1); pf[2 * j] = (short)(w & 0xffff); pf[2 * j + 1] = (short)(w >> 16); }
                    const int kb = 32 * kg + 16 * s2 + 4 * hf;
#pragma unroll
                    for (int dg = 0; dg < 2; ++dg) {
                        const LAS bf16_t* vr = Vs + (32 * dg + qi) * KP + kb;
                        const s16x4 va = *(const LAS s16x4*)vr, vb = *(const LAS s16x4*)(vr + 8);
                        bf16x8 vf; vf[0] = va[0]; vf[1] = va[1]; vf[2] = va[2]; vf[3] = va[3]; vf[4] = vb[0]; vf[5] = vb[1]; vf[6] = vb[2]; vf[7] = vb[3];
                        if (dg == 0) O0 = __builtin_amdgcn_mfma_f32_32x32x16_bf16(vf, pf, O0, 0, 0, 0);
                        else O1 = __builtin_amdgcn_mfma_f32_32x32x16_bf16(vf, pf, O1, 0, 0, 0);
                    }
                }
            kt = ktn; par ^= 1;
        }
        const float ltot = lsum + __shfl_xor(lsum, 32);
        const float inv = 1.0f / ltot;
        bf16_t* op = ATT + qrow * 512 + head * 64;
#pragma unroll
        for (int dg = 0; dg < 2; ++dg)
#pragma unroll
            for (int rq = 0; rq < 4; ++rq) {
                const int d0 = 32 * dg + 8 * rq + 4 * hf;
                u32x2 w;
                if (dg == 0) { w.x = cvt_pk_bf16(O0[4 * rq] * inv, O0[4 * rq + 1] * inv); w.y = cvt_pk_bf16(O0[4 * rq + 2] * inv, O0[4 * rq + 3] * inv); }
                else { w.x = cvt_pk_bf16(O1[4 * rq] * inv, O1[4 * rq + 1] * inv); w.y = cvt_pk_bf16(O1[4 * rq + 2] * inv, O1[4 * rq + 3] * inv); }
                *(u32x2*)(op + d0) = w;
            }
    }
}

template <int CTRL> __device__ __forceinline__ float dpp_add(float x) {
    return x + __builtin_bit_cast(float, __builtin_amdgcn_update_dpp(0, __builtin_bit_cast(int, x), CTRL, 0xf, 0xf, false));
}
__device__ __forceinline__ float row16_sum(float x) { x = dpp_add<0x128>(x); x = dpp_add<0x124>(x); x = dpp_add<0x122>(x); x = dpp_add<0x121>(x); return x; }
template <int VAR> __device__ __forceinline__ void p4_scan(const Args& a, LAS unsigned char* lds, int tid, int lane, int wave, int G) {
    unsigned char* ws = a.ws;
    const bf16_t* FB = (const bf16_t*)(ws + WS_FEAT);
    constexpr int TS = 32, NBLK = (CL + SEQ) / TS;
    constexpr int OPF = TS * 5 * 64;
    LAS float* OPS = (LAS float*)lds;
    LAS float* VB = OPS + 2 * OPF;
    LAS float* YBUF = VB + 2 * TS * 32;
    const int rl = 4 * wave + (lane >> 4), cg = lane & 15;
    for (int unit = blockIdx.x; unit < NB * NH * 4; unit += G) {
        const int half = unit & 1, dir = (unit >> 1) & 1, h = (unit >> 2) & 7, b = unit >> 5;
        const size_t astr = FEAT_STRIDE / 2;
        const bf16_t* arrp[5] = { FB + (size_t)(dir ? F_WB : F_WF) * astr, FB + (size_t)F_A * astr, FB + (size_t)(dir ? F_BB : F_BF) * astr, FB + (size_t)(dir ? F_KB : F_KF) * astr, FB + (size_t)F_R * astr };
        const bf16_t* vp = FB + (size_t)F_V * astr;
        bf16_t* Y = (bf16_t*)(ws + (dir ? WS_YB : WS_YF));
        auto row_of = [&](int s) -> int { return (s < CL) ? (T + b * CL + (dir ? (CL - 1 - s) : s)) : (b * SEQ + (dir ? (SEQ - 1 - (s - CL)) : (s - CL))); };
        u32x2 pre[6];
        auto fetch = [&](int blk) {
#pragma unroll
            for (int it = 0; it < 6; ++it) { const int q = tid + 512 * it; pre[it] = (u32x2){0u, 0u};
                if (q < TS * 88) { const int st = q / 88, rem = q % 88; const int row = row_of(blk * TS + st);
                    if (rem < 80) { const int ar = rem >> 4, ci = rem & 15; const bf16_t* p = (ar == 0 ? arrp[0] : ar == 1 ? arrp[1] : ar == 2 ? arrp[2] : ar == 3 ? arrp[3] : arrp[4]);
                        pre[it] = *(const u32x2*)(p + (size_t)row * RD + h * 64 + 4 * ci); }
                    else { const int ci = rem - 80; pre[it] = *(const u32x2*)(vp + (size_t)row * RD + h * 64 + half * 32 + 4 * ci); } } }
        };
        auto commit = [&](int buf) {
#pragma unroll
            for (int it = 0; it < 6; ++it) { const int q = tid + 512 * it;
                if (q < TS * 88) { const int st = q / 88, rem = q % 88;
                    f32x4 v = (f32x4){lo16(pre[it].x), hi16(pre[it].x), lo16(pre[it].y), hi16(pre[it].y)};
                    if (SCAN_CHUNKED && rem < 16) { v[0] = __expf(v[0]) - 1.0f; v[1] = __expf(v[1]) - 1.0f; v[2] = __expf(v[2]) - 1.0f; v[3] = __expf(v[3]) - 1.0f; }
                    if (rem < 80) *(LAS f32x4*)(OPS + buf * OPF + st * 320 + rem * 4) = v;
                    else *(LAS f32x4*)(VB + buf * TS * 32 + st * 32 + (rem - 80) * 4) = v; } }
        };
        __syncthreads();
        fetch(0); commit(0);
        __syncthreads();
        f32x4 S = (f32x4){0.f, 0.f, 0.f, 0.f};
        for (int blk = 0; blk < NBLK; ++blk) {
            const int buf = blk & 1;
            if (blk + 1 < NBLK) fetch(blk + 1);
            const LAS float* ob = OPS + buf * OPF + 4 * cg; const LAS float* vb = VB + buf * TS * 32 + rl; LAS float* yb = YBUF + buf * TS * 32 + rl;
            float ykeep = 0.f;
            f32x4 qw[3], qa[3], qb[3], qk[3], qr[3]; float qv[3];
#define SCAN_LOAD(st_, sl_) do { qw[sl_] = *(const LAS f32x4*)(ob + (st_) * 320); qa[sl_] = *(const LAS f32x4*)(ob + (st_) * 320 + 64); qb[sl_] = *(const LAS f32x4*)(ob + (st_) * 320 + 128); \
                qk[sl_] = *(const LAS f32x4*)(ob + (st_) * 320 + 192); qr[sl_] = *(const LAS f32x4*)(ob + (st_) * 320 + 256); qv[sl_] = vb[(st_) * 32]; } while (0)
            SCAN_LOAD(0, 0); SCAN_LOAD(1, 1);
#pragma unroll
            for (int st = 0; st < TS; ++st) {
                if (st + 2 < TS && (VAR != 2 || st < 1)) SCAN_LOAD(st + 2, (st + 2) % 3);
                const f32x4 ow = qw[st % 3], av = DBG_NOA ? (f32x4){0.f, 0.f, 0.f, 0.f} : qa[st % 3], bv = DBG_NOB ? (f32x4){0.f, 0.f, 0.f, 0.f} : qb[st % 3], kv = qk[st % 3], rv = qr[st % 3]; const float vi = qv[st % 3];
                float sa = fmaf(S[3], av[3], fmaf(S[2], av[2], fmaf(S[1], av[1], S[0] * av[0])));
                const f32x4 S1 = S + S * ow + kv * vi;
                if (VAR != 1) sa = row16_sum(sa);
                S = S1 + bv * sa;
                float y = fmaf(S[3], rv[3], fmaf(S[2], rv[2], fmaf(S[1], rv[1], S[0] * rv[0])));
                if (VAR != 1) y = row16_sum(y);
                ykeep = (cg == (st & 15)) ? y : ykeep;
                if ((st & 15) == 15) yb[((st & ~15) + cg) * 32] = ykeep;
            }
#undef SCAN_LOAD
            if (blk + 1 < NBLK) commit(buf ^ 1);
            __syncthreads();
            if (blk >= CL / TS) {
                const int st = tid >> 4, pr = tid & 15;
                const int row = row_of(blk * TS + st);
                const float y0 = YBUF[buf * TS * 32 + st * 32 + 2 * pr], y1 = YBUF[buf * TS * 32 + st * 32 + 2 * pr + 1];
                *(unsigned*)(Y + (size_t)row * RD + h * 64 + half * 32 + 2 * pr) = pk2(y0, y1);
            }
        }
    }
}

constexpr int CS_SLOT = 16384, CS_AT = 0, CS_RT = 2304, CS_BH = 4608, CS_KH = 6912, CS_VV = 9216, CS_AAK = 11520, CS_TT = 12800, CS_ARK = 14080, CS_GC = 15360;
constexpr int CS_SCR = 4 * CS_SLOT, CS_SCR_BYTES = 6144, CS_BT = 0, CS_KT = 2304, CS_NN = 4608, CS_FLAGS = CS_SCR + 4 * CS_SCR_BYTES;
typedef short v4i16_t __attribute__((ext_vector_type(4)));
__device__ __forceinline__ bf16x8 pack8(f32x4 x, f32x4 y) {
    u32x4 w; w.x = cvt_pk_bf16(x[0], x[1]); w.y = cvt_pk_bf16(x[2], x[3]); w.z = cvt_pk_bf16(y[0], y[1]); w.w = cvt_pk_bf16(y[2], y[3]);
    return __builtin_bit_cast(bf16x8, w);
}
__device__ __forceinline__ bf16x8 join8(s16x4 x, s16x4 y) { bf16x8 r; r[0] = x[0]; r[1] = x[1]; r[2] = x[2]; r[3] = x[3]; r[4] = y[0]; r[5] = y[1]; r[6] = y[2]; r[7] = y[3]; return r; }
__device__ __forceinline__ s16x4 lds_tr4(const LAS unsigned char* p) { return __builtin_bit_cast(s16x4, __builtin_amdgcn_ds_read_tr16_b64_v4i16((LAS v4i16_t*)p)); }
template <int CTRL> __device__ __forceinline__ float dpp_shr_add(float x) {
    return x + __builtin_bit_cast(float, __builtin_amdgcn_update_dpp(0, __builtin_bit_cast(int, x), CTRL, 0xf, 0xf, true));
}
template <bool TEST> __device__ __forceinline__ void p4_scan_chunked(const Args& a, LAS unsigned char* lds, int tid, int lane, int wave, int G) {
    unsigned char* ws = a.ws;
    const bf16_t* FB = (const bf16_t*)(ws + WS_FEAT);
    const size_t astr = FEAT_STRIDE / 2;
    constexpr int NCH = (CL + SEQ) / 16;
    volatile LAS unsigned* flags = (volatile LAS unsigned*)(lds + CS_FLAGS);
    for (int unit = blockIdx.x; unit < NB * NH * 2; unit += G) {
        const int dir = unit & 1, h = (unit >> 1) & 7, b = unit >> 4;
        __syncthreads();
        for (int i = tid; i < (CS_FLAGS + 64) / 16; i += 512) *(LAS u32x4*)(lds + 16 * i) = (u32x4){0u, 0u, 0u, 0u};
        __syncthreads();
        auto row_of = [&](int s) -> int { return (s < CL) ? (T + b * CL + (dir ? (CL - 1 - s) : s)) : (b * SEQ + (dir ? (SEQ - 1 - (s - CL)) : (s - CL))); };
        if (wave < 4) {
            const int il = lane & 15, g = lane >> 4, ich = 16 * wave + il;
            bf16_t* Y = (bf16_t*)(ws + (dir ? WS_YB : WS_YF));
            f32x4 ST[4];
#pragma unroll
            for (int jt = 0; jt < 4; ++jt) ST[jt] = (f32x4){0.f, 0.f, 0.f, 0.f};
            const f32x4 zero4 = (f32x4){0.f, 0.f, 0.f, 0.f}; const s16x4 z16 = (s16x4){0, 0, 0, 0};
            const int troff = (4 * g + (il >> 2)) * 144 + 8 * (il & 3);
            for (int c = 0; c < NCH; ++c) {
                const int slot = c & 3; LAS unsigned char* sb = lds + slot * CS_SLOT;
                while (flags[slot] != (unsigned)(c + 1)) __builtin_amdgcn_s_sleep(1);
                __builtin_amdgcn_fence(__ATOMIC_ACQUIRE, "workgroup");
                const bf16x8 sf0 = pack8(ST[0], ST[1]), sf1 = pack8(ST[2], ST[3]);
                const LAS unsigned char* atp = sb + CS_AT + il * 144 + 8 * g;
                const bf16x8 a0 = join8(*(const LAS s16x4*)(atp), *(const LAS s16x4*)(atp + 32)), a1 = join8(*(const LAS s16x4*)(atp + 64), *(const LAS s16x4*)(atp + 96));
                const LAS unsigned char* rtp = sb + CS_RT + il * 144 + 8 * g;
                const bf16x8 r0 = join8(*(const LAS s16x4*)(rtp), *(const LAS s16x4*)(rtp + 32)), r1 = join8(*(const LAS s16x4*)(rtp + 64), *(const LAS s16x4*)(rtp + 96));
                const bf16x8 aak = *(const LAS bf16x8*)(sb + CS_AAK + il * 80 + 16 * g);
                const bf16x8 ttf = *(const LAS bf16x8*)(sb + CS_TT + il * 80 + 16 * g);
                const bf16x8 ark = *(const LAS bf16x8*)(sb + CS_ARK + il * 80 + 16 * g);
                const s16x4 vv = lds_tr4(sb + CS_VV + troff + 32 * wave);
                f32x4 zw1 = zero4, zyy = zero4, zuu = zero4; asm volatile("" : "+v"(zw1), "+v"(zyy), "+v"(zuu));
                f32x4 w1 = __builtin_amdgcn_mfma_f32_16x16x32_bf16(a0, sf0, zw1, 0, 0, 0);
                w1 = __builtin_amdgcn_mfma_f32_16x16x32_bf16(a1, sf1, w1, 0, 0, 0);
                w1 = __builtin_amdgcn_mfma_f32_16x16x32_bf16(aak, join8(vv, z16), w1, 0, 0, 0);
                f32x4 yy = __builtin_amdgcn_mfma_f32_16x16x32_bf16(r0, sf0, zyy, 0, 0, 0);
                yy = __builtin_amdgcn_mfma_f32_16x16x32_bf16(r1, sf1, yy, 0, 0, 0);
                const bf16x8 w1f = pack8(w1, zero4);
                const f32x4 uu = __builtin_amdgcn_mfma_f32_16x16x32_bf16(ttf, w1f, zuu, 0, 0, 0);
                bf16x8 uv; { u32x4 w; w.x = cvt_pk_bf16(uu[0], uu[1]); w.y = cvt_pk_bf16(uu[2], uu[3]); const u32x2 v2 = __builtin_bit_cast(u32x2, vv); w.z = v2.x; w.w = v2.y; uv = __builtin_bit_cast(bf16x8, w); }
#pragma unroll
                for (int jt = 0; jt < 4; ++jt) {
                    const f32x4 gc = *(const LAS f32x4*)(sb + CS_GC + (16 * jt + 4 * g) * 4);
                    const bf16x8 bk = join8(lds_tr4(sb + CS_BH + troff + 32 * jt), lds_tr4(sb + CS_KH + troff + 32 * jt));
                    ST[jt] = __builtin_amdgcn_mfma_f32_16x16x32_bf16(bk, uv, ST[jt] * gc, 0, 0, 0);
                }
                yy = __builtin_amdgcn_mfma_f32_16x16x32_bf16(ark, uv, yy, 0, 0, 0);
                asm volatile("s_waitcnt lgkmcnt(0)" ::: "memory");
                if (lane == 0) __hip_atomic_fetch_add((LAS unsigned*)(lds + CS_FLAGS) + 4 + slot, 1u, __ATOMIC_RELEASE, __HIP_MEMORY_SCOPE_WORKGROUP);
                if (c >= CL / 16) {
#pragma unroll
                    for (int rg = 0; rg < 4; ++rg) { const int row = row_of(16 * c + 4 * g + rg); Y[(size_t)row * RD + h * 64 + ich] = (bf16_t)f2bf(yy[rg]); }
                }
            }
        } else {
            const int p = wave - 4, jg = lane >> 4, t = lane & 15;
            LAS unsigned char* scr = lds + CS_SCR + p * CS_SCR_BYTES;
            u32x4 raw[6][2];
            auto load_raw = [&](int c) {
                const size_t ro = (size_t)row_of(16 * c + t) * RD + h * 64 + 16 * jg;
#pragma unroll
                for (int hf = 0; hf < 2; ++hf) {
                    raw[0][hf] = *(const u32x4*)(FB + (size_t)(dir ? F_WB : F_WF) * astr + ro + 8 * hf); raw[1][hf] = *(const u32x4*)(FB + (size_t)F_A * astr + ro + 8 * hf);
                    raw[2][hf] = *(const u32x4*)(FB + (size_t)(dir ? F_BB : F_BF) * astr + ro + 8 * hf); raw[3][hf] = *(const u32x4*)(FB + (size_t)(dir ? F_KB : F_KF) * astr + ro + 8 * hf);
                    raw[4][hf] = *(const u32x4*)(FB + (size_t)F_R * astr + ro + 8 * hf); raw[5][hf] = *(const u32x4*)(FB + (size_t)F_V * astr + ro + 8 * hf); }
            };
            load_raw(p);
            const int tn = lane & 15, gq = lane >> 4;
            for (int c = p; c < NCH; c += 4) {
                const int slot = c & 3; LAS unsigned char* sb = lds + slot * CS_SLOT;
                float cs[16], lwv[16];
#pragma unroll
                for (int q = 0; q < 8; ++q) { const unsigned w = raw[0][q >> 2][q & 3]; lwv[2 * q] = lo16(w); lwv[2 * q + 1] = hi16(w); }
#pragma unroll
                for (int q = 0; q < 16; ++q) { float x = lwv[q]; x = dpp_shr_add<0x111>(x); x = dpp_shr_add<0x112>(x); x = dpp_shr_add<0x114>(x); x = dpp_shr_add<0x118>(x); cs[q] = x; }
                float Gc[16], Gi[16], Gp[16], G15[16];
#pragma unroll
                for (int q = 0; q < 16; ++q) { Gc[q] = __expf(cs[q]); Gi[q] = __expf(-cs[q]); Gp[q] = __expf(cs[q] - lwv[q]); G15[q] = __shfl(Gc[q], (lane & 48) | 15); }
                while (flags[4 + slot] != (unsigned)(4 * (c >> 2))) __builtin_amdgcn_s_sleep(1);
                __builtin_amdgcn_fence(__ATOMIC_ACQUIRE, "workgroup");
                {
                    u32x4 wa[2], wr[2], wb[2], wk[2], wbh[2], wkh[2];
#pragma unroll
                    for (int q = 0; q < 8; ++q) {
                        const unsigned ua = raw[1][q >> 2][q & 3], ub = raw[2][q >> 2][q & 3], uk = raw[3][q >> 2][q & 3], ur = raw[4][q >> 2][q & 3];
                        const float a0 = lo16(ua) * Gp[2 * q], a1 = hi16(ua) * Gp[2 * q + 1], r0 = lo16(ur) * Gc[2 * q], r1 = hi16(ur) * Gc[2 * q + 1];
                        const float b0 = lo16(ub) * Gi[2 * q], b1 = hi16(ub) * Gi[2 * q + 1], k0 = lo16(uk) * Gi[2 * q], k1 = hi16(uk) * Gi[2 * q + 1];
                        wa[q >> 2][q & 3] = cvt_pk_bf16(a0, a1); wr[q >> 2][q & 3] = cvt_pk_bf16(r0, r1); wb[q >> 2][q & 3] = cvt_pk_bf16(b0, b1); wk[q >> 2][q & 3] = cvt_pk_bf16(k0, k1);
                        wbh[q >> 2][q & 3] = cvt_pk_bf16(b0 * G15[2 * q], b1 * G15[2 * q + 1]); wkh[q >> 2][q & 3] = cvt_pk_bf16(k0 * G15[2 * q], k1 * G15[2 * q + 1]);
                    }
                    const int ro = t * 144 + 32 * jg;
#pragma unroll
                    for (int hf = 0; hf < 2; ++hf) {
                        *(LAS u32x4*)(sb + CS_AT + ro + 16 * hf) = wa[hf]; *(LAS u32x4*)(sb + CS_RT + ro + 16 * hf) = wr[hf];
                        *(LAS u32x4*)(scr + CS_BT + ro + 16 * hf) = wb[hf]; *(LAS u32x4*)(scr + CS_KT + ro + 16 * hf) = wk[hf];
                        *(LAS u32x4*)(sb + CS_BH + ro + 16 * hf) = wbh[hf]; *(LAS u32x4*)(sb + CS_KH + ro + 16 * hf) = wkh[hf];
                        *(LAS u32x4*)(sb + CS_VV + ro + 16 * hf) = raw[5][hf];
                    }
                    if (t == 15) {
#pragma unroll
                        for (int q = 0; q < 4; ++q) *(LAS f32x4*)(sb + CS_GC + (16 * jg + 4 * q) * 4) = (f32x4){Gc[4 * q], Gc[4 * q + 1], Gc[4 * q + 2], Gc[4 * q + 3]};
                    }
                }
                if (c + 4 < NCH) load_raw(c + 4);
                asm volatile("s_waitcnt lgkmcnt(0)" ::: "memory");
                f32x4 m0 = (f32x4){0.f, 0.f, 0.f, 0.f}, m1 = m0, m3 = m0, m4 = m0;
                asm volatile("" : "+v"(m0), "+v"(m1), "+v"(m3), "+v"(m4));
#pragma unroll
                for (int ks = 0; ks < 2; ++ks) {
                    const bf16x8 xa = *(const LAS bf16x8*)(sb + CS_AT + tn * 144 + 64 * ks + 16 * gq), xr = *(const LAS bf16x8*)(sb + CS_RT + tn * 144 + 64 * ks + 16 * gq);
                    const bf16x8 yb = *(const LAS bf16x8*)(scr + CS_BT + tn * 144 + 64 * ks + 16 * gq), yk = *(const LAS bf16x8*)(scr + CS_KT + tn * 144 + 64 * ks + 16 * gq);
                    m0 = __builtin_amdgcn_mfma_f32_16x16x32_bf16(yb, xa, m0, 0, 0, 0);
                    m1 = __builtin_amdgcn_mfma_f32_16x16x32_bf16(yk, xa, m1, 0, 0, 0);
                    m3 = __builtin_amdgcn_mfma_f32_16x16x32_bf16(yb, xr, m3, 0, 0, 0);
                    m4 = __builtin_amdgcn_mfma_f32_16x16x32_bf16(yk, xr, m4, 0, 0, 0);
                }
                {
                    f32x4 n0, q1, q3, q4;
#pragma unroll
                    for (int rg = 0; rg < 4; ++rg) { const int s = 4 * gq + rg; const bool lt = s < tn, le = s <= tn;
                        n0[rg] = lt ? m0[rg] : 0.f; q1[rg] = lt ? m1[rg] : 0.f; q3[rg] = le ? m3[rg] : 0.f; q4[rg] = le ? m4[rg] : 0.f;
                        *(LAS float*)(scr + CS_NN + (s * 16 + tn) * 4) = n0[rg]; }
                    u32x2 w1; w1.x = cvt_pk_bf16(q1[0], q1[1]); w1.y = cvt_pk_bf16(q1[2], q1[3]);
                    *(LAS u32x2*)(sb + CS_AAK + tn * 80 + 16 * gq) = w1;
                    u32x4 w3; w3.x = cvt_pk_bf16(q3[0], q3[1]); w3.y = cvt_pk_bf16(q3[2], q3[3]); w3.z = cvt_pk_bf16(q4[0], q4[1]); w3.w = cvt_pk_bf16(q4[2], q4[3]);
                    *(LAS u32x4*)(sb + CS_ARK + tn * 80 + 16 * gq) = w3;
                }
                asm volatile("s_waitcnt lgkmcnt(0)" ::: "memory");
                float Tc[16];
#pragma unroll
                for (int s = 0; s < 16; ++s) Tc[s] = (s == tn) ? 1.0f : 0.0f;
                {
                    const LAS f32x4* NR = (const LAS f32x4*)(scr + CS_NN);
                    f32x4 cq[4], nq[4];
#pragma unroll
                    for (int k = 0; k < 4; ++k) { cq[k] = NR[4 * 14 + k]; nq[k] = cq[k]; }
#pragma unroll
                    for (int s = 14; s >= 0; --s) {
                        if (s > 0) {
#pragma unroll
                            for (int k = 0; k < 4; ++k) if (4 * k + 3 > s - 1) nq[k] = NR[4 * (s - 1) + k];
                        }
                        float acc0 = 0.f, acc1 = 0.f;
#pragma unroll
                        for (int q = s + 1; q < 16; ++q) { if (q & 1) acc1 += Tc[q] * cq[q >> 2][q & 3]; else acc0 += Tc[q] * cq[q >> 2][q & 3]; }
                        Tc[s] = (s < tn) ? (acc0 + acc1) : Tc[s];
#pragma unroll
                        for (int k = 0; k < 4; ++k) cq[k] = nq[k];
                    }
                }
                if (lane < 16) {
#pragma unroll
                    for (int g4 = 0; g4 < 4; ++g4) { u32x2 w; w.x = cvt_pk_bf16(Tc[4 * g4], Tc[4 * g4 + 1]); w.y = cvt_pk_bf16(Tc[4 * g4 + 2], Tc[4 * g4 + 3]); *(LAS u32x2*)(sb + CS_TT + tn * 80 + 16 * g4) = w; }
                }
                __builtin_amdgcn_fence(__ATOMIC_RELEASE, "workgroup");
                asm volatile("s_waitcnt lgkmcnt(0)" ::: "memory");
                if (lane == 0) flags[slot] = (unsigned)(c + 1);
            }
        }
    }
}

__device__ __forceinline__ void p5_rwkv_out(const Args& a, int lane, int wave, int G) {
    unsigned char* ws = a.ws;
    const bf16_t* FB = (const bf16_t*)(ws + WS_FEAT); const size_t astr = FEAT_STRIDE / 2;
    const bf16_t* YF = (const bf16_t*)(ws + WS_YF); const bf16_t* YBk = (const bf16_t*)(ws + WS_YB);
    bf16_t* RWK = (bf16_t*)(ws + WS_RWK);
    const int gw = blockIdx.x * 8 + wave, NGW = G * 8;
    const int c0 = 8 * lane;
    float lnw[8], lnb[8], rk[8];
#pragma unroll
    for (int j = 0; j < 8; ++j) { lnw[j] = a.in[I_LNW][c0 + j]; lnb[j] = a.in[I_LNB][c0 + j]; rk[j] = a.in[I_RK][c0 + j]; }
    auto ld8 = [&](const bf16_t* p, float (&o)[8]) { const u32x4 w = *(const u32x4*)p;
#pragma unroll
        for (int j = 0; j < 4; ++j) { o[2 * j] = lo16(w[j]); o[2 * j + 1] = hi16(w[j]); } };
    for (int m = gw; m < T; m += NGW) {
        const size_t o = (size_t)m * RD + c0;
        float yf[8], yb[8], r[8], kf[8], kb[8], v[8], g[8];
        ld8(YF + o, yf); ld8(YBk + o, yb); ld8(FB + F_R * astr + o, r); ld8(FB + F_KF * astr + o, kf); ld8(FB + F_KB * astr + o, kb); ld8(FB + F_V * astr + o, v); ld8(FB + F_G * astr + o, g);
        float s = 0.f, bs = 0.f;
#pragma unroll
        for (int j = 0; j < 8; ++j) { yf[j] += yb[j]; s += yf[j]; bs += r[j] * (kf[j] + kb[j]) * rk[j]; }
        s += __shfl_xor(s, 1); s += __shfl_xor(s, 2); s += __shfl_xor(s, 4);
        bs += __shfl_xor(bs, 1); bs += __shfl_xor(bs, 2); bs += __shfl_xor(bs, 4);
        const float mean = s * (1.f / 64.f); float q = 0.f;
#pragma unroll
        for (int j = 0; j < 8; ++j) { yf[j] -= mean; q += yf[j] * yf[j]; }
        q += __shfl_xor(q, 1); q += __shfl_xor(q, 2); q += __shfl_xor(q, 4);
        const float rstd = 1.0f / sqrtf(q * (1.f / 64.f) + GN_EPS);
        float out[8];
#pragma unroll
        for (int j = 0; j < 8; ++j) out[j] = (yf[j] * rstd * lnw[j] + lnb[j] + bs * v[j]) * g[j];
        u32x4 w; w.x = pk2(out[0], out[1]); w.y = pk2(out[2], out[3]); w.z = pk2(out[4], out[5]); w.w = pk2(out[6], out[7]);
        *(u32x4*)(RWK + o) = w;
    }
}

template <bool PROBE> __device__ __forceinline__ void p9_postmix_router(const Args& a, LAS unsigned char* lds, int tid, int lane, int wave, int G) {
    unsigned char* ws = a.ws;
    const float* MOD = (const float*)(ws + WS_CTL) + CW_MOD;
    const bf16_t* MIX = (const bf16_t*)(ws + WS_MIX);
    bf16_t* HF = (bf16_t*)(ws + (PROBE ? WS_H + 160 * MiB : WS_HF));
    int* cnt = (int*)(ws + WS_CTL) + (PROBE ? 12000 : CW_CNT);
    int* slot_tok = (int*)(ws + (PROBE ? WS_H + 240 * MiB : WS_SLOT_TOK)); float* slot_gate = (float*)(ws + (PROBE ? WS_H + 248 * MiB : WS_SLOT_GATE)); unsigned* tokk = (unsigned*)(ws + (PROBE ? WS_H + 256 * MiB : WS_TOKK));
    constexpr int HP = 1028;
    LAS float* HL = (LAS float*)lds;
    LAS float* PART = HL + 16 * HP;
    LAS int* SEL_E = (LAS int*)(lds + 90112); LAS float* SEL_G = (LAS float*)(lds + 90112 + 2048); LAS int* SEL_M = (LAS int*)(lds + 90112 + 4096);
    LAS int* HIST = (LAS int*)(lds + 90112 + 6144); LAS int* BASE = HIST + 32;
    int nsel = 0;
    const int ti = lane & 15, kq = lane >> 4;
    float wb0[32], wb1[32];
    {
        const float* wr = a.in[I_WROUTER];
#pragma unroll
        for (int ks = 0; ks < 32; ++ks) { const int k = 128 * wave + 4 * ks + kq; wb0[ks] = wr[k * NE + ti]; wb1[ks] = wr[k * NE + 16 + ti]; }
    }
    const float brt = a.in[I_BROUTER][lane & 31];
    for (int unit = blockIdx.x; unit < T / 16; unit += G) {
        const int tok0 = unit * 16;
        __syncthreads();
        {
            const int m0 = tok0 + 2 * wave; const int b = m0 >> 12;
            f32x4 v[2][4]; float s[2] = {0.f, 0.f};
#pragma unroll
            for (int tt = 0; tt < 2; ++tt) { const u32x2* mr = (const u32x2*)(MIX + (size_t)(m0 + tt) * D) + lane;
#pragma unroll
                for (int j = 0; j < 4; ++j) { const u32x2 w = mr[64 * j]; v[tt][j] = (f32x4){lo16(w.x), hi16(w.x), lo16(w.y), hi16(w.y)}; s[tt] += (v[tt][j].x * v[tt][j].x + v[tt][j].y * v[tt][j].y) + (v[tt][j].z * v[tt][j].z + v[tt][j].w * v[tt][j].w); } }
            f32x4 xv[2][4];
#pragma unroll
            for (int tt = 0; tt < 2; ++tt) { const f32x4* xr = (const f32x4*)(a.in[I_X] + (size_t)(m0 + tt) * D) + lane;
#pragma unroll
                for (int j = 0; j < 4; ++j) xv[tt][j] = xr[64 * j]; }
#pragma unroll
            for (int o = 1; o < 64; o <<= 1) { s[0] += __shfl_xor(s[0], o); s[1] += __shfl_xor(s[1], o); }
            float s2[2] = {0.f, 0.f};
#pragma unroll
            for (int j = 0; j < 4; ++j) {
                const f32x4 g = ((const f32x4*)a.in[I_GPOSTMIX])[64 * j + lane], gt = ((const f32x4*)(MOD + b * 6144 + 2048))[64 * j + lane];
#pragma unroll
                for (int tt = 0; tt < 2; ++tt) {
                    const float rstd = __builtin_amdgcn_rsqf(s[tt] * (1.f / D) + RMS_EPS);
                    v[tt][j] = xv[tt][j] + gt * (v[tt][j] * rstd * g);
                    ((f32x4*)((PROBE ? (float*)(ws + WS_H) : a.out) + (size_t)(m0 + tt) * D))[64 * j + lane] = v[tt][j];
                    s2[tt] += (v[tt][j].x * v[tt][j].x + v[tt][j].y * v[tt][j].y) + (v[tt][j].z * v[tt][j].z + v[tt][j].w * v[tt][j].w);
                }
            }
#pragma unroll
            for (int o = 1; o < 64; o <<= 1) { s2[0] += __shfl_xor(s2[0], o); s2[1] += __shfl_xor(s2[1], o); }
#pragma unroll
            for (int j = 0; j < 4; ++j) {
                const f32x4 g = ((const f32x4*)a.in[I_GPREFFN])[64 * j + lane], sh = ((const f32x4*)(MOD + b * 6144 + 3072))[64 * j + lane], sc = ((const f32x4*)(MOD + b * 6144 + 4096))[64 * j + lane];
#pragma unroll
                for (int tt = 0; tt < 2; ++tt) {
                    const float rstd2 = __builtin_amdgcn_rsqf(s2[tt] * (1.f / D) + RMS_EPS);
                    const f32x4 hv = (v[tt][j] * rstd2 * g) * (sc + 1.0f) + sh;
                    ((unsigned*)((unsigned char*)HF + (size_t)(m0 + tt) * D))[64 * j + lane] = pk4_fp8(hv.x * F8_ASCALE, hv.y * F8_ASCALE, hv.z * F8_ASCALE, hv.w * F8_ASCALE);
                    *(LAS f32x4*)(HL + (2 * wave + tt) * HP + 256 * j + 4 * lane) = hv;
                }
            }
        }
        __syncthreads();
        {
            f32x4 acc0 = (f32x4){0.f, 0.f, 0.f, 0.f}, acc1 = acc0;
#pragma unroll
            for (int ks = 0; ks < 32; ++ks) {
                const float av = HL[ti * HP + 128 * wave + 4 * ks + kq];
                acc0 = __builtin_amdgcn_mfma_f32_16x16x4f32(av, wb0[ks], acc0, 0, 0, 0);
                acc1 = __builtin_amdgcn_mfma_f32_16x16x4f32(av, wb1[ks], acc1, 0, 0, 0);
            }
#pragma unroll
            for (int r = 0; r < 4; ++r) { PART[(wave * 16 + 4 * kq + r) * 32 + ti] = acc0[r]; PART[(wave * 16 + 4 * kq + r) * 32 + 16 + ti] = acc1[r]; }
        }
        __syncthreads();
        {
            const int tl = 2 * wave + (lane >> 5); const int m = tok0 + tl;
            const int e = lane & 31;
            float lg = brt;
#pragma unroll
            for (int w = 0; w < 8; ++w) lg += PART[(w * 16 + tl) * 32 + e];
            float tv[4]; int ti4[4];
#pragma unroll
            for (int k = 0; k < 4; ++k) {
                float bv = lg; int bi = e;
#pragma unroll
                for (int o = 1; o < 32; o <<= 1) { const float ov = __shfl_xor(bv, o); const int oi = __shfl_xor(bi, o); if (ov > bv || (ov == bv && oi < bi)) { bv = ov; bi = oi; } }
                tv[k] = bv; ti4[k] = bi;
                if (e == bi) lg = -3.0e38f;
            }
            const float e1 = __expf(tv[1] - tv[0]), e2 = __expf(tv[2] - tv[0]), e3 = __expf(tv[3] - tv[0]);
            const float inv = 1.0f / (1.0f + e1 + e2 + e3);
            if (e < 4) {
                const int ek = e == 0 ? ti4[0] : e == 1 ? ti4[1] : e == 2 ? ti4[2] : ti4[3];
                const float gk = (e == 0 ? 1.0f : e == 1 ? e1 : e == 2 ? e2 : e3) * inv;
                const int si = nsel * 64 + tl * 4 + e;
                SEL_E[si] = ek; SEL_G[si] = gk; SEL_M[si] = m;
            }
        }
        ++nsel;
    }
    __syncthreads();
    if (tid < 32) HIST[tid] = 0;
    __syncthreads();
    int my_e = 0, my_lr = 0; const bool have = tid < nsel * 64;
    if (have) { my_e = SEL_E[tid]; my_lr = __hip_atomic_fetch_add(HIST + my_e, 1, __ATOMIC_RELAXED, __HIP_MEMORY_SCOPE_WORKGROUP); }
    __syncthreads();
    if (tid < 32) { const int n = HIST[tid]; BASE[tid] = n ? atomicAdd(cnt + tid, n) : 0; }
    __syncthreads();
    if (have) { const int rank = BASE[my_e] + my_lr; const int m = SEL_M[tid];
        slot_tok[my_e * T + rank] = m; slot_gate[(size_t)my_e * T + rank] = SEL_G[tid];
        tokk[m * 4 + (tid & 3)] = ((unsigned)my_e << 20) | (unsigned)rank; }
}

__device__ __forceinline__ void moe_table(const Args& a, LAS int* tstart, int tid) {
    const int* cnt = (const int*)(a.ws + WS_CTL) + CW_CNT;
    __syncthreads();
    if (tid == 0) { int acc = 0; for (int e = 0; e < NE; ++e) { tstart[e] = acc; acc += (__hip_atomic_load(cnt + e, __ATOMIC_RELAXED, __HIP_MEMORY_SCOPE_AGENT) + 255) >> 8; } tstart[NE] = acc; }
    __syncthreads();
}

__device__ __forceinline__ void p12_combine(const Args& a, LAS int* tstart, int lane, int wave, int G) {
    unsigned char* ws = a.ws;
    const float* MOD = (const float*)(ws + WS_CTL) + CW_MOD;
    const unsigned char* YB = (const unsigned char*)(ws + WS_YBUF); const unsigned* tokk = (const unsigned*)(ws + WS_TOKK);
    const int gw = blockIdx.x * 8 + wave, NGW = G * 8;
    for (int m = gw; m < T; m += NGW) {
        const int b = m >> 12;
        const u32x4 tk4 = *(const u32x4*)(tokk + m * 4);
        unsigned yw[4][4];
#pragma unroll
        for (int k = 0; k < 4; ++k) {
            const unsigned tk = tk4[k]; const int e = (int)(tk >> 20), rank = (int)(tk & 0xfffffu);
            const unsigned* yr = (const unsigned*)(YB + ((size_t)tstart[e] * 256 + rank) * D) + lane;
#pragma unroll
            for (int j = 0; j < 4; ++j) yw[k][j] = yr[64 * j];
        }
        f32x4 xr[4];
#pragma unroll
        for (int j = 0; j < 4; ++j) xr[j] = ((const f32x4*)(a.out + (size_t)m * D))[64 * j + lane];
        f32x4 y[4]; float s = 0.f;
#pragma unroll
        for (int j = 0; j < 4; ++j) { y[j] = (f32x4){0.f, 0.f, 0.f, 0.f};
#pragma unroll
            for (int k = 0; k < 4; ++k) { const f32x2_t lo = __builtin_amdgcn_cvt_pk_f32_fp8((int)yw[k][j], false), hi = __builtin_amdgcn_cvt_pk_f32_fp8((int)yw[k][j], true); y[j] += (f32x4){lo.x, lo.y, hi.x, hi.y}; }
            s += (y[j][0] * y[j][0] + y[j][1] * y[j][1]) + (y[j][2] * y[j][2] + y[j][3] * y[j][3]); }
        const float rstd = __builtin_amdgcn_rsqf(wave_sum(s) * (1.f / D) + RMS_EPS * F8_YSCALE * F8_YSCALE);
#pragma unroll
        for (int j = 0; j < 4; ++j) {
            const f32x4 g = ((const f32x4*)a.in[I_GPOSTFFN])[64 * j + lane], gt = ((const f32x4*)(MOD + b * 6144 + 5120))[64 * j + lane];
            ((f32x4*)(a.out + (size_t)m * D))[64 * j + lane] = xr[j] + gt * (y[j] * rstd * g);
        }
    }
}

constexpr int N_PHASES = 13;
__global__ void __launch_bounds__(512, 2) mega_fwd(Args args) {
    extern __shared__ __attribute__((aligned(16))) unsigned char lds_raw[];
    LAS unsigned char* lds = (LAS unsigned char*)lds_raw;
    const int tid = threadIdx.x, lane = tid & 63, wave = __builtin_amdgcn_readfirstlane(tid >> 6);
    const int G = gridDim.x;
    volatile LAS unsigned* MISC = (volatile LAS unsigned*)(lds + MISC_OFF);
    LAS int* tstart = (LAS int*)(lds + RING_BYTES);
    for (int u = tid; u < (LDS_BYTES - RING_BYTES) / 4; u += 512) ((LAS unsigned*)(lds + RING_BYTES))[u] = 0u;
    __syncthreads();
    unsigned char* ws = args.ws;
    const int lo = args.ph_lo, hi = args.ph_hi;
    unsigned* barw = (unsigned*)(ws + WS_CTL) + (args.bar_region ? (131072 + (args.bar_region - 1) * 4096) : CW_BAR);
    XcdBarrier bar; bar.bar = barw; bar.x = 0; bar.st = nullptr;
    if (hi - lo > 1) bar = xcd_barrier_post(barw, MISC + 8);
#ifndef PH_MASK
#define PH_MASK 0x1FFF
#endif
#define IN(k) (((PH_MASK >> (k)) & 1) && lo <= (k) && (k) < hi)
#define SEAM(k) do { if (IN(k) && IN((k) + 1)) xcd_barrier(bar); } while (0)

    if (IN(0)) { p0_prologue(args, lds, tid, lane, wave, G); SEAM(0); }
    if (IN(1)) { p1_norm(args, lane, wave, G); SEAM(1); }
    if (IN(2)) {
        SchedProj S{(const char*)(ws + WS_WIN), G, (int)blockIdx.x};
        EpiZ E{(bf16_t*)(ws + WS_Z), (const float*)(ws + WS_MISC)};
        pg8::gemm_phase<1024, EpiZ, SchedProj>(lds, (const char*)(ws + WS_HX), S, E);
        SEAM(2);
    }
    if (IN(3)) { p3a_pointwise(args, tid, G); if (IN(4)) xcd_barrier(bar); p3b_features(args, lds, tid, lane, wave, G); SEAM(3); }
    if (IN(5)) { if (SCAN_CHUNKED && !SCAN_FORCE_DIRECT) p4_scan_chunked<false>(args, lds, tid, lane, wave, G); else p4_scan<0>(args, lds, tid, lane, wave, G);
        p4_attention(args, lds, tid, lane, wave, G);
        moe_weight_copies(args, lds, tid, lane, wave);
        SEAM(5); }
#if DBG_SCAN
    if (IN(6) && blockIdx.x == 0) {
        const bf16_t* Yt = (const bf16_t*)(ws + (DBG_DIR ? WS_YB : WS_YF)); const bf16_t* Y2 = (const bf16_t*)(ws + 272 * MiB);
        LAS float* red = (LAS float*)lds; float* dbg = (float*)(ws + WS_CTL) + 12288;
        int first = -1; float worst = 0.f;
        for (int ci = 0; ci < 256; ++ci) {
            float e2 = 0.f, r2 = 0.f;
            for (int i = tid; i < 16 * 512; i += 512) { const int cc = DBG_DIR ? (255 - ci) : ci; const size_t o = (size_t)(cc * 16) * 512 + i; const float yt = bf2f(Yt[o]), y2 = bf2f(Y2[o]); e2 += (yt - y2) * (yt - y2); r2 += yt * yt; }
            e2 = wave_sum(e2); r2 = wave_sum(r2);
            __syncthreads(); if (lane == 0) { red[wave] = e2; red[8 + wave] = r2; } __syncthreads();
            float E = 0.f, R = 0.f; for (int w8 = 0; w8 < 8; ++w8) { E += red[w8]; R += red[8 + w8]; }
            const float rel = sqrtf(E / fmaxf(R, 1e-20f));
            if (first < 0 && !(rel < 0.03f)) first = ci;
            if (ci == DBG_CHUNK) { worst = rel;
                if (DBG_MODE == 2) { float z = 0.f; for (int i = tid; i < 16 * 512; i += 512) { const int cc = DBG_DIR ? (255 - ci) : ci; z += ((Y2[(size_t)(cc * 16) * 512 + i] & 0x7fff) > 0x7f80) ? 1.f : 0.f; }
                    z = wave_sum(z); __syncthreads(); if (lane == 0) red[16 + wave] = z; __syncthreads(); float Z = 0.f; for (int w8 = 0; w8 < 8; ++w8) Z += red[16 + w8]; worst = Z / 8192.f; } }
        }
        if (tid == 0) dbg[0] = DBG_MODE ? worst : ((first < 0) ? 0.f : (float)(first + 1) / 256.f);
    }
#endif
    if (IN(6)) {
        p5_rwkv_out(args, lane, wave, G);
        SchedDense<512> S{(const char*)(ws + WS_WUPA), G, (int)blockIdx.x};
        EpiUp<false> E{(bf16_t*)(ws + WS_MERGED), (const bf16_t*)(ws + WS_Z)};
        pg8::gemm_phase<512, EpiUp<false>, SchedDense<512>>(lds, (const char*)(ws + WS_ATT), S, E);
        SEAM(6);
    }
    if (IN(7)) {
        SchedDense<512> S{(const char*)(ws + WS_WUPR), G, (int)blockIdx.x};
        EpiUp<true> E{(bf16_t*)(ws + WS_MERGED), (const bf16_t*)(ws + WS_Z)};
        pg8::gemm_phase<512, EpiUp<true>, SchedDense<512>>(lds, (const char*)(ws + WS_RWK), S, E);
        SEAM(7);
    }
    if (IN(8)) {
        SchedDense<1024> S{(const char*)(ws + WS_WOUT), G, (int)blockIdx.x};
        EpiMix E{(bf16_t*)(ws + WS_MIX)};
        pg8::gemm_phase<1024, EpiMix, SchedDense<1024>>(lds, (const char*)(ws + WS_MERGED), S, E);
        SEAM(8);
    }
    if (IN(9)) { p9_postmix_router<false>(args, lds, tid, lane, wave, G); SEAM(9); }
    if (IN(10)) {
        moe_table(args, tstart, tid);
        SchedMoe<8, true, 1> S{(const char*)(ws + WS_WGU), G, (int)blockIdx.x, tstart, (const int*)(ws + WS_CTL) + CW_CNT, (const int*)(ws + WS_SLOT_TOK)};
        EpiMoe1 E{(bf16_t*)(ws + WS_H), args.in[I_BGU]};
        pg8::gemm_phase<1024, EpiMoe1, SchedMoe<8, true, 1>, true>(lds, (const char*)(ws + WS_HF), S, E);
        SEAM(10);
    }
    if (IN(11)) {
        moe_table(args, tstart, tid);
        SchedMoe<4, false, 1> S{(const char*)(ws + WS_WDN), G, (int)blockIdx.x, tstart, (const int*)(ws + WS_CTL) + CW_CNT, (const int*)(ws + WS_SLOT_TOK)};
        EpiMoe2 E{(unsigned char*)(ws + WS_YBUF), args.in[I_BDN], (const float*)(ws + WS_SLOT_GATE), (const int*)(ws + WS_CTL) + CW_CNT};
        pg8::gemm_phase<1024, EpiMoe2, SchedMoe<4, false, 1>, true>(lds, (const char*)(ws + WS_H), S, E);
        SEAM(11);
    }
    if (IN(12)) { moe_table(args, tstart, tid); p12_combine(args, tstart, lane, wave, G); }
#ifdef PROBE_PHASE
    if (lo == 15 && blockIdx.x == 0 && tid < 32) { unsigned* ctl = (unsigned*)(ws + WS_CTL); if (tid == 0) { ctl[CW_QATT] = 0u; ctl[CW_QTR] = PROBE_QTR0; } ctl[CW_CNT + tid] = 0u; }
    if (lo == 16) p9_postmix_router<true>(args, lds, tid, lane, wave, G);
    if (lo == 18) p4_attention(args, lds, tid, lane, wave, G);
    if (lo == 13) p3a_pointwise(args, tid, G);
    if (lo == 14) p3b_features(args, lds, tid, lane, wave, G);
#endif
#undef IN
#undef SEAM
}

extern "C" void kernel_launch(void* const* d_in, const int* in_sizes, int n_in, void* d_out, int out_size, void* d_ws, size_t ws_size, hipStream_t stream) {
    static int grid = 0;
    if (grid == 0) {
        if (n_in != 38 || out_size != T * D || ws_size < WS_END) { fprintf(stderr, "kernel_launch: unexpected problem shape (n_in %d, out %d, ws %zu)\n", n_in, out_size, ws_size); grid = -1; return; }
        int dev = 0, cus = 0, per_cu = 0;
        if (hipGetDevice(&dev) != hipSuccess || hipDeviceGetAttribute(&cus, hipDeviceAttributeMultiprocessorCount, dev) != hipSuccess) { grid = -1; return; }
        if (hipFuncSetAttribute((const void*)mega_fwd, hipFuncAttributeMaxDynamicSharedMemorySize, LDS_BYTES) != hipSuccess) { fprintf(stderr, "kernel_launch: hipFuncSetAttribute failed\n"); grid = -1; return; }
        if (hipOccupancyMaxActiveBlocksPerMultiprocessor(&per_cu, (const void*)mega_fwd, 512, LDS_BYTES) != hipSuccess || per_cu < 1) fprintf(stderr, "kernel_launch: occupancy query says %d\n", per_cu);
        (void)hipGetLastError();
        grid = cus;
    }
    if (grid < 0) return;
    (void)hipMemsetAsync((char*)d_ws + WS_CTL, 0, CTL_BYTES, stream);
    Args a{};
    for (int i = 0; i < 38; ++i) a.in[i] = (const float*)d_in[i];
    a.out = (float*)d_out; a.ws = (unsigned char*)d_ws;
#if MK_ONE_LAUNCH
    a.ph_lo = 0; a.ph_hi = N_PHASES;
    hipLaunchKernelGGL(mega_fwd, dim3(grid), dim3(512), LDS_BYTES, stream, a);
#ifdef PROBE_PHASE
#ifdef PROBE_PRE
    { a.ph_lo = PROBE_PRE; a.ph_hi = PROBE_PRE + 1; hipLaunchKernelGGL(mega_fwd, dim3(grid), dim3(512), LDS_BYTES, stream, a); }
#endif
    for (int rep = 0; rep < PROBE_REPS; ++rep) { a.ph_lo = PROBE_PHASE; a.ph_hi = PROBE_HI; a.bar_region = 1 + rep; hipLaunchKernelGGL(mega_fwd, dim3(grid), dim3(512), LDS_BYTES, stream, a); }
#endif
#else
    for (int p = 0; p < N_PHASES; ++p) { a.ph_lo = p; a.ph_hi = p + 1; hipLaunchKernelGGL(mega_fwd, dim3(grid), dim3(512), LDS_BYTES, stream, a); }
#endif
}
```

```cpp
#include <hip/hip_runtime.h>
#include <cstdio>
#include <cstdint>

#ifndef MK_ONE_LAUNCH
#define MK_ONE_LAUNCH 1
#endif
#ifndef PROBE_QTR0
#define PROBE_QTR0 0u
#endif
#ifndef PROBE_HI
#define PROBE_HI (PROBE_PHASE + 1)
#endif
#ifndef SCAN_CHUNKED
#define SCAN_CHUNKED 1
#endif
#ifndef SCAN_FORCE_DIRECT
#define SCAN_FORCE_DIRECT 0
#endif
#ifndef DBG_SCAN
#define DBG_SCAN 0
#define DBG_DIR 0
#define DBG_MODE 0
#define DBG_CHUNK 0
#endif
#ifndef DBG_NOA
#define DBG_NOA 0
#define DBG_NOB 0
#endif
#ifndef DBG_D
#define DBG_D 0
#endif
#ifndef DBG_TI
#define DBG_TI 0
#endif
#ifndef CS_LOCKSTEP
#define CS_LOCKSTEP 0
#endif

#define GAS __attribute__((address_space(1)))
#define LAS __attribute__((address_space(3)))
typedef unsigned short bf16_t;
typedef short bf16x8 __attribute__((ext_vector_type(8)));
typedef short s16x4 __attribute__((ext_vector_type(4)));
typedef float f32x4 __attribute__((ext_vector_type(4)));
typedef float f32x16 __attribute__((ext_vector_type(16)));
typedef unsigned u32x4 __attribute__((ext_vector_type(4)));
typedef unsigned u32x2 __attribute__((ext_vector_type(2)));

constexpr int NB = 8, SEQ = 4096, T = NB * SEQ, D = 1024, CL = 256, TC = NB * CL, ROWS = T + TC;
constexpr int NH = 8, HD = 64, NKV = 2, RD = 512;
constexpr int NE = 32, TOPK = 4, DE = 1024;
constexpr int PROJ_SRC = 4736;
constexpr int ZP = 4864;
constexpr int ZC_Q = 0, ZC_K = 512, ZC_V = 640, ZC_R = 768, ZC_RK = 1280, ZC_RV = 1792, ZC_LORA = 2304, ZC_G = 2816;
constexpr int NTILE_N = ZP / 256;
constexpr float RMS_EPS = 1e-6f, GN_EPS = 64e-5f;
constexpr float F8_WSCALE = 32.0f, F8_ASCALE = 4.0f, F8_HSCALE = 8.0f, F8_YSCALE = 32.0f;

constexpr size_t MiB = 1u << 20;
constexpr size_t WS_CTL = 0, CTL_BYTES = 1 * MiB;
constexpr size_t WS_WIN = 1 * MiB;
constexpr size_t WS_WUPA = 11 * MiB, WS_WUPR = 12 * MiB;
constexpr size_t WS_WOUT = 13 * MiB;
constexpr size_t WS_LORA = 15 * MiB;
constexpr size_t WS_MISC = 15 * MiB + 512 * 1024;
constexpr size_t WS_WGU = 16 * MiB;
constexpr size_t WS_WDN = 144 * MiB;
constexpr size_t WS_HX = 208 * MiB;
constexpr size_t WS_YF = 208 * MiB, WS_YB = 240 * MiB;
constexpr size_t WS_HF = 208 * MiB;
constexpr size_t WS_Z = 276 * MiB;
constexpr size_t WS_SLOT_TOK = 272 * MiB;
constexpr size_t WS_FEAT = 599 * MiB;
constexpr size_t FEAT_STRIDE = 34 * MiB;
constexpr size_t WS_MERGED = 769 * MiB;
constexpr size_t WS_MIX = 599 * MiB;
constexpr size_t WS_QR = 939 * MiB;
constexpr size_t WS_RWK = 939 * MiB;
constexpr size_t WS_KA = 971 * MiB;
constexpr size_t WS_VT = 980 * MiB;
constexpr size_t WS_ATT = 990 * MiB;
constexpr size_t WS_SLOT_GATE = 276 * MiB;
constexpr size_t WS_TOKK = 280 * MiB;
constexpr size_t WS_H = 281 * MiB;
constexpr int MAXTILES = 544, MAXSLOT = MAXTILES * 256;
constexpr size_t WS_YBUF = 553 * MiB;
constexpr size_t WS_END = 1024 * MiB;
static_assert(WS_YBUF + (size_t)MAXSLOT * 1024 * 2 <= WS_QR, "ws map");
static_assert(WS_H + (size_t)MAXSLOT * 1024 * 2 <= WS_YBUF, "ws map");
static_assert(WS_Z + (size_t)ROWS * ZP * 2 <= WS_FEAT, "ws map");
static_assert(WS_FEAT + 10 * FEAT_STRIDE <= WS_QR, "ws map");
static_assert(WS_ATT + (size_t)T * 512 * 2 <= WS_END, "ws map");
static_assert(WS_VT + 9 * MiB <= WS_ATT && WS_KA + (size_t)ROWS * 128 * 2 <= WS_VT, "ws map");
enum { F_R = 0, F_V, F_A, F_KF, F_KB, F_BF, F_BB, F_WF, F_WB, F_G };
constexpr int CW_BAR = 4096;
constexpr int CW_CNT = 8192;
constexpr int CW_QATT = 8320, CW_QTR = 8384;
constexpr int CW_MOD = 16384;
static_assert((CW_MOD + 9 * 6144) * 4 <= (int)CTL_BYTES, "ctl");

constexpr int RING_BYTES = 131072;
constexpr int MISC_OFF = RING_BYTES + 320;
constexpr int LDS_BYTES = 147456;
constexpr int TCNT_OFF = RING_BYTES + 384;
constexpr int NOFF_OFF = RING_BYTES + 2048;
constexpr int TOK_OFF = RING_BYTES + 10240;
constexpr int SIDE_OFF = RING_BYTES + 12288;
static_assert(SIDE_OFF + 4096 <= LDS_BYTES, "lds map");

#define LDS_WAIT() asm volatile("s_waitcnt lgkmcnt(0)" ::: "memory")
#define VM_WAIT() asm volatile("s_waitcnt vmcnt(0)" ::: "memory")
__device__ __forceinline__ float bf2f(unsigned b) { return __uint_as_float(b << 16); }
__device__ __forceinline__ unsigned f2bf(float f) { unsigned u = __float_as_uint(f); return (u + 0x7fffu + ((u >> 16) & 1u)) >> 16; }
__device__ __forceinline__ unsigned pk2(float lo, float hi) { return f2bf(lo) | (f2bf(hi) << 16); }
__device__ __forceinline__ float lo16(unsigned w) { return __uint_as_float(w << 16); }
__device__ __forceinline__ float hi16(unsigned w) { return __uint_as_float(w & 0xffff0000u); }
__device__ __forceinline__ float sigmoidf_(float x) { return __builtin_amdgcn_rcpf(1.0f + __expf(-x)); }
__device__ __forceinline__ float wave_sum(float v) {
#pragma unroll
    for (int o = 1; o < 64; o <<= 1) v += __shfl_xor(v, o);
    return v;
}

#define XB_TMO      128
#define XB_XCNT(j)  (256  + 64 * (j))
#define XB_XSUB(j)  (1280 + 64 * (j))
#define XB_XGEN(j)  (2304 + 64 * (j))
#define XB_TOP      3328
#define XB_TOPGEN   3392
#define XCD_BAR_WORDS 3456
#define XB_SPIN_CAP (1u << 22)
__device__ __forceinline__ unsigned xb_ld(unsigned* p)              { return __hip_atomic_load(p, __ATOMIC_RELAXED, __HIP_MEMORY_SCOPE_AGENT); }
__device__ __forceinline__ unsigned xb_add(unsigned* p, unsigned v) { return __hip_atomic_fetch_add(p, v, __ATOMIC_RELAXED, __HIP_MEMORY_SCOPE_AGENT); }
__device__ __forceinline__ unsigned xb_xcc_id() { return (unsigned)__builtin_amdgcn_s_getreg((3 << 11) | 20) & 0xFu; }
#define XB_SPIN(cond, bar) do { unsigned _sp = 0; while (cond) { __builtin_amdgcn_s_sleep(1); \
    if ((++_sp & 255u) == 0u) { if (xb_ld(&(bar)[XB_TMO])) break; if (_sp > XB_SPIN_CAP) { atomicAdd(&(bar)[XB_TMO], 1u); break; } } } } while (0)
struct XcdBarrier { unsigned* bar; unsigned x; volatile LAS unsigned* st; };
__device__ __forceinline__ XcdBarrier xcd_barrier_post(unsigned* bar, volatile LAS unsigned* st) {
    XcdBarrier b; b.bar = bar; b.x = xb_xcc_id(); b.st = st;
    if (threadIdx.x == 0) (void)xb_add(&bar[XB_XCNT(b.x)], 1u);
    return b;
}
__device__ __forceinline__ void xcd_barrier_complete(unsigned* bar, unsigned x, unsigned& nloc, unsigned& nx) {
    const unsigned G = gridDim.x * gridDim.y * gridDim.z;
    unsigned sum, cnt, mine, sp = 0u;
    for (;;) {
        sum = 0u; cnt = 0u; mine = 0u;
#pragma unroll
        for (unsigned j = 0; j < 16; ++j) { const unsigned c = xb_ld(&bar[XB_XCNT(j)]); sum += c; cnt += (c > 0u) ? 1u : 0u; mine = (j == x) ? c : mine; }
        if (sum == G) break;
        __builtin_amdgcn_s_sleep(1);
        if ((++sp & 255u) == 0u) { if (xb_ld(&bar[XB_TMO])) break; if (sp > XB_SPIN_CAP) { atomicAdd(&bar[XB_TMO], 1u); break; } }
    }
    nloc = mine > 0u ? mine : 1u; nx = cnt > 0u ? cnt : 1u;
}
__device__ __forceinline__ void xcd_barrier(const XcdBarrier& b) {
    asm volatile("s_waitcnt vmcnt(0)" ::: "memory");
    __syncthreads();
    if (threadIdx.x == 0) {
        unsigned* bar = b.bar;
        __builtin_amdgcn_s_waitcnt(0);
        unsigned nloc = b.st[0], nx = b.st[1];
        if (nloc == 0u) { xcd_barrier_complete(bar, b.x, nloc, nx); b.st[0] = nloc; b.st[1] = nx; }
        const unsigned old = xb_add(&bar[XB_XSUB(b.x)], 1u);
        const unsigned gen = old / nloc;
        if (old + 1u == (gen + 1u) * nloc) {
            __builtin_amdgcn_fence(__ATOMIC_RELEASE, "agent");
            asm volatile("s_waitcnt vmcnt(0)" ::: "memory");
            const unsigned og = xb_add(&bar[XB_TOP], 1u);
            const unsigned tg = og / nx;
            if (og + 1u == (tg + 1u) * nx) xb_add(&bar[XB_TOPGEN], 1u);
            else XB_SPIN(xb_ld(&bar[XB_TOPGEN]) == tg, bar);
            __builtin_amdgcn_fence(__ATOMIC_ACQUIRE, "agent");
            xb_add(&bar[XB_XGEN(b.x)], 1u);
            asm volatile("s_waitcnt vmcnt(0)" ::: "memory");
        } else {
            XB_SPIN(xb_ld(&bar[XB_XGEN(b.x)]) == gen, bar);
            __builtin_amdgcn_fence(__ATOMIC_ACQUIRE, "agent");
            asm volatile("s_waitcnt vmcnt(0)" ::: "memory");
        }
    }
    __syncthreads();
}

namespace pg8 {
constexpr int BM = 256, BK = 64, HALF = 128, HTB = HALF * BK * 2, STAGE_BYTES = 8 * HTB;
__host__ __device__ __forceinline__ int lds_byte(int r, int c) { const int st = (r >> 4) * 2 + (c >> 5), rr = r & 15, cc = c & 31, ob = rr * 64 + cc * 2; return st * 1024 + (ob ^ (((ob >> 9) & 1) << 5)); }
__host__ __device__ __forceinline__ void stage_rc(int b, int& R, int& C) { const int st = b / 1024, sb = b % 1024, swz = sb ^ (((sb >> 9) & 1) << 5); R = (st >> 1) * 16 + swz / 64; C = (st & 1) * 32 + (swz % 64) / 2; }
__host__ __device__ __forceinline__ int perm32(int rho) { const int n = rho >> 4, i = rho & 15; return 8 * (i >> 2) + 4 * n + (i & 3); }

struct GUnit { const char* B; int pm, pn, e, lrow0; };

typedef int i32x8 __attribute__((ext_vector_type(8)));
template <int K, class Epi, class Sched, bool F8 = false>
__device__ __forceinline__ void gemm_phase(LAS unsigned char* lds, const char* Aroot, const Sched& S, const Epi& E) {
    const int tid = threadIdx.x, wid = __builtin_amdgcn_readfirstlane(tid >> 6), lane = tid & 63, wr = wid >> 2, wc = wid & 3, fr = lane & 15, fq = lane >> 4;
    constexpr int EB = F8 ? 1 : 2;
    constexpr int nt = K * EB / (BK * 2);
    static_assert(!Sched::GATHER || nt >= 6, "gather offsets are computed in the second K iteration");
    int Rr[2], Cc[2]; unsigned voffB[2];
#pragma unroll
    for (int i = 0; i < 2; ++i) { int R, C; stage_rc(tid * 16 + i * 8192, R, C); const int Rb = Epi::PERM ? ((R & ~31) + perm32(R & 31)) : R;
        Rr[i] = R; Cc[i] = C; voffB[i] = (unsigned)(Rb * K * EB + C * 2); }
    constexpr size_t kstep = (size_t)(BK * 2);
    constexpr size_t hstep = (size_t)HALF * K * EB;
    const unsigned ldsw = (unsigned)wid * 1024u;
    const int aoff = lds_byte(wr * 64 + fr, fq * 8), boff = lds_byte(wc * 32 + fr, fq * 8);
#define PG8_SA(b, h) (((b) * 2 + (h)) * HTB)
#define PG8_SB(b, h) ((4 + (b) * 2 + (h)) * HTB)
#define PG8_STAGEB(bufoff, gbase) do { _Pragma("unroll") for (int _i = 0; _i < 2; ++_i) \
        __builtin_amdgcn_global_load_lds((const unsigned*)((const char*)(gbase) + voffB[_i]), (LAS unsigned*)(lds + (bufoff) + ldsw + _i * 8192), 16, 0, 0); } while (0)
#define PG8_STAGEA(bufoff, base, o0, o1, kb) do { unsigned _o0 = (o0), _o1 = (o1); asm volatile("" : "+v"(_o0), "+v"(_o1));     \
        const char* _gb = (base) + (size_t)(kb); \
        __builtin_amdgcn_global_load_lds((const unsigned*)(_gb + _o0), (LAS unsigned*)(lds + (bufoff) + ldsw), 16, 0, 0); \
        __builtin_amdgcn_global_load_lds((const unsigned*)(_gb + _o1), (LAS unsigned*)(lds + (bufoff) + ldsw + 8192), 16, 0, 0); } while (0)
#define PG8_LD8(dst, off) do { const u32x4 _p0 = *(const LAS u32x4*)(lds + (off)), _p1 = *(const LAS u32x4*)(lds + (off) + 1024); dst = (i32x8){(int)_p0.x, (int)_p0.y, (int)_p0.z, (int)_p0.w, (int)_p1.x, (int)_p1.y, (int)_p1.z, (int)_p1.w}; } while (0)
#define PG8_LDA(dst, b, h) do { if constexpr (F8) { _Pragma("unroll") for (int m = 0; m < 4; ++m) PG8_LD8(dst##8[m], PG8_SA(b, h) + aoff + m * 2048); } \
        else { _Pragma("unroll") for (int m = 0; m < 4; ++m) _Pragma("unroll") for (int k = 0; k < 2; ++k) dst[m][k] = *(const LAS bf16x8*)(lds + PG8_SA(b, h) + aoff + m * 2048 + k * 1024); } } while (0)
#define PG8_LDB(dst, b, h) do { if constexpr (F8) { _Pragma("unroll") for (int n = 0; n < 2; ++n) PG8_LD8(dst##8[n], PG8_SB(b, h) + boff + n * 2048); } \
        else { _Pragma("unroll") for (int n = 0; n < 2; ++n) _Pragma("unroll") for (int k = 0; k < 2; ++k) dst[n][k] = *(const LAS bf16x8*)(lds + PG8_SB(b, h) + boff + n * 2048 + k * 1024); } } while (0)
#define PG8_MMA(ai, bj, At, Bt) do { __builtin_amdgcn_s_setprio(1); _Pragma("unroll") for (int m = 0; m < 4; ++m) _Pragma("unroll") for (int n = 0; n < 2; ++n) { \
        if constexpr (F8) asm volatile("v_mfma_scale_f32_16x16x128_f8f6f4 %0, %1, %2, %0, %3, %3 op_sel_hi:[0,0,0]" : "+v"(acc[ai][bj][m][n]) : "v"(Bt##8[n]), "v"(At##8[m]), "v"(f8scale)); \
        else { _Pragma("unroll") for (int k = 0; k < 2; ++k) acc[ai][bj][m][n] = __builtin_amdgcn_mfma_f32_16x16x32_bf16(Bt[n][k], At[m][k], acc[ai][bj][m][n], 0, 0, 0); } } \
        __builtin_amdgcn_s_setprio(0); } while (0)
#define PG8_WAIT_V(n) asm volatile("s_waitcnt vmcnt(" #n ")" ::: "memory")
#define PG8_WAIT_L(n) asm volatile("s_waitcnt lgkmcnt(" #n ")" ::: "memory")
#define PG8_BAR __builtin_amdgcn_s_barrier()
#define PG8_SCHED __builtin_amdgcn_sched_barrier(0)
    GUnit cur, nxt; int ui = 0;
    if (!S.next(0, cur)) return;
    f32x4 acc[2][2][4][2];
#pragma unroll
    for (int a = 0; a < 2; ++a)
#pragma unroll
        for (int b = 0; b < 2; ++b)
#pragma unroll
            for (int m = 0; m < 4; ++m)
#pragma unroll
                for (int n = 0; n < 2; ++n) acc[a][b][m][n] = (f32x4){0.f, 0.f, 0.f, 0.f};
    bf16x8 At[4][2], B0[2][2], B1[2][2];
    const int f8scale = 0x7f7f7f7f;
    i32x8 At8[4], B08[2], B18[2];
    unsigned c00, c01, c10, c11;
    const char* cA = Aroot;
    if constexpr (Sched::GATHER) {
        c00 = S.arow(cur, Rr[0]) * (unsigned)(K * EB) + (unsigned)Cc[0] * 2u; c01 = S.arow(cur, Rr[1]) * (unsigned)(K * EB) + (unsigned)Cc[1] * 2u;
        c10 = S.arow(cur, HALF + Rr[0]) * (unsigned)(K * EB) + (unsigned)Cc[0] * 2u; c11 = S.arow(cur, HALF + Rr[1]) * (unsigned)(K * EB) + (unsigned)Cc[1] * 2u;
    } else {
        c00 = (unsigned)(Rr[0] * K * EB + Cc[0] * 2); c01 = (unsigned)(Rr[1] * K * EB + Cc[1] * 2); c10 = c00 + (unsigned)(HALF * K * EB); c11 = c01 + (unsigned)(HALF * K * EB);
        cA = Aroot + (size_t)S.arow(cur, 0) * (size_t)(K * EB);
    }
    const char* cB = cur.B;
    PG8_STAGEB(PG8_SB(0, 0), cB); PG8_STAGEA(PG8_SA(0, 0), cA, c00, c01, 0); PG8_STAGEB(PG8_SB(0, 1), cB + hstep); PG8_STAGEA(PG8_SA(0, 1), cA, c10, c11, 0);
    if (wr == 1) PG8_BAR;
    PG8_WAIT_V(4); PG8_BAR;
    PG8_STAGEB(PG8_SB(1, 0), cB + kstep); PG8_STAGEA(PG8_SA(1, 0), cA, c00, c01, kstep); PG8_STAGEB(PG8_SB(1, 1), cB + hstep + kstep);
    PG8_WAIT_V(6); PG8_BAR;
    for (;;) {
        const bool has_next = S.next(ui + 1, nxt);
        unsigned n00 = c00, n01 = c01, n10 = c10, n11 = c11; const char* nB = cB; const char* nA = cA;
        LAS u32x4* noff_lds = (LAS u32x4*)(lds + NOFF_OFF) + tid;
        if constexpr (Epi::SIDE) __builtin_amdgcn_global_load_lds((const unsigned*)E.side_ptr(cur, tid), (LAS unsigned*)(lds + SIDE_OFF + (ui & 1) * 2048 + wid * 256), 4, 0, 0);
        if (has_next) {
            if constexpr (Sched::GATHER) __builtin_amdgcn_global_load_lds((const unsigned*)S.tok_ptr(nxt, tid), (LAS unsigned*)(lds + TOK_OFF + wid * 256), 4, 0, 0);
            else nA = Aroot + (size_t)S.arow(nxt, 0) * (size_t)(K * EB);
            nB = nxt.B;
        } else if constexpr (Sched::GATHER) { *noff_lds = (u32x4){c00, c01, c10, c11}; }
        for (int t = 0; t < nt; t += 2) {
            const bool last = (t == nt - 2);
            if constexpr (Sched::GATHER) { if (t == 2 && has_next) {
                int tz = tid; asm volatile("" : "+v"(tz));
                int R0, C0, R1, C1; stage_rc(tz * 16, R0, C0); stage_rc(tz * 16 + 8192, R1, C1);
                const LAS int* tk = (const LAS int*)(lds + TOK_OFF);
                u32x4 nn;
                nn.x = S.tok_row(nxt, R0, tk[R0]) * (unsigned)(K * EB) + (unsigned)C0 * 2u; nn.y = S.tok_row(nxt, R1, tk[R1]) * (unsigned)(K * EB) + (unsigned)C1 * 2u;
                nn.z = S.tok_row(nxt, HALF + R0, tk[HALF + R0]) * (unsigned)(K * EB) + (unsigned)C0 * 2u; nn.w = S.tok_row(nxt, HALF + R1, tk[HALF + R1]) * (unsigned)(K * EB) + (unsigned)C1 * 2u;
                *((LAS u32x4*)(lds + NOFF_OFF) + tz) = nn; } }
            const size_t k1 = (size_t)(t + 1) * kstep;
            const size_t k2 = last ? 0 : (size_t)(t + 2) * kstep, k3 = k2 + kstep;
            if constexpr (Sched::GATHER) { if (last) { const u32x4 nn = *noff_lds; n00 = nn.x; n01 = nn.y; n10 = nn.z; n11 = nn.w; } }
            const unsigned a00 = last ? n00 : c00, a01 = last ? n01 : c01, a10 = last ? n10 : c10, a11 = last ? n11 : c11; const char* a2 = last ? nA : cA;
            const char* b2 = last ? nB : cB + (size_t)(t + 2) * kstep; const char* b3 = b2 + kstep;
            PG8_LDB(B0, 0, 0); PG8_SCHED; PG8_LDA(At, 0, 0); PG8_STAGEA(PG8_SA(1, 1), cA, c10, c11, k1);
            PG8_WAIT_L(8); PG8_BAR; PG8_WAIT_L(0); PG8_MMA(0, 0, At, B0); PG8_BAR; PG8_SCHED;
            PG8_LDB(B1, 0, 1); PG8_STAGEB(PG8_SB(0, 0), b2);
            PG8_BAR; PG8_WAIT_L(0); PG8_MMA(0, 1, At, B1); PG8_BAR;
            PG8_LDA(At, 0, 1); PG8_STAGEA(PG8_SA(0, 0), a2, a00, a01, k2);
            PG8_BAR; PG8_WAIT_L(0); PG8_MMA(1, 0, At, B0); PG8_BAR; PG8_SCHED;
            PG8_STAGEB(PG8_SB(0, 1), b2 + hstep);
            PG8_WAIT_V(6); PG8_BAR; PG8_MMA(1, 1, At, B1); PG8_BAR;
            PG8_LDB(B0, 1, 0); PG8_SCHED; PG8_LDA(At, 1, 0); PG8_STAGEA(PG8_SA(0, 1), a2, a10, a11, k2);
            PG8_WAIT_L(8); PG8_BAR; PG8_WAIT_L(0); PG8_MMA(0, 0, At, B0); PG8_BAR; PG8_SCHED;
            PG8_LDB(B1, 1, 1); PG8_STAGEB(PG8_SB(1, 0), b3);
            PG8_BAR; PG8_WAIT_L(0); PG8_MMA(0, 1, At, B1); PG8_BAR;
            PG8_LDA(At, 1, 1); PG8_STAGEA(PG8_SA(1, 0), a2, a00, a01, k3);
            PG8_BAR; PG8_WAIT_L(0); PG8_MMA(1, 0, At, B0); PG8_BAR; PG8_SCHED;
            PG8_STAGEB(PG8_SB(1, 1), b3 + hstep);
            PG8_WAIT_V(6); PG8_BAR; PG8_MMA(1, 1, At, B1); PG8_BAR;
        }
        if (wr == 0) PG8_BAR;
        if constexpr (F8) asm volatile("s_nop 15\n\ts_nop 15" ::: "memory");
        E(acc, cur, wr, wc, fr, fq, lds + (ui & 1) * 2048);
        if (!has_next) break;
#pragma unroll
        for (int a = 0; a < 2; ++a)
#pragma unroll
            for (int b = 0; b < 2; ++b)
#pragma unroll
                for (int m = 0; m < 4; ++m)
#pragma unroll
                    for (int n = 0; n < 2; ++n) acc[a][b][m][n] = (f32x4){0.f, 0.f, 0.f, 0.f};
        cur = nxt; cB = nB; cA = nA; c00 = n00; c01 = n01; c10 = n10; c11 = n11; ++ui;
        if (wr == 1) PG8_BAR;
    }
    PG8_WAIT_V(0);
    PG8_BAR;
#undef PG8_SA
#undef PG8_SB
#undef PG8_STAGEA
#undef PG8_STAGEB
#undef PG8_LDA
#undef PG8_LDB
#undef PG8_MMA
#undef PG8_LD8
#undef PG8_WAIT_V
#undef PG8_WAIT_L
#undef PG8_BAR
#undef PG8_SCHED
}
}
using pg8::GUnit;

struct Args { const float* in[38]; float* out; unsigned char* ws; int ph_lo, ph_hi, bar_region, pad; };
enum { I_X = 0, I_C, I_CTX, I_CCTX, I_WADA, I_BADA, I_GPREMIX, I_GPOSTMIX, I_GPREFFN, I_GPOSTFFN, I_WIN, I_BIN, I_MUP, I_MUN, I_SINKS, I_W0F, I_W0B, I_W2F, I_W2B,
       I_A0F, I_A0B, I_A2F, I_A2B, I_G2, I_KK, I_KA, I_RK, I_LNW, I_LNB, I_WUPA, I_WUPR, I_WOUT, I_WROUTER, I_BROUTER, I_WGU, I_BGU, I_WDN, I_BDN };

__device__ __forceinline__ unsigned pk4_fp8(float a, float b, float c, float d) { int w = 0; w = __builtin_amdgcn_cvt_pk_fp8_f32(a, b, w, false); w = __builtin_amdgcn_cvt_pk_fp8_f32(c, d, w, true); return (unsigned)w; }
typedef float f32x2_t __attribute__((ext_vector_type(2)));
typedef __bf16 bf16x2_t __attribute__((ext_vector_type(2)));
__device__ __forceinline__ unsigned cvt_pk_bf16_asm(float lo, float hi) { unsigned r; asm volatile("v_cvt_pk_bf16_f32 %0, %1, %2" : "=v"(r) : "v"(lo), "v"(hi)); return r; }
__device__ __forceinline__ unsigned cvt_pk_bf16(float lo, float hi) { const f32x2_t v = {lo, hi}; const bf16x2_t b = __builtin_convertvector(v, bf16x2_t); return __builtin_bit_cast(unsigned, b); }

__device__ __forceinline__ void tile_order(int L, int nM, int nN, int& pm, int& pn) {
    const int nwg = nM * nN; int wgid = L;
    { const int q = nwg / 8, r = nwg % 8, xcd = wgid % 8, off = wgid / 8; wgid = (xcd < r ? xcd * (q + 1) : r * (q + 1) + (xcd - r) * q) + off; }
    const int nig = 8 * nN, gid = wgid / nig, fm = gid * 8, gsz = (nM - fm) < 8 ? (nM - fm) : 8;
    pm = fm + ((wgid % nig) % gsz); pn = (wgid % nig) / gsz;
}

struct SchedProj {           static constexpr bool GATHER = false;
    const char* Bt; int G, c;
    __device__ __forceinline__ bool next(int i, GUnit& u) const {
        const int L = i * G + c; constexpr int NXU = 128 * NTILE_N;
        if (L >= NXU + 72) return false;
        int pm, pn;
        if (L < NXU) tile_order(L, 128, NTILE_N, pm, pn); else { const int l2 = L - NXU; pm = 128 + l2 / 9; pn = 2 + l2 % 9; }
        u.pm = pm; u.pn = pn; u.e = 0; u.lrow0 = 0; u.B = Bt + (size_t)pn * 256 * D * 2; return true;
    }
    __device__ __forceinline__ unsigned arow(const GUnit& u, int r) const { return (unsigned)(u.pm * 256 + r); }
};
template <int K> struct SchedDense {
    static constexpr bool GATHER = false;
    const char* Bt; int G, c;
    __device__ __forceinline__ bool next(int i, GUnit& u) const {
        const int L = i * G + c; if (L >= 128 * 4) return false;
        int pm, pn; tile_order(L, 128, 4, pm, pn);
        u.pm = pm; u.pn = pn; u.e = 0; u.lrow0 = 0; u.B = Bt + (size_t)pn * 256 * K * 2; return true;
    }
    __device__ __forceinline__ unsigned arow(const GUnit& u, int r) const { return (unsigned)(u.pm * 256 + r); }
};
template <int NPN, bool GATHER_, int EB = 2> struct SchedMoe {
    static constexpr bool GATHER = GATHER_;
    const char* Bt; int G, c; const LAS int* tstart; const int* cnt; const int* slot_tok; const LAS int* tcnt;
    __device__ __forceinline__ bool next(int i, GUnit& u) const {
        const int L = i * G + c; const int TT = __builtin_amdgcn_readfirstlane(tstart[NE]);
        if (L >= TT * NPN) return false;
        const int rt = L / NPN, pn = L % NPN; int e = 0;
#pragma unroll
        for (int j = 1; j < NE; ++j) e += (tstart[j] <= rt) ? 1 : 0;
        e = __builtin_amdgcn_readfirstlane(e);
        u.pm = rt; u.pn = pn; u.e = e; u.lrow0 = __builtin_amdgcn_readfirstlane((rt - tstart[e]) * 256);
        u.B = Bt + ((size_t)e * (NPN * 256) + (size_t)pn * 256) * DE * EB; return true;
    }
    __device__ __forceinline__ unsigned arow(const GUnit& u, int r) const {
        if (GATHER) { const int lr = u.lrow0 + r; const int n = cnt[u.e]; const unsigned tok = (unsigned)slot_tok[u.e * T + (lr < T ? lr : T - 1)]; return (lr < n) ? tok : 0u; }
        return (unsigned)(u.pm * 256 + r);
    }
    __device__ __forceinline__ const int* tok_ptr(const GUnit& u, int tid) const { const int lr = u.lrow0 + (tid & 255); return slot_tok + u.e * T + (lr < T ? lr : T - 1); }
    __device__ __forceinline__ unsigned tok_row(const GUnit& u, int r, int tok) const { return (u.lrow0 + r < tcnt[u.e]) ? (unsigned)tok : 0u; }
};

struct EpiZ {
    static constexpr bool PERM = true, SIDE = true;
    bf16_t* Z; const float* bias;
    __device__ __forceinline__ const float* side_ptr(const GUnit& u, int tid) const { return bias + u.pn * 256 + (tid & 255); }
    __device__ __forceinline__ void operator()(const f32x4 (&acc)[2][2][4][2], const GUnit& u, int wr, int wc, int fr, int fq, LAS unsigned char* lds) const {
        const int row0 = u.pm * 256 + wr * 64 + fr, col0 = u.pn * 256 + wc * 32 + 8 * fq;
        const LAS float* sb = (const LAS float*)(lds + SIDE_OFF) + 256 + wc * 32 + 8 * fq;
        f32x4 bv[2][2];
#pragma unroll
        for (int bj = 0; bj < 2; ++bj)
#pragma unroll
            for (int n = 0; n < 2; ++n) bv[bj][n] = *(const LAS f32x4*)(sb + bj * 128 + 4 * n);
#pragma unroll
        for (int ai = 0; ai < 2; ++ai)
#pragma unroll
            for (int m = 0; m < 4; ++m) { bf16_t* rowp = Z + (size_t)(row0 + ai * 128 + m * 16) * ZP + col0;
#pragma unroll
                for (int bj = 0; bj < 2; ++bj) { const f32x4 v0 = acc[ai][bj][m][0] + bv[bj][0], v1 = acc[ai][bj][m][1] + bv[bj][1];
                    u32x4 w; w.x = cvt_pk_bf16(v0[0], v0[1]); w.y = cvt_pk_bf16(v0[2], v0[3]); w.z = cvt_pk_bf16(v1[0], v1[1]); w.w = cvt_pk_bf16(v1[2], v1[3]);
                    *(u32x4*)(rowp + bj * 128) = w; } }
    }
};
template <bool SECOND> struct EpiUp {
    static constexpr bool PERM = true, SIDE = false;
    bf16_t* O; const bf16_t* Z;
    __device__ __forceinline__ void operator()(const f32x4 (&acc)[2][2][4][2], const GUnit& u, int wr, int wc, int fr, int fq, LAS unsigned char*) const {
        const int row0 = u.pm * 256 + wr * 64 + fr, col0 = u.pn * 256 + wc * 32 + 8 * fq;
#pragma unroll
        for (int ai = 0; ai < 2; ++ai)
#pragma unroll
            for (int m = 0; m < 4; ++m) { const size_t row = (size_t)(row0 + ai * 128 + m * 16);
#pragma unroll
                for (int bj = 0; bj < 2; ++bj) {
                    const u32x4 g = *(const u32x4*)(Z + row * ZP + ZC_G + (SECOND ? 1024 : 0) + col0 + bj * 128);
                    const f32x4 a0 = acc[ai][bj][m][0], a1 = acc[ai][bj][m][1];
                    float o[8];
                    o[0] = sigmoidf_(lo16(g.x)) * a0[0]; o[1] = sigmoidf_(hi16(g.x)) * a0[1]; o[2] = sigmoidf_(lo16(g.y)) * a0[2]; o[3] = sigmoidf_(hi16(g.y)) * a0[3];
                    o[4] = sigmoidf_(lo16(g.z)) * a1[0]; o[5] = sigmoidf_(hi16(g.z)) * a1[1]; o[6] = sigmoidf_(lo16(g.w)) * a1[2]; o[7] = sigmoidf_(hi16(g.w)) * a1[3];
                    bf16_t* op = O + row * 1024 + col0 + bj * 128;
                    if (SECOND) { const u32x4 p = *(const u32x4*)op;
                        o[0] += lo16(p.x); o[1] += hi16(p.x); o[2] += lo16(p.y); o[3] += hi16(p.y); o[4] += lo16(p.z); o[5] += hi16(p.z); o[6] += lo16(p.w); o[7] += hi16(p.w); }
                    u32x4 w; w.x = cvt_pk_bf16(o[0], o[1]); w.y = cvt_pk_bf16(o[2], o[3]); w.z = cvt_pk_bf16(o[4], o[5]); w.w = cvt_pk_bf16(o[6], o[7]);
                    *(u32x4*)op = w; } }
    }
};
struct EpiMix {
    static constexpr bool PERM = true, SIDE = false;
    bf16_t* C;
    __device__ __forceinline__ void operator()(const f32x4 (&acc)[2][2][4][2], const GUnit& u, int wr, int wc, int fr, int fq, LAS unsigned char*) const {
        const int row0 = u.pm * 256 + wr * 64 + fr, col0 = u.pn * 256 + wc * 32 + 8 * fq;
#pragma unroll
        for (int ai = 0; ai < 2; ++ai)
#pragma unroll
            for (int m = 0; m < 4; ++m) { bf16_t* rowp = C + (size_t)(row0 + ai * 128 + m * 16) * 1024 + col0;
#pragma unroll
                for (int bj = 0; bj < 2; ++bj) { const f32x4 v0 = acc[ai][bj][m][0], v1 = acc[ai][bj][m][1];
                    u32x4 w; w.x = cvt_pk_bf16(v0[0], v0[1]); w.y = cvt_pk_bf16(v0[2], v0[3]); w.z = cvt_pk_bf16(v1[0], v1[1]); w.w = cvt_pk_bf16(v1[2], v1[3]);
                    *(u32x4*)(rowp + bj * 128) = w; } }
    }
};
__device__ __forceinline__ float swiglu1(float g, float up) {
    g = fminf(g, 7.0f); up = fminf(fmaxf(up, -7.0f), 7.0f);
    return (up + 1.0f) * (g * sigmoidf_(1.702f * g));
}
struct EpiMoe1 {
    static constexpr bool PERM = true, SIDE = true;
    bf16_t* H; const float* bgu;
    __device__ __forceinline__ const float* side_ptr(const GUnit& u, int tid) const { return bgu + (size_t)u.e * 2048 + u.pn * 256 + (tid & 255); }
    __device__ __forceinline__ void operator()(const f32x4 (&acc)[2][2][4][2], const GUnit& u, int wr, int wc, int fr, int fq, LAS unsigned char* lds) const {
        const int row0 = u.pm * 256 + wr * 64 + fr, col0 = u.pn * 256 + wc * 32 + 8 * fq;
        const LAS float* b = (const LAS float*)(lds + SIDE_OFF) + 256 + wc * 32 + 8 * fq;
        constexpr float sc = 1.0f / (F8_WSCALE * F8_ASCALE);
#pragma unroll
        for (int bj = 0; bj < 2; ++bj) {
            const f32x4 b0 = *(const LAS f32x4*)(b + bj * 128), b1 = *(const LAS f32x4*)(b + bj * 128 + 4);
#pragma unroll
            for (int ai = 0; ai < 2; ++ai)
#pragma unroll
                for (int m = 0; m < 4; ++m) {
                    const f32x4 v0 = acc[ai][bj][m][0] * sc + b0, v1 = acc[ai][bj][m][1] * sc + b1;
                    *(unsigned*)((unsigned char*)H + (size_t)(row0 + ai * 128 + m * 16) * 1024 + (col0 >> 1) + bj * 64) =
                        pk4_fp8(swiglu1(v0[0], v0[1]) * F8_HSCALE, swiglu1(v0[2], v0[3]) * F8_HSCALE, swiglu1(v1[0], v1[1]) * F8_HSCALE, swiglu1(v1[2], v1[3]) * F8_HSCALE);
                }
        }
    }
};
struct EpiMoe2 {
    static constexpr bool PERM = true, SIDE = true;
    unsigned char* Y; const float* bdn; const float* slot_gate; const LAS int* tcnt;
    __device__ __forceinline__ const float* side_ptr(const GUnit& u, int tid) const {
        const int lr = u.lrow0 + (tid & 255);
        return (tid < 256) ? slot_gate + (size_t)u.e * T + (lr < T ? lr : T - 1) : bdn + (size_t)u.e * 1024 + u.pn * 256 + (tid & 255);
    }
    __device__ __forceinline__ void operator()(const f32x4 (&acc)[2][2][4][2], const GUnit& u, int wr, int wc, int fr, int fq, LAS unsigned char* lds) const {
        const int r0 = wr * 64 + fr, col0 = u.pn * 256 + wc * 32 + 8 * fq;
        const LAS float* sd = (const LAS float*)(lds + SIDE_OFF);
        const LAS float* b = sd + 256 + wc * 32 + 8 * fq; const int n_e = tcnt[u.e];
        constexpr float sc = 1.0f / (F8_WSCALE * F8_HSCALE);
        f32x4 bv[2][2];
#pragma unroll
        for (int bj = 0; bj < 2; ++bj)
#pragma unroll
            for (int n = 0; n < 2; ++n) bv[bj][n] = *(const LAS f32x4*)(b + bj * 128 + 4 * n);
#pragma unroll
        for (int ai = 0; ai < 2; ++ai)
#pragma unroll
            for (int m = 0; m < 4; ++m) { const int r = r0 + ai * 128 + m * 16; const int lr = u.lrow0 + r;
                const float gt = ((lr < n_e) ? sd[r] : 0.0f) * F8_YSCALE;
                unsigned char* rowp = Y + (size_t)(u.pm * 256 + r) * 1024 + col0;
#pragma unroll
                for (int bj = 0; bj < 2; ++bj) { const f32x4 v0 = (acc[ai][bj][m][0] * sc + bv[bj][0]) * gt, v1 = (acc[ai][bj][m][1] * sc + bv[bj][1]) * gt;
                    u32x2 w; w.x = pk4_fp8(v0[0], v0[1], v0[2], v0[3]); w.y = pk4_fp8(v1[0], v1[1], v1[2], v1[3]);
                    *(u32x2*)(rowp + bj * 128) = w; } }
    }
};

__device__ __forceinline__ void p0_transpose_item(const float* W, int K, int N, bf16_t* WT, int row_off, LAS float* scr, int item, int lane) {
    const int nblk = N / 32, kb = item / nblk, nb = item % nblk, k0 = 64 * kb, n0 = 32 * nb;
#pragma unroll 32
    for (int i = 0; i < 32; ++i) { const int kk = 2 * i + (lane >> 5); scr[kk * 33 + (lane & 31)] = W[(size_t)(k0 + kk) * N + n0 + (lane & 31)]; }
    LDS_WAIT(); asm volatile("" ::: "memory");
    const int c = lane & 7;
#pragma unroll
    for (int j = 0; j < 4; ++j) { const int n = (lane >> 3) + 8 * j; const LAS float* s = scr + (8 * c) * 33 + n;
        u32x4 o; o.x = pk2(s[0 * 33], s[1 * 33]); o.y = pk2(s[2 * 33], s[3 * 33]); o.z = pk2(s[4 * 33], s[5 * 33]); o.w = pk2(s[6 * 33], s[7 * 33]);
        *(u32x4*)(WT + (size_t)(row_off + n0 + n) * K + k0 + 8 * c) = o; }
    LDS_WAIT(); asm volatile("" ::: "memory");
}
__device__ __forceinline__ void p0_prologue(const Args& a, LAS unsigned char* lds, int tid, int lane, int wave, int G) {
    unsigned char* ws = a.ws;
    {
        float* MOD = (float*)(ws + WS_CTL) + CW_MOD;
        LAS float* sl = (LAS float*)lds;
        LAS float* red = sl + 9 * 1024;
        if (blockIdx.x < 96) {
            for (int i = tid; i < 9 * 1024; i += 512) { const int r = i >> 10, k = i & 1023; const float v = (r < 8) ? a.in[I_C][r * D + k] : a.in[I_CCTX][k]; sl[i] = v * sigmoidf_(v); }
            __syncthreads();
            for (int it = blockIdx.x; it < 96; it += G) {
                const int n = it * 64 + lane; float acc[9];
#pragma unroll
                for (int r = 0; r < 9; ++r) acc[r] = 0.f;
                const float* w = a.in[I_WADA] + (size_t)(wave * 128) * 6144 + n;
#pragma unroll 8
                for (int kk = 0; kk < 128; ++kk) { const float wv = w[(size_t)kk * 6144];
#pragma unroll
                    for (int r = 0; r < 9; ++r) acc[r] += sl[r * 1024 + wave * 128 + kk] * wv; }
#pragma unroll
                for (int r = 0; r < 9; ++r) red[(wave * 9 + r) * 64 + lane] = acc[r];
                __syncthreads();
                for (int i = tid; i < 9 * 64; i += 512) { const int r = i >> 6, c = i & 63; float s = a.in[I_BADA][it * 64 + c];
#pragma unroll
                    for (int w8 = 0; w8 < 8; ++w8) s += red[(w8 * 9 + r) * 64 + c];
                    MOD[r * 6144 + it * 64 + c] = s; }
                __syncthreads();
            }
        }
        __syncthreads();
    }
    {
        float* misc = (float*)(ws + WS_MISC);
        const int gt = blockIdx.x * 512 + tid, NGT = G * 512;
        for (int n = gt; n < ZP; n += NGT) misc[n] = (n < 2688) ? a.in[I_BIN][n] : ((n < 2816) ? 0.f : a.in[I_BIN][n - 128]);
        for (int n = gt; n < 1024; n += NGT) { const int p = n >> 4, i = n & 15; const float inv = powf(10000.0f, -(float)i / 16.0f); float s, c; sincosf((float)p * inv, &s, &c); misc[ZP + n] = c; misc[ZP + 1024 + n] = s; }
        u32x4* zr = (u32x4*)((bf16_t*)(ws + WS_WIN) + (size_t)2688 * D);
        for (int n = gt; n < 128 * D / 8; n += NGT) zr[n] = (u32x4){0u, 0u, 0u, 0u};
    }
    {
        LAS float* scr = (LAS float*)(lds + wave * 8704);
        const int gw = blockIdx.x * 8 + wave, NGW = G * 8;
        constexpr int J_IN = 16 * (PROJ_SRC / 32), J_UP = 8 * 32, J_OUT = 16 * 32, J_L = 16, J_G2 = 32, J_GU1 = 16 * 64, J_DN1 = 16 * 32;
        constexpr int NITEMS = J_IN + 2 * J_UP + J_OUT + 4 * J_L + J_G2;
        bf16_t* lora = (bf16_t*)(ws + WS_LORA);
        for (int it = gw; it < NITEMS; it += NGW) {
            int r = it;
            if (r < J_IN) { const int nb = r % (PROJ_SRC / 32); p0_transpose_item(a.in[I_WIN], D, PROJ_SRC, (bf16_t*)(ws + WS_WIN), (nb * 32 >= 2688) ? 128 : 0, scr, r, lane); continue; } r -= J_IN;
            if (r < J_UP) { p0_transpose_item(a.in[I_WUPA], 512, D, (bf16_t*)(ws + WS_WUPA), 0, scr, r, lane); continue; } r -= J_UP;
            if (r < J_UP) { p0_transpose_item(a.in[I_WUPR], 512, D, (bf16_t*)(ws + WS_WUPR), 0, scr, r, lane); continue; } r -= J_UP;
            if (r < J_OUT) { p0_transpose_item(a.in[I_WOUT], D, D, (bf16_t*)(ws + WS_WOUT), 0, scr, r, lane); continue; } r -= J_OUT;
            if (r < J_L) { p0_transpose_item(a.in[I_W2F], 64, 512, lora, 0, scr, r, lane); continue; } r -= J_L;
            if (r < J_L) { p0_transpose_item(a.in[I_W2B], 64, 512, lora + 32768, 0, scr, r, lane); continue; } r -= J_L;
            if (r < J_L) { p0_transpose_item(a.in[I_A2F], 64, 512, lora + 2 * 32768, 0, scr, r, lane); continue; } r -= J_L;
            if (r < J_L) { p0_transpose_item(a.in[I_A2B], 64, 512, lora + 3 * 32768, 0, scr, r, lane); continue; } r -= J_L;
            p0_transpose_item(a.in[I_G2], 128, 512, lora + 4 * 32768, 0, scr, r, lane);
        }
    }
}

__device__ __forceinline__ void p0_transpose_item_f8(const float* W, int K, int N, unsigned char* WT, LAS float* scr, int item, int lane, float sc) {
    const int nblk = N / 32, kb = item / nblk, nb = item % nblk, k0 = 64 * kb, n0 = 32 * nb;
#pragma unroll 32
    for (int i = 0; i < 32; ++i) { const int kk = 2 * i + (lane >> 5); scr[kk * 33 + (lane & 31)] = W[(size_t)(k0 + kk) * N + n0 + (lane & 31)] * sc; }
    LDS_WAIT(); asm volatile("" ::: "memory");
    const int c = lane & 7;
#pragma unroll
    for (int j = 0; j < 4; ++j) { const int n = (lane >> 3) + 8 * j; const LAS float* s = scr + (8 * c) * 33 + n;
        u32x2 o; o.x = pk4_fp8(s[0 * 33], s[1 * 33], s[2 * 33], s[3 * 33]); o.y = pk4_fp8(s[4 * 33], s[5 * 33], s[6 * 33], s[7 * 33]);
        *(u32x2*)(WT + (size_t)(n0 + n) * K + k0 + 8 * c) = o; }
    LDS_WAIT(); asm volatile("" ::: "memory");
}
__device__ __forceinline__ int queue_pull(unsigned* q, LAS unsigned char* lds, int tid) {
    volatile LAS int* w = (volatile LAS int*)(lds + RING_BYTES + 256);
    __syncthreads();
    if (tid == 0) *w = (int)__hip_atomic_fetch_add(q, 1u, __ATOMIC_RELAXED, __HIP_MEMORY_SCOPE_AGENT);
    __syncthreads();
    return *w;
}
__device__ __forceinline__ void moe_weight_copies(const Args& a, LAS unsigned char* lds, int tid, int lane, int wave) {
    unsigned char* ws = a.ws;
    LAS float* scr = (LAS float*)(lds + wave * 8704);
    constexpr int J_GU1 = 16 * 64, J_DN1 = 16 * 32, NCHUNK = (NE * J_GU1 + NE * J_DN1) / 128;
    unsigned* q = (unsigned*)(ws + WS_CTL) + CW_QTR;
    for (;;) {
        const int ch = queue_pull(q, lds, tid);
        if (ch >= NCHUNK) break;
#pragma unroll 1
        for (int k = 0; k < 16; ++k) {
            int r = ch * 128 + wave * 16 + k;
            if (r < NE * J_GU1) { const int e = r / J_GU1; p0_transpose_item_f8(a.in[I_WGU] + (size_t)e * D * 2048, D, 2048, (unsigned char*)(ws + WS_WGU) + (size_t)e * 2048 * D, scr, r % J_GU1, lane, F8_WSCALE); }
            else { r -= NE * J_GU1; const int e = r / J_DN1; p0_transpose_item_f8(a.in[I_WDN] + (size_t)e * DE * D, DE, D, (unsigned char*)(ws + WS_WDN) + (size_t)e * D * DE, scr, r % J_DN1, lane, F8_WSCALE); }
        }
    }
}

__device__ __forceinline__ void p1_norm(const Args& a, int lane, int wave, int G) {
    const float* MOD = (const float*)(a.ws + WS_CTL) + CW_MOD;
    bf16_t* HX = (bf16_t*)(a.ws + WS_HX);
    const int gw = blockIdx.x * 8 + wave, NGW = G * 8;
    for (int m = gw; m < ROWS; m += NGW) {
        const float* xrow = (m < T) ? a.in[I_X] + (size_t)m * D : a.in[I_CTX] + (size_t)(m - T) * D;
        const int r = (m < T) ? (m >> 12) : 8;
        const f32x4* xr = (const f32x4*)xrow + lane;
        f32x4 v[4]; float s = 0.f;
#pragma unroll
        for (int j = 0; j < 4; ++j) { v[j] = xr[64 * j]; s += (v[j].x * v[j].x + v[j].y * v[j].y) + (v[j].z * v[j].z + v[j].w * v[j].w); }
        const float rstd = 1.0f / sqrtf(wave_sum(s) * (1.f / D) + RMS_EPS);
        unsigned long long* o8 = (unsigned long long*)(HX + (size_t)m * D) + lane;
#pragma unroll
        for (int j = 0; j < 4; ++j) {
            const f32x4 g = ((const f32x4*)a.in[I_GPREMIX])[64 * j + lane], sh = ((const f32x4*)(MOD + r * 6144))[64 * j + lane], sc = ((const f32x4*)(MOD + r * 6144 + 1024))[64 * j + lane];
            const f32x4 h = (v[j] * rstd * g) * (sc + 1.0f) + sh;
            o8[64 * j] = (unsigned long long)pk2(h.x, h.y) | ((unsigned long long)pk2(h.z, h.w) << 32);
        }
    }
}

constexpr size_t WS_ACT = WS_HX;
__device__ __forceinline__ void p3a_pointwise(const Args& a, int tid, int G) {
    unsigned char* ws = a.ws;
    const bf16_t* Z = (const bf16_t*)(ws + WS_Z);
    bf16_t* FB = (bf16_t*)(ws + WS_FEAT); bf16_t* ACT = (bf16_t*)(ws + WS_ACT);
    const float* rc = (const float*)(ws + WS_MISC) + ZP; const float* rs = rc + 1024;
    const int cv = tid % 240, rg = tid / 240;
    float mp[8], mn[8];
    if (tid < 480) {
#pragma unroll
        for (int j = 0; j < 8; ++j) { mp[j] = a.in[I_MUP][8 * cv + j]; mn[j] = a.in[I_MUN][8 * cv + j]; }
    }
    for (int unit = blockIdx.x; unit < ROWS / 16; unit += G) {
        const int row0 = unit * 16;
        const bool isx = row0 < T;
        const int slen = isx ? SEQ : CL;
        const int pos0 = isx ? (row0 & (SEQ - 1)) : ((row0 - T) & (CL - 1));
        if (tid < 480) {
            const int r0 = row0 + 8 * rg, p0 = pos0 + 8 * rg;
            const bf16_t* zp = Z + (size_t)r0 * ZP + ZC_R + 8 * cv;
            u32x4 prv = (u32x4){0u, 0u, 0u, 0u};
            if (p0 > 0) prv = *(const u32x4*)(zp - ZP);
            u32x4 cur = *(const u32x4*)zp;
#pragma unroll
            for (int i = 0; i < 8; ++i) {
                u32x4 nxt = (u32x4){0u, 0u, 0u, 0u};
                if (p0 + i < slen - 1) nxt = *(const u32x4*)(zp + (size_t)(i + 1) * ZP);
                float o[8];
#pragma unroll
                for (int j = 0; j < 4; ++j) {
                    const float c0 = lo16(cur[j]), c1 = hi16(cur[j]);
                    o[2 * j] = c0 + mp[2 * j] * (lo16(prv[j]) - c0) + mn[2 * j] * (lo16(nxt[j]) - c0);
                    o[2 * j + 1] = c1 + mp[2 * j + 1] * (hi16(prv[j]) - c1) + mn[2 * j + 1] * (hi16(nxt[j]) - c1);
                }
                bf16_t* op;
                if (cv < 64) op = FB + (size_t)F_R * (FEAT_STRIDE / 2) + (size_t)(r0 + i) * RD + 8 * cv;
                else if (cv < 128) op = FB + (size_t)F_A * (FEAT_STRIDE / 2) + (size_t)(r0 + i) * RD + 8 * (cv - 64);
                else if (cv < 192) op = FB + (size_t)F_V * (FEAT_STRIDE / 2) + (size_t)(r0 + i) * RD + 8 * (cv - 128);
                else {
                    op = ACT + (size_t)(r0 + i) * 384 + 8 * (cv - 192);
                    if (cv < 208) {
#pragma unroll
                        for (int j = 0; j < 8; ++j) o[j] = 1.0f - 2.0f * __builtin_amdgcn_rcpf(__expf(2.0f * o[j]) + 1.0f);
                    } else if (cv >= 224) {
#pragma unroll
                        for (int j = 0; j < 8; ++j) o[j] = sigmoidf_(o[j]);
                    }
                }
                u32x4 w; w.x = pk2(o[0], o[1]); w.y = pk2(o[2], o[3]); w.z = pk2(o[4], o[5]); w.w = pk2(o[6], o[7]);
                *(u32x4*)op = w;
                prv = cur; cur = nxt;
            }
        }
        {
            bf16_t* QR = (bf16_t*)(ws + WS_QR); bf16_t* KA = (bf16_t*)(ws + WS_KA); bf16_t* VT = (bf16_t*)(ws + WS_VT);
#pragma unroll 1
            for (int idx = tid; idx < 16 * 40; idx += 512) {
                const int tk = idx / 40, j = idx % 40; const int row = row0 + tk, pos = pos0 + tk;
                const int hh = j >> 2, part = (j >> 1) & 1, sub = j & 1;
                const bool isq = hh < 8;
                if (isq && !isx) continue;
                const int zc = isq ? (ZC_Q + hh * 64) : (ZC_K + (hh - 8) * 64);
                const bf16_t* zp = Z + (size_t)row * ZP + zc + part * 32 + sub * 8;
                const u32x4 t1 = *(const u32x4*)zp, t2 = *(const u32x4*)(zp + 16);
                float x1[8], x2[8], o1[8], o2[8];
#pragma unroll
                for (int q = 0; q < 4; ++q) { x1[2 * q] = lo16(t1[q]); x1[2 * q + 1] = hi16(t1[q]); x2[2 * q] = lo16(t2[q]); x2[2 * q + 1] = hi16(t2[q]); }
                if (isx) {
                    const int p = part ? (pos & 63) : (pos >> 6);
                    const float sc = isq ? (0.125f * 1.44269504089f) : 1.0f;
                    const f32x4 cA = *(const f32x4*)(rc + p * 16 + sub * 8), cB = *(const f32x4*)(rc + p * 16 + sub * 8 + 4), sA = *(const f32x4*)(rs + p * 16 + sub * 8), sB = *(const f32x4*)(rs + p * 16 + sub * 8 + 4);
#pragma unroll
                    for (int q = 0; q < 8; ++q) { const float c = q < 4 ? cA[q & 3] : cB[q & 3], s = q < 4 ? sA[q & 3] : sB[q & 3];
                        o1[q] = (x1[q] * c - x2[q] * s) * sc; o2[q] = (x2[q] * c + x1[q] * s) * sc; }
                } else {
#pragma unroll
                    for (int q = 0; q < 8; ++q) { o1[q] = x1[q]; o2[q] = x2[q]; }
                }
                u32x4 w1, w2;
#pragma unroll
                for (int q = 0; q < 4; ++q) { w1[q] = pk2(o1[2 * q], o1[2 * q + 1]); w2[q] = pk2(o2[2 * q], o2[2 * q + 1]); }
                bf16_t* op = isq ? (QR + (size_t)row * 512 + hh * 64 + part * 32 + sub * 8) : (KA + (size_t)row * 128 + (hh - 8) * 64 + part * 32 + sub * 8);
                *(u32x4*)op = w1; *(u32x4*)(op + 16) = w2;
            }
            if (tid < 256) {
                const int cidx = tid & 127, tg = tid >> 7; const int g = cidx >> 6, d = cidx & 63;
                unsigned short vv[8];
#pragma unroll
                for (int q = 0; q < 8; ++q) vv[q] = Z[(size_t)(row0 + 8 * tg + q) * ZP + ZC_V + cidx];
                u32x4 w; w.x = vv[0] | ((unsigned)vv[1] << 16); w.y = vv[2] | ((unsigned)vv[3] << 16); w.z = vv[4] | ((unsigned)vv[5] << 16); w.w = vv[6] | ((unsigned)vv[7] << 16);
                bf16_t* op;
                if (isx) { const int b = row0 >> 12; op = VT + ((size_t)(b * 2 + g) * 64 + d) * SEQ + pos0 + 8 * tg; }
                else { const int b = (row0 - T) >> 8; op = VT + (size_t)NB * 2 * 64 * SEQ + ((size_t)(b * 2 + g) * 64 + d) * CL + pos0 + 8 * tg; }
                *(u32x4*)op = w;
            }
        }
    }
}

__device__ __forceinline__ void p3b_features(const Args& a, LAS unsigned char* lds, int tid, int lane, int wave, int G) {
    unsigned char* ws = a.ws;
    const bf16_t* lora = (const bf16_t*)(ws + WS_LORA);
    const bf16_t* ACT = (const bf16_t*)(ws + WS_ACT);
    bf16_t* FB = (bf16_t*)(ws + WS_FEAT);
    const int h = blockIdx.x & 7;
    constexpr int P64 = 72, P128 = 136;
    LAS bf16_t* WL = (LAS bf16_t*)lds;
    LAS bf16_t* WG2 = WL + 4 * 64 * P64;
    __syncthreads();
    for (int i = tid; i < 4 * 64 * 8; i += 512) { const int m = i >> 9, r = (i >> 3) & 63, c = i & 7; const int ch = 16 * ((r >> 2) & 3) + 4 * (r >> 4) + (r & 3);
        *(LAS u32x4*)(WL + (m * 64 + r) * P64 + 8 * c) = *(const u32x4*)(lora + (size_t)m * 32768 + (size_t)(h * 64 + ch) * 64 + 8 * c); }
    for (int i = tid; i < 64 * 16; i += 512) { const int r = i >> 4, c = i & 15; const int ch = 16 * ((r >> 2) & 3) + 4 * (r >> 4) + (r & 3);
        *(LAS u32x4*)(WG2 + r * P128 + 8 * c) = *(const u32x4*)(lora + (size_t)4 * 32768 + (size_t)(h * 64 + ch) * 128 + 8 * c); }
    __syncthreads();
    const int tk = lane & 15, cg = lane >> 4;
    f32x4 w0f[4], w0b[4], a0f[4], a0b[4], kkw[4], kaw[4];
#pragma unroll
    for (int cs = 0; cs < 4; ++cs) { const int c = h * 64 + 16 * cg + 4 * cs;
        w0f[cs] = *(const f32x4*)(a.in[I_W0F] + c); w0b[cs] = *(const f32x4*)(a.in[I_W0B] + c); a0f[cs] = *(const f32x4*)(a.in[I_A0F] + c); a0b[cs] = *(const f32x4*)(a.in[I_A0B] + c);
        kkw[cs] = *(const f32x4*)(a.in[I_KK] + c); kaw[cs] = *(const f32x4*)(a.in[I_KA] + c); }
    for (int tt = blockIdx.x >> 3; tt < ROWS / 128; tt += (G >> 3)) {
        const int row = tt * 128 + 16 * wave + tk;
        bf16x8 bfr[12];
        const bf16_t* ap = ACT + (size_t)row * 384 + 8 * cg;
#pragma unroll
        for (int kb = 0; kb < 12; ++kb) bfr[kb] = *(const bf16x8*)(ap + 32 * kb);
        bf16_t* frow = FB + (size_t)row * RD + h * 64 + 16 * cg;
        u32x2 kraw[4];
#pragma unroll
        for (int cs = 0; cs < 4; ++cs) kraw[cs] = *(const u32x2*)(frow + (size_t)F_A * (FEAT_STRIDE / 2) + 4 * cs);
        auto store16 = [&](int arr, const f32x4 (&v)[4]) {
            u32x4 w0, w1;
            w0.x = cvt_pk_bf16_asm(v[0][0], v[0][1]); w0.y = cvt_pk_bf16_asm(v[0][2], v[0][3]); w0.z = cvt_pk_bf16_asm(v[1][0], v[1][1]); w0.w = cvt_pk_bf16_asm(v[1][2], v[1][3]);
            w1.x = cvt_pk_bf16_asm(v[2][0], v[2][1]); w1.y = cvt_pk_bf16_asm(v[2][2], v[2][3]); w1.z = cvt_pk_bf16_asm(v[3][0], v[3][1]); w1.w = cvt_pk_bf16_asm(v[3][2], v[3][3]);
            u32x4* p = (u32x4*)(frow + (size_t)arr * (FEAT_STRIDE / 2)); p[0] = w0; p[1] = w1;
        };
        auto lora_mm = [&](int m, int kb0, f32x4 (&acc)[4]) {
#pragma unroll
            for (int cs = 0; cs < 4; ++cs) acc[cs] = (f32x4){0.f, 0.f, 0.f, 0.f};
            const int nkb = (m == 4) ? 4 : 2;
#pragma unroll
            for (int kb = 0; kb < 4; ++kb) if (kb < nkb) {
#pragma unroll
                for (int cs = 0; cs < 4; ++cs) {
                    const bf16x8 afr = (m == 4) ? *(const LAS bf16x8*)(WG2 + (16 * cs + tk) * P128 + 32 * kb + 8 * cg) : *(const LAS bf16x8*)(WL + (m * 64 + 16 * cs + tk) * P64 + 32 * kb + 8 * cg);
                    acc[cs] = __builtin_amdgcn_mfma_f32_16x16x32_bf16(afr, bfr[kb0 + kb], acc[cs], 0, 0, 0);
                }
            }
        };
        f32x4 acc[4];
        lora_mm(0, 0, acc);
#pragma unroll
        for (int cs = 0; cs < 4; ++cs)
#pragma unroll
            for (int j = 0; j < 4; ++j) acc[cs][j] = SCAN_CHUNKED ? (-0.60653065971f * sigmoidf_(acc[cs][j] + w0f[cs][j])) : (__expf(-0.60653065971f * sigmoidf_(acc[cs][j] + w0f[cs][j])) - 1.0f);
        store16(F_WF, acc);
        lora_mm(1, 2, acc);
#pragma unroll
        for (int cs = 0; cs < 4; ++cs)
#pragma unroll
            for (int j = 0; j < 4; ++j) acc[cs][j] = SCAN_CHUNKED ? (-0.60653065971f * sigmoidf_(acc[cs][j] + w0b[cs][j])) : (__expf(-0.60653065971f * sigmoidf_(acc[cs][j] + w0b[cs][j])) - 1.0f);
        store16(F_WB, acc);
        lora_mm(4, 8, acc);
        asm volatile("s_nop 7\n\ts_nop 7" ::: "memory");
        store16(F_G, acc);
        f32x4 iclf[4], iclb[4];
        lora_mm(2, 4, iclf);
        lora_mm(3, 6, iclb);
#pragma unroll
        for (int cs = 0; cs < 4; ++cs)
#pragma unroll
            for (int j = 0; j < 4; ++j) { iclf[cs][j] = sigmoidf_(iclf[cs][j] + a0f[cs][j]); iclb[cs][j] = sigmoidf_(iclb[cs][j] + a0b[cs][j]); }
        f32x4 kv[4]; float nrm = 0.f;
#pragma unroll
        for (int cs = 0; cs < 4; ++cs) {
            kv[cs] = (f32x4){lo16(kraw[cs].x), hi16(kraw[cs].x), lo16(kraw[cs].y), hi16(kraw[cs].y)};
            const f32x4 kk = kv[cs] * kkw[cs];
            nrm += (kk[0] * kk[0] + kk[1] * kk[1]) + (kk[2] * kk[2] + kk[3] * kk[3]);
        }
        nrm += __shfl_xor(nrm, 16); nrm += __shfl_xor(nrm, 32);
        const float inv = 1.0f / fmaxf(sqrtf(nrm), 1e-12f);
        f32x4 oa[4], obf[4], obb[4], okf[4], okb[4];
#pragma unroll
        for (int cs = 0; cs < 4; ++cs) {
            const f32x4 kkn = kv[cs] * kkw[cs] * inv;
            oa[cs] = -kkn; obf[cs] = kkn * iclf[cs]; obb[cs] = kkn * iclb[cs];
            okf[cs] = kv[cs] * ((iclf[cs] - 1.0f) * kaw[cs] + 1.0f); okb[cs] = kv[cs] * ((iclb[cs] - 1.0f) * kaw[cs] + 1.0f);
        }
        store16(F_A, oa); store16(F_BF, obf); store16(F_BB, obb); store16(F_KF, okf); store16(F_KB, okb);
    }
}

__device__ __forceinline__ void p4_attention(const Args& a, LAS unsigned char* lds, int tid, int lane, int wave, int G) {
    unsigned char* ws = a.ws;
    const bf16_t* QR = (const bf16_t*)(ws + WS_QR); const bf16_t* KA = (const bf16_t*)(ws + WS_KA); const bf16_t* VT = (const bf16_t*)(ws + WS_VT);
    bf16_t* ATT = (bf16_t*)(ws + WS_ATT);
    constexpr int KP = 72;
    LAS bf16_t* Ks0 = (LAS bf16_t*)lds;
    const int qi = lane & 31, hf = lane >> 5;
    unsigned* qatt = (unsigned*)(ws + WS_CTL) + CW_QATT;
    for (int it = 0;; ++it) {
        int upull = 0; if ((it & 1) == 0) { upull = queue_pull(qatt, lds, tid); *(volatile LAS int*)(lds + RING_BYTES + 260) = upull; } else upull = *(volatile LAS int*)(lds + RING_BYTES + 260);
        const int unit = 2 * upull + (it & 1);
        if (unit >= NB * NKV * (SEQ / 64)) break;
        const int qb = unit & 63, g = (unit >> 6) & 1, b = unit >> 7;
        const int q0 = qb * 64;
        const int head = g * 4 + (wave >> 1), qloc = 32 * (wave & 1) + qi;
        const size_t qrow = (size_t)b * SEQ + q0 + qloc;
        bf16x8 qf[4];
#pragma unroll
        for (int s = 0; s < 4; ++s) qf[s] = *(const bf16x8*)(QR + qrow * 512 + head * 64 + 16 * s + 8 * hf);
        float m = a.in[I_SINKS][head] * 1.44269504089f, lsum = hf ? 0.f : 1.f;
        f32x16 O0, O1;
#pragma unroll
        for (int r = 0; r < 16; ++r) { O0[r] = 0.f; O1[r] = 0.f; }
        const int rr = tid >> 3, ch = tid & 7;
        auto tile_ok = [&](int kt) -> bool { const int kp = q0 - 128 + 64 * kt; return kt >= 5 || (kp >= 0 && kp < SEQ); };
        u32x4 kreg, vreg;
        auto fetch_tile = [&](int kt) {
            const int kp0 = q0 - 128 + 64 * kt;
            const bf16_t* kp = (kt < 5) ? KA + ((size_t)b * SEQ + kp0 + rr) * 128 + g * 64 + 8 * ch
                                        : KA + ((size_t)T + b * CL + 64 * (kt - 5) + rr) * 128 + g * 64 + 8 * ch;
            const bf16_t* vp = (kt < 5) ? VT + ((size_t)(b * 2 + g) * 64 + rr) * SEQ + kp0 + 8 * ch
                                        : VT + (size_t)NB * 2 * 64 * SEQ + ((size_t)(b * 2 + g) * 64 + rr) * CL + 64 * (kt - 5) + 8 * ch;
            kreg = *(const u32x4*)kp; vreg = *(const u32x4*)vp;
        };
        int kt = 0; while (!tile_ok(kt)) ++kt;
        fetch_tile(kt);
        int par = 0;
        __syncthreads();
        for (; kt < 9; ) {
            LAS bf16_t* Ks = Ks0 + par * (2 * 64 * KP); LAS bf16_t* Vs = Ks + 64 * KP;
            *(LAS u32x4*)(Ks + rr * KP + 8 * ch) = kreg; *(LAS u32x4*)(Vs + rr * KP + 8 * ch) = vreg;
            __syncthreads();
            int ktn = kt + 1; while (ktn < 9 && !tile_ok(ktn)) ++ktn;
            if (ktn < 9) fetch_tile(ktn);
            f32x16 X0, X1;
#pragma unroll
            for (int r = 0; r < 16; ++r) { X0[r] = 0.f; X1[r] = 0.f; }
#pragma unroll
            for (int s = 0; s < 4; ++s) {
                const bf16x8 k0 = *(const LAS bf16x8*)(Ks + qi * KP + 16 * s + 8 * hf), k1 = *(const LAS bf16x8*)(Ks + (32 + qi) * KP + 16 * s + 8 * hf);
                X0 = __builtin_amdgcn_mfma_f32_32x32x16_bf16(k0, qf[s], X0, 0, 0, 0);
                X1 = __builtin_amdgcn_mfma_f32_32x32x16_bf16(k1, qf[s], X1, 0, 0, 0);
            }
            if (kt == 0 || kt == 4) {
#pragma unroll
                for (int r = 0; r < 16; ++r) { const int k0i = (r & 3) + 8 * (r >> 2) + 4 * hf, k1i = 32 + k0i;
                    const bool v0 = (kt == 0) ? (k0i >= qloc) : (k0i <= qloc), v1 = (kt == 0) ? (k1i >= qloc) : (k1i <= qloc);
                    X0[r] = v0 ? X0[r] : -1e30f; X1[r] = v1 ? X1[r] : -1e30f; }
            }
            float mx0 = X0[0], mx1 = X1[0];
#pragma unroll
            for (int r = 1; r < 16; ++r) { mx0 = __builtin_fmaxf(mx0, X0[r]); mx1 = __builtin_fmaxf(mx1, X1[r]); }
            float mx = __builtin_fmaxf(mx0, mx1);
            mx = __builtin_fmaxf(mx, __shfl_xor(mx, 32));
            const float mn = __builtin_fmaxf(m, mx);
            if (__any(mn > m)) {
                const float alpha = __builtin_amdgcn_exp2f(m - mn);
                lsum *= alpha;
#pragma unroll
                for (int r = 0; r < 16; ++r) { O0[r] *= alpha; O1[r] *= alpha; }
                m = mn;
            }
            float ps0 = 0.f, ps1 = 0.f;
#pragma unroll
            for (int r = 0; r < 16; ++r) { X0[r] = __builtin_amdgcn_exp2f(X0[r] - m); X1[r] = __builtin_amdgcn_exp2f(X1[r] - m); ps0 += X0[r]; ps1 += X1[r]; }
            lsum += ps0 + ps1;
#pragma unroll
            for (int kg = 0; kg < 2; ++kg)
#pragma unroll
                for (int s2 = 0; s2 < 2; ++s2) {
                    bf16x8 pf;
#pragma unroll
                    for (int j = 0; j < 4; ++j) { const float p0 = kg ? X1[8 * s2 + 2 * j] : X0[8 * s2 + 2 * j], p1 = kg ? X1[8 * s2 + 2 * j + 1] : X0[8 * s2 + 2 * j + 1];
                        const unsigned w = cvt_pk_bf16(p0, p1); pf[2 * j] = (short)(w & 0xffff); pf[2 * j + 1] = (short)(w >> 16); }
                    const int kb = 32 * kg + 16 * s2 + 4 * hf;
#pragma unroll
                    for (int dg = 0; dg < 2; ++dg) {
                        const LAS bf16_t* vr = Vs + (32 * dg + qi) * KP + kb;
                        const s16x4 va = *(const LAS s16x4*)vr, vb = *(const LAS s16x4*)(vr + 8);
                        bf16x8 vf; vf[0] = va[0]; vf[1] = va[1]; vf[2] = va[2]; vf[3] = va[3]; vf[4] = vb[0]; vf[5] = vb[1]; vf[6] = vb[2]; vf[7] = vb[3];
                        if (dg == 0) O0 = __builtin_amdgcn_mfma_f32_32x32x16_bf16(vf, pf, O0, 0, 0, 0);
                        else O1 = __builtin_amdgcn_mfma_f32_32x32x16_bf16(vf, pf, O1, 0, 0, 0);
                    }
                }
            kt = ktn; par ^= 1;
        }
        const float ltot = lsum + __shfl_xor(lsum, 32);
        const float inv = 1.0f / ltot;
        bf16_t* op = ATT + qrow * 512 + head * 64;
#pragma unroll
        for (int dg = 0; dg < 2; ++dg)
#pragma unroll
            for (int rq = 0; rq < 4; ++rq) {
                const int d0 = 32 * dg + 8 * rq + 4 * hf;
                u32x2 w;
                if (dg == 0) { w.x = cvt_pk_bf16(O0[4 * rq] * inv, O0[4 * rq + 1] * inv); w.y = cvt_pk_bf16(O0[4 * rq + 2] * inv, O0[4 * rq + 3] * inv); }
                else { w.x = cvt_pk_bf16(O1[4 * rq] * inv, O1[4 * rq + 1] * inv); w.y = cvt_pk_bf16(O1[4 * rq + 2] * inv, O1[4 * rq + 3] * inv); }
                *(u32x2*)(op + d0) = w;
            }
    }
}

template <int CTRL> __device__ __forceinline__ float dpp_add(float x) {
    return x + __builtin_bit_cast(float, __builtin_amdgcn_update_dpp(0, __builtin_bit_cast(int, x), CTRL, 0xf, 0xf, false));
}
__device__ __forceinline__ float row16_sum(float x) { x = dpp_add<0x128>(x); x = dpp_add<0x124>(x); x = dpp_add<0x122>(x); x = dpp_add<0x121>(x); return x; }
template <int VAR> __device__ __forceinline__ void p4_scan(const Args& a, LAS unsigned char* lds, int tid, int lane, int wave, int G) {
    unsigned char* ws = a.ws;
    const bf16_t* FB = (const bf16_t*)(ws + WS_FEAT);
    constexpr int TS = 32, NBLK = (CL + SEQ) / TS;
    constexpr int OPF = TS * 5 * 64;
    LAS float* OPS = (LAS float*)lds;
    LAS float* VB = OPS + 2 * OPF;
    LAS float* YBUF = VB + 2 * TS * 32;
    const int rl = 4 * wave + (lane >> 4), cg = lane & 15;
    for (int unit = blockIdx.x; unit < NB * NH * 4; unit += G) {
        const int half = unit & 1, dir = (unit >> 1) & 1, h = (unit >> 2) & 7, b = unit >> 5;
        const size_t astr = FEAT_STRIDE / 2;
        const bf16_t* arrp[5] = { FB + (size_t)(dir ? F_WB : F_WF) * astr, FB + (size_t)F_A * astr, FB + (size_t)(dir ? F_BB : F_BF) * astr, FB + (size_t)(dir ? F_KB : F_KF) * astr, FB + (size_t)F_R * astr };
        const bf16_t* vp = FB + (size_t)F_V * astr;
        bf16_t* Y = (bf16_t*)(ws + (dir ? WS_YB : WS_YF));
        auto row_of = [&](int s) -> int { return (s < CL) ? (T + b * CL + (dir ? (CL - 1 - s) : s)) : (b * SEQ + (dir ? (SEQ - 1 - (s - CL)) : (s - CL))); };
        u32x2 pre[6];
        auto fetch = [&](int blk) {
#pragma unroll
            for (int it = 0; it < 6; ++it) { const int q = tid + 512 * it; pre[it] = (u32x2){0u, 0u};
                if (q < TS * 88) { const int st = q / 88, rem = q % 88; const int row = row_of(blk * TS + st);
                    if (rem < 80) { const int ar = rem >> 4, ci = rem & 15; const bf16_t* p = (ar == 0 ? arrp[0] : ar == 1 ? arrp[1] : ar == 2 ? arrp[2] : ar == 3 ? arrp[3] : arrp[4]);
                        pre[it] = *(const u32x2*)(p + (size_t)row * RD + h * 64 + 4 * ci); }
                    else { const int ci = rem - 80; pre[it] = *(const u32x2*)(vp + (size_t)row * RD + h * 64 + half * 32 + 4 * ci); } } }
        };
        auto commit = [&](int buf) {
#pragma unroll
            for (int it = 0; it < 6; ++it) { const int q = tid + 512 * it;
                if (q < TS * 88) { const int st = q / 88, rem = q % 88;
                    f32x4 v = (f32x4){lo16(pre[it].x), hi16(pre[it].x), lo16(pre[it].y), hi16(pre[it].y)};
                    if (SCAN_CHUNKED && rem < 16) { v[0] = __expf(v[0]) - 1.0f; v[1] = __expf(v[1]) - 1.0f; v[2] = __expf(v[2]) - 1.0f; v[3] = __expf(v[3]) - 1.0f; }
                    if (rem < 80) *(LAS f32x4*)(OPS + buf * OPF + st * 320 + rem * 4) = v;
                    else *(LAS f32x4*)(VB + buf * TS * 32 + st * 32 + (rem - 80) * 4) = v; } }
        };
        __syncthreads();
        fetch(0); commit(0);
        __syncthreads();
        f32x4 S = (f32x4){0.f, 0.f, 0.f, 0.f};
        for (int blk = 0; blk < NBLK; ++blk) {
            const int buf = blk & 1;
            if (blk + 1 < NBLK) fetch(blk + 1);
            const LAS float* ob = OPS + buf * OPF + 4 * cg; const LAS float* vb = VB + buf * TS * 32 + rl; LAS float* yb = YBUF + buf * TS * 32 + rl;
            float ykeep = 0.f;
            f32x4 qw[3], qa[3], qb[3], qk[3], qr[3]; float qv[3];
#define SCAN_LOAD(st_, sl_) do { qw[sl_] = *(const LAS f32x4*)(ob + (st_) * 320); qa[sl_] = *(const LAS f32x4*)(ob + (st_) * 320 + 64); qb[sl_] = *(const LAS f32x4*)(ob + (st_) * 320 + 128); \
                qk[sl_] = *(const LAS f32x4*)(ob + (st_) * 320 + 192); qr[sl_] = *(const LAS f32x4*)(ob + (st_) * 320 + 256); qv[sl_] = vb[(st_) * 32]; } while (0)
            SCAN_LOAD(0, 0); SCAN_LOAD(1, 1);
#pragma unroll
            for (int st = 0; st < TS; ++st) {
                if (st + 2 < TS && (VAR != 2 || st < 1)) SCAN_LOAD(st + 2, (st + 2) % 3);
                const f32x4 ow = qw[st % 3], av = DBG_NOA ? (f32x4){0.f, 0.f, 0.f, 0.f} : qa[st % 3], bv = DBG_NOB ? (f32x4){0.f, 0.f, 0.f, 0.f} : qb[st % 3], kv = qk[st % 3], rv = qr[st % 3]; const float vi = qv[st % 3];
                float sa = fmaf(S[3], av[3], fmaf(S[2], av[2], fmaf(S[1], av[1], S[0] * av[0])));
                const f32x4 S1 = S + S * ow + kv * vi;
                if (VAR != 1) sa = row16_sum(sa);
                S = S1 + bv * sa;
                float y = fmaf(S[3], rv[3], fmaf(S[2], rv[2], fmaf(S[1], rv[1], S[0] * rv[0])));
                if (VAR != 1) y = row16_sum(y);
                ykeep = (cg == (st & 15)) ? y : ykeep;
                if ((st & 15) == 15) yb[((st & ~15) + cg) * 32] = ykeep;
            }
#undef SCAN_LOAD
            if (blk + 1 < NBLK) commit(buf ^ 1);
            __syncthreads();
            if (blk >= CL / TS) {
                const int st = tid >> 4, pr = tid & 15;
                const int row = row_of(blk * TS + st);
                const float y0 = YBUF[buf * TS * 32 + st * 32 + 2 * pr], y1 = YBUF[buf * TS * 32 + st * 32 + 2 * pr + 1];
                *(unsigned*)(Y + (size_t)row * RD + h * 64 + half * 32 + 2 * pr) = pk2(y0, y1);
            }
        }
    }
}

constexpr int CS_SLOT = 16384, CS_AT = 0, CS_RT = 2304, CS_BH = 4608, CS_KH = 6912, CS_VV = 9216, CS_AAK = 11520, CS_TT = 12800, CS_ARK = 14080, CS_GC = 15360;
constexpr int CS_SCR = 4 * CS_SLOT, CS_SCR_BYTES = 6144, CS_BT = 0, CS_KT = 2304, CS_NN = 4608, CS_FLAGS = CS_SCR + 4 * CS_SCR_BYTES;
typedef short v4i16_t __attribute__((ext_vector_type(4)));
__device__ __forceinline__ bf16x8 pack8(f32x4 x, f32x4 y) {
    u32x4 w; w.x = cvt_pk_bf16(x[0], x[1]); w.y = cvt_pk_bf16(x[2], x[3]); w.z = cvt_pk_bf16(y[0], y[1]); w.w = cvt_pk_bf16(y[2], y[3]);
    return __builtin_bit_cast(bf16x8, w);
}
__device__ __forceinline__ bf16x8 join8(s16x4 x, s16x4 y) { bf16x8 r; r[0] = x[0]; r[1] = x[1]; r[2] = x[2]; r[3] = x[3]; r[4] = y[0]; r[5] = y[1]; r[6] = y[2]; r[7] = y[3]; return r; }
__device__ __forceinline__ s16x4 lds_tr4(const LAS unsigned char* p) { return __builtin_bit_cast(s16x4, __builtin_amdgcn_ds_read_tr16_b64_v4i16((LAS v4i16_t*)p)); }
template <int CTRL> __device__ __forceinline__ float dpp_shr_add(float x) {
    return x + __builtin_bit_cast(float, __builtin_amdgcn_update_dpp(0, __builtin_bit_cast(int, x), CTRL, 0xf, 0xf, true));
}
template <bool TEST> __device__ __forceinline__ void p4_scan_chunked(const Args& a, LAS unsigned char* lds, int tid, int lane, int wave, int G) {
    unsigned char* ws = a.ws;
    const bf16_t* FB = (const bf16_t*)(ws + WS_FEAT);
    const size_t astr = FEAT_STRIDE / 2;
    constexpr int NCH = (CL + SEQ) / 16;
    volatile LAS unsigned* flags = (volatile LAS unsigned*)(lds + CS_FLAGS);
    for (int unit = blockIdx.x; unit < NB * NH * 2; unit += G) {
        const int dir = unit & 1, h = (unit >> 1) & 7, b = unit >> 4;
        __syncthreads();
        for (int i = tid; i < (CS_FLAGS + 64) / 16; i += 512) *(LAS u32x4*)(lds + 16 * i) = (u32x4){0u, 0u, 0u, 0u};
        __syncthreads();
        auto row_of = [&](int s) -> int { return (s < CL) ? (T + b * CL + (dir ? (CL - 1 - s) : s)) : (b * SEQ + (dir ? (SEQ - 1 - (s - CL)) : (s - CL))); };
        if (wave < 4) {
            const int il = lane & 15, g = lane >> 4, ich = 16 * wave + il;
            bf16_t* Y = (bf16_t*)(ws + (dir ? WS_YB : WS_YF));
            f32x4 ST[4];
#pragma unroll
            for (int jt = 0; jt < 4; ++jt) ST[jt] = (f32x4){0.f, 0.f, 0.f, 0.f};
            const f32x4 zero4 = (f32x4){0.f, 0.f, 0.f, 0.f}; const s16x4 z16 = (s16x4){0, 0, 0, 0};
            const int troff = (4 * g + (il >> 2)) * 144 + 8 * (il & 3);
            for (int c = 0; c < NCH; ++c) {
                const int slot = c & 3; LAS unsigned char* sb = lds + slot * CS_SLOT;
                while (flags[slot] != (unsigned)(c + 1)) __builtin_amdgcn_s_sleep(1);
                __builtin_amdgcn_fence(__ATOMIC_ACQUIRE, "workgroup");
                const bf16x8 sf0 = pack8(ST[0], ST[1]), sf1 = pack8(ST[2], ST[3]);
                const LAS unsigned char* atp = sb + CS_AT + il * 144 + 8 * g;
                const bf16x8 a0 = join8(*(const LAS s16x4*)(atp), *(const LAS s16x4*)(atp + 32)), a1 = join8(*(const LAS s16x4*)(atp + 64), *(const LAS s16x4*)(atp + 96));
                const LAS unsigned char* rtp = sb + CS_RT + il * 144 + 8 * g;
                const bf16x8 r0 = join8(*(const LAS s16x4*)(rtp), *(const LAS s16x4*)(rtp + 32)), r1 = join8(*(const LAS s16x4*)(rtp + 64), *(const LAS s16x4*)(rtp + 96));
                const bf16x8 aak = *(const LAS bf16x8*)(sb + CS_AAK + il * 80 + 16 * g);
                const bf16x8 ttf = *(const LAS bf16x8*)(sb + CS_TT + il * 80 + 16 * g);
                const bf16x8 ark = *(const LAS bf16x8*)(sb + CS_ARK + il * 80 + 16 * g);
                const s16x4 vv = lds_tr4(sb + CS_VV + troff + 32 * wave);
                f32x4 zw1 = zero4, zyy = zero4, zuu = zero4; asm volatile("" : "+v"(zw1), "+v"(zyy), "+v"(zuu));
                f32x4 w1 = __builtin_amdgcn_mfma_f32_16x16x32_bf16(a0, sf0, zw1, 0, 0, 0);
                w1 = __builtin_amdgcn_mfma_f32_16x16x32_bf16(a1, sf1, w1, 0, 0, 0);
                w1 = __builtin_amdgcn_mfma_f32_16x16x32_bf16(aak, join8(vv, z16), w1, 0, 0, 0);
                f32x4 yy = __builtin_amdgcn_mfma_f32_16x16x32_bf16(r0, sf0, zyy, 0, 0, 0);
                yy = __builtin_amdgcn_mfma_f32_16x16x32_bf16(r1, sf1, yy, 0, 0, 0);
                const bf16x8 w1f = pack8(w1, zero4);
                const f32x4 uu = __builtin_amdgcn_mfma_f32_16x16x32_bf16(ttf, w1f, zuu, 0, 0, 0);
                bf16x8 uv; { u32x4 w; w.x = cvt_pk_bf16(uu[0], uu[1]); w.y = cvt_pk_bf16(uu[2], uu[3]); const u32x2 v2 = __builtin_bit_cast(u32x2, vv); w.z = v2.x; w.w = v2.y; uv = __builtin_bit_cast(bf16x8, w); }
#pragma unroll
                for (int jt = 0; jt < 4; ++jt) {
                    const f32x4 gc = *(const LAS f32x4*)(sb + CS_GC + (16 * jt + 4 * g) * 4);
                    const bf16x8 bk = join8(lds_tr4(sb + CS_BH + troff + 32 * jt), lds_tr4(sb + CS_KH + troff + 32 * jt));
                    ST[jt] = __builtin_amdgcn_mfma_f32_16x16x32_bf16(bk, uv, ST[jt] * gc, 0, 0, 0);
                }
                yy = __builtin_amdgcn_mfma_f32_16x16x32_bf16(ark, uv, yy, 0, 0, 0);
                asm volatile("s_waitcnt lgkmcnt(0)" ::: "memory");
                if (lane == 0) __hip_atomic_fetch_add((LAS unsigned*)(lds + CS_FLAGS) + 4 + slot, 1u, __ATOMIC_RELEASE, __HIP_MEMORY_SCOPE_WORKGROUP);
                if (c >= CL / 16) {
#pragma unroll
                    for (int rg = 0; rg < 4; ++rg) { const int row = row_of(16 * c + 4 * g + rg); Y[(size_t)row * RD + h * 64 + ich] = (bf16_t)f2bf(yy[rg]); }
                }
            }
        } else {
            const int p = wave - 4, jg = lane >> 4, t = lane & 15;
            LAS unsigned char* scr = lds + CS_SCR + p * CS_SCR_BYTES;
            u32x4 raw[6][2];
            auto load_raw = [&](int c) {
                const size_t ro = (size_t)row_of(16 * c + t) * RD + h * 64 + 16 * jg;
#pragma unroll
                for (int hf = 0; hf < 2; ++hf) {
                    raw[0][hf] = *(const u32x4*)(FB + (size_t)(dir ? F_WB : F_WF) * astr + ro + 8 * hf); raw[1][hf] = *(const u32x4*)(FB + (size_t)F_A * astr + ro + 8 * hf);
                    raw[2][hf] = *(const u32x4*)(FB + (size_t)(dir ? F_BB : F_BF) * astr + ro + 8 * hf); raw[3][hf] = *(const u32x4*)(FB + (size_t)(dir ? F_KB : F_KF) * astr + ro + 8 * hf);
                    raw[4][hf] = *(const u32x4*)(FB + (size_t)F_R * astr + ro + 8 * hf); raw[5][hf] = *(const u32x4*)(FB + (size_t)F_V * astr + ro + 8 * hf); }
            };
            load_raw(p);
            const int tn = lane & 15, gq = lane >> 4;
            for (int c = p; c < NCH; c += 4) {
                const int slot = c & 3; LAS unsigned char* sb = lds + slot * CS_SLOT;
                float cs[16], lwv[16];
#pragma unroll
                for (int q = 0; q < 8; ++q) { const unsigned w = raw[0][q >> 2][q & 3]; lwv[2 * q] = lo16(w); lwv[2 * q + 1] = hi16(w); }
#pragma unroll
                for (int q = 0; q < 16; ++q) { float x = lwv[q]; x = dpp_shr_add<0x111>(x); x = dpp_shr_add<0x112>(x); x = dpp_shr_add<0x114>(x); x = dpp_shr_add<0x118>(x); cs[q] = x; }
                float Gc[16], Gi[16], Gp[16], G15[16];
#pragma unroll
                for (int q = 0; q < 16; ++q) { Gc[q] = __expf(cs[q]); Gi[q] = __expf(-cs[q]); Gp[q] = __expf(cs[q] - lwv[q]); G15[q] = __shfl(Gc[q], (lane & 48) | 15); }
                while (flags[4 + slot] != (unsigned)(4 * (c >> 2))) __builtin_amdgcn_s_sleep(1);
                __builtin_amdgcn_fence(__ATOMIC_ACQUIRE, "workgroup");
                {
                    u32x4 wa[2], wr[2], wb[2], wk[2], wbh[2], wkh[2];
#pragma unroll
                    for (int q = 0; q < 8; ++q) {
                        const unsigned ua = raw[1][q >> 2][q & 3], ub = raw[2][q >> 2][q & 3], uk = raw[3][q >> 2][q & 3], ur = raw[4][q >> 2][q & 3];
                        const float a0 = lo16(ua) * Gp[2 * q], a1 = hi16(ua) * Gp[2 * q + 1], r0 = lo16(ur) * Gc[2 * q], r1 = hi16(ur) * Gc[2 * q + 1];
                        const float b0 = lo16(ub) * Gi[2 * q], b1 = hi16(ub) * Gi[2 * q + 1], k0 = lo16(uk) * Gi[2 * q], k1 = hi16(uk) * Gi[2 * q + 1];
                        wa[q >> 2][q & 3] = cvt_pk_bf16(a0, a1); wr[q >> 2][q & 3] = cvt_pk_bf16(r0, r1); wb[q >> 2][q & 3] = cvt_pk_bf16(b0, b1); wk[q >> 2][q & 3] = cvt_pk_bf16(k0, k1);
                        wbh[q >> 2][q & 3] = cvt_pk_bf16(b0 * G15[2 * q], b1 * G15[2 * q + 1]); wkh[q >> 2][q & 3] = cvt_pk_bf16(k0 * G15[2 * q], k1 * G15[2 * q + 1]);
                    }
                    const int ro = t * 144 + 32 * jg;
#pragma unroll
                    for (int hf = 0; hf < 2; ++hf) {
                        *(LAS u32x4*)(sb + CS_AT + ro + 16 * hf) = wa[hf]; *(LAS u32x4*)(sb + CS_RT + ro + 16 * hf) = wr[hf];
                        *(LAS u32x4*)(scr + CS_BT + ro + 16 * hf) = wb[hf]; *(LAS u32x4*)(scr + CS_KT + ro + 16 * hf) = wk[hf];
                        *(LAS u32x4*)(sb + CS_BH + ro + 16 * hf) = wbh[hf]; *(LAS u32x4*)(sb + CS_KH + ro + 16 * hf) = wkh[hf];
                        *(LAS u32x4*)(sb + CS_VV + ro + 16 * hf) = raw[5][hf];
                    }
                    if (t == 15) {
#pragma unroll
                        for (int q = 0; q < 4; ++q) *(LAS f32x4*)(sb + CS_GC + (16 * jg + 4 * q) * 4) = (f32x4){Gc[4 * q], Gc[4 * q + 1], Gc[4 * q + 2], Gc[4 * q + 3]};
                    }
                }
                if (c + 4 < NCH) load_raw(c + 4);
                asm volatile("s_waitcnt lgkmcnt(0)" ::: "memory");
                f32x4 m0 = (f32x4){0.f, 0.f, 0.f, 0.f}, m1 = m0, m3 = m0, m4 = m0;
                asm volatile("" : "+v"(m0), "+v"(m1), "+v"(m3), "+v"(m4));
#pragma unroll
                for (int ks = 0; ks < 2; ++ks) {
                    const bf16x8 xa = *(const LAS bf16x8*)(sb + CS_AT + tn * 144 + 64 * ks + 16 * gq), xr = *(const LAS bf16x8*)(sb + CS_RT + tn * 144 + 64 * ks + 16 * gq);
                    const bf16x8 yb = *(const LAS bf16x8*)(scr + CS_BT + tn * 144 + 64 * ks + 16 * gq), yk = *(const LAS bf16x8*)(scr + CS_KT + tn * 144 + 64 * ks + 16 * gq);
                    m0 = __builtin_amdgcn_mfma_f32_16x16x32_bf16(yb, xa, m0, 0, 0, 0);
                    m1 = __builtin_amdgcn_mfma_f32_16x16x32_bf16(yk, xa, m1, 0, 0, 0);
                    m3 = __builtin_amdgcn_mfma_f32_16x16x32_bf16(yb, xr, m3, 0, 0, 0);
                    m4 = __builtin_amdgcn_mfma_f32_16x16x32_bf16(yk, xr, m4, 0, 0, 0);
                }
                {
                    f32x4 n0, q1, q3, q4;
#pragma unroll
                    for (int rg = 0; rg < 4; ++rg) { const int s = 4 * gq + rg; const bool lt = s < tn, le = s <= tn;
                        n0[rg] = lt ? m0[rg] : 0.f; q1[rg] = lt ? m1[rg] : 0.f; q3[rg] = le ? m3[rg] : 0.f; q4[rg] = le ? m4[rg] : 0.f;
                        *(LAS float*)(scr + CS_NN + (s * 16 + tn) * 4) = n0[rg]; }
                    u32x2 w1; w1.x = cvt_pk_bf16(q1[0], q1[1]); w1.y = cvt_pk_bf16(q1[2], q1[3]);
                    *(LAS u32x2*)(sb + CS_AAK + tn * 80 + 16 * gq) = w1;
                    u32x4 w3; w3.x = cvt_pk_bf16(q3[0], q3[1]); w3.y = cvt_pk_bf16(q3[2], q3[3]); w3.z = cvt_pk_bf16(q4[0], q4[1]); w3.w = cvt_pk_bf16(q4[2], q4[3]);
                    *(LAS u32x4*)(sb + CS_ARK + tn * 80 + 16 * gq) = w3;
                }
                asm volatile("s_waitcnt lgkmcnt(0)" ::: "memory");
                float Tc[16];
#pragma unroll
                for (int s = 0; s < 16; ++s) Tc[s] = (s == tn) ? 1.0f : 0.0f;
                {
                    const LAS f32x4* NR = (const LAS f32x4*)(scr + CS_NN);
                    f32x4 cq[4], nq[4];
#pragma unroll
                    for (int k = 0; k < 4; ++k) { cq[k] = NR[4 * 14 + k]; nq[k] = cq[k]; }
#pragma unroll
                    for (int s = 14; s >= 0; --s) {
                        if (s > 0) {
#pragma unroll
                            for (int k = 0; k < 4; ++k) if (4 * k + 3 > s - 1) nq[k] = NR[4 * (s - 1) + k];
                        }
                        float acc0 = 0.f, acc1 = 0.f;
#pragma unroll
                        for (int q = s + 1; q < 16; ++q) { if (q & 1) acc1 += Tc[q] * cq[q >> 2][q & 3]; else acc0 += Tc[q] * cq[q >> 2][q & 3]; }
                        Tc[s] = (s < tn) ? (acc0 + acc1) : Tc[s];
#pragma unroll
                        for (int k = 0; k < 4; ++k) cq[k] = nq[k];
                    }
                }
                if (lane < 16) {
#pragma unroll
                    for (int g4 = 0; g4 < 4; ++g4) { u32x2 w; w.x = cvt_pk_bf16(Tc[4 * g4], Tc[4 * g4 + 1]); w.y = cvt_pk_bf16(Tc[4 * g4 + 2], Tc[4 * g4 + 3]); *(LAS u32x2*)(sb + CS_TT + tn * 80 + 16 * g4) = w; }
                }
                __builtin_amdgcn_fence(__ATOMIC_RELEASE, "workgroup");
                asm volatile("s_waitcnt lgkmcnt(0)" ::: "memory");
                if (lane == 0) flags[slot] = (unsigned)(c + 1);
            }
        }
    }
}

__device__ __forceinline__ void p5_rwkv_out(const Args& a, int lane, int wave, int G) {
    unsigned char* ws = a.ws;
    const bf16_t* FB = (const bf16_t*)(ws + WS_FEAT); const size_t astr = FEAT_STRIDE / 2;
    const bf16_t* YF = (const bf16_t*)(ws + WS_YF); const bf16_t* YBk = (const bf16_t*)(ws + WS_YB);
    bf16_t* RWK = (bf16_t*)(ws + WS_RWK);
    const int gw = blockIdx.x * 8 + wave, NGW = G * 8;
    const int c0 = 8 * lane;
    float lnw[8], lnb[8], rk[8];
#pragma unroll
    for (int j = 0; j < 8; ++j) { lnw[j] = a.in[I_LNW][c0 + j]; lnb[j] = a.in[I_LNB][c0 + j]; rk[j] = a.in[I_RK][c0 + j]; }
    auto ld8 = [&](const bf16_t* p, float (&o)[8]) { const u32x4 w = *(const u32x4*)p;
#pragma unroll
        for (int j = 0; j < 4; ++j) { o[2 * j] = lo16(w[j]); o[2 * j + 1] = hi16(w[j]); } };
    for (int m = gw; m < T; m += NGW) {
        const size_t o = (size_t)m * RD + c0;
        float yf[8], yb[8], r[8], kf[8], kb[8], v[8], g[8];
        ld8(YF + o, yf); ld8(YBk + o, yb); ld8(FB + F_R * astr + o, r); ld8(FB + F_KF * astr + o, kf); ld8(FB + F_KB * astr + o, kb); ld8(FB + F_V * astr + o, v); ld8(FB + F_G * astr + o, g);
        float s = 0.f, bs = 0.f;
#pragma unroll
        for (int j = 0; j < 8; ++j) { yf[j] += yb[j]; s += yf[j]; bs += r[j] * (kf[j] + kb[j]) * rk[j]; }
        s += __shfl_xor(s, 1); s += __shfl_xor(s, 2); s += __shfl_xor(s, 4);
        bs += __shfl_xor(bs, 1); bs += __shfl_xor(bs, 2); bs += __shfl_xor(bs, 4);
        const float mean = s * (1.f / 64.f); float q = 0.f;
#pragma unroll
        for (int j = 0; j < 8; ++j) { yf[j] -= mean; q += yf[j] * yf[j]; }
        q += __shfl_xor(q, 1); q += __shfl_xor(q, 2); q += __shfl_xor(q, 4);
        const float rstd = 1.0f / sqrtf(q * (1.f / 64.f) + GN_EPS);
        float out[8];
#pragma unroll
        for (int j = 0; j < 8; ++j) out[j] = (yf[j] * rstd * lnw[j] + lnb[j] + bs * v[j]) * g[j];
        u32x4 w; w.x = pk2(out[0], out[1]); w.y = pk2(out[2], out[3]); w.z = pk2(out[4], out[5]); w.w = pk2(out[6], out[7]);
        *(u32x4*)(RWK + o) = w;
    }
}

template <bool PROBE> __device__ __forceinline__ void p9_postmix_router(const Args& a, LAS unsigned char* lds, int tid, int lane, int wave, int G) {
    unsigned char* ws = a.ws;
    const float* MOD = (const float*)(ws + WS_CTL) + CW_MOD;
    const bf16_t* MIX = (const bf16_t*)(ws + WS_MIX);
    bf16_t* HF = (bf16_t*)(ws + (PROBE ? WS_H + 160 * MiB : WS_HF));
    int* cnt = (int*)(ws + WS_CTL) + (PROBE ? 12000 : CW_CNT);
    int* slot_tok = (int*)(ws + (PROBE ? WS_H + 240 * MiB : WS_SLOT_TOK)); float* slot_gate = (float*)(ws + (PROBE ? WS_H + 248 * MiB : WS_SLOT_GATE)); unsigned* tokk = (unsigned*)(ws + (PROBE ? WS_H + 256 * MiB : WS_TOKK));
    constexpr int HP = 1028;
    LAS float* HL = (LAS float*)lds;
    LAS float* PART = HL + 16 * HP;
    LAS int* SEL_E = (LAS int*)(lds + 90112); LAS float* SEL_G = (LAS float*)(lds + 90112 + 2048); LAS int* SEL_M = (LAS int*)(lds + 90112 + 4096);
    LAS int* HIST = (LAS int*)(lds + 90112 + 6144); LAS int* BASE = HIST + 32;
    int nsel = 0;
    const int ti = lane & 15, kq = lane >> 4;
    float wb0[32], wb1[32];
    {
        const float* wr = a.in[I_WROUTER];
#pragma unroll
        for (int ks = 0; ks < 32; ++ks) { const int k = 128 * wave + 4 * ks + kq; wb0[ks] = wr[k * NE + ti]; wb1[ks] = wr[k * NE + 16 + ti]; }
    }
    const float brt = a.in[I_BROUTER][lane & 31];
    for (int unit = blockIdx.x; unit < T / 16; unit += G) {
        const int tok0 = unit * 16;
        __syncthreads();
        {
            const int m0 = tok0 + 2 * wave; const int b = m0 >> 12;
            f32x4 v[2][4]; float s[2] = {0.f, 0.f};
#pragma unroll
            for (int tt = 0; tt < 2; ++tt) { const u32x2* mr = (const u32x2*)(MIX + (size_t)(m0 + tt) * D) + lane;
#pragma unroll
                for (int j = 0; j < 4; ++j) { const u32x2 w = mr[64 * j]; v[tt][j] = (f32x4){lo16(w.x), hi16(w.x), lo16(w.y), hi16(w.y)}; s[tt] += (v[tt][j].x * v[tt][j].x + v[tt][j].y * v[tt][j].y) + (v[tt][j].z * v[tt][j].z + v[tt][j].w * v[tt][j].w); } }
            f32x4 xv[2][4];
#pragma unroll
            for (int tt = 0; tt < 2; ++tt) { const f32x4* xr = (const f32x4*)(a.in[I_X] + (size_t)(m0 + tt) * D) + lane;
#pragma unroll
                for (int j = 0; j < 4; ++j) xv[tt][j] = xr[64 * j]; }
#pragma unroll
            for (int o = 1; o < 64; o <<= 1) { s[0] += __shfl_xor(s[0], o); s[1] += __shfl_xor(s[1], o); }
            float s2[2] = {0.f, 0.f};
#pragma unroll
            for (int j = 0; j < 4; ++j) {
                const f32x4 g = ((const f32x4*)a.in[I_GPOSTMIX])[64 * j + lane], gt = ((const f32x4*)(MOD + b * 6144 + 2048))[64 * j + lane];
#pragma unroll
                for (int tt = 0; tt < 2; ++tt) {
                    const float rstd = __builtin_amdgcn_rsqf(s[tt] * (1.f / D) + RMS_EPS);
                    v[tt][j] = xv[tt][j] + gt * (v[tt][j] * rstd * g);
                    ((f32x4*)((PROBE ? (float*)(ws + WS_H) : a.out) + (size_t)(m0 + tt) * D))[64 * j + lane] = v[tt][j];
                    s2[tt] += (v[tt][j].x * v[tt][j].x + v[tt][j].y * v[tt][j].y) + (v[tt][j].z * v[tt][j].z + v[tt][j].w * v[tt][j].w);
                }
            }
#pragma unroll
            for (int o = 1; o < 64; o <<= 1) { s2[0] += __shfl_xor(s2[0], o); s2[1] += __shfl_xor(s2[1], o); }
#pragma unroll
            for (int j = 0; j < 4; ++j) {
                const f32x4 g = ((const f32x4*)a.in[I_GPREFFN])[64 * j + lane], sh = ((const f32x4*)(MOD + b * 6144 + 3072))[64 * j + lane], sc = ((const f32x4*)(MOD + b * 6144 + 4096))[64 * j + lane];
#pragma unroll
                for (int tt = 0; tt < 2; ++tt) {
                    const float rstd2 = __builtin_amdgcn_rsqf(s2[tt] * (1.f / D) + RMS_EPS);
                    const f32x4 hv = (v[tt][j] * rstd2 * g) * (sc + 1.0f) + sh;
                    ((unsigned*)((unsigned char*)HF + (size_t)(m0 + tt) * D))[64 * j + lane] = pk4_fp8(hv.x * F8_ASCALE, hv.y * F8_ASCALE, hv.z * F8_ASCALE, hv.w * F8_ASCALE);
                    *(LAS f32x4*)(HL + (2 * wave + tt) * HP + 256 * j + 4 * lane) = hv;
                }
            }
        }
        __syncthreads();
        {
            f32x4 acc0 = (f32x4){0.f, 0.f, 0.f, 0.f}, acc1 = acc0;
#pragma unroll
            for (int ks = 0; ks < 32; ++ks) {
                const float av = HL[ti * HP + 128 * wave + 4 * ks + kq];
                acc0 = __builtin_amdgcn_mfma_f32_16x16x4f32(av, wb0[ks], acc0, 0, 0, 0);
                acc1 = __builtin_amdgcn_mfma_f32_16x16x4f32(av, wb1[ks], acc1, 0, 0, 0);
            }
#pragma unroll
            for (int r = 0; r < 4; ++r) { PART[(wave * 16 + 4 * kq + r) * 32 + ti] = acc0[r]; PART[(wave * 16 + 4 * kq + r) * 32 + 16 + ti] = acc1[r]; }
        }
        __syncthreads();
        {
            const int tl = 2 * wave + (lane >> 5); const int m = tok0 + tl;
            const int e = lane & 31;
            float lg = brt;
#pragma unroll
            for (int w = 0; w < 8; ++w) lg += PART[(w * 16 + tl) * 32 + e];
            float tv[4]; int ti4[4];
#pragma unroll
            for (int k = 0; k < 4; ++k) {
                float bv = lg; int bi = e;
#pragma unroll
                for (int o = 1; o < 32; o <<= 1) { const float ov = __shfl_xor(bv, o); const int oi = __shfl_xor(bi, o); if (ov > bv || (ov == bv && oi < bi)) { bv = ov; bi = oi; } }
                tv[k] = bv; ti4[k] = bi;
                if (e == bi) lg = -3.0e38f;
            }
            const float e1 = __expf(tv[1] - tv[0]), e2 = __expf(tv[2] - tv[0]), e3 = __expf(tv[3] - tv[0]);
            const float inv = 1.0f / (1.0f + e1 + e2 + e3);
            if (e < 4) {
                const int ek = e == 0 ? ti4[0] : e == 1 ? ti4[1] : e == 2 ? ti4[2] : ti4[3];
                const float gk = (e == 0 ? 1.0f : e == 1 ? e1 : e == 2 ? e2 : e3) * inv;
                const int si = nsel * 64 + tl * 4 + e;
                SEL_E[si] = ek; SEL_G[si] = gk; SEL_M[si] = m;
            }
        }
        ++nsel;
    }
    __syncthreads();
    if (tid < 32) HIST[tid] = 0;
    __syncthreads();
    int my_e = 0, my_lr = 0; const bool have = tid < nsel * 64;
    if (have) { my_e = SEL_E[tid]; my_lr = __hip_atomic_fetch_add(HIST + my_e, 1, __ATOMIC_RELAXED, __HIP_MEMORY_SCOPE_WORKGROUP); }
    __syncthreads();
    if (tid < 32) { const int n = HIST[tid]; BASE[tid] = n ? atomicAdd(cnt + tid, n) : 0; }
    __syncthreads();
    if (have) { const int rank = BASE[my_e] + my_lr; const int m = SEL_M[tid];
        slot_tok[my_e * T + rank] = m; slot_gate[(size_t)my_e * T + rank] = SEL_G[tid];
        tokk[m * 4 + (tid & 3)] = ((unsigned)my_e << 20) | (unsigned)rank; }
}

__device__ __forceinline__ void moe_table(const Args& a, LAS int* tstart, int tid) {
    const int* cnt = (const int*)(a.ws + WS_CTL) + CW_CNT;
    __syncthreads();
    if (tid < 32) {
        const int n = __hip_atomic_load(cnt + tid, __ATOMIC_RELAXED, __HIP_MEMORY_SCOPE_AGENT); const int tl = (n + 255) >> 8;
        int incl = tl;
#pragma unroll
        for (int o = 1; o < 32; o <<= 1) { const int v = __shfl_up(incl, o, 32); if (tid >= o) incl += v; }
        tstart[tid] = incl - tl; tstart[TCNT_OFF / 4 - RING_BYTES / 4 + tid] = n; if (tid == 31) tstart[NE] = incl;
    }
    __syncthreads();
}

__device__ __forceinline__ void p12_combine(const Args& a, LAS int* tstart, int lane, int wave, int G) {
    unsigned char* ws = a.ws;
    const float* MOD = (const float*)(ws + WS_CTL) + CW_MOD;
    const unsigned char* YB = (const unsigned char*)(ws + WS_YBUF); const unsigned* tokk = (const unsigned*)(ws + WS_TOKK);
    const int gw = blockIdx.x * 8 + wave, NGW = G * 8;
    for (int m = gw; m < T; m += NGW) {
        const int b = m >> 12;
        const u32x4 tk4 = *(const u32x4*)(tokk + m * 4);
        unsigned yw[4][4];
#pragma unroll
        for (int k = 0; k < 4; ++k) {
            const unsigned tk = tk4[k]; const int e = (int)(tk >> 20), rank = (int)(tk & 0xfffffu);
            const unsigned* yr = (const unsigned*)(YB + ((size_t)tstart[e] * 256 + rank) * D) + lane;
#pragma unroll
            for (int j = 0; j < 4; ++j) yw[k][j] = yr[64 * j];
        }
        f32x4 xr[4];
#pragma unroll
        for (int j = 0; j < 4; ++j) xr[j] = ((const f32x4*)(a.out + (size_t)m * D))[64 * j + lane];
        f32x4 y[4]; float s = 0.f;
#pragma unroll
        for (int j = 0; j < 4; ++j) { y[j] = (f32x4){0.f, 0.f, 0.f, 0.f};
#pragma unroll
            for (int k = 0; k < 4; ++k) { const f32x2_t lo = __builtin_amdgcn_cvt_pk_f32_fp8((int)yw[k][j], false), hi = __builtin_amdgcn_cvt_pk_f32_fp8((int)yw[k][j], true); y[j] += (f32x4){lo.x, lo.y, hi.x, hi.y}; }
            s += (y[j][0] * y[j][0] + y[j][1] * y[j][1]) + (y[j][2] * y[j][2] + y[j][3] * y[j][3]); }
        const float rstd = __builtin_amdgcn_rsqf(wave_sum(s) * (1.f / D) + RMS_EPS * F8_YSCALE * F8_YSCALE);
#pragma unroll
        for (int j = 0; j < 4; ++j) {
            const f32x4 g = ((const f32x4*)a.in[I_GPOSTFFN])[64 * j + lane], gt = ((const f32x4*)(MOD + b * 6144 + 5120))[64 * j + lane];
            ((f32x4*)(a.out + (size_t)m * D))[64 * j + lane] = xr[j] + gt * (y[j] * rstd * g);
        }
    }
}

constexpr int N_PHASES = 13;
__global__ void __launch_bounds__(512, 2) mega_fwd(Args args) {
    extern __shared__ __attribute__((aligned(16))) unsigned char lds_raw[];
    LAS unsigned char* lds = (LAS unsigned char*)lds_raw;
    const int tid = threadIdx.x, lane = tid & 63, wave = __builtin_amdgcn_readfirstlane(tid >> 6);
    const int G = gridDim.x;
    volatile LAS unsigned* MISC = (volatile LAS unsigned*)(lds + MISC_OFF);
    LAS int* tstart = (LAS int*)(lds + RING_BYTES);
    for (int u = tid; u < (LDS_BYTES - RING_BYTES) / 4; u += 512) ((LAS unsigned*)(lds + RING_BYTES))[u] = 0u;
    __syncthreads();
    unsigned char* ws = args.ws;
    const int lo = args.ph_lo, hi = args.ph_hi;
    unsigned* barw = (unsigned*)(ws + WS_CTL) + (args.bar_region ? (131072 + (args.bar_region - 1) * 4096) : CW_BAR);
    XcdBarrier bar; bar.bar = barw; bar.x = 0; bar.st = nullptr;
    if (hi - lo > 1) bar = xcd_barrier_post(barw, MISC + 8);
#ifndef PH_MASK
#define PH_MASK 0x1FFF
#endif
#define IN(k) (((PH_MASK >> (k)) & 1) && lo <= (k) && (k) < hi)
#define SEAM(k) do { if (IN(k) && IN((k) + 1)) xcd_barrier(bar); } while (0)

    if (IN(0)) { p0_prologue(args, lds, tid, lane, wave, G); SEAM(0); }
    if (IN(1)) { p1_norm(args, lane, wave, G); SEAM(1); }
    if (IN(2)) {
        SchedProj S{(const char*)(ws + WS_WIN), G, (int)blockIdx.x};
        EpiZ E{(bf16_t*)(ws + WS_Z), (const float*)(ws + WS_MISC)};
        pg8::gemm_phase<1024, EpiZ, SchedProj>(lds, (const char*)(ws + WS_HX), S, E);
        SEAM(2);
    }
    if (IN(3)) { p3a_pointwise(args, tid, G); if (IN(4)) xcd_barrier(bar); p3b_features(args, lds, tid, lane, wave, G); SEAM(3); }
    if (IN(5)) { if (SCAN_CHUNKED && !SCAN_FORCE_DIRECT) p4_scan_chunked<false>(args, lds, tid, lane, wave, G); else p4_scan<0>(args, lds, tid, lane, wave, G);
        p4_attention(args, lds, tid, lane, wave, G);
        moe_weight_copies(args, lds, tid, lane, wave);
        SEAM(5); }
#if DBG_SCAN
    if (IN(6) && blockIdx.x == 0) {
        const bf16_t* Yt = (const bf16_t*)(ws + (DBG_DIR ? WS_YB : WS_YF)); const bf16_t* Y2 = (const bf16_t*)(ws + 272 * MiB);
        LAS float* red = (LAS float*)lds; float* dbg = (float*)(ws + WS_CTL) + 12288;
        int first = -1; float worst = 0.f;
        for (int ci = 0; ci < 256; ++ci) {
            float e2 = 0.f, r2 = 0.f;
            for (int i = tid; i < 16 * 512; i += 512) { const int cc = DBG_DIR ? (255 - ci) : ci; const size_t o = (size_t)(cc * 16) * 512 + i; const float yt = bf2f(Yt[o]), y2 = bf2f(Y2[o]); e2 += (yt - y2) * (yt - y2); r2 += yt * yt; }
            e2 = wave_sum(e2); r2 = wave_sum(r2);
            __syncthreads(); if (lane == 0) { red[wave] = e2; red[8 + wave] = r2; } __syncthreads();
            float E = 0.f, R = 0.f; for (int w8 = 0; w8 < 8; ++w8) { E += red[w8]; R += red[8 + w8]; }
            const float rel = sqrtf(E / fmaxf(R, 1e-20f));
            if (first < 0 && !(rel < 0.03f)) first = ci;
            if (ci == DBG_CHUNK) { worst = rel;
                if (DBG_MODE == 2) { float z = 0.f; for (int i = tid; i < 16 * 512; i += 512) { const int cc = DBG_DIR ? (255 - ci) : ci; z += ((Y2[(size_t)(cc * 16) * 512 + i] & 0x7fff) > 0x7f80) ? 1.f : 0.f; }
                    z = wave_sum(z); __syncthreads(); if (lane == 0) red[16 + wave] = z; __syncthreads(); float Z = 0.f; for (int w8 = 0; w8 < 8; ++w8) Z += red[16 + w8]; worst = Z / 8192.f; } }
        }
        if (tid == 0) dbg[0] = DBG_MODE ? worst : ((first < 0) ? 0.f : (float)(first + 1) / 256.f);
    }
#endif
    if (IN(6)) {
        p5_rwkv_out(args, lane, wave, G);
        SchedDense<512> S{(const char*)(ws + WS_WUPA), G, (int)blockIdx.x};
        EpiUp<false> E{(bf16_t*)(ws + WS_MERGED), (const bf16_t*)(ws + WS_Z)};
        pg8::gemm_phase<512, EpiUp<false>, SchedDense<512>>(lds, (const char*)(ws + WS_ATT), S, E);
        SEAM(6);
    }
    if (IN(7)) {
        SchedDense<512> S{(const char*)(ws + WS_WUPR), G, (int)blockIdx.x};
        EpiUp<true> E{(bf16_t*)(ws + WS_MERGED), (const bf16_t*)(ws + WS_Z)};
        pg8::gemm_phase<512, EpiUp<true>, SchedDense<512>>(lds, (const char*)(ws + WS_RWK), S, E);
        SEAM(7);
    }
    if (IN(8)) {
        SchedDense<1024> S{(const char*)(ws + WS_WOUT), G, (int)blockIdx.x};
        EpiMix E{(bf16_t*)(ws + WS_MIX)};
        pg8::gemm_phase<1024, EpiMix, SchedDense<1024>>(lds, (const char*)(ws + WS_MERGED), S, E);
        SEAM(8);
    }
    if (IN(9)) { p9_postmix_router<false>(args, lds, tid, lane, wave, G); SEAM(9); }
    if (IN(10)) {
        moe_table(args, tstart, tid);
        SchedMoe<8, true, 1> S{(const char*)(ws + WS_WGU), G, (int)blockIdx.x, tstart, (const int*)(ws + WS_CTL) + CW_CNT, (const int*)(ws + WS_SLOT_TOK), (const LAS int*)(lds + TCNT_OFF)};
        EpiMoe1 E{(bf16_t*)(ws + WS_H), args.in[I_BGU]};
        pg8::gemm_phase<1024, EpiMoe1, SchedMoe<8, true, 1>, true>(lds, (const char*)(ws + WS_HF), S, E);
        SEAM(10);
    }
    if (IN(11)) {
        moe_table(args, tstart, tid);
        SchedMoe<4, false, 1> S{(const char*)(ws + WS_WDN), G, (int)blockIdx.x, tstart, (const int*)(ws + WS_CTL) + CW_CNT, (const int*)(ws + WS_SLOT_TOK), (const LAS int*)(lds + TCNT_OFF)};
        EpiMoe2 E{(unsigned char*)(ws + WS_YBUF), args.in[I_BDN], (const float*)(ws + WS_SLOT_GATE), (const LAS int*)(lds + TCNT_OFF)};
        pg8::gemm_phase<1024, EpiMoe2, SchedMoe<4, false, 1>, true>(lds, (const char*)(ws + WS_H), S, E);
        SEAM(11);
    }
    if (IN(12)) { moe_table(args, tstart, tid); p12_combine(args, tstart, lane, wave, G); }
#ifdef PROBE_PHASE
    if (lo == 15 && blockIdx.x == 0 && tid < 32) { unsigned* ctl = (unsigned*)(ws + WS_CTL); if (tid == 0) { ctl[CW_QATT] = 0u; ctl[CW_QTR] = PROBE_QTR0; } ctl[CW_CNT + tid] = 0u; }
    if (lo == 16) p9_postmix_router<true>(args, lds, tid, lane, wave, G);
    if (lo == 18) p4_attention(args, lds, tid, lane, wave, G);
    if (lo == 13) p3a_pointwise(args, tid, G);
    if (lo == 14) p3b_features(args, lds, tid, lane, wave, G);
#endif
#undef IN
#undef SEAM
}

extern "C" void kernel_launch(void* const* d_in, const int* in_sizes, int n_in, void* d_out, int out_size, void* d_ws, size_t ws_size, hipStream_t stream) {
    static int grid = 0;
    if (grid == 0) {
        if (n_in != 38 || out_size != T * D || ws_size < WS_END) { fprintf(stderr, "kernel_launch: unexpected problem shape (n_in %d, out %d, ws %zu)\n", n_in, out_size, ws_size); grid = -1; return; }
        int dev = 0, cus = 0, per_cu = 0;
        if (hipGetDevice(&dev) != hipSuccess || hipDeviceGetAttribute(&cus, hipDeviceAttributeMultiprocessorCount, dev) != hipSuccess) { grid = -1; return; }
        if (hipFuncSetAttribute((const void*)mega_fwd, hipFuncAttributeMaxDynamicSharedMemorySize, LDS_BYTES) != hipSuccess) { fprintf(stderr, "kernel_launch: hipFuncSetAttribute failed\n"); grid = -1; return; }
        if (hipOccupancyMaxActiveBlocksPerMultiprocessor(&per_cu, (const void*)mega_fwd, 512, LDS_BYTES) != hipSuccess || per_cu < 1) fprintf(stderr, "kernel_launch: occupancy query says %d\n", per_cu);
        (void)hipGetLastError();
        grid = cus;
    }
    if (grid < 0) return;
    (void)hipMemsetAsync((char*)d_ws + WS_CTL, 0, CTL_BYTES, stream);
    Args a{};
    for (int i = 0; i < 38; ++i) a.in[i] = (const float*)d_in[i];
    a.out = (float*)d_out; a.ws = (unsigned char*)d_ws;
#if MK_ONE_LAUNCH
    a.ph_lo = 0; a.ph_hi = N_PHASES;
    hipLaunchKernelGGL(mega_fwd, dim3(grid), dim3(512), LDS_BYTES, stream, a);
#ifdef PROBE_PHASE
#ifdef PROBE_PRE
    { a.ph_lo = PROBE_PRE; a.ph_hi = PROBE_PRE + 1; hipLaunchKernelGGL(mega_fwd, dim3(grid), dim3(512), LDS_BYTES, stream, a); }
#endif
    for (int rep = 0; rep < PROBE_REPS; ++rep) { a.ph_lo = PROBE_PHASE; a.ph_hi = PROBE_HI; a.bar_region = 1 + rep; hipLaunchKernelGGL(mega_fwd, dim3(grid), dim3(512), LDS_BYTES, stream, a); }
#endif
#else
    for (int p = 0; p < N_PHASES; ++p) { a.ph_lo = p; a.ph_hi = p + 1; hipLaunchKernelGGL(mega_fwd, dim3(grid), dim3(512), LDS_BYTES, stream, a); }
#endif
}
```

```cpp
#include <hip/hip_runtime.h>
#include <cstdio>
#include <cstdint>

#ifndef MK_ONE_LAUNCH
#define MK_ONE_LAUNCH 1
#endif
#ifndef PROBE_QTR0
#define PROBE_QTR0 0u
#endif
#ifndef PROBE_HI
#define PROBE_HI (PROBE_PHASE + 1)
#endif
#ifndef SCAN_CHUNKED
#define SCAN_CHUNKED 1
#endif
#ifndef SCAN_FORCE_DIRECT
#define SCAN_FORCE_DIRECT 0
#endif
#ifndef DBG_SCAN
#define DBG_SCAN 0
#define DBG_DIR 0
#define DBG_MODE 0
#define DBG_CHUNK 0
#endif
#ifndef DBG_NOA
#define DBG_NOA 0
#define DBG_NOB 0
#endif
#ifndef DBG_D
#define DBG_D 0
#endif
#ifndef DBG_TI
#define DBG_TI 0
#endif
#ifndef CS_LOCKSTEP
#define CS_LOCKSTEP 0
#endif

#define GAS __attribute__((address_space(1)))
#define LAS __attribute__((address_space(3)))
typedef unsigned short bf16_t;
typedef short bf16x8 __attribute__((ext_vector_type(8)));
typedef short s16x4 __attribute__((ext_vector_type(4)));
typedef float f32x4 __attribute__((ext_vector_type(4)));
typedef float f32x16 __attribute__((ext_vector_type(16)));
typedef unsigned u32x4 __attribute__((ext_vector_type(4)));
typedef unsigned u32x2 __attribute__((ext_vector_type(2)));

constexpr int NB = 8, SEQ = 4096, T = NB * SEQ, D = 1024, CL = 256, TC = NB * CL, ROWS = T + TC;
constexpr int NH = 8, HD = 64, NKV = 2, RD = 512;
constexpr int NE = 32, TOPK = 4, DE = 1024;
constexpr int PROJ_SRC = 4736;
constexpr int ZP = 4864;
constexpr int ZC_Q = 0, ZC_K = 512, ZC_V = 640, ZC_R = 768, ZC_RK = 1280, ZC_RV = 1792, ZC_LORA = 2304, ZC_G = 2816;
constexpr int NTILE_N = ZP / 256;
constexpr float RMS_EPS = 1e-6f, GN_EPS = 64e-5f;
constexpr float F8_WSCALE = 32.0f, F8_ASCALE = 4.0f, F8_HSCALE = 8.0f, F8_YSCALE = 32.0f;

constexpr size_t MiB = 1u << 20;
constexpr size_t WS_CTL = 0, CTL_BYTES = 1 * MiB;
constexpr size_t WS_WIN = 1 * MiB;
constexpr size_t WS_WUPA = 11 * MiB, WS_WUPR = 12 * MiB;
constexpr size_t WS_WOUT = 13 * MiB;
constexpr size_t WS_LORA = 15 * MiB;
constexpr size_t WS_MISC = 15 * MiB + 512 * 1024;
constexpr size_t WS_WGU = 16 * MiB;
constexpr size_t WS_WDN = 144 * MiB;
constexpr size_t WS_HX = 208 * MiB;
constexpr size_t WS_YF = 208 * MiB, WS_YB = 240 * MiB;
constexpr size_t WS_HF = 208 * MiB;
constexpr size_t WS_Z = 276 * MiB;
constexpr size_t WS_SLOT_TOK = 272 * MiB;
constexpr size_t WS_FEAT = 599 * MiB;
constexpr size_t FEAT_STRIDE = 34 * MiB;
constexpr size_t WS_MERGED = 769 * MiB;
constexpr size_t WS_MIX = 599 * MiB;
constexpr size_t WS_QR = 939 * MiB;
constexpr size_t WS_RWK = 939 * MiB;
constexpr size_t WS_KA = 971 * MiB;
constexpr size_t WS_VT = 980 * MiB;
constexpr size_t WS_ATT = 990 * MiB;
constexpr size_t WS_SLOT_GATE = 276 * MiB;
constexpr size_t WS_TOKK = 280 * MiB;
constexpr size_t WS_H = 281 * MiB;
constexpr int MAXTILES = 544, MAXSLOT = MAXTILES * 256;
constexpr size_t WS_YBUF = 417 * MiB;
constexpr size_t WS_END = 1024 * MiB;
static_assert(WS_YBUF + (size_t)MAXSLOT * 1024 <= WS_MIX, "ws map");
static_assert(WS_H + (size_t)MAXSLOT * 1024 <= WS_YBUF, "ws map");
static_assert(WS_Z + (size_t)ROWS * ZP * 2 <= WS_FEAT, "ws map");
static_assert(WS_FEAT + 10 * FEAT_STRIDE <= WS_QR, "ws map");
static_assert(WS_ATT + (size_t)T * 512 * 2 <= WS_END, "ws map");
static_assert(WS_VT + 9 * MiB <= WS_ATT && WS_KA + (size_t)ROWS * 128 * 2 <= WS_VT, "ws map");
enum { F_R = 0, F_V, F_A, F_KF, F_KB, F_BF, F_BB, F_WF, F_WB, F_G };
constexpr int CW_BAR = 4096;
constexpr int CW_CNT = 8192;
constexpr int CW_QATT = 8320, CW_QTR = 8384;
constexpr int CW_MOD = 16384;
static_assert((CW_MOD + 9 * 6144) * 4 <= (int)CTL_BYTES, "ctl");

constexpr int RING_BYTES = 131072;
constexpr int MISC_OFF = RING_BYTES + 320;
constexpr int LDS_BYTES = 147456;
constexpr int TCNT_OFF = RING_BYTES + 384;
constexpr int NOFF_OFF = RING_BYTES + 2048;
constexpr int TOK_OFF = RING_BYTES + 10240;
constexpr int SIDE_OFF = RING_BYTES + 12288;
static_assert(SIDE_OFF + 4096 <= LDS_BYTES, "lds map");

#define LDS_WAIT() asm volatile("s_waitcnt lgkmcnt(0)" ::: "memory")
#define VM_WAIT() asm volatile("s_waitcnt vmcnt(0)" ::: "memory")
__device__ __forceinline__ float bf2f(unsigned b) { return __uint_as_float(b << 16); }
__device__ __forceinline__ unsigned f2bf(float f) { unsigned u = __float_as_uint(f); return (u + 0x7fffu + ((u >> 16) & 1u)) >> 16; }
__device__ __forceinline__ unsigned pk2(float lo, float hi) { return f2bf(lo) | (f2bf(hi) << 16); }
__device__ __forceinline__ float lo16(unsigned w) { return __uint_as_float(w << 16); }
__device__ __forceinline__ float hi16(unsigned w) { return __uint_as_float(w & 0xffff0000u); }
__device__ __forceinline__ float sigmoidf_(float x) { return __builtin_amdgcn_rcpf(1.0f + __expf(-x)); }
__device__ __forceinline__ float wave_sum(float v) {
#pragma unroll
    for (int o = 1; o < 64; o <<= 1) v += __shfl_xor(v, o);
    return v;
}

#define XB_TMO      128
#define XB_XCNT(j)  (256  + 64 * (j))
#define XB_XSUB(j)  (1280 + 64 * (j))
#define XB_XGEN(j)  (2304 + 64 * (j))
#define XB_TOP      3328
#define XB_TOPGEN   3392
#define XCD_BAR_WORDS 3456
#define XB_SPIN_CAP (1u << 22)
__device__ __forceinline__ unsigned xb_ld(unsigned* p)              { return __hip_atomic_load(p, __ATOMIC_RELAXED, __HIP_MEMORY_SCOPE_AGENT); }
__device__ __forceinline__ unsigned xb_add(unsigned* p, unsigned v) { return __hip_atomic_fetch_add(p, v, __ATOMIC_RELAXED, __HIP_MEMORY_SCOPE_AGENT); }
__device__ __forceinline__ unsigned xb_xcc_id() { return (unsigned)__builtin_amdgcn_s_getreg((3 << 11) | 20) & 0xFu; }
#define XB_SPIN(cond, bar) do { unsigned _sp = 0; while (cond) { __builtin_amdgcn_s_sleep(1); \
    if ((++_sp & 255u) == 0u) { if (xb_ld(&(bar)[XB_TMO])) break; if (_sp > XB_SPIN_CAP) { atomicAdd(&(bar)[XB_TMO], 1u); break; } } } } while (0)
struct XcdBarrier { unsigned* bar; unsigned x; volatile LAS unsigned* st; };
__device__ __forceinline__ XcdBarrier xcd_barrier_post(unsigned* bar, volatile LAS unsigned* st) {
    XcdBarrier b; b.bar = bar; b.x = xb_xcc_id(); b.st = st;
    if (threadIdx.x == 0) (void)xb_add(&bar[XB_XCNT(b.x)], 1u);
    return b;
}
__device__ __forceinline__ void xcd_barrier_complete(unsigned* bar, unsigned x, unsigned& nloc, unsigned& nx) {
    const unsigned G = gridDim.x * gridDim.y * gridDim.z;
    unsigned sum, cnt, mine, sp = 0u;
    for (;;) {
        sum = 0u; cnt = 0u; mine = 0u;
#pragma unroll
        for (unsigned j = 0; j < 16; ++j) { const unsigned c = xb_ld(&bar[XB_XCNT(j)]); sum += c; cnt += (c > 0u) ? 1u : 0u; mine = (j == x) ? c : mine; }
        if (sum == G) break;
        __builtin_amdgcn_s_sleep(1);
        if ((++sp & 255u) == 0u) { if (xb_ld(&bar[XB_TMO])) break; if (sp > XB_SPIN_CAP) { atomicAdd(&bar[XB_TMO], 1u); break; } }
    }
    nloc = mine > 0u ? mine : 1u; nx = cnt > 0u ? cnt : 1u;
}
__device__ __forceinline__ void xcd_barrier(const XcdBarrier& b) {
    asm volatile("s_waitcnt vmcnt(0)" ::: "memory");
    __syncthreads();
    if (threadIdx.x == 0) {
        unsigned* bar = b.bar;
        __builtin_amdgcn_s_waitcnt(0);
        unsigned nloc = b.st[0], nx = b.st[1];
        if (nloc == 0u) { xcd_barrier_complete(bar, b.x, nloc, nx); b.st[0] = nloc; b.st[1] = nx; }
        const unsigned old = xb_add(&bar[XB_XSUB(b.x)], 1u);
        const unsigned gen = old / nloc;
        if (old + 1u == (gen + 1u) * nloc) {
            __builtin_amdgcn_fence(__ATOMIC_RELEASE, "agent");
            asm volatile("s_waitcnt vmcnt(0)" ::: "memory");
            const unsigned og = xb_add(&bar[XB_TOP], 1u);
            const unsigned tg = og / nx;
            if (og + 1u == (tg + 1u) * nx) xb_add(&bar[XB_TOPGEN], 1u);
            else XB_SPIN(xb_ld(&bar[XB_TOPGEN]) == tg, bar);
            __builtin_amdgcn_fence(__ATOMIC_ACQUIRE, "agent");
            xb_add(&bar[XB_XGEN(b.x)], 1u);
            asm volatile("s_waitcnt vmcnt(0)" ::: "memory");
        } else {
            XB_SPIN(xb_ld(&bar[XB_XGEN(b.x)]) == gen, bar);
            __builtin_amdgcn_fence(__ATOMIC_ACQUIRE, "agent");
            asm volatile("s_waitcnt vmcnt(0)" ::: "memory");
        }
    }
    __syncthreads();
}

namespace pg8 {
constexpr int BM = 256, BK = 64, HALF = 128, HTB = HALF * BK * 2, STAGE_BYTES = 8 * HTB;
__host__ __device__ __forceinline__ int lds_byte(int r, int c) { const int st = (r >> 4) * 2 + (c >> 5), rr = r & 15, cc = c & 31, ob = rr * 64 + cc * 2; return st * 1024 + (ob ^ (((ob >> 9) & 1) << 5)); }
__host__ __device__ __forceinline__ void stage_rc(int b, int& R, int& C) { const int st = b / 1024, sb = b % 1024, swz = sb ^ (((sb >> 9) & 1) << 5); R = (st >> 1) * 16 + swz / 64; C = (st & 1) * 32 + (swz % 64) / 2; }
__host__ __device__ __forceinline__ int perm32(int rho) { const int n = rho >> 4, i = rho & 15; return 8 * (i >> 2) + 4 * n + (i & 3); }

struct GUnit { const char* B; int pm, pn, e, lrow0; };

typedef int i32x8 __attribute__((ext_vector_type(8)));
template <int K, class Epi, class Sched, bool F8 = false>
__device__ __forceinline__ void gemm_phase(LAS unsigned char* lds, const char* Aroot, const Sched& S, const Epi& E) {
    const int tid = threadIdx.x, wid = __builtin_amdgcn_readfirstlane(tid >> 6), lane = tid & 63, wr = wid >> 2, wc = wid & 3, fr = lane & 15, fq = lane >> 4;
    constexpr int EB = F8 ? 1 : 2;
    constexpr int nt = K * EB / (BK * 2);
    static_assert(!Sched::GATHER || nt >= 6, "gather offsets are computed in the second K iteration");
    int Rr[2], Cc[2]; unsigned voffB[2];
#pragma unroll
    for (int i = 0; i < 2; ++i) { int R, C; stage_rc(tid * 16 + i * 8192, R, C); const int Rb = Epi::PERM ? ((R & ~31) + perm32(R & 31)) : R;
        Rr[i] = R; Cc[i] = C; voffB[i] = (unsigned)(Rb * K * EB + C * 2); }
    constexpr size_t kstep = (size_t)(BK * 2);
    constexpr size_t hstep = (size_t)HALF * K * EB;
    const unsigned ldsw = (unsigned)wid * 1024u;
    const int aoff = lds_byte(wr * 64 + fr, fq * 8), boff = lds_byte(wc * 32 + fr, fq * 8);
#define PG8_SA(b, h) (((b) * 2 + (h)) * HTB)
#define PG8_SB(b, h) ((4 + (b) * 2 + (h)) * HTB)
#define PG8_STAGEB(bufoff, gbase) do { _Pragma("unroll") for (int _i = 0; _i < 2; ++_i) \
        __builtin_amdgcn_global_load_lds((const unsigned*)((const char*)(gbase) + voffB[_i]), (LAS unsigned*)(lds + (bufoff) + ldsw + _i * 8192), 16, 0, 0); } while (0)
#define PG8_STAGEA(bufoff, base, o0, o1, kb) do { unsigned _o0 = (o0), _o1 = (o1); asm volatile("" : "+v"(_o0), "+v"(_o1));     \
        const char* _gb = (base) + (size_t)(kb); \
        __builtin_amdgcn_global_load_lds((const unsigned*)(_gb + _o0), (LAS unsigned*)(lds + (bufoff) + ldsw), 16, 0, 0); \
        __builtin_amdgcn_global_load_lds((const unsigned*)(_gb + _o1), (LAS unsigned*)(lds + (bufoff) + ldsw + 8192), 16, 0, 0); } while (0)
#define PG8_LD8(dst, off) do { const u32x4 _p0 = *(const LAS u32x4*)(lds + (off)), _p1 = *(const LAS u32x4*)(lds + (off) + 1024); dst = (i32x8){(int)_p0.x, (int)_p0.y, (int)_p0.z, (int)_p0.w, (int)_p1.x, (int)_p1.y, (int)_p1.z, (int)_p1.w}; } while (0)
#define PG8_LDA(dst, b, h) do { if constexpr (F8) { _Pragma("unroll") for (int m = 0; m < 4; ++m) PG8_LD8(dst##8[m], PG8_SA(b, h) + aoff + m * 2048); } \
        else { _Pragma("unroll") for (int m = 0; m < 4; ++m) _Pragma("unroll") for (int k = 0; k < 2; ++k) dst[m][k] = *(const LAS bf16x8*)(lds + PG8_SA(b, h) + aoff + m * 2048 + k * 1024); } } while (0)
#define PG8_LDB(dst, b, h) do { if constexpr (F8) { _Pragma("unroll") for (int n = 0; n < 2; ++n) PG8_LD8(dst##8[n], PG8_SB(b, h) + boff + n * 2048); } \
        else { _Pragma("unroll") for (int n = 0; n < 2; ++n) _Pragma("unroll") for (int k = 0; k < 2; ++k) dst[n][k] = *(const LAS bf16x8*)(lds + PG8_SB(b, h) + boff + n * 2048 + k * 1024); } } while (0)
#define PG8_MMA(ai, bj, At, Bt) do { __builtin_amdgcn_s_setprio(1); _Pragma("unroll") for (int m = 0; m < 4; ++m) _Pragma("unroll") for (int n = 0; n < 2; ++n) { \
        if constexpr (F8) asm volatile("v_mfma_scale_f32_16x16x128_f8f6f4 %0, %1, %2, %0, %3, %3 op_sel_hi:[0,0,0]" : "+v"(acc[ai][bj][m][n]) : "v"(Bt##8[n]), "v"(At##8[m]), "v"(f8scale)); \
        else { _Pragma("unroll") for (int k = 0; k < 2; ++k) acc[ai][bj][m][n] = __builtin_amdgcn_mfma_f32_16x16x32_bf16(Bt[n][k], At[m][k], acc[ai][bj][m][n], 0, 0, 0); } } \
        __builtin_amdgcn_s_setprio(0); } while (0)
#define PG8_WAIT_V(n) asm volatile("s_waitcnt vmcnt(" #n ")" ::: "memory")
#define PG8_WAIT_L(n) asm volatile("s_waitcnt lgkmcnt(" #n ")" ::: "memory")
#define PG8_BAR __builtin_amdgcn_s_barrier()
#define PG8_SCHED __builtin_amdgcn_sched_barrier(0)
    GUnit cur, nxt; int ui = 0;
    if (!S.next(0, cur)) return;
    f32x4 acc[2][2][4][2];
#pragma unroll
    for (int a = 0; a < 2; ++a)
#pragma unroll
        for (int b = 0; b < 2; ++b)
#pragma unroll
            for (int m = 0; m < 4; ++m)
#pragma unroll
                for (int n = 0; n < 2; ++n) acc[a][b][m][n] = (f32x4){0.f, 0.f, 0.f, 0.f};
    bf16x8 At[4][2], B0[2][2], B1[2][2];
    const int f8scale = 0x7f7f7f7f;
    i32x8 At8[4], B08[2], B18[2];
    unsigned c00, c01, c10, c11;
    const char* cA = Aroot;
    if constexpr (Sched::GATHER) {
        c00 = S.arow(cur, Rr[0]) * (unsigned)(K * EB) + (unsigned)Cc[0] * 2u; c01 = S.arow(cur, Rr[1]) * (unsigned)(K * EB) + (unsigned)Cc[1] * 2u;
        c10 = S.arow(cur, HALF + Rr[0]) * (unsigned)(K * EB) + (unsigned)Cc[0] * 2u; c11 = S.arow(cur, HALF + Rr[1]) * (unsigned)(K * EB) + (unsigned)Cc[1] * 2u;
    } else {
        c00 = (unsigned)(Rr[0] * K * EB + Cc[0] * 2); c01 = (unsigned)(Rr[1] * K * EB + Cc[1] * 2); c10 = c00 + (unsigned)(HALF * K * EB); c11 = c01 + (unsigned)(HALF * K * EB);
        cA = Aroot + (size_t)S.arow(cur, 0) * (size_t)(K * EB);
    }
    const char* cB = cur.B;
    PG8_STAGEB(PG8_SB(0, 0), cB); PG8_STAGEA(PG8_SA(0, 0), cA, c00, c01, 0); PG8_STAGEB(PG8_SB(0, 1), cB + hstep); PG8_STAGEA(PG8_SA(0, 1), cA, c10, c11, 0);
    if (wr == 1) PG8_BAR;
    PG8_WAIT_V(4); PG8_BAR;
    PG8_STAGEB(PG8_SB(1, 0), cB + kstep); PG8_STAGEA(PG8_SA(1, 0), cA, c00, c01, kstep); PG8_STAGEB(PG8_SB(1, 1), cB + hstep + kstep);
    PG8_WAIT_V(6); PG8_BAR;
    for (;;) {
        const bool has_next = S.next(ui + 1, nxt);
        unsigned n00 = c00, n01 = c01, n10 = c10, n11 = c11; const char* nB = cB; const char* nA = cA;
        LAS u32x4* noff_lds = (LAS u32x4*)(lds + NOFF_OFF) + tid;
        if constexpr (Epi::SIDE) __builtin_amdgcn_global_load_lds((const unsigned*)E.side_ptr(cur, tid), (LAS unsigned*)(lds + SIDE_OFF + (ui & 1) * 2048 + wid * 256), 4, 0, 0);
        if (has_next) {
            if constexpr (Sched::GATHER) __builtin_amdgcn_global_load_lds((const unsigned*)S.tok_ptr(nxt, tid), (LAS unsigned*)(lds + TOK_OFF + wid * 256), 4, 0, 0);
            else nA = Aroot + (size_t)S.arow(nxt, 0) * (size_t)(K * EB);
            nB = nxt.B;
        } else if constexpr (Sched::GATHER) { *noff_lds = (u32x4){c00, c01, c10, c11}; }
        for (int t = 0; t < nt; t += 2) {
            const bool last = (t == nt - 2);
            if constexpr (Sched::GATHER) { if (t == 2 && has_next) {
                int tz = tid; asm volatile("" : "+v"(tz));
                int R0, C0, R1, C1; stage_rc(tz * 16, R0, C0); stage_rc(tz * 16 + 8192, R1, C1);
                const LAS int* tk = (const LAS int*)(lds + TOK_OFF);
                u32x4 nn;
                nn.x = S.tok_row(nxt, R0, tk[R0]) * (unsigned)(K * EB) + (unsigned)C0 * 2u; nn.y = S.tok_row(nxt, R1, tk[R1]) * (unsigned)(K * EB) + (unsigned)C1 * 2u;
                nn.z = S.tok_row(nxt, HALF + R0, tk[HALF + R0]) * (unsigned)(K * EB) + (unsigned)C0 * 2u; nn.w = S.tok_row(nxt, HALF + R1, tk[HALF + R1]) * (unsigned)(K * EB) + (unsigned)C1 * 2u;
                *((LAS u32x4*)(lds + NOFF_OFF) + tz) = nn; } }
            const size_t k1 = (size_t)(t + 1) * kstep;
            const size_t k2 = last ? 0 : (size_t)(t + 2) * kstep, k3 = k2 + kstep;
            if constexpr (Sched::GATHER) { if (last) { const u32x4 nn = *noff_lds; n00 = nn.x; n01 = nn.y; n10 = nn.z; n11 = nn.w; } }
            const unsigned a00 = last ? n00 : c00, a01 = last ? n01 : c01, a10 = last ? n10 : c10, a11 = last ? n11 : c11; const char* a2 = last ? nA : cA;
            const char* b2 = last ? nB : cB + (size_t)(t + 2) * kstep; const char* b3 = b2 + kstep;
            PG8_LDB(B0, 0, 0); PG8_SCHED; PG8_LDA(At, 0, 0); PG8_STAGEA(PG8_SA(1, 1), cA, c10, c11, k1);
            PG8_WAIT_L(8); PG8_BAR; PG8_WAIT_L(0); PG8_MMA(0, 0, At, B0); PG8_BAR; PG8_SCHED;
            PG8_LDB(B1, 0, 1); PG8_STAGEB(PG8_SB(0, 0), b2);
            PG8_BAR; PG8_WAIT_L(0); PG8_MMA(0, 1, At, B1); PG8_BAR;
            PG8_LDA(At, 0, 1); PG8_STAGEA(PG8_SA(0, 0), a2, a00, a01, k2);
            PG8_BAR; PG8_WAIT_L(0); PG8_MMA(1, 0, At, B0); PG8_BAR; PG8_SCHED;
            PG8_STAGEB(PG8_SB(0, 1), b2 + hstep);
            PG8_WAIT_V(6); PG8_BAR; PG8_MMA(1, 1, At, B1); PG8_BAR;
            PG8_LDB(B0, 1, 0); PG8_SCHED; PG8_LDA(At, 1, 0); PG8_STAGEA(PG8_SA(0, 1), a2, a10, a11, k2);
            PG8_WAIT_L(8); PG8_BAR; PG8_WAIT_L(0); PG8_MMA(0, 0, At, B0); PG8_BAR; PG8_SCHED;
            PG8_LDB(B1, 1, 1); PG8_STAGEB(PG8_SB(1, 0), b3);
            PG8_BAR; PG8_WAIT_L(0); PG8_MMA(0, 1, At, B1); PG8_BAR;
            PG8_LDA(At, 1, 1); PG8_STAGEA(PG8_SA(1, 0), a2, a00, a01, k3);
            PG8_BAR; PG8_WAIT_L(0); PG8_MMA(1, 0, At, B0); PG8_BAR; PG8_SCHED;
            PG8_STAGEB(PG8_SB(1, 1), b3 + hstep);
            PG8_WAIT_V(6); PG8_BAR; PG8_MMA(1, 1, At, B1); PG8_BAR;
        }
        if (wr == 0) PG8_BAR;
        if constexpr (F8) asm volatile("s_nop 15\n\ts_nop 15" ::: "memory");
        E(acc, cur, wr, wc, fr, fq, lds + (ui & 1) * 2048);
        if (!has_next) break;
#pragma unroll
        for (int a = 0; a < 2; ++a)
#pragma unroll
            for (int b = 0; b < 2; ++b)
#pragma unroll
                for (int m = 0; m < 4; ++m)
#pragma unroll
                    for (int n = 0; n < 2; ++n) acc[a][b][m][n] = (f32x4){0.f, 0.f, 0.f, 0.f};
        cur = nxt; cB = nB; cA = nA; c00 = n00; c01 = n01; c10 = n10; c11 = n11; ++ui;
        if (wr == 1) PG8_BAR;
    }
    PG8_WAIT_V(0);
    PG8_BAR;
#undef PG8_SA
#undef PG8_SB
#undef PG8_STAGEA
#undef PG8_STAGEB
#undef PG8_LDA
#undef PG8_LDB
#undef PG8_MMA
#undef PG8_LD8
#undef PG8_WAIT_V
#undef PG8_WAIT_L
#undef PG8_BAR
#undef PG8_SCHED
}
}
using pg8::GUnit;

struct Args { const float* in[38]; float* out; unsigned char* ws; int ph_lo, ph_hi, bar_region, pad; };
enum { I_X = 0, I_C, I_CTX, I_CCTX, I_WADA, I_BADA, I_GPREMIX, I_GPOSTMIX, I_GPREFFN, I_GPOSTFFN, I_WIN, I_BIN, I_MUP, I_MUN, I_SINKS, I_W0F, I_W0B, I_W2F, I_W2B,
       I_A0F, I_A0B, I_A2F, I_A2B, I_G2, I_KK, I_KA, I_RK, I_LNW, I_LNB, I_WUPA, I_WUPR, I_WOUT, I_WROUTER, I_BROUTER, I_WGU, I_BGU, I_WDN, I_BDN };

__device__ __forceinline__ unsigned pk4_fp8(float a, float b, float c, float d) { int w = 0; w = __builtin_amdgcn_cvt_pk_fp8_f32(a, b, w, false); w = __builtin_amdgcn_cvt_pk_fp8_f32(c, d, w, true); return (unsigned)w; }
typedef float f32x2_t __attribute__((ext_vector_type(2)));
typedef __bf16 bf16x2_t __attribute__((ext_vector_type(2)));
__device__ __forceinline__ unsigned cvt_pk_bf16_asm(float lo, float hi) { unsigned r; asm volatile("v_cvt_pk_bf16_f32 %0, %1, %2" : "=v"(r) : "v"(lo), "v"(hi)); return r; }
__device__ __forceinline__ unsigned cvt_pk_bf16(float lo, float hi) { const f32x2_t v = {lo, hi}; const bf16x2_t b = __builtin_convertvector(v, bf16x2_t); return __builtin_bit_cast(unsigned, b); }

__device__ __forceinline__ void tile_order(int L, int nM, int nN, int& pm, int& pn) {
    const int nwg = nM * nN; int wgid = L;
    { const int q = nwg / 8, r = nwg % 8, xcd = wgid % 8, off = wgid / 8; wgid = (xcd < r ? xcd * (q + 1) : r * (q + 1) + (xcd - r) * q) + off; }
    const int nig = 8 * nN, gid = wgid / nig, fm = gid * 8, gsz = (nM - fm) < 8 ? (nM - fm) : 8;
    pm = fm + ((wgid % nig) % gsz); pn = (wgid % nig) / gsz;
}

struct SchedProj {           static constexpr bool GATHER = false;
    const char* Bt; int G, c;
    __device__ __forceinline__ bool next(int i, GUnit& u) const {
        const int L = i * G + c; constexpr int NXU = 128 * NTILE_N;
        if (L >= NXU + 72) return false;
        int pm, pn;
        if (L < NXU) tile_order(L, 128, NTILE_N, pm, pn); else { const int l2 = L - NXU; pm = 128 + l2 / 9; pn = 2 + l2 % 9; }
        u.pm = pm; u.pn = pn; u.e = 0; u.lrow0 = 0; u.B = Bt + (size_t)pn * 256 * D * 2; return true;
    }
    __device__ __forceinline__ unsigned arow(const GUnit& u, int r) const { return (unsigned)(u.pm * 256 + r); }
};
template <int K> struct SchedDense {
    static constexpr bool GATHER = false;
    const char* Bt; int G, c;
    __device__ __forceinline__ bool next(int i, GUnit& u) const {
        const int L = i * G + c; if (L >= 128 * 4) return false;
        int pm, pn; tile_order(L, 128, 4, pm, pn);
        u.pm = pm; u.pn = pn; u.e = 0; u.lrow0 = 0; u.B = Bt + (size_t)pn * 256 * K * 2; return true;
    }
    __device__ __forceinline__ unsigned arow(const GUnit& u, int r) const { return (unsigned)(u.pm * 256 + r); }
};
template <int NPN, bool GATHER_, int EB = 2> struct SchedMoe {
    static constexpr bool GATHER = GATHER_;
    const char* Bt; int G, c; const LAS int* tstart; const int* cnt; const int* slot_tok; const LAS int* tcnt;
    __device__ __forceinline__ bool next(int i, GUnit& u) const {
        const int L = i * G + c; const int TT = __builtin_amdgcn_readfirstlane(tstart[NE]);
        if (L >= TT * NPN) return false;
        const int rt = L / NPN, pn = L % NPN; int e = 0;
#pragma unroll
        for (int j = 1; j < NE; ++j) e += (tstart[j] <= rt) ? 1 : 0;
        e = __builtin_amdgcn_readfirstlane(e);
        u.pm = rt; u.pn = pn; u.e = e; u.lrow0 = __builtin_amdgcn_readfirstlane((rt - tstart[e]) * 256);
        u.B = Bt + ((size_t)e * (NPN * 256) + (size_t)pn * 256) * DE * EB; return true;
    }
    __device__ __forceinline__ unsigned arow(const GUnit& u, int r) const {
        if (GATHER) { const int lr = u.lrow0 + r; const int n = cnt[u.e]; const unsigned tok = (unsigned)slot_tok[u.e * T + (lr < T ? lr : T - 1)]; return (lr < n) ? tok : 0u; }
        return (unsigned)(u.pm * 256 + r);
    }
    __device__ __forceinline__ const int* tok_ptr(const GUnit& u, int tid) const { const int lr = u.lrow0 + (tid & 255); return slot_tok + u.e * T + (lr < T ? lr : T - 1); }
    __device__ __forceinline__ unsigned tok_row(const GUnit& u, int r, int tok) const { return (u.lrow0 + r < tcnt[u.e]) ? (unsigned)tok : 0u; }
};

struct EpiZ {
    static constexpr bool PERM = true, SIDE = true;
    bf16_t* Z; const float* bias;
    __device__ __forceinline__ const float* side_ptr(const GUnit& u, int tid) const { return bias + u.pn * 256 + (tid & 255); }
    __device__ __forceinline__ void operator()(const f32x4 (&acc)[2][2][4][2], const GUnit& u, int wr, int wc, int fr, int fq, LAS unsigned char* lds) const {
        const int row0 = u.pm * 256 + wr * 64 + fr, col0 = u.pn * 256 + wc * 32 + 8 * fq;
        const LAS float* sb = (const LAS float*)(lds + SIDE_OFF) + 256 + wc * 32 + 8 * fq;
        f32x4 bv[2][2];
#pragma unroll
        for (int bj = 0; bj < 2; ++bj)
#pragma unroll
            for (int n = 0; n < 2; ++n) bv[bj][n] = *(const LAS f32x4*)(sb + bj * 128 + 4 * n);
#pragma unroll
        for (int ai = 0; ai < 2; ++ai)
#pragma unroll
            for (int m = 0; m < 4; ++m) { bf16_t* rowp = Z + (size_t)(row0 + ai * 128 + m * 16) * ZP + col0;
#pragma unroll
                for (int bj = 0; bj < 2; ++bj) { const f32x4 v0 = acc[ai][bj][m][0] + bv[bj][0], v1 = acc[ai][bj][m][1] + bv[bj][1];
                    u32x4 w; w.x = cvt_pk_bf16(v0[0], v0[1]); w.y = cvt_pk_bf16(v0[2], v0[3]); w.z = cvt_pk_bf16(v1[0], v1[1]); w.w = cvt_pk_bf16(v1[2], v1[3]);
                    *(u32x4*)(rowp + bj * 128) = w; } }
    }
};
template <bool SECOND> struct EpiUp {
    static constexpr bool PERM = true, SIDE = false;
    bf16_t* O; const bf16_t* Z;
    __device__ __forceinline__ void operator()(const f32x4 (&acc)[2][2][4][2], const GUnit& u, int wr, int wc, int fr, int fq, LAS unsigned char*) const {
        const int row0 = u.pm * 256 + wr * 64 + fr, col0 = u.pn * 256 + wc * 32 + 8 * fq;
#pragma unroll
        for (int ai = 0; ai < 2; ++ai)
#pragma unroll
            for (int m = 0; m < 4; ++m) { const size_t row = (size_t)(row0 + ai * 128 + m * 16);
#pragma unroll
                for (int bj = 0; bj < 2; ++bj) {
                    const u32x4 g = *(const u32x4*)(Z + row * ZP + ZC_G + (SECOND ? 1024 : 0) + col0 + bj * 128);
                    const f32x4 a0 = acc[ai][bj][m][0], a1 = acc[ai][bj][m][1];
                    float o[8];
                    o[0] = sigmoidf_(lo16(g.x)) * a0[0]; o[1] = sigmoidf_(hi16(g.x)) * a0[1]; o[2] = sigmoidf_(lo16(g.y)) * a0[2]; o[3] = sigmoidf_(hi16(g.y)) * a0[3];
                    o[4] = sigmoidf_(lo16(g.z)) * a1[0]; o[5] = sigmoidf_(hi16(g.z)) * a1[1]; o[6] = sigmoidf_(lo16(g.w)) * a1[2]; o[7] = sigmoidf_(hi16(g.w)) * a1[3];
                    bf16_t* op = O + row * 1024 + col0 + bj * 128;
                    if (SECOND) { const u32x4 p = *(const u32x4*)op;
                        o[0] += lo16(p.x); o[1] += hi16(p.x); o[2] += lo16(p.y); o[3] += hi16(p.y); o[4] += lo16(p.z); o[5] += hi16(p.z); o[6] += lo16(p.w); o[7] += hi16(p.w); }
                    u32x4 w; w.x = cvt_pk_bf16(o[0], o[1]); w.y = cvt_pk_bf16(o[2], o[3]); w.z = cvt_pk_bf16(o[4], o[5]); w.w = cvt_pk_bf16(o[6], o[7]);
                    *(u32x4*)op = w; } }
    }
};
struct EpiMix {
    static constexpr bool PERM = true, SIDE = false;
    bf16_t* C;
    __device__ __forceinline__ void operator()(const f32x4 (&acc)[2][2][4][2], const GUnit& u, int wr, int wc, int fr, int fq, LAS unsigned char*) const {
        const int row0 = u.pm * 256 + wr * 64 + fr, col0 = u.pn * 256 + wc * 32 + 8 * fq;
#pragma unroll
        for (int ai = 0; ai < 2; ++ai)
#pragma unroll
            for (int m = 0; m < 4; ++m) { bf16_t* rowp = C + (size_t)(row0 + ai * 128 + m * 16) * 1024 + col0;
#pragma unroll
                for (int bj = 0; bj < 2; ++bj) { const f32x4 v0 = acc[ai][bj][m][0], v1 = acc[ai][bj][m][1];
                    u32x4 w; w.x = cvt_pk_bf16(v0[0], v0[1]); w.y = cvt_pk_bf16(v0[2], v0[3]); w.z = cvt_pk_bf16(v1[0], v1[1]); w.w = cvt_pk_bf16(v1[2], v1[3]);
                    *(u32x4*)(rowp + bj * 128) = w; } }
    }
};
__device__ __forceinline__ float swiglu1(float g, float up) {
    g = fminf(g, 7.0f); up = fminf(fmaxf(up, -7.0f), 7.0f);
    return (up + 1.0f) * (g * sigmoidf_(1.702f * g));
}
struct EpiMoe1 {
    static constexpr bool PERM = true, SIDE = true;
    bf16_t* H; const float* bgu;
    __device__ __forceinline__ const float* side_ptr(const GUnit& u, int tid) const { return bgu + (size_t)u.e * 2048 + u.pn * 256 + (tid & 255); }
    __device__ __forceinline__ void operator()(const f32x4 (&acc)[2][2][4][2], const GUnit& u, int wr, int wc, int fr, int fq, LAS unsigned char* lds) const {
        const int row0 = u.pm * 256 + wr * 64 + fr, col0 = u.pn * 256 + wc * 32 + 8 * fq;
        const LAS float* b = (const LAS float*)(lds + SIDE_OFF) + 256 + wc * 32 + 8 * fq;
        constexpr float sc = 1.0f / (F8_WSCALE * F8_ASCALE);
#pragma unroll
        for (int bj = 0; bj < 2; ++bj) {
            const f32x4 b0 = *(const LAS f32x4*)(b + bj * 128), b1 = *(const LAS f32x4*)(b + bj * 128 + 4);
#pragma unroll
            for (int ai = 0; ai < 2; ++ai)
#pragma unroll
                for (int m = 0; m < 4; ++m) {
                    const f32x4 v0 = acc[ai][bj][m][0] * sc + b0, v1 = acc[ai][bj][m][1] * sc + b1;
                    *(unsigned*)((unsigned char*)H + (size_t)(row0 + ai * 128 + m * 16) * 1024 + (col0 >> 1) + bj * 64) =
                        pk4_fp8(swiglu1(v0[0], v0[1]) * F8_HSCALE, swiglu1(v0[2], v0[3]) * F8_HSCALE, swiglu1(v1[0], v1[1]) * F8_HSCALE, swiglu1(v1[2], v1[3]) * F8_HSCALE);
                }
        }
    }
};
struct EpiMoe2 {
    static constexpr bool PERM = true, SIDE = true;
    unsigned char* Y; const float* bdn; const float* slot_gate; const LAS int* tcnt;
    __device__ __forceinline__ const float* side_ptr(const GUnit& u, int tid) const {
        const int lr = u.lrow0 + (tid & 255);
        return (tid < 256) ? slot_gate + (size_t)u.e * T + (lr < T ? lr : T - 1) : bdn + (size_t)u.e * 1024 + u.pn * 256 + (tid & 255);
    }
    __device__ __forceinline__ void operator()(const f32x4 (&acc)[2][2][4][2], const GUnit& u, int wr, int wc, int fr, int fq, LAS unsigned char* lds) const {
        const int r0 = wr * 64 + fr, col0 = u.pn * 256 + wc * 32 + 8 * fq;
        const LAS float* sd = (const LAS float*)(lds + SIDE_OFF);
        const LAS float* b = sd + 256 + wc * 32 + 8 * fq; const int n_e = tcnt[u.e];
        constexpr float sc = 1.0f / (F8_WSCALE * F8_HSCALE);
        f32x4 bv[2][2];
#pragma unroll
        for (int bj = 0; bj < 2; ++bj)
#pragma unroll
            for (int n = 0; n < 2; ++n) bv[bj][n] = *(const LAS f32x4*)(b + bj * 128 + 4 * n);
#pragma unroll
        for (int ai = 0; ai < 2; ++ai)
#pragma unroll
            for (int m = 0; m < 4; ++m) { const int r = r0 + ai * 128 + m * 16; const int lr = u.lrow0 + r;
                const float gt = ((lr < n_e) ? sd[r] : 0.0f) * F8_YSCALE;
                unsigned char* rowp = Y + (size_t)(u.pm * 256 + r) * 1024 + col0;
#pragma unroll
                for (int bj = 0; bj < 2; ++bj) { const f32x4 v0 = (acc[ai][bj][m][0] * sc + bv[bj][0]) * gt, v1 = (acc[ai][bj][m][1] * sc + bv[bj][1]) * gt;
                    u32x2 w; w.x = pk4_fp8(v0[0], v0[1], v0[2], v0[3]); w.y = pk4_fp8(v1[0], v1[1], v1[2], v1[3]);
                    *(u32x2*)(rowp + bj * 128) = w; } }
    }
};

__device__ __forceinline__ void p0_transpose_item(const float* W, int K, int N, bf16_t* WT, int row_off, LAS float* scr, int item, int lane) {
    const int nblk = N / 32, kb = item / nblk, nb = item % nblk, k0 = 64 * kb, n0 = 32 * nb;
#pragma unroll 32
    for (int i = 0; i < 32; ++i) { const int kk = 2 * i + (lane >> 5); scr[kk * 33 + (lane & 31)] = W[(size_t)(k0 + kk) * N + n0 + (lane & 31)]; }
    LDS_WAIT(); asm volatile("" ::: "memory");
    const int c = lane & 7;
#pragma unroll
    for (int j = 0; j < 4; ++j) { const int n = (lane >> 3) + 8 * j; const LAS float* s = scr + (8 * c) * 33 + n;
        u32x4 o; o.x = pk2(s[0 * 33], s[1 * 33]); o.y = pk2(s[2 * 33], s[3 * 33]); o.z = pk2(s[4 * 33], s[5 * 33]); o.w = pk2(s[6 * 33], s[7 * 33]);
        *(u32x4*)(WT + (size_t)(row_off + n0 + n) * K + k0 + 8 * c) = o; }
    LDS_WAIT(); asm volatile("" ::: "memory");
}
__device__ __forceinline__ void p0_prologue(const Args& a, LAS unsigned char* lds, int tid, int lane, int wave, int G) {
    unsigned char* ws = a.ws;
    {
        float* MOD = (float*)(ws + WS_CTL) + CW_MOD;
        LAS float* sl = (LAS float*)lds;
        LAS float* red = sl + 9 * 1024;
        if (blockIdx.x < 96) {
            for (int i = tid; i < 9 * 1024; i += 512) { const int r = i >> 10, k = i & 1023; const float v = (r < 8) ? a.in[I_C][r * D + k] : a.in[I_CCTX][k]; sl[i] = v * sigmoidf_(v); }
            __syncthreads();
            for (int it = blockIdx.x; it < 96; it += G) {
                const int n = it * 64 + lane; float acc[9];
#pragma unroll
                for (int r = 0; r < 9; ++r) acc[r] = 0.f;
                const float* w = a.in[I_WADA] + (size_t)(wave * 128) * 6144 + n;
#pragma unroll 32
                for (int kk = 0; kk < 128; ++kk) { const float wv = w[(size_t)kk * 6144];
#pragma unroll
                    for (int r = 0; r < 9; ++r) acc[r] += sl[r * 1024 + wave * 128 + kk] * wv; }
#pragma unroll
                for (int r = 0; r < 9; ++r) red[(wave * 9 + r) * 64 + lane] = acc[r];
                __syncthreads();
                for (int i = tid; i < 9 * 64; i += 512) { const int r = i >> 6, c = i & 63; float s = a.in[I_BADA][it * 64 + c];
#pragma unroll
                    for (int w8 = 0; w8 < 8; ++w8) s += red[(w8 * 9 + r) * 64 + c];
                    MOD[r * 6144 + it * 64 + c] = s; }
                __syncthreads();
            }
        }
        __syncthreads();
    }
    {
        float* misc = (float*)(ws + WS_MISC);
        const int gt = blockIdx.x * 512 + tid, NGT = G * 512;
        for (int n = gt; n < ZP; n += NGT) misc[n] = (n < 2688) ? a.in[I_BIN][n] : ((n < 2816) ? 0.f : a.in[I_BIN][n - 128]);
        for (int n = gt; n < 1024; n += NGT) { const int p = n >> 4, i = n & 15; const float inv = powf(10000.0f, -(float)i / 16.0f); float s, c; sincosf((float)p * inv, &s, &c); misc[ZP + n] = c; misc[ZP + 1024 + n] = s; }
        u32x4* zr = (u32x4*)((bf16_t*)(ws + WS_WIN) + (size_t)2688 * D);
        for (int n = gt; n < 128 * D / 8; n += NGT) zr[n] = (u32x4){0u, 0u, 0u, 0u};
    }
    {
        LAS float* scr = (LAS float*)(lds + wave * 8704);
        const int gw = blockIdx.x * 8 + wave, NGW = G * 8;
        constexpr int J_IN = 16 * (PROJ_SRC / 32), J_UP = 8 * 32, J_OUT = 16 * 32, J_L = 16, J_G2 = 32, J_GU1 = 16 * 64, J_DN1 = 16 * 32;
        constexpr int NITEMS = J_IN + 2 * J_UP + J_OUT + 4 * J_L + J_G2;
        bf16_t* lora = (bf16_t*)(ws + WS_LORA);
        for (int it = gw; it < NITEMS; it += NGW) {
            int r = it;
            if (r < J_IN) { const int nb = r % (PROJ_SRC / 32); p0_transpose_item(a.in[I_WIN], D, PROJ_SRC, (bf16_t*)(ws + WS_WIN), (nb * 32 >= 2688) ? 128 : 0, scr, r, lane); continue; } r -= J_IN;
            if (r < J_UP) { p0_transpose_item(a.in[I_WUPA], 512, D, (bf16_t*)(ws + WS_WUPA), 0, scr, r, lane); continue; } r -= J_UP;
            if (r < J_UP) { p0_transpose_item(a.in[I_WUPR], 512, D, (bf16_t*)(ws + WS_WUPR), 0, scr, r, lane); continue; } r -= J_UP;
            if (r < J_OUT) { p0_transpose_item(a.in[I_WOUT], D, D, (bf16_t*)(ws + WS_WOUT), 0, scr, r, lane); continue; } r -= J_OUT;
            if (r < J_L) { p0_transpose_item(a.in[I_W2F], 64, 512, lora, 0, scr, r, lane); continue; } r -= J_L;
            if (r < J_L) { p0_transpose_item(a.in[I_W2B], 64, 512, lora + 32768, 0, scr, r, lane); continue; } r -= J_L;
            if (r < J_L) { p0_transpose_item(a.in[I_A2F], 64, 512, lora + 2 * 32768, 0, scr, r, lane); continue; } r -= J_L;
            if (r < J_L) { p0_transpose_item(a.in[I_A2B], 64, 512, lora + 3 * 32768, 0, scr, r, lane); continue; } r -= J_L;
            p0_transpose_item(a.in[I_G2], 128, 512, lora + 4 * 32768, 0, scr, r, lane);
        }
    }
}

__device__ __forceinline__ void p0_transpose_item_f8(const float* W, int K, int N, unsigned char* WT, LAS float* scr, int item, int lane, float sc) {
    const int nblk = N / 32, kb = item / nblk, nb = item % nblk, k0 = 64 * kb, n0 = 32 * nb;
#pragma unroll 32
    for (int i = 0; i < 32; ++i) { const int kk = 2 * i + (lane >> 5); scr[kk * 33 + (lane & 31)] = W[(size_t)(k0 + kk) * N + n0 + (lane & 31)] * sc; }
    LDS_WAIT(); asm volatile("" ::: "memory");
    const int c = lane & 7;
#pragma unroll
    for (int j = 0; j < 4; ++j) { const int n = (lane >> 3) + 8 * j; const LAS float* s = scr + (8 * c) * 33 + n;
        u32x2 o; o.x = pk4_fp8(s[0 * 33], s[1 * 33], s[2 * 33], s[3 * 33]); o.y = pk4_fp8(s[4 * 33], s[5 * 33], s[6 * 33], s[7 * 33]);
        *(u32x2*)(WT + (size_t)(n0 + n) * K + k0 + 8 * c) = o; }
    LDS_WAIT(); asm volatile("" ::: "memory");
}
__device__ __forceinline__ int queue_pull(unsigned* q, LAS unsigned char* lds, int tid) {
    volatile LAS int* w = (volatile LAS int*)(lds + RING_BYTES + 256);
    __syncthreads();
    if (tid == 0) *w = (int)__hip_atomic_fetch_add(q, 1u, __ATOMIC_RELAXED, __HIP_MEMORY_SCOPE_AGENT);
    __syncthreads();
    return *w;
}
__device__ __forceinline__ void moe_weight_copies(const Args& a, LAS unsigned char* lds, int tid, int lane, int wave) {
    unsigned char* ws = a.ws;
    LAS float* scr = (LAS float*)(lds + wave * 8704);
    constexpr int J_GU1 = 16 * 64, J_DN1 = 16 * 32, NCHUNK = (NE * J_GU1 + NE * J_DN1) / 128;
    unsigned* q = (unsigned*)(ws + WS_CTL) + CW_QTR;
    for (;;) {
        const int ch = queue_pull(q, lds, tid);
        if (ch >= NCHUNK) break;
#pragma unroll 1
        for (int k = 0; k < 16; ++k) {
            int r = ch * 128 + wave * 16 + k;
            if (r < NE * J_GU1) { const int e = r / J_GU1; p0_transpose_item_f8(a.in[I_WGU] + (size_t)e * D * 2048, D, 2048, (unsigned char*)(ws + WS_WGU) + (size_t)e * 2048 * D, scr, r % J_GU1, lane, F8_WSCALE); }
            else { r -= NE * J_GU1; const int e = r / J_DN1; p0_transpose_item_f8(a.in[I_WDN] + (size_t)e * DE * D, DE, D, (unsigned char*)(ws + WS_WDN) + (size_t)e * D * DE, scr, r % J_DN1, lane, F8_WSCALE); }
        }
    }
}

__device__ __forceinline__ void p1_norm(const Args& a, int lane, int wave, int G) {
    const float* MOD = (const float*)(a.ws + WS_CTL) + CW_MOD;
    bf16_t* HX = (bf16_t*)(a.ws + WS_HX);
    const int gw = blockIdx.x * 8 + wave, NGW = G * 8;
    for (int m = gw; m < ROWS; m += NGW) {
        const float* xrow = (m < T) ? a.in[I_X] + (size_t)m * D : a.in[I_CTX] + (size_t)(m - T) * D;
        const int r = (m < T) ? (m >> 12) : 8;
        const f32x4* xr = (const f32x4*)xrow + lane;
        f32x4 v[4]; float s = 0.f;
#pragma unroll
        for (int j = 0; j < 4; ++j) { v[j] = xr[64 * j]; s += (v[j].x * v[j].x + v[j].y * v[j].y) + (v[j].z * v[j].z + v[j].w * v[j].w); }
        const float rstd = 1.0f / sqrtf(wave_sum(s) * (1.f / D) + RMS_EPS);
        unsigned long long* o8 = (unsigned long long*)(HX + (size_t)m * D) + lane;
#pragma unroll
        for (int j = 0; j < 4; ++j) {
            const f32x4 g = ((const f32x4*)a.in[I_GPREMIX])[64 * j + lane], sh = ((const f32x4*)(MOD + r * 6144))[64 * j + lane], sc = ((const f32x4*)(MOD + r * 6144 + 1024))[64 * j + lane];
            const f32x4 h = (v[j] * rstd * g) * (sc + 1.0f) + sh;
            o8[64 * j] = (unsigned long long)pk2(h.x, h.y) | ((unsigned long long)pk2(h.z, h.w) << 32);
        }
    }
}

constexpr size_t WS_ACT = WS_HX;
__device__ __forceinline__ void p3a_pointwise(const Args& a, int tid, int G) {
    unsigned char* ws = a.ws;
    const bf16_t* Z = (const bf16_t*)(ws + WS_Z);
    bf16_t* FB = (bf16_t*)(ws + WS_FEAT); bf16_t* ACT = (bf16_t*)(ws + WS_ACT);
    const float* rc = (const float*)(ws + WS_MISC) + ZP; const float* rs = rc + 1024;
    const int cv = tid % 240, rg = tid / 240;
    float mp[8], mn[8];
    if (tid < 480) {
#pragma unroll
        for (int j = 0; j < 8; ++j) { mp[j] = a.in[I_MUP][8 * cv + j]; mn[j] = a.in[I_MUN][8 * cv + j]; }
    }
    for (int unit = blockIdx.x; unit < ROWS / 16; unit += G) {
        const int row0 = unit * 16;
        const bool isx = row0 < T;
        const int slen = isx ? SEQ : CL;
        const int pos0 = isx ? (row0 & (SEQ - 1)) : ((row0 - T) & (CL - 1));
        if (tid < 480) {
            const int r0 = row0 + 8 * rg, p0 = pos0 + 8 * rg;
            const bf16_t* zp = Z + (size_t)r0 * ZP + ZC_R + 8 * cv;
            u32x4 prv = (u32x4){0u, 0u, 0u, 0u};
            if (p0 > 0) prv = *(const u32x4*)(zp - ZP);
            u32x4 cur = *(const u32x4*)zp;
#pragma unroll
            for (int i = 0; i < 8; ++i) {
                u32x4 nxt = (u32x4){0u, 0u, 0u, 0u};
                if (p0 + i < slen - 1) nxt = *(const u32x4*)(zp + (size_t)(i + 1) * ZP);
                float o[8];
#pragma unroll
                for (int j = 0; j < 4; ++j) {
                    const float c0 = lo16(cur[j]), c1 = hi16(cur[j]);
                    o[2 * j] = c0 + mp[2 * j] * (lo16(prv[j]) - c0) + mn[2 * j] * (lo16(nxt[j]) - c0);
                    o[2 * j + 1] = c1 + mp[2 * j + 1] * (hi16(prv[j]) - c1) + mn[2 * j + 1] * (hi16(nxt[j]) - c1);
                }
                bf16_t* op;
                if (cv < 64) op = FB + (size_t)F_R * (FEAT_STRIDE / 2) + (size_t)(r0 + i) * RD + 8 * cv;
                else if (cv < 128) op = FB + (size_t)F_A * (FEAT_STRIDE / 2) + (size_t)(r0 + i) * RD + 8 * (cv - 64);
                else if (cv < 192) op = FB + (size_t)F_V * (FEAT_STRIDE / 2) + (size_t)(r0 + i) * RD + 8 * (cv - 128);
                else {
                    op = ACT + (size_t)(r0 + i) * 384 + 8 * (cv - 192);
                    if (cv < 208) {
#pragma unroll
                        for (int j = 0; j < 8; ++j) o[j] = 1.0f - 2.0f * __builtin_amdgcn_rcpf(__expf(2.0f * o[j]) + 1.0f);
                    } else if (cv >= 224) {
#pragma unroll
                        for (int j = 0; j < 8; ++j) o[j] = sigmoidf_(o[j]);
                    }
                }
                u32x4 w; w.x = pk2(o[0], o[1]); w.y = pk2(o[2], o[3]); w.z = pk2(o[4], o[5]); w.w = pk2(o[6], o[7]);
                *(u32x4*)op = w;
                prv = cur; cur = nxt;
            }
        }
        {
            bf16_t* QR = (bf16_t*)(ws + WS_QR); bf16_t* KA = (bf16_t*)(ws + WS_KA); bf16_t* VT = (bf16_t*)(ws + WS_VT);
#pragma unroll 1
            for (int idx = tid; idx < 16 * 40; idx += 512) {
                const int tk = idx / 40, j = idx % 40; const int row = row0 + tk, pos = pos0 + tk;
                const int hh = j >> 2, part = (j >> 1) & 1, sub = j & 1;
                const bool isq = hh < 8;
                if (isq && !isx) continue;
                const int zc = isq ? (ZC_Q + hh * 64) : (ZC_K + (hh - 8) * 64);
                const bf16_t* zp = Z + (size_t)row * ZP + zc + part * 32 + sub * 8;
                const u32x4 t1 = *(const u32x4*)zp, t2 = *(const u32x4*)(zp + 16);
                float x1[8], x2[8], o1[8], o2[8];
#pragma unroll
                for (int q = 0; q < 4; ++q) { x1[2 * q] = lo16(t1[q]); x1[2 * q + 1] = hi16(t1[q]); x2[2 * q] = lo16(t2[q]); x2[2 * q + 1] = hi16(t2[q]); }
                if (isx) {
                    const int p = part ? (pos & 63) : (pos >> 6);
                    const float sc = isq ? (0.125f * 1.44269504089f) : 1.0f;
                    const f32x4 cA = *(const f32x4*)(rc + p * 16 + sub * 8), cB = *(const f32x4*)(rc + p * 16 + sub * 8 + 4), sA = *(const f32x4*)(rs + p * 16 + sub * 8), sB = *(const f32x4*)(rs + p * 16 + sub * 8 + 4);
#pragma unroll
                    for (int q = 0; q < 8; ++q) { const float c = q < 4 ? cA[q & 3] : cB[q & 3], s = q < 4 ? sA[q & 3] : sB[q & 3];
                        o1[q] = (x1[q] * c - x2[q] * s) * sc; o2[q] = (x2[q] * c + x1[q] * s) * sc; }
                } else {
#pragma unroll
                    for (int q = 0; q < 8; ++q) { o1[q] = x1[q]; o2[q] = x2[q]; }
                }
                u32x4 w1, w2;
#pragma unroll
                for (int q = 0; q < 4; ++q) { w1[q] = pk2(o1[2 * q], o1[2 * q + 1]); w2[q] = pk2(o2[2 * q], o2[2 * q + 1]); }
                bf16_t* op = isq ? (QR + (size_t)row * 512 + hh * 64 + part * 32 + sub * 8) : (KA + (size_t)row * 128 + (hh - 8) * 64 + part * 32 + sub * 8);
                *(u32x4*)op = w1; *(u32x4*)(op + 16) = w2;
            }
            if (tid < 256) {
                const int cidx = tid & 127, tg = tid >> 7; const int g = cidx >> 6, d = cidx & 63;
                unsigned short vv[8];
#pragma unroll
                for (int q = 0; q < 8; ++q) vv[q] = Z[(size_t)(row0 + 8 * tg + q) * ZP + ZC_V + cidx];
                u32x4 w; w.x = vv[0] | ((unsigned)vv[1] << 16); w.y = vv[2] | ((unsigned)vv[3] << 16); w.z = vv[4] | ((unsigned)vv[5] << 16); w.w = vv[6] | ((unsigned)vv[7] << 16);
                bf16_t* op;
                if (isx) { const int b = row0 >> 12; op = VT + ((size_t)(b * 2 + g) * 64 + d) * SEQ + pos0 + 8 * tg; }
                else { const int b = (row0 - T) >> 8; op = VT + (size_t)NB * 2 * 64 * SEQ + ((size_t)(b * 2 + g) * 64 + d) * CL + pos0 + 8 * tg; }
                *(u32x4*)op = w;
            }
        }
    }
}

__device__ __forceinline__ void p3b_features(const Args& a, LAS unsigned char* lds, int tid, int lane, int wave, int G) {
    unsigned char* ws = a.ws;
    const bf16_t* lora = (const bf16_t*)(ws + WS_LORA);
    const bf16_t* ACT = (const bf16_t*)(ws + WS_ACT);
    bf16_t* FB = (bf16_t*)(ws + WS_FEAT);
    const int h = blockIdx.x & 7;
    constexpr int P64 = 72, P128 = 136;
    LAS bf16_t* WL = (LAS bf16_t*)lds;
    LAS bf16_t* WG2 = WL + 4 * 64 * P64;
    __syncthreads();
    for (int i = tid; i < 4 * 64 * 8; i += 512) { const int m = i >> 9, r = (i >> 3) & 63, c = i & 7; const int ch = 16 * ((r >> 2) & 3) + 4 * (r >> 4) + (r & 3);
        *(LAS u32x4*)(WL + (m * 64 + r) * P64 + 8 * c) = *(const u32x4*)(lora + (size_t)m * 32768 + (size_t)(h * 64 + ch) * 64 + 8 * c); }
    for (int i = tid; i < 64 * 16; i += 512) { const int r = i >> 4, c = i & 15; const int ch = 16 * ((r >> 2) & 3) + 4 * (r >> 4) + (r & 3);
        *(LAS u32x4*)(WG2 + r * P128 + 8 * c) = *(const u32x4*)(lora + (size_t)4 * 32768 + (size_t)(h * 64 + ch) * 128 + 8 * c); }
    __syncthreads();
    const int tk = lane & 15, cg = lane >> 4;
    f32x4 w0f[4], w0b[4], a0f[4], a0b[4], kkw[4], kaw[4];
#pragma unroll
    for (int cs = 0; cs < 4; ++cs) { const int c = h * 64 + 16 * cg + 4 * cs;
        w0f[cs] = *(const f32x4*)(a.in[I_W0F] + c); w0b[cs] = *(const f32x4*)(a.in[I_W0B] + c); a0f[cs] = *(const f32x4*)(a.in[I_A0F] + c); a0b[cs] = *(const f32x4*)(a.in[I_A0B] + c);
        kkw[cs] = *(const f32x4*)(a.in[I_KK] + c); kaw[cs] = *(const f32x4*)(a.in[I_KA] + c); }
    for (int tt = blockIdx.x >> 3; tt < ROWS / 128; tt += (G >> 3)) {
        const int row = tt * 128 + 16 * wave + tk;
        bf16x8 bfr[12];
        const bf16_t* ap = ACT + (size_t)row * 384 + 8 * cg;
#pragma unroll
        for (int kb = 0; kb < 12; ++kb) bfr[kb] = *(const bf16x8*)(ap + 32 * kb);
        bf16_t* frow = FB + (size_t)row * RD + h * 64 + 16 * cg;
        u32x2 kraw[4];
#pragma unroll
        for (int cs = 0; cs < 4; ++cs) kraw[cs] = *(const u32x2*)(frow + (size_t)F_A * (FEAT_STRIDE / 2) + 4 * cs);
        auto store16 = [&](int arr, const f32x4 (&v)[4]) {
            u32x4 w0, w1;
            w0.x = cvt_pk_bf16_asm(v[0][0], v[0][1]); w0.y = cvt_pk_bf16_asm(v[0][2], v[0][3]); w0.z = cvt_pk_bf16_asm(v[1][0], v[1][1]); w0.w = cvt_pk_bf16_asm(v[1][2], v[1][3]);
            w1.x = cvt_pk_bf16_asm(v[2][0], v[2][1]); w1.y = cvt_pk_bf16_asm(v[2][2], v[2][3]); w1.z = cvt_pk_bf16_asm(v[3][0], v[3][1]); w1.w = cvt_pk_bf16_asm(v[3][2], v[3][3]);
            u32x4* p = (u32x4*)(frow + (size_t)arr * (FEAT_STRIDE / 2)); p[0] = w0; p[1] = w1;
        };
        auto lora_mm = [&](int m, int kb0, f32x4 (&acc)[4]) {
#pragma unroll
            for (int cs = 0; cs < 4; ++cs) acc[cs] = (f32x4){0.f, 0.f, 0.f, 0.f};
            const int nkb = (m == 4) ? 4 : 2;
#pragma unroll
            for (int kb = 0; kb < 4; ++kb) if (kb < nkb) {
#pragma unroll
                for (int cs = 0; cs < 4; ++cs) {
                    const bf16x8 afr = (m == 4) ? *(const LAS bf16x8*)(WG2 + (16 * cs + tk) * P128 + 32 * kb + 8 * cg) : *(const LAS bf16x8*)(WL + (m * 64 + 16 * cs + tk) * P64 + 32 * kb + 8 * cg);
                    acc[cs] = __builtin_amdgcn_mfma_f32_16x16x32_bf16(afr, bfr[kb0 + kb], acc[cs], 0, 0, 0);
                }
            }
        };
        f32x4 acc[4];
        lora_mm(0, 0, acc);
#pragma unroll
        for (int cs = 0; cs < 4; ++cs)
#pragma unroll
            for (int j = 0; j < 4; ++j) acc[cs][j] = SCAN_CHUNKED ? (-0.60653065971f * sigmoidf_(acc[cs][j] + w0f[cs][j])) : (__expf(-0.60653065971f * sigmoidf_(acc[cs][j] + w0f[cs][j])) - 1.0f);
        store16(F_WF, acc);
        lora_mm(1, 2, acc);
#pragma unroll
        for (int cs = 0; cs < 4; ++cs)
#pragma unroll
            for (int j = 0; j < 4; ++j) acc[cs][j] = SCAN_CHUNKED ? (-0.60653065971f * sigmoidf_(acc[cs][j] + w0b[cs][j])) : (__expf(-0.60653065971f * sigmoidf_(acc[cs][j] + w0b[cs][j])) - 1.0f);
        store16(F_WB, acc);
        lora_mm(4, 8, acc);
        asm volatile("s_nop 7\n\ts_nop 7" ::: "memory");
        store16(F_G, acc);
        f32x4 iclf[4], iclb[4];
        lora_mm(2, 4, iclf);
        lora_mm(3, 6, iclb);
#pragma unroll
        for (int cs = 0; cs < 4; ++cs)
#pragma unroll
            for (int j = 0; j < 4; ++j) { iclf[cs][j] = sigmoidf_(iclf[cs][j] + a0f[cs][j]); iclb[cs][j] = sigmoidf_(iclb[cs][j] + a0b[cs][j]); }
        f32x4 kv[4]; float nrm = 0.f;
#pragma unroll
        for (int cs = 0; cs < 4; ++cs) {
            kv[cs] = (f32x4){lo16(kraw[cs].x), hi16(kraw[cs].x), lo16(kraw[cs].y), hi16(kraw[cs].y)};
            const f32x4 kk = kv[cs] * kkw[cs];
            nrm += (kk[0] * kk[0] + kk[1] * kk[1]) + (kk[2] * kk[2] + kk[3] * kk[3]);
        }
        nrm += __shfl_xor(nrm, 16); nrm += __shfl_xor(nrm, 32);
        const float inv = 1.0f / fmaxf(sqrtf(nrm), 1e-12f);
        f32x4 oa[4], obf[4], obb[4], okf[4], okb[4];
#pragma unroll
        for (int cs = 0; cs < 4; ++cs) {
            const f32x4 kkn = kv[cs] * kkw[cs] * inv;
            oa[cs] = -kkn; obf[cs] = kkn * iclf[cs]; obb[cs] = kkn * iclb[cs];
            okf[cs] = kv[cs] * ((iclf[cs] - 1.0f) * kaw[cs] + 1.0f); okb[cs] = kv[cs] * ((iclb[cs] - 1.0f) * kaw[cs] + 1.0f);
        }
        store16(F_A, oa); store16(F_BF, obf); store16(F_BB, obb); store16(F_KF, okf); store16(F_KB, okb);
    }
}

__device__ __forceinline__ void p4_attention(const Args& a, LAS unsigned char* lds, int tid, int lane, int wave, int G) {
    unsigned char* ws = a.ws;
    const bf16_t* QR = (const bf16_t*)(ws + WS_QR); const bf16_t* KA = (const bf16_t*)(ws + WS_KA); const bf16_t* VT = (const bf16_t*)(ws + WS_VT);
    bf16_t* ATT = (bf16_t*)(ws + WS_ATT);
    constexpr int KP = 72;
    LAS bf16_t* Ks0 = (LAS bf16_t*)lds;
    const int qi = lane & 31, hf = lane >> 5;
    unsigned* qatt = (unsigned*)(ws + WS_CTL) + CW_QATT;
    for (int it = 0;; ++it) {
        int upull = 0; if ((it & 1) == 0) { upull = queue_pull(qatt, lds, tid); *(volatile LAS int*)(lds + RING_BYTES + 260) = upull; } else upull = *(volatile LAS int*)(lds + RING_BYTES + 260);
        const int unit = 2 * upull + (it & 1);
        if (unit >= NB * NKV * (SEQ / 64)) break;
        const int qb = unit & 63, g = (unit >> 6) & 1, b = unit >> 7;
        const int q0 = qb * 64;
        const int head = g * 4 + (wave >> 1), qloc = 32 * (wave & 1) + qi;
        const size_t qrow = (size_t)b * SEQ + q0 + qloc;
        bf16x8 qf[4];
#pragma unroll
        for (int s = 0; s < 4; ++s) qf[s] = *(const bf16x8*)(QR + qrow * 512 + head * 64 + 16 * s + 8 * hf);
        float m = a.in[I_SINKS][head] * 1.44269504089f, lsum = hf ? 0.f : 1.f;
        f32x16 O0, O1;
#pragma unroll
        for (int r = 0; r < 16; ++r) { O0[r] = 0.f; O1[r] = 0.f; }
        const int rr = tid >> 3, ch = tid & 7;
        auto tile_ok = [&](int kt) -> bool { const int kp = q0 - 128 + 64 * kt; return kt >= 5 || (kp >= 0 && kp < SEQ); };
        u32x4 kreg[3], vreg[3];
        auto fetch_tile = [&](int kt, u32x4& kr, u32x4& vr) {
            int kp0 = q0 - 128 + 64 * kt; kp0 = kp0 < 0 ? 0 : (kp0 > SEQ - 64 ? SEQ - 64 : kp0);
            const bf16_t* kp = (kt < 5) ? KA + ((size_t)b * SEQ + kp0 + rr) * 128 + g * 64 + 8 * ch
                                        : KA + ((size_t)T + b * CL + 64 * (kt - 5) + rr) * 128 + g * 64 + 8 * ch;
            const bf16_t* vp = (kt < 5) ? VT + ((size_t)(b * 2 + g) * 64 + rr) * SEQ + kp0 + 8 * ch
                                        : VT + (size_t)NB * 2 * 64 * SEQ + ((size_t)(b * 2 + g) * 64 + rr) * CL + 64 * (kt - 5) + 8 * ch;
            kr = *(const u32x4*)kp; vr = *(const u32x4*)vp;
        };
        fetch_tile(0, kreg[0], vreg[0]);
        fetch_tile(1, kreg[1], vreg[1]);
        int par = 0;
        __syncthreads();
#pragma unroll
        for (int kt = 0; kt < 9; ++kt) {
            const bool ok = tile_ok(kt);
            LAS bf16_t* Ks = Ks0 + par * (2 * 64 * KP); LAS bf16_t* Vs = Ks + 64 * KP;
            if (ok) {
                *(LAS u32x4*)(Ks + rr * KP + 8 * ch) = kreg[kt % 3]; *(LAS u32x4*)(Vs + rr * KP + 8 * ch) = vreg[kt % 3];
                __syncthreads();
            }
            if (kt + 2 < 9) fetch_tile(kt + 2, kreg[(kt + 2) % 3], vreg[(kt + 2) % 3]);
            if (ok) {
                f32x16 X0, X1;
#pragma unroll
                for (int r = 0; r < 16; ++r) { X0[r] = 0.f; X1[r] = 0.f; }
#pragma unroll
                for (int s = 0; s < 4; ++s) {
                    const bf16x8 k0 = *(const LAS bf16x8*)(Ks + qi * KP + 16 * s + 8 * hf), k1 = *(const LAS bf16x8*)(Ks + (32 + qi) * KP + 16 * s + 8 * hf);
                    X0 = __builtin_amdgcn_mfma_f32_32x32x16_bf16(k0, qf[s], X0, 0, 0, 0);
                    X1 = __builtin_amdgcn_mfma_f32_32x32x16_bf16(k1, qf[s], X1, 0, 0, 0);
                }
                if (kt == 0 || kt == 4) {
#pragma unroll
                    for (int r = 0; r < 16; ++r) { const int k0i = (r & 3) + 8 * (r >> 2) + 4 * hf, k1i = 32 + k0i;
                        const bool v0 = (kt == 0) ? (k0i >= qloc) : (k0i <= qloc), v1 = (kt == 0) ? (k1i >= qloc) : (k1i <= qloc);
                        X0[r] = v0 ? X0[r] : -1e30f; X1[r] = v1 ? X1[r] : -1e30f; }
                }
                float mx0 = X0[0], mx1 = X1[0];
#pragma unroll
                for (int r = 1; r < 16; ++r) { mx0 = __builtin_fmaxf(mx0, X0[r]); mx1 = __builtin_fmaxf(mx1, X1[r]); }
                float mx = __builtin_fmaxf(mx0, mx1);
                mx = __builtin_fmaxf(mx, __shfl_xor(mx, 32));
                const float mn = __builtin_fmaxf(m, mx);
                if (__any(mn > m)) {
                    const float alpha = __builtin_amdgcn_exp2f(m - mn);
                    lsum *= alpha;
#pragma unroll
                    for (int r = 0; r < 16; ++r) { O0[r] *= alpha; O1[r] *= alpha; }
                    m = mn;
                }
                float ps0 = 0.f, ps1 = 0.f;
#pragma unroll
                for (int r = 0; r < 16; ++r) { X0[r] = __builtin_amdgcn_exp2f(X0[r] - m); X1[r] = __builtin_amdgcn_exp2f(X1[r] - m); ps0 += X0[r]; ps1 += X1[r]; }
                lsum += ps0 + ps1;
#pragma unroll
                for (int kg = 0; kg < 2; ++kg)
#pragma unroll
                    for (int s2 = 0; s2 < 2; ++s2) {
                        bf16x8 pf;
#pragma unroll
                        for (int j = 0; j < 4; ++j) { const float p0 = kg ? X1[8 * s2 + 2 * j] : X0[8 * s2 + 2 * j], p1 = kg ? X1[8 * s2 + 2 * j + 1] : X0[8 * s2 + 2 * j + 1];
                            const unsigned w = cvt_pk_bf16(p0, p1); pf[2 * j] = (short)(w & 0xffff); pf[2 * j + 1] = (short)(w >> 16); }
                        const int kb = 32 * kg + 16 * s2 + 4 * hf;
#pragma unroll
                        for (int dg = 0; dg < 2; ++dg) {
                            const LAS bf16_t* vr = Vs + (32 * dg + qi) * KP + kb;
                            const s16x4 va = *(const LAS s16x4*)vr, vb = *(const LAS s16x4*)(vr + 8);
                            bf16x8 vf; vf[0] = va[0]; vf[1] = va[1]; vf[2] = va[2]; vf[3] = va[3]; vf[4] = vb[0]; vf[5] = vb[1]; vf[6] = vb[2]; vf[7] = vb[3];
                            if (dg == 0) O0 = __builtin_amdgcn_mfma_f32_32x32x16_bf16(vf, pf, O0, 0, 0, 0);
                            else O1 = __builtin_amdgcn_mfma_f32_32x32x16_bf16(vf, pf, O1, 0, 0, 0);
                        }
                    }
                par ^= 1;
            }
        }
        const float ltot = lsum + __shfl_xor(lsum, 32);
        const float inv = 1.0f / ltot;
        bf16_t* op = ATT + qrow * 512 + head * 64;
#pragma unroll
        for (int dg = 0; dg < 2; ++dg)
#pragma unroll
            for (int rq = 0; rq < 4; ++rq) {
                const int d0 = 32 * dg + 8 * rq + 4 * hf;
                u32x2 w;
                if (dg == 0) { w.x = cvt_pk_bf16(O0[4 * rq] * inv, O0[4 * rq + 1] * inv); w.y = cvt_pk_bf16(O0[4 * rq + 2] * inv, O0[4 * rq + 3] * inv); }
                else { w.x = cvt_pk_bf16(O1[4 * rq] * inv, O1[4 * rq + 1] * inv); w.y = cvt_pk_bf16(O1[4 * rq + 2] * inv, O1[4 * rq + 3] * inv); }
                *(u32x2*)(op + d0) = w;
            }
    }
}

template <int CTRL> __device__ __forceinline__ float dpp_add(float x) {
    return x + __builtin_bit_cast(float, __builtin_amdgcn_update_dpp(0, __builtin_bit_cast(int, x), CTRL, 0xf, 0xf, false));
}
__device__ __forceinline__ float row16_sum(float x) { x = dpp_add<0x128>(x); x = dpp_add<0x124>(x); x = dpp_add<0x122>(x); x = dpp_add<0x121>(x); return x; }
template <int VAR> __device__ __forceinline__ void p4_scan(const Args& a, LAS unsigned char* lds, int tid, int lane, int wave, int G) {
    unsigned char* ws = a.ws;
    const bf16_t* FB = (const bf16_t*)(ws + WS_FEAT);
    constexpr int TS = 32, NBLK = (CL + SEQ) / TS;
    constexpr int OPF = TS * 5 * 64;
    LAS float* OPS = (LAS float*)lds;
    LAS float* VB = OPS + 2 * OPF;
    LAS float* YBUF = VB + 2 * TS * 32;
    const int rl = 4 * wave + (lane >> 4), cg = lane & 15;
    for (int unit = blockIdx.x; unit < NB * NH * 4; unit += G) {
        const int half = unit & 1, dir = (unit >> 1) & 1, h = (unit >> 2) & 7, b = unit >> 5;
        const size_t astr = FEAT_STRIDE / 2;
        const bf16_t* arrp[5] = { FB + (size_t)(dir ? F_WB : F_WF) * astr, FB + (size_t)F_A * astr, FB + (size_t)(dir ? F_BB : F_BF) * astr, FB + (size_t)(dir ? F_KB : F_KF) * astr, FB + (size_t)F_R * astr };
        const bf16_t* vp = FB + (size_t)F_V * astr;
        bf16_t* Y = (bf16_t*)(ws + (dir ? WS_YB : WS_YF));
        auto row_of = [&](int s) -> int { return (s < CL) ? (T + b * CL + (dir ? (CL - 1 - s) : s)) : (b * SEQ + (dir ? (SEQ - 1 - (s - CL)) : (s - CL))); };
        u32x2 pre[6];
        auto fetch = [&](int blk) {
#pragma unroll
            for (int it = 0; it < 6; ++it) { const int q = tid + 512 * it; pre[it] = (u32x2){0u, 0u};
                if (q < TS * 88) { const int st = q / 88, rem = q % 88; const int row = row_of(blk * TS + st);
                    if (rem < 80) { const int ar = rem >> 4, ci = rem & 15; const bf16_t* p = (ar == 0 ? arrp[0] : ar == 1 ? arrp[1] : ar == 2 ? arrp[2] : ar == 3 ? arrp[3] : arrp[4]);
                        pre[it] = *(const u32x2*)(p + (size_t)row * RD + h * 64 + 4 * ci); }
                    else { const int ci = rem - 80; pre[it] = *(const u32x2*)(vp + (size_t)row * RD + h * 64 + half * 32 + 4 * ci); } } }
        };
        auto commit = [&](int buf) {
#pragma unroll
            for (int it = 0; it < 6; ++it) { const int q = tid + 512 * it;
                if (q < TS * 88) { const int st = q / 88, rem = q % 88;
                    f32x4 v = (f32x4){lo16(pre[it].x), hi16(pre[it].x), lo16(pre[it].y), hi16(pre[it].y)};
                    if (SCAN_CHUNKED && rem < 16) { v[0] = __expf(v[0]) - 1.0f; v[1] = __expf(v[1]) - 1.0f; v[2] = __expf(v[2]) - 1.0f; v[3] = __expf(v[3]) - 1.0f; }
                    if (rem < 80) *(LAS f32x4*)(OPS + buf * OPF + st * 320 + rem * 4) = v;
                    else *(LAS f32x4*)(VB + buf * TS * 32 + st * 32 + (rem - 80) * 4) = v; } }
        };
        __syncthreads();
        fetch(0); commit(0);
        __syncthreads();
        f32x4 S = (f32x4){0.f, 0.f, 0.f, 0.f};
        for (int blk = 0; blk < NBLK; ++blk) {
            const int buf = blk & 1;
            if (blk + 1 < NBLK) fetch(blk + 1);
            const LAS float* ob = OPS + buf * OPF + 4 * cg; const LAS float* vb = VB + buf * TS * 32 + rl; LAS float* yb = YBUF + buf * TS * 32 + rl;
            float ykeep = 0.f;
            f32x4 qw[3], qa[3], qb[3], qk[3], qr[3]; float qv[3];
#define SCAN_LOAD(st_, sl_) do { qw[sl_] = *(const LAS f32x4*)(ob + (st_) * 320); qa[sl_] = *(const LAS f32x4*)(ob + (st_) * 320 + 64); qb[sl_] = *(const LAS f32x4*)(ob + (st_) * 320 + 128); \
                qk[sl_] = *(const LAS f32x4*)(ob + (st_) * 320 + 192); qr[sl_] = *(const LAS f32x4*)(ob + (st_) * 320 + 256); qv[sl_] = vb[(st_) * 32]; } while (0)
            SCAN_LOAD(0, 0); SCAN_LOAD(1, 1);
#pragma unroll
            for (int st = 0; st < TS; ++st) {
                if (st + 2 < TS && (VAR != 2 || st < 1)) SCAN_LOAD(st + 2, (st + 2) % 3);
                const f32x4 ow = qw[st % 3], av = DBG_NOA ? (f32x4){0.f, 0.f, 0.f, 0.f} : qa[st % 3], bv = DBG_NOB ? (f32x4){0.f, 0.f, 0.f, 0.f} : qb[st % 3], kv = qk[st % 3], rv = qr[st % 3]; const float vi = qv[st % 3];
                float sa = fmaf(S[3], av[3], fmaf(S[2], av[2], fmaf(S[1], av[1], S[0] * av[0])));
                const f32x4 S1 = S + S * ow + kv * vi;
                if (VAR != 1) sa = row16_sum(sa);
                S = S1 + bv * sa;
                float y = fmaf(S[3], rv[3], fmaf(S[2], rv[2], fmaf(S[1], rv[1], S[0] * rv[0])));
                if (VAR != 1) y = row16_sum(y);
                ykeep = (cg == (st & 15)) ? y : ykeep;
                if ((st & 15) == 15) yb[((st & ~15) + cg) * 32] = ykeep;
            }
#undef SCAN_LOAD
            if (blk + 1 < NBLK) commit(buf ^ 1);
            __syncthreads();
            if (blk >= CL / TS) {
                const int st = tid >> 4, pr = tid & 15;
                const int row = row_of(blk * TS + st);
                const float y0 = YBUF[buf * TS * 32 + st * 32 + 2 * pr], y1 = YBUF[buf * TS * 32 + st * 32 + 2 * pr + 1];
                *(unsigned*)(Y + (size_t)row * RD + h * 64 + half * 32 + 2 * pr) = pk2(y0, y1);
            }
        }
    }
}

constexpr int CS_SLOT = 16384, CS_AT = 0, CS_RT = 2304, CS_BH = 4608, CS_KH = 6912, CS_VV = 9216, CS_AAK = 11520, CS_TT = 12800, CS_ARK = 14080, CS_GC = 15360;
constexpr int CS_SCR = 4 * CS_SLOT, CS_SCR_BYTES = 6144, CS_BT = 0, CS_KT = 2304, CS_NN = 4608, CS_FLAGS = CS_SCR + 4 * CS_SCR_BYTES;
typedef short v4i16_t __attribute__((ext_vector_type(4)));
__device__ __forceinline__ bf16x8 pack8(f32x4 x, f32x4 y) {
    u32x4 w; w.x = cvt_pk_bf16(x[0], x[1]); w.y = cvt_pk_bf16(x[2], x[3]); w.z = cvt_pk_bf16(y[0], y[1]); w.w = cvt_pk_bf16(y[2], y[3]);
    return __builtin_bit_cast(bf16x8, w);
}
__device__ __forceinline__ bf16x8 join8(s16x4 x, s16x4 y) { bf16x8 r; r[0] = x[0]; r[1] = x[1]; r[2] = x[2]; r[3] = x[3]; r[4] = y[0]; r[5] = y[1]; r[6] = y[2]; r[7] = y[3]; return r; }
__device__ __forceinline__ s16x4 lds_tr4(const LAS unsigned char* p) { return __builtin_bit_cast(s16x4, __builtin_amdgcn_ds_read_tr16_b64_v4i16((LAS v4i16_t*)p)); }
template <int CTRL> __device__ __forceinline__ float dpp_shr_add(float x) {
    return x + __builtin_bit_cast(float, __builtin_amdgcn_update_dpp(0, __builtin_bit_cast(int, x), CTRL, 0xf, 0xf, true));
}
template <bool TEST> __device__ __forceinline__ void p4_scan_chunked(const Args& a, LAS unsigned char* lds, int tid, int lane, int wave, int G) {
    unsigned char* ws = a.ws;
    const bf16_t* FB = (const bf16_t*)(ws + WS_FEAT);
    const size_t astr = FEAT_STRIDE / 2;
    constexpr int NCH = (CL + SEQ) / 16;
    volatile LAS unsigned* flags = (volatile LAS unsigned*)(lds + CS_FLAGS);
    for (int unit = blockIdx.x; unit < NB * NH * 2; unit += G) {
        const int dir = unit & 1, h = (unit >> 1) & 7, b = unit >> 4;
        __syncthreads();
        for (int i = tid; i < (CS_FLAGS + 64) / 16; i += 512) *(LAS u32x4*)(lds + 16 * i) = (u32x4){0u, 0u, 0u, 0u};
        __syncthreads();
        auto row_of = [&](int s) -> int { return (s < CL) ? (T + b * CL + (dir ? (CL - 1 - s) : s)) : (b * SEQ + (dir ? (SEQ - 1 - (s - CL)) : (s - CL))); };
        if (wave < 4) {
            const int il = lane & 15, g = lane >> 4, ich = 16 * wave + il;
            bf16_t* Y = (bf16_t*)(ws + (dir ? WS_YB : WS_YF));
            f32x4 ST[4];
#pragma unroll
            for (int jt = 0; jt < 4; ++jt) ST[jt] = (f32x4){0.f, 0.f, 0.f, 0.f};
            const f32x4 zero4 = (f32x4){0.f, 0.f, 0.f, 0.f}; const s16x4 z16 = (s16x4){0, 0, 0, 0};
            const int troff = (4 * g + (il >> 2)) * 144 + 8 * (il & 3);
            for (int c = 0; c < NCH; ++c) {
                const int slot = c & 3; LAS unsigned char* sb = lds + slot * CS_SLOT;
                while (flags[slot] != (unsigned)(c + 1)) __builtin_amdgcn_s_sleep(1);
                __builtin_amdgcn_fence(__ATOMIC_ACQUIRE, "workgroup");
#ifdef PROBE_SCANV
                if (a.bar_region && PROBE_SCANV == 1) { if (lane == 0) __hip_atomic_fetch_add((LAS unsigned*)(lds + CS_FLAGS) + 4 + slot, 1u, __ATOMIC_RELEASE, __HIP_MEMORY_SCOPE_WORKGROUP); continue; }
#endif
                const bf16x8 sf0 = pack8(ST[0], ST[1]), sf1 = pack8(ST[2], ST[3]);
                const LAS unsigned char* atp = sb + CS_AT + il * 144 + 8 * g;
                const bf16x8 a0 = join8(*(const LAS s16x4*)(atp), *(const LAS s16x4*)(atp + 32)), a1 = join8(*(const LAS s16x4*)(atp + 64), *(const LAS s16x4*)(atp + 96));
                const LAS unsigned char* rtp = sb + CS_RT + il * 144 + 8 * g;
                const bf16x8 r0 = join8(*(const LAS s16x4*)(rtp), *(const LAS s16x4*)(rtp + 32)), r1 = join8(*(const LAS s16x4*)(rtp + 64), *(const LAS s16x4*)(rtp + 96));
                const bf16x8 aak = *(const LAS bf16x8*)(sb + CS_AAK + il * 80 + 16 * g);
                const bf16x8 ttf = *(const LAS bf16x8*)(sb + CS_TT + il * 80 + 16 * g);
                const bf16x8 ark = *(const LAS bf16x8*)(sb + CS_ARK + il * 80 + 16 * g);
                const s16x4 vv = lds_tr4(sb + CS_VV + troff + 32 * wave);
                f32x4 zw1 = zero4, zyy = zero4, zuu = zero4; asm volatile("" : "+v"(zw1), "+v"(zyy), "+v"(zuu));
                f32x4 w1 = __builtin_amdgcn_mfma_f32_16x16x32_bf16(a0, sf0, zw1, 0, 0, 0);
                w1 = __builtin_amdgcn_mfma_f32_16x16x32_bf16(a1, sf1, w1, 0, 0, 0);
                w1 = __builtin_amdgcn_mfma_f32_16x16x32_bf16(aak, join8(vv, z16), w1, 0, 0, 0);
                f32x4 yy = __builtin_amdgcn_mfma_f32_16x16x32_bf16(r0, sf0, zyy, 0, 0, 0);
                yy = __builtin_amdgcn_mfma_f32_16x16x32_bf16(r1, sf1, yy, 0, 0, 0);
                const bf16x8 w1f = pack8(w1, zero4);
                const f32x4 uu = __builtin_amdgcn_mfma_f32_16x16x32_bf16(ttf, w1f, zuu, 0, 0, 0);
                bf16x8 uv; { u32x4 w; w.x = cvt_pk_bf16(uu[0], uu[1]); w.y = cvt_pk_bf16(uu[2], uu[3]); const u32x2 v2 = __builtin_bit_cast(u32x2, vv); w.z = v2.x; w.w = v2.y; uv = __builtin_bit_cast(bf16x8, w); }
#pragma unroll
                for (int jt = 0; jt < 4; ++jt) {
                    const f32x4 gc = *(const LAS f32x4*)(sb + CS_GC + (16 * jt + 4 * g) * 4);
                    const bf16x8 bk = join8(lds_tr4(sb + CS_BH + troff + 32 * jt), lds_tr4(sb + CS_KH + troff + 32 * jt));
                    ST[jt] = __builtin_amdgcn_mfma_f32_16x16x32_bf16(bk, uv, ST[jt] * gc, 0, 0, 0);
                }
                yy = __builtin_amdgcn_mfma_f32_16x16x32_bf16(ark, uv, yy, 0, 0, 0);
                asm volatile("s_waitcnt lgkmcnt(0)" ::: "memory");
                if (lane == 0) __hip_atomic_fetch_add((LAS unsigned*)(lds + CS_FLAGS) + 4 + slot, 1u, __ATOMIC_RELEASE, __HIP_MEMORY_SCOPE_WORKGROUP);
                if (c >= CL / 16) {
#pragma unroll
                    for (int rg = 0; rg < 4; ++rg) { const int row = row_of(16 * c + 4 * g + rg); Y[(size_t)row * RD + h * 64 + ich] = (bf16_t)f2bf(yy[rg]); }
                }
            }
        } else {
            const int p = wave - 4, jg = lane >> 4, t = lane & 15;
            LAS unsigned char* scr = lds + CS_SCR + p * CS_SCR_BYTES;
            u32x4 raw[6][2];
            auto load_raw = [&](int c) {
                const size_t ro = (size_t)row_of(16 * c + t) * RD + h * 64 + 16 * jg;
#pragma unroll
                for (int hf = 0; hf < 2; ++hf) {
                    raw[0][hf] = *(const u32x4*)(FB + (size_t)(dir ? F_WB : F_WF) * astr + ro + 8 * hf); raw[1][hf] = *(const u32x4*)(FB + (size_t)F_A * astr + ro + 8 * hf);
                    raw[2][hf] = *(const u32x4*)(FB + (size_t)(dir ? F_BB : F_BF) * astr + ro + 8 * hf); raw[3][hf] = *(const u32x4*)(FB + (size_t)(dir ? F_KB : F_KF) * astr + ro + 8 * hf);
                    raw[4][hf] = *(const u32x4*)(FB + (size_t)F_R * astr + ro + 8 * hf); raw[5][hf] = *(const u32x4*)(FB + (size_t)F_V * astr + ro + 8 * hf); }
            };
            load_raw(p);
            const int tn = lane & 15, gq = lane >> 4;
            for (int c = p; c < NCH; c += 4) {
                const int slot = c & 3; LAS unsigned char* sb = lds + slot * CS_SLOT;
#ifdef PROBE_SCANV
                if (a.bar_region && PROBE_SCANV == 2) { while (flags[4 + slot] != (unsigned)(4 * (c >> 2))) __builtin_amdgcn_s_sleep(1); if (lane == 0) flags[slot] = (unsigned)(c + 1); continue; }
#endif
                float cs[16], lwv[16];
#pragma unroll
                for (int q = 0; q < 8; ++q) { const unsigned w = raw[0][q >> 2][q & 3]; lwv[2 * q] = lo16(w); lwv[2 * q + 1] = hi16(w); }
#pragma unroll
                for (int q = 0; q < 16; ++q) { float x = lwv[q]; x = dpp_shr_add<0x111>(x); x = dpp_shr_add<0x112>(x); x = dpp_shr_add<0x114>(x); x = dpp_shr_add<0x118>(x); cs[q] = x; }
                float Gc[16], Gi[16], Gp[16], G15[16];
#pragma unroll
                for (int q = 0; q < 16; ++q) { Gc[q] = __builtin_amdgcn_exp2f(cs[q] * 1.44269504089f); Gi[q] = __builtin_amdgcn_exp2f(cs[q] * -1.44269504089f);
                    Gp[q] = __builtin_bit_cast(float, __builtin_amdgcn_update_dpp(0x3f800000, __builtin_bit_cast(int, Gc[q]), 0x111, 0xf, 0xf, false));
                    G15[q] = __builtin_bit_cast(float, __builtin_amdgcn_update_dpp(0, __builtin_bit_cast(int, Gc[q]), 0x15F, 0xf, 0xf, false)); }
                while (flags[4 + slot] != (unsigned)(4 * (c >> 2))) __builtin_amdgcn_s_sleep(1);
                __builtin_amdgcn_fence(__ATOMIC_ACQUIRE, "workgroup");
                {
                    u32x4 wa[2], wr[2], wb[2], wk[2], wbh[2], wkh[2];
#pragma unroll
                    for (int q = 0; q < 8; ++q) {
                        const unsigned ua = raw[1][q >> 2][q & 3], ub = raw[2][q >> 2][q & 3], uk = raw[3][q >> 2][q & 3], ur = raw[4][q >> 2][q & 3];
                        const float a0 = lo16(ua) * Gp[2 * q], a1 = hi16(ua) * Gp[2 * q + 1], r0 = lo16(ur) * Gc[2 * q], r1 = hi16(ur) * Gc[2 * q + 1];
                        const float b0 = lo16(ub) * Gi[2 * q], b1 = hi16(ub) * Gi[2 * q + 1], k0 = lo16(uk) * Gi[2 * q], k1 = hi16(uk) * Gi[2 * q + 1];
                        wa[q >> 2][q & 3] = cvt_pk_bf16(a0, a1); wr[q >> 2][q & 3] = cvt_pk_bf16(r0, r1); wb[q >> 2][q & 3] = cvt_pk_bf16(b0, b1); wk[q >> 2][q & 3] = cvt_pk_bf16(k0, k1);
                        wbh[q >> 2][q & 3] = cvt_pk_bf16(b0 * G15[2 * q], b1 * G15[2 * q + 1]); wkh[q >> 2][q & 3] = cvt_pk_bf16(k0 * G15[2 * q], k1 * G15[2 * q + 1]);
                    }
                    const int ro = t * 144 + 32 * jg;
#pragma unroll
                    for (int hf = 0; hf < 2; ++hf) {
                        *(LAS u32x4*)(sb + CS_AT + ro + 16 * hf) = wa[hf]; *(LAS u32x4*)(sb + CS_RT + ro + 16 * hf) = wr[hf];
                        *(LAS u32x4*)(scr + CS_BT + ro + 16 * hf) = wb[hf]; *(LAS u32x4*)(scr + CS_KT + ro + 16 * hf) = wk[hf];
                        *(LAS u32x4*)(sb + CS_BH + ro + 16 * hf) = wbh[hf]; *(LAS u32x4*)(sb + CS_KH + ro + 16 * hf) = wkh[hf];
                        *(LAS u32x4*)(sb + CS_VV + ro + 16 * hf) = raw[5][hf];
                    }
                    if (t == 15) {
#pragma unroll
                        for (int q = 0; q < 4; ++q) *(LAS f32x4*)(sb + CS_GC + (16 * jg + 4 * q) * 4) = (f32x4){Gc[4 * q], Gc[4 * q + 1], Gc[4 * q + 2], Gc[4 * q + 3]};
                    }
                }
                if (c + 4 < NCH) load_raw(c + 4);
                asm volatile("s_waitcnt lgkmcnt(0)" ::: "memory");
                f32x4 m0 = (f32x4){0.f, 0.f, 0.f, 0.f}, m1 = m0, m3 = m0, m4 = m0;
                asm volatile("" : "+v"(m0), "+v"(m1), "+v"(m3), "+v"(m4));
#pragma unroll
                for (int ks = 0; ks < 2; ++ks) {
                    const bf16x8 xa = *(const LAS bf16x8*)(sb + CS_AT + tn * 144 + 64 * ks + 16 * gq), xr = *(const LAS bf16x8*)(sb + CS_RT + tn * 144 + 64 * ks + 16 * gq);
                    const bf16x8 yb = *(const LAS bf16x8*)(scr + CS_BT + tn * 144 + 64 * ks + 16 * gq), yk = *(const LAS bf16x8*)(scr + CS_KT + tn * 144 + 64 * ks + 16 * gq);
                    m0 = __builtin_amdgcn_mfma_f32_16x16x32_bf16(yb, xa, m0, 0, 0, 0);
                    m1 = __builtin_amdgcn_mfma_f32_16x16x32_bf16(yk, xa, m1, 0, 0, 0);
                    m3 = __builtin_amdgcn_mfma_f32_16x16x32_bf16(yb, xr, m3, 0, 0, 0);
                    m4 = __builtin_amdgcn_mfma_f32_16x16x32_bf16(yk, xr, m4, 0, 0, 0);
                }
                {
                    f32x4 n0, q1, q3, q4;
#pragma unroll
                    for (int rg = 0; rg < 4; ++rg) { const int s = 4 * gq + rg; const bool lt = s < tn, le = s <= tn;
                        n0[rg] = lt ? m0[rg] : 0.f; q1[rg] = lt ? m1[rg] : 0.f; q3[rg] = le ? m3[rg] : 0.f; q4[rg] = le ? m4[rg] : 0.f;
                        *(LAS float*)(scr + CS_NN + (s * 16 + tn) * 4) = n0[rg]; }
                    u32x2 w1; w1.x = cvt_pk_bf16(q1[0], q1[1]); w1.y = cvt_pk_bf16(q1[2], q1[3]);
                    *(LAS u32x2*)(sb + CS_AAK + tn * 80 + 16 * gq) = w1;
                    u32x4 w3; w3.x = cvt_pk_bf16(q3[0], q3[1]); w3.y = cvt_pk_bf16(q3[2], q3[3]); w3.z = cvt_pk_bf16(q4[0], q4[1]); w3.w = cvt_pk_bf16(q4[2], q4[3]);
                    *(LAS u32x4*)(sb + CS_ARK + tn * 80 + 16 * gq) = w3;
                }
                asm volatile("s_waitcnt lgkmcnt(0)" ::: "memory");
                float Tc[16];
#pragma unroll
                for (int s = 0; s < 16; ++s) Tc[s] = (s == tn) ? 1.0f : 0.0f;
                {
                    const LAS f32x4* NR = (const LAS f32x4*)(scr + CS_NN);
                    f32x4 cq[4], nq[4];
#pragma unroll
                    for (int k = 0; k < 4; ++k) { cq[k] = NR[4 * 14 + k]; nq[k] = cq[k]; }
#pragma unroll
                    for (int s = 14; s >= 0; --s) {
                        if (s > 0) {
#pragma unroll
                            for (int k = 0; k < 4; ++k) if (4 * k + 3 > s - 1) nq[k] = NR[4 * (s - 1) + k];
                        }
                        float acc0 = 0.f, acc1 = 0.f;
#pragma unroll
                        for (int q = s + 1; q < 16; ++q) { if (q & 1) acc1 += Tc[q] * cq[q >> 2][q & 3]; else acc0 += Tc[q] * cq[q >> 2][q & 3]; }
                        Tc[s] = (s < tn) ? (acc0 + acc1) : Tc[s];
#pragma unroll
                        for (int k = 0; k < 4; ++k) cq[k] = nq[k];
                    }
                }
                if (lane < 16) {
#pragma unroll
                    for (int g4 = 0; g4 < 4; ++g4) { u32x2 w; w.x = cvt_pk_bf16(Tc[4 * g4], Tc[4 * g4 + 1]); w.y = cvt_pk_bf16(Tc[4 * g4 + 2], Tc[4 * g4 + 3]); *(LAS u32x2*)(sb + CS_TT + tn * 80 + 16 * g4) = w; }
                }
                __builtin_amdgcn_fence(__ATOMIC_RELEASE, "workgroup");
                asm volatile("s_waitcnt lgkmcnt(0)" ::: "memory");
                if (lane == 0) flags[slot] = (unsigned)(c + 1);
            }
        }
    }
}

__device__ __forceinline__ void p5_rwkv_out(const Args& a, int lane, int wave, int G) {
    unsigned char* ws = a.ws;
    const bf16_t* FB = (const bf16_t*)(ws + WS_FEAT); const size_t astr = FEAT_STRIDE / 2;
    const bf16_t* YF = (const bf16_t*)(ws + WS_YF); const bf16_t* YBk = (const bf16_t*)(ws + WS_YB);
    bf16_t* RWK = (bf16_t*)(ws + WS_RWK);
    const int gw = blockIdx.x * 8 + wave, NGW = G * 8;
    const int c0 = 8 * lane;
    float lnw[8], lnb[8], rk[8];
#pragma unroll
    for (int j = 0; j < 8; ++j) { lnw[j] = a.in[I_LNW][c0 + j]; lnb[j] = a.in[I_LNB][c0 + j]; rk[j] = a.in[I_RK][c0 + j]; }
    auto ld8 = [&](const bf16_t* p, float (&o)[8]) { const u32x4 w = *(const u32x4*)p;
#pragma unroll
        for (int j = 0; j < 4; ++j) { o[2 * j] = lo16(w[j]); o[2 * j + 1] = hi16(w[j]); } };
    for (int m = gw; m < T; m += NGW) {
        const size_t o = (size_t)m * RD + c0;
        float yf[8], yb[8], r[8], kf[8], kb[8], v[8], g[8];
        ld8(YF + o, yf); ld8(YBk + o, yb); ld8(FB + F_R * astr + o, r); ld8(FB + F_KF * astr + o, kf); ld8(FB + F_KB * astr + o, kb); ld8(FB + F_V * astr + o, v); ld8(FB + F_G * astr + o, g);
        float s = 0.f, bs = 0.f;
#pragma unroll
        for (int j = 0; j < 8; ++j) { yf[j] += yb[j]; s += yf[j]; bs += r[j] * (kf[j] + kb[j]) * rk[j]; }
        s += __shfl_xor(s, 1); s += __shfl_xor(s, 2); s += __shfl_xor(s, 4);
        bs += __shfl_xor(bs, 1); bs += __shfl_xor(bs, 2); bs += __shfl_xor(bs, 4);
        const float mean = s * (1.f / 64.f); float q = 0.f;
#pragma unroll
        for (int j = 0; j < 8; ++j) { yf[j] -= mean; q += yf[j] * yf[j]; }
        q += __shfl_xor(q, 1); q += __shfl_xor(q, 2); q += __shfl_xor(q, 4);
        const float rstd = 1.0f / sqrtf(q * (1.f / 64.f) + GN_EPS);
        float out[8];
#pragma unroll
        for (int j = 0; j < 8; ++j) out[j] = (yf[j] * rstd * lnw[j] + lnb[j] + bs * v[j]) * g[j];
        u32x4 w; w.x = pk2(out[0], out[1]); w.y = pk2(out[2], out[3]); w.z = pk2(out[4], out[5]); w.w = pk2(out[6], out[7]);
        *(u32x4*)(RWK + o) = w;
    }
}

template <bool PROBE> __device__ __forceinline__ void p9_postmix_router(const Args& a, LAS unsigned char* lds, int tid, int lane, int wave, int G) {
    unsigned char* ws = a.ws;
    const float* MOD = (const float*)(ws + WS_CTL) + CW_MOD;
    const bf16_t* MIX = (const bf16_t*)(ws + WS_MIX);
    bf16_t* HF = (bf16_t*)(ws + (PROBE ? WS_H + 160 * MiB : WS_HF));
    int* cnt = (int*)(ws + WS_CTL) + (PROBE ? 12000 : CW_CNT);
    int* slot_tok = (int*)(ws + (PROBE ? WS_H + 240 * MiB : WS_SLOT_TOK)); float* slot_gate = (float*)(ws + (PROBE ? WS_H + 248 * MiB : WS_SLOT_GATE)); unsigned* tokk = (unsigned*)(ws + (PROBE ? WS_H + 256 * MiB : WS_TOKK));
    constexpr int HP = 1028;
    LAS float* HL = (LAS float*)lds;
    LAS float* PART = HL + 16 * HP;
    LAS int* SEL_E = (LAS int*)(lds + 90112); LAS float* SEL_G = (LAS float*)(lds + 90112 + 2048); LAS int* SEL_M = (LAS int*)(lds + 90112 + 4096);
    LAS int* HIST = (LAS int*)(lds + 90112 + 6144); LAS int* BASE = HIST + 32;
    int nsel = 0;
    const int ti = lane & 15, kq = lane >> 4;
    float wb0[32], wb1[32];
    {
        const float* wr = a.in[I_WROUTER];
#pragma unroll
        for (int ks = 0; ks < 32; ++ks) { const int k = 128 * wave + 4 * ks + kq; wb0[ks] = wr[k * NE + ti]; wb1[ks] = wr[k * NE + 16 + ti]; }
    }
    const float brt = a.in[I_BROUTER][lane & 31];
    for (int unit = blockIdx.x; unit < T / 16; unit += G) {
        const int tok0 = unit * 16;
        __syncthreads();
        {
            const int m0 = tok0 + 2 * wave; const int b = m0 >> 12;
            f32x4 v[2][4]; float s[2] = {0.f, 0.f};
#pragma unroll
            for (int tt = 0; tt < 2; ++tt) { const u32x2* mr = (const u32x2*)(MIX + (size_t)(m0 + tt) * D) + lane;
#pragma unroll
                for (int j = 0; j < 4; ++j) { const u32x2 w = mr[64 * j]; v[tt][j] = (f32x4){lo16(w.x), hi16(w.x), lo16(w.y), hi16(w.y)}; s[tt] += (v[tt][j].x * v[tt][j].x + v[tt][j].y * v[tt][j].y) + (v[tt][j].z * v[tt][j].z + v[tt][j].w * v[tt][j].w); } }
            f32x4 xv[2][4];
#pragma unroll
            for (int tt = 0; tt < 2; ++tt) { const f32x4* xr = (const f32x4*)(a.in[I_X] + (size_t)(m0 + tt) * D) + lane;
#pragma unroll
                for (int j = 0; j < 4; ++j) xv[tt][j] = xr[64 * j]; }
#pragma unroll
            for (int o = 1; o < 64; o <<= 1) { s[0] += __shfl_xor(s[0], o); s[1] += __shfl_xor(s[1], o); }
            float s2[2] = {0.f, 0.f};
#pragma unroll
            for (int j = 0; j < 4; ++j) {
                const f32x4 g = ((const f32x4*)a.in[I_GPOSTMIX])[64 * j + lane], gt = ((const f32x4*)(MOD + b * 6144 + 2048))[64 * j + lane];
#pragma unroll
                for (int tt = 0; tt < 2; ++tt) {
                    const float rstd = __builtin_amdgcn_rsqf(s[tt] * (1.f / D) + RMS_EPS);
                    v[tt][j] = xv[tt][j] + gt * (v[tt][j] * rstd * g);
                    s2[tt] += (v[tt][j].x * v[tt][j].x + v[tt][j].y * v[tt][j].y) + (v[tt][j].z * v[tt][j].z + v[tt][j].w * v[tt][j].w);
                }
            }
#pragma unroll
            for (int o = 1; o < 64; o <<= 1) { s2[0] += __shfl_xor(s2[0], o); s2[1] += __shfl_xor(s2[1], o); }
#pragma unroll
            for (int j = 0; j < 4; ++j) {
                const f32x4 g = ((const f32x4*)a.in[I_GPREFFN])[64 * j + lane], sh = ((const f32x4*)(MOD + b * 6144 + 3072))[64 * j + lane], sc = ((const f32x4*)(MOD + b * 6144 + 4096))[64 * j + lane];
#pragma unroll
                for (int tt = 0; tt < 2; ++tt) {
                    const float rstd2 = __builtin_amdgcn_rsqf(s2[tt] * (1.f / D) + RMS_EPS);
                    const f32x4 hv = (v[tt][j] * rstd2 * g) * (sc + 1.0f) + sh;
                    ((unsigned*)((unsigned char*)HF + (size_t)(m0 + tt) * D))[64 * j + lane] = pk4_fp8(hv.x * F8_ASCALE, hv.y * F8_ASCALE, hv.z * F8_ASCALE, hv.w * F8_ASCALE);
                    *(LAS f32x4*)(HL + (2 * wave + tt) * HP + 256 * j + 4 * lane) = hv;
                }
            }
        }
        __syncthreads();
        {
            f32x4 acc0 = (f32x4){0.f, 0.f, 0.f, 0.f}, acc1 = acc0;
#pragma unroll
            for (int ks = 0; ks < 32; ++ks) {
                const float av = HL[ti * HP + 128 * wave + 4 * ks + kq];
                acc0 = __builtin_amdgcn_mfma_f32_16x16x4f32(av, wb0[ks], acc0, 0, 0, 0);
                acc1 = __builtin_amdgcn_mfma_f32_16x16x4f32(av, wb1[ks], acc1, 0, 0, 0);
            }
#pragma unroll
            for (int r = 0; r < 4; ++r) { PART[(wave * 16 + 4 * kq + r) * 32 + ti] = acc0[r]; PART[(wave * 16 + 4 * kq + r) * 32 + 16 + ti] = acc1[r]; }
        }
        __syncthreads();
        {
            const int tl = 2 * wave + (lane >> 5); const int m = tok0 + tl;
            const int e = lane & 31;
            float lg = brt;
#pragma unroll
            for (int w = 0; w < 8; ++w) lg += PART[(w * 16 + tl) * 32 + e];
            float tv[4]; int ti4[4];
#pragma unroll
            for (int k = 0; k < 4; ++k) {
                float bv = lg; int bi = e;
#pragma unroll
                for (int o = 1; o < 32; o <<= 1) { const float ov = __shfl_xor(bv, o); const int oi = __shfl_xor(bi, o); if (ov > bv || (ov == bv && oi < bi)) { bv = ov; bi = oi; } }
                tv[k] = bv; ti4[k] = bi;
                if (e == bi) lg = -3.0e38f;
            }
            const float e1 = __expf(tv[1] - tv[0]), e2 = __expf(tv[2] - tv[0]), e3 = __expf(tv[3] - tv[0]);
            const float inv = 1.0f / (1.0f + e1 + e2 + e3);
            if (e < 4) {
                const int ek = e == 0 ? ti4[0] : e == 1 ? ti4[1] : e == 2 ? ti4[2] : ti4[3];
                const float gk = (e == 0 ? 1.0f : e == 1 ? e1 : e == 2 ? e2 : e3) * inv;
                const int si = nsel * 64 + tl * 4 + e;
                SEL_E[si] = ek; SEL_G[si] = gk; SEL_M[si] = m;
            }
        }
        ++nsel;
    }
    __syncthreads();
    if (tid < 32) HIST[tid] = 0;
    __syncthreads();
    int my_e = 0, my_lr = 0; const bool have = tid < nsel * 64;
    if (have) { my_e = SEL_E[tid]; my_lr = __hip_atomic_fetch_add(HIST + my_e, 1, __ATOMIC_RELAXED, __HIP_MEMORY_SCOPE_WORKGROUP); }
    __syncthreads();
    if (tid < 32) { const int n = HIST[tid]; BASE[tid] = n ? atomicAdd(cnt + tid, n) : 0; }
    __syncthreads();
    if (have) { const int rank = BASE[my_e] + my_lr; const int m = SEL_M[tid];
        slot_tok[my_e * T + rank] = m; slot_gate[(size_t)my_e * T + rank] = SEL_G[tid];
        tokk[m * 4 + (tid & 3)] = ((unsigned)my_e << 20) | (unsigned)rank; }
}

__device__ __forceinline__ void moe_table(const Args& a, LAS int* tstart, int tid) {
    const int* cnt = (const int*)(a.ws + WS_CTL) + CW_CNT;
    __syncthreads();
    if (tid < 32) {
        const int n = __hip_atomic_load(cnt + tid, __ATOMIC_RELAXED, __HIP_MEMORY_SCOPE_AGENT); const int tl = (n + 255) >> 8;
        int incl = tl;
#pragma unroll
        for (int o = 1; o < 32; o <<= 1) { const int v = __shfl_up(incl, o, 32); if (tid >= o) incl += v; }
        tstart[tid] = incl - tl; tstart[TCNT_OFF / 4 - RING_BYTES / 4 + tid] = n; if (tid == 31) tstart[NE] = incl;
    }
    __syncthreads();
}

__device__ __forceinline__ void p12_combine(const Args& a, LAS int* tstart, int lane, int wave, int G) {
    unsigned char* ws = a.ws;
    const float* MOD = (const float*)(ws + WS_CTL) + CW_MOD;
    const unsigned char* YB = (const unsigned char*)(ws + WS_YBUF); const unsigned* tokk = (const unsigned*)(ws + WS_TOKK);
    const bf16_t* MIX = (const bf16_t*)(ws + WS_MIX);
    const int gw = blockIdx.x * 8 + wave, NGW = G * 8;
    u32x4 tkn = (gw < T) ? *(const u32x4*)(tokk + gw * 4) : (u32x4){0u, 0u, 0u, 0u};
    for (int m = gw; m < T; m += NGW) {
        const int b = m >> 12;
        const u32x4 tk4 = tkn;
        if (m + NGW < T) tkn = *(const u32x4*)(tokk + (m + NGW) * 4);
        unsigned yw[4][4];
#pragma unroll
        for (int k = 0; k < 4; ++k) {
            const unsigned tk = tk4[k]; const int e = (int)(tk >> 20), rank = (int)(tk & 0xfffffu);
            const unsigned* yr = (const unsigned*)(YB + ((size_t)tstart[e] * 256 + rank) * D) + lane;
#pragma unroll
            for (int j = 0; j < 4; ++j) yw[k][j] = yr[64 * j];
        }
        f32x4 xr[4], mv[4]; float sm = 0.f;
#pragma unroll
        for (int j = 0; j < 4; ++j) { xr[j] = ((const f32x4*)(a.in[I_X] + (size_t)m * D))[64 * j + lane];
            const u32x2 w = ((const u32x2*)(MIX + (size_t)m * D))[64 * j + lane]; mv[j] = (f32x4){lo16(w.x), hi16(w.x), lo16(w.y), hi16(w.y)};
            sm += (mv[j].x * mv[j].x + mv[j].y * mv[j].y) + (mv[j].z * mv[j].z + mv[j].w * mv[j].w); }
        f32x4 y[4]; float s = 0.f;
#pragma unroll
        for (int j = 0; j < 4; ++j) { y[j] = (f32x4){0.f, 0.f, 0.f, 0.f};
#pragma unroll
            for (int k = 0; k < 4; ++k) { const f32x2_t lo = __builtin_amdgcn_cvt_pk_f32_fp8((int)yw[k][j], false), hi = __builtin_amdgcn_cvt_pk_f32_fp8((int)yw[k][j], true); y[j] += (f32x4){lo.x, lo.y, hi.x, hi.y}; }
            s += (y[j][0] * y[j][0] + y[j][1] * y[j][1]) + (y[j][2] * y[j][2] + y[j][3] * y[j][3]); }
#pragma unroll
        for (int o = 1; o < 64; o <<= 1) { s += __shfl_xor(s, o); sm += __shfl_xor(sm, o); }
        const float rstd = __builtin_amdgcn_rsqf(s * (1.f / D) + RMS_EPS * F8_YSCALE * F8_YSCALE);
        const float rstdm = __builtin_amdgcn_rsqf(sm * (1.f / D) + RMS_EPS);
#pragma unroll
        for (int j = 0; j < 4; ++j) {
            const f32x4 g = ((const f32x4*)a.in[I_GPOSTFFN])[64 * j + lane], gt = ((const f32x4*)(MOD + b * 6144 + 5120))[64 * j + lane];
            const f32x4 gm = ((const f32x4*)a.in[I_GPOSTMIX])[64 * j + lane], gtm = ((const f32x4*)(MOD + b * 6144 + 2048))[64 * j + lane];
            const f32x4 x1 = xr[j] + gtm * (mv[j] * rstdm * gm);
            ((f32x4*)(a.out + (size_t)m * D))[64 * j + lane] = x1 + gt * (y[j] * rstd * g);
        }
    }
}

constexpr int N_PHASES = 13;
__global__ void __launch_bounds__(512, 2) mega_fwd(Args args) {
    extern __shared__ __attribute__((aligned(16))) unsigned char lds_raw[];
    LAS unsigned char* lds = (LAS unsigned char*)lds_raw;
    const int tid = threadIdx.x, lane = tid & 63, wave = __builtin_amdgcn_readfirstlane(tid >> 6);
    const int G = gridDim.x;
    volatile LAS unsigned* MISC = (volatile LAS unsigned*)(lds + MISC_OFF);
    LAS int* tstart = (LAS int*)(lds + RING_BYTES);
    for (int u = tid; u < (LDS_BYTES - RING_BYTES) / 4; u += 512) ((LAS unsigned*)(lds + RING_BYTES))[u] = 0u;
    __syncthreads();
    unsigned char* ws = args.ws;
    const int lo = args.ph_lo, hi = args.ph_hi;
    unsigned* barw = (unsigned*)(ws + WS_CTL) + (args.bar_region ? (131072 + (args.bar_region - 1) * 4096) : CW_BAR);
    XcdBarrier bar; bar.bar = barw; bar.x = 0; bar.st = nullptr;
    if (hi - lo > 1) bar = xcd_barrier_post(barw, MISC + 8);
#ifndef PH_MASK
#define PH_MASK 0x1FFF
#endif
#define IN(k) (((PH_MASK >> (k)) & 1) && lo <= (k) && (k) < hi)
#define SEAM(k) do { if (IN(k) && IN((k) + 1)) xcd_barrier(bar); } while (0)

    if (IN(0)) { p0_prologue(args, lds, tid, lane, wave, G); SEAM(0); }
    if (IN(1)) { p1_norm(args, lane, wave, G); SEAM(1); }
    if (IN(2)) {
        SchedProj S{(const char*)(ws + WS_WIN), G, (int)blockIdx.x};
        EpiZ E{(bf16_t*)(ws + WS_Z), (const float*)(ws + WS_MISC)};
        pg8::gemm_phase<1024, EpiZ, SchedProj>(lds, (const char*)(ws + WS_HX), S, E);
        SEAM(2);
    }
    if (IN(3)) { p3a_pointwise(args, tid, G); if (IN(4)) xcd_barrier(bar); p3b_features(args, lds, tid, lane, wave, G); SEAM(3); }
    if (IN(5)) { if (SCAN_CHUNKED && !SCAN_FORCE_DIRECT) p4_scan_chunked<false>(args, lds, tid, lane, wave, G); else p4_scan<0>(args, lds, tid, lane, wave, G);
        p4_attention(args, lds, tid, lane, wave, G);
        moe_weight_copies(args, lds, tid, lane, wave);
        SEAM(5); }
#if DBG_SCAN
    if (IN(6) && blockIdx.x == 0) {
        const bf16_t* Yt = (const bf16_t*)(ws + (DBG_DIR ? WS_YB : WS_YF)); const bf16_t* Y2 = (const bf16_t*)(ws + 272 * MiB);
        LAS float* red = (LAS float*)lds; float* dbg = (float*)(ws + WS_CTL) + 12288;
        int first = -1; float worst = 0.f;
        for (int ci = 0; ci < 256; ++ci) {
            float e2 = 0.f, r2 = 0.f;
            for (int i = tid; i < 16 * 512; i += 512) { const int cc = DBG_DIR ? (255 - ci) : ci; const size_t o = (size_t)(cc * 16) * 512 + i; const float yt = bf2f(Yt[o]), y2 = bf2f(Y2[o]); e2 += (yt - y2) * (yt - y2); r2 += yt * yt; }
            e2 = wave_sum(e2); r2 = wave_sum(r2);
            __syncthreads(); if (lane == 0) { red[wave] = e2; red[8 + wave] = r2; } __syncthreads();
            float E = 0.f, R = 0.f; for (int w8 = 0; w8 < 8; ++w8) { E += red[w8]; R += red[8 + w8]; }
            const float rel = sqrtf(E / fmaxf(R, 1e-20f));
            if (first < 0 && !(rel < 0.03f)) first = ci;
            if (ci == DBG_CHUNK) { worst = rel;
                if (DBG_MODE == 2) { float z = 0.f; for (int i = tid; i < 16 * 512; i += 512) { const int cc = DBG_DIR ? (255 - ci) : ci; z += ((Y2[(size_t)(cc * 16) * 512 + i] & 0x7fff) > 0x7f80) ? 1.f : 0.f; }
                    z = wave_sum(z); __syncthreads(); if (lane == 0) red[16 + wave] = z; __syncthreads(); float Z = 0.f; for (int w8 = 0; w8 < 8; ++w8) Z += red[16 + w8]; worst = Z / 8192.f; } }
        }
        if (tid == 0) dbg[0] = DBG_MODE ? worst : ((first < 0) ? 0.f : (float)(first + 1) / 256.f);
    }
#endif
    if (IN(6)) {
        p5_rwkv_out(args, lane, wave, G);
        SchedDense<512> S{(const char*)(ws + WS_WUPA), G, (int)blockIdx.x};
        EpiUp<false> E{(bf16_t*)(ws + WS_MERGED), (const bf16_t*)(ws + WS_Z)};
        pg8::gemm_phase<512, EpiUp<false>, SchedDense<512>>(lds, (const char*)(ws + WS_ATT), S, E);
        SEAM(6);
    }
    if (IN(7)) {
        SchedDense<512> S{(const char*)(ws + WS_WUPR), G, (int)blockIdx.x};
        EpiUp<true> E{(bf16_t*)(ws + WS_MERGED), (const bf16_t*)(ws + WS_Z)};
        pg8::gemm_phase<512, EpiUp<true>, SchedDense<512>>(lds, (const char*)(ws + WS_RWK), S, E);
        SEAM(7);
    }
    if (IN(8)) {
        SchedDense<1024> S{(const char*)(ws + WS_WOUT), G, (int)blockIdx.x};
        EpiMix E{(bf16_t*)(ws + WS_MIX)};
        pg8::gemm_phase<1024, EpiMix, SchedDense<1024>>(lds, (const char*)(ws + WS_MERGED), S, E);
        SEAM(8);
    }
    if (IN(9)) { p9_postmix_router<false>(args, lds, tid, lane, wave, G); SEAM(9); }
    if (IN(10)) {
        moe_table(args, tstart, tid);
        SchedMoe<8, true, 1> S{(const char*)(ws + WS_WGU), G, (int)blockIdx.x, tstart, (const int*)(ws + WS_CTL) + CW_CNT, (const int*)(ws + WS_SLOT_TOK), (const LAS int*)(lds + TCNT_OFF)};
        EpiMoe1 E{(bf16_t*)(ws + WS_H), args.in[I_BGU]};
        pg8::gemm_phase<1024, EpiMoe1, SchedMoe<8, true, 1>, true>(lds, (const char*)(ws + WS_HF), S, E);
        SEAM(10);
    }
    if (IN(11)) {
        moe_table(args, tstart, tid);
        SchedMoe<4, false, 1> S{(const char*)(ws + WS_WDN), G, (int)blockIdx.x, tstart, (const int*)(ws + WS_CTL) + CW_CNT, (const int*)(ws + WS_SLOT_TOK), (const LAS int*)(lds + TCNT_OFF)};
        EpiMoe2 E{(unsigned char*)(ws + WS_YBUF), args.in[I_BDN], (const float*)(ws + WS_SLOT_GATE), (const LAS int*)(lds + TCNT_OFF)};
        pg8::gemm_phase<1024, EpiMoe2, SchedMoe<4, false, 1>, true>(lds, (const char*)(ws + WS_H), S, E);
        SEAM(11);
    }
    if (IN(12)) { moe_table(args, tstart, tid); p12_combine(args, tstart, lane, wave, G); }
#ifdef PROBE_PHASE
    if (lo == 15 && blockIdx.x == 0 && tid < 32) { unsigned* ctl = (unsigned*)(ws + WS_CTL); if (tid == 0) { ctl[CW_QATT] = 0u; ctl[CW_QTR] = PROBE_QTR0; } ctl[CW_CNT + tid] = 0u; }
    if (lo == 16) p9_postmix_router<true>(args, lds, tid, lane, wave, G);
    if (lo == 18) p4_attention(args, lds, tid, lane, wave, G);
    if (lo == 13) p3a_pointwise(args, tid, G);
    if (lo == 14) p3b_features(args, lds, tid, lane, wave, G);
#endif
#undef IN
#undef SEAM
}

extern "C" void kernel_launch(void* const* d_in, const int* in_sizes, int n_in, void* d_out, int out_size, void* d_ws, size_t ws_size, hipStream_t stream) {
    static int grid = 0;
    if (grid == 0) {
        if (n_in != 38 || out_size != T * D || ws_size < WS_END) { fprintf(stderr, "kernel_launch: unexpected problem shape (n_in %d, out %d, ws %zu)\n", n_in, out_size, ws_size); grid = -1; return; }
        int dev = 0, cus = 0, per_cu = 0;
        if (hipGetDevice(&dev) != hipSuccess || hipDeviceGetAttribute(&cus, hipDeviceAttributeMultiprocessorCount, dev) != hipSuccess) { grid = -1; return; }
        if (hipFuncSetAttribute((const void*)mega_fwd, hipFuncAttributeMaxDynamicSharedMemorySize, LDS_BYTES) != hipSuccess) { fprintf(stderr, "kernel_launch: hipFuncSetAttribute failed\n"); grid = -1; return; }
        if (hipOccupancyMaxActiveBlocksPerMultiprocessor(&per_cu, (const void*)mega_fwd, 512, LDS_BYTES) != hipSuccess || per_cu < 1) fprintf(stderr, "kernel_launch: occupancy query says %d\n", per_cu);
        (void)hipGetLastError();
        grid = cus;
    }
    if (grid < 0) return;
    (void)hipMemsetAsync((char*)d_ws + WS_CTL, 0, CTL_BYTES, stream);
    Args a{};
    for (int i = 0; i < 38; ++i) a.in[i] = (const float*)d_in[i];
    a.out = (float*)d_out; a.ws = (unsigned char*)d_ws;
#if MK_ONE_LAUNCH
    a.ph_lo = 0; a.ph_hi = N_PHASES;
    hipLaunchKernelGGL(mega_fwd, dim3(grid), dim3(512), LDS_BYTES, stream, a);
#ifdef PROBE_PHASE
#ifdef PROBE_PRE
    { a.ph_lo = PROBE_PRE; a.ph_hi = PROBE_PRE + 1; hipLaunchKernelGGL(mega_fwd, dim3(grid), dim3(512), LDS_BYTES, stream, a); }
#endif
    for (int rep = 0; rep < PROBE_REPS; ++rep) { a.ph_lo = PROBE_PHASE; a.ph_hi = PROBE_HI; a.bar_region = 1 + rep; hipLaunchKernelGGL(mega_fwd, dim3(grid), dim3(512), LDS_BYTES, stream, a); }
#endif
#else
    for (int p = 0; p < N_PHASES; ++p) { a.ph_lo = p; a.ph_hi = p + 1; hipLaunchKernelGGL(mega_fwd, dim3(grid), dim3(512), LDS_BYTES, stream, a); }
#endif
}
```

```cpp
#include <hip/hip_runtime.h>
#include <cstdio>
#include <cstdint>

#ifndef MK_ONE_LAUNCH
#define MK_ONE_LAUNCH 1
#endif
#ifndef PROBE_QTR0
#define PROBE_QTR0 0u
#endif
#ifndef PROBE_HI
#define PROBE_HI (PROBE_PHASE + 1)
#endif
#ifndef SCAN_CHUNKED
#define SCAN_CHUNKED 1
#endif
#ifndef SCAN_FORCE_DIRECT
#define SCAN_FORCE_DIRECT 0
#endif
#ifndef DBG_SCAN
#define DBG_SCAN 0
#define DBG_DIR 0
#define DBG_MODE 0
#define DBG_CHUNK 0
#endif
#ifndef DBG_NOA
#define DBG_NOA 0
#define DBG_NOB 0
#endif
#ifndef DBG_D
#define DBG_D 0
#endif
#ifndef DBG_TI
#define DBG_TI 0
#endif
#ifndef CS_LOCKSTEP
#define CS_LOCKSTEP 0
#endif

#define GAS __attribute__((address_space(1)))
#define LAS __attribute__((address_space(3)))
typedef unsigned short bf16_t;
typedef short bf16x8 __attribute__((ext_vector_type(8)));
typedef short s16x4 __attribute__((ext_vector_type(4)));
typedef float f32x4 __attribute__((ext_vector_type(4)));
typedef float f32x16 __attribute__((ext_vector_type(16)));
typedef unsigned u32x4 __attribute__((ext_vector_type(4)));
typedef unsigned u32x2 __attribute__((ext_vector_type(2)));

constexpr int NB = 8, SEQ = 4096, T = NB * SEQ, D = 1024, CL = 256, TC = NB * CL, ROWS = T + TC;
constexpr int NH = 8, HD = 64, NKV = 2, RD = 512;
constexpr int NE = 32, TOPK = 4, DE = 1024;
constexpr int PROJ_SRC = 4736;
constexpr int ZP = 4864;
constexpr int ZC_Q = 0, ZC_K = 512, ZC_V = 640, ZC_R = 768, ZC_RK = 1280, ZC_RV = 1792, ZC_LORA = 2304, ZC_G = 2816;
constexpr int NTILE_N = ZP / 256;
constexpr float RMS_EPS = 1e-6f, GN_EPS = 64e-5f;
constexpr float F8_WSCALE = 32.0f, F8_ASCALE = 4.0f, F8_HSCALE = 8.0f, F8_YSCALE = 32.0f;

constexpr size_t MiB = 1u << 20;
constexpr size_t WS_CTL = 0, CTL_BYTES = 1 * MiB;
constexpr size_t WS_WIN = 1 * MiB;
constexpr size_t WS_WUPA = 11 * MiB, WS_WUPR = 12 * MiB;
constexpr size_t WS_WOUT = 13 * MiB;
constexpr size_t WS_LORA = 15 * MiB;
constexpr size_t WS_MISC = 15 * MiB + 512 * 1024;
constexpr size_t WS_WGU = 16 * MiB;
constexpr size_t WS_WDN = 144 * MiB;
constexpr size_t WS_HX = 208 * MiB;
constexpr size_t WS_YF = 208 * MiB, WS_YB = 240 * MiB;
constexpr size_t WS_HF = 208 * MiB;
constexpr size_t WS_Z = 276 * MiB;
constexpr size_t WS_SLOT_TOK = 272 * MiB;
constexpr size_t WS_FEAT = 599 * MiB;
constexpr size_t FEAT_STRIDE = 34 * MiB;
constexpr size_t WS_MERGED = 769 * MiB;
constexpr size_t WS_MIX = 599 * MiB;
constexpr size_t WS_QR = 939 * MiB;
constexpr size_t WS_RWK = 939 * MiB;
constexpr size_t WS_KA = 971 * MiB;
constexpr size_t WS_VT = 980 * MiB;
constexpr size_t WS_ATT = 990 * MiB;
constexpr size_t WS_SLOT_GATE = 276 * MiB;
constexpr size_t WS_TOKK = 280 * MiB;
constexpr size_t WS_H = 281 * MiB;
constexpr int MAXTILES = 544, MAXSLOT = MAXTILES * 256;
constexpr size_t WS_YBUF = 417 * MiB;
constexpr size_t WS_END = 1024 * MiB;
static_assert(WS_YBUF + (size_t)MAXSLOT * 1024 <= WS_MIX, "ws map");
static_assert(WS_H + (size_t)MAXSLOT * 1024 <= WS_YBUF, "ws map");
static_assert(WS_Z + (size_t)ROWS * ZP * 2 <= WS_FEAT, "ws map");
static_assert(WS_FEAT + 10 * FEAT_STRIDE <= WS_QR, "ws map");
static_assert(WS_ATT + (size_t)T * 512 * 2 <= WS_END, "ws map");
static_assert(WS_VT + 9 * MiB <= WS_ATT && WS_KA + (size_t)ROWS * 128 * 2 <= WS_VT, "ws map");
enum { F_R = 0, F_V, F_A, F_KF, F_KB, F_BF, F_BB, F_WF, F_WB, F_G };
constexpr int CW_BAR = 4096;
constexpr int CW_CNT = 8192;
constexpr int CW_QATT = 8320, CW_QTR = 8384;
constexpr int CW_MOD = 16384;
static_assert((CW_MOD + 9 * 6144) * 4 <= (int)CTL_BYTES, "ctl");

constexpr int RING_BYTES = 131072;
constexpr int MISC_OFF = RING_BYTES + 320;
constexpr int LDS_BYTES = 147456;
constexpr int TCNT_OFF = RING_BYTES + 384;
constexpr int NOFF_OFF = RING_BYTES + 2048;
constexpr int TOK_OFF = RING_BYTES + 10240;
constexpr int SIDE_OFF = RING_BYTES + 12288;
static_assert(SIDE_OFF + 4096 <= LDS_BYTES, "lds map");

#define LDS_WAIT() asm volatile("s_waitcnt lgkmcnt(0)" ::: "memory")
#define VM_WAIT() asm volatile("s_waitcnt vmcnt(0)" ::: "memory")
__device__ __forceinline__ float bf2f(unsigned b) { return __uint_as_float(b << 16); }
__device__ __forceinline__ unsigned f2bf(float f) { unsigned u = __float_as_uint(f); return (u + 0x7fffu + ((u >> 16) & 1u)) >> 16; }
__device__ __forceinline__ unsigned pk2(float lo, float hi) { return f2bf(lo) | (f2bf(hi) << 16); }
__device__ __forceinline__ float lo16(unsigned w) { return __uint_as_float(w << 16); }
__device__ __forceinline__ float hi16(unsigned w) { return __uint_as_float(w & 0xffff0000u); }
__device__ __forceinline__ float sigmoidf_(float x) { return __builtin_amdgcn_rcpf(1.0f + __expf(-x)); }
__device__ __forceinline__ float wave_sum(float v) {
#pragma unroll
    for (int o = 1; o < 64; o <<= 1) v += __shfl_xor(v, o);
    return v;
}

#define XB_TMO      128
#define XB_XCNT(j)  (256  + 64 * (j))
#define XB_XSUB(j)  (1280 + 64 * (j))
#define XB_XGEN(j)  (2304 + 64 * (j))
#define XB_TOP      3328
#define XB_TOPGEN   3392
#define XCD_BAR_WORDS 3456
#define XB_SPIN_CAP (1u << 22)
__device__ __forceinline__ unsigned xb_ld(unsigned* p)              { return __hip_atomic_load(p, __ATOMIC_RELAXED, __HIP_MEMORY_SCOPE_AGENT); }
__device__ __forceinline__ unsigned xb_add(unsigned* p, unsigned v) { return __hip_atomic_fetch_add(p, v, __ATOMIC_RELAXED, __HIP_MEMORY_SCOPE_AGENT); }
__device__ __forceinline__ unsigned xb_xcc_id() { return (unsigned)__builtin_amdgcn_s_getreg((3 << 11) | 20) & 0xFu; }
#define XB_SPIN(cond, bar) do { unsigned _sp = 0; while (cond) { __builtin_amdgcn_s_sleep(1); \
    if ((++_sp & 255u) == 0u) { if (xb_ld(&(bar)[XB_TMO])) break; if (_sp > XB_SPIN_CAP) { atomicAdd(&(bar)[XB_TMO], 1u); break; } } } } while (0)
struct XcdBarrier { unsigned* bar; unsigned x; volatile LAS unsigned* st; };
__device__ __forceinline__ XcdBarrier xcd_barrier_post(unsigned* bar, volatile LAS unsigned* st) {
    XcdBarrier b; b.bar = bar; b.x = xb_xcc_id(); b.st = st;
    if (threadIdx.x == 0) (void)xb_add(&bar[XB_XCNT(b.x)], 1u);
    return b;
}
__device__ __forceinline__ void xcd_barrier_complete(unsigned* bar, unsigned x, unsigned& nloc, unsigned& nx) {
    const unsigned G = gridDim.x * gridDim.y * gridDim.z;
    unsigned sum, cnt, mine, sp = 0u;
    for (;;) {
        sum = 0u; cnt = 0u; mine = 0u;
#pragma unroll
        for (unsigned j = 0; j < 16; ++j) { const unsigned c = xb_ld(&bar[XB_XCNT(j)]); sum += c; cnt += (c > 0u) ? 1u : 0u; mine = (j == x) ? c : mine; }
        if (sum == G) break;
        __builtin_amdgcn_s_sleep(1);
        if ((++sp & 255u) == 0u) { if (xb_ld(&bar[XB_TMO])) break; if (sp > XB_SPIN_CAP) { atomicAdd(&bar[XB_TMO], 1u); break; } }
    }
    nloc = mine > 0u ? mine : 1u; nx = cnt > 0u ? cnt : 1u;
}
__device__ __forceinline__ void xcd_barrier(const XcdBarrier& b) {
    asm volatile("s_waitcnt vmcnt(0)" ::: "memory");
    __syncthreads();
    if (threadIdx.x == 0) {
        unsigned* bar = b.bar;
        __builtin_amdgcn_s_waitcnt(0);
        unsigned nloc = b.st[0], nx = b.st[1];
        if (nloc == 0u) { xcd_barrier_complete(bar, b.x, nloc, nx); b.st[0] = nloc; b.st[1] = nx; }
        const unsigned old = xb_add(&bar[XB_XSUB(b.x)], 1u);
        const unsigned gen = old / nloc;
        if (old + 1u == (gen + 1u) * nloc) {
            __builtin_amdgcn_fence(__ATOMIC_RELEASE, "agent");
            asm volatile("s_waitcnt vmcnt(0)" ::: "memory");
            const unsigned og = xb_add(&bar[XB_TOP], 1u);
            const unsigned tg = og / nx;
            if (og + 1u == (tg + 1u) * nx) xb_add(&bar[XB_TOPGEN], 1u);
            else XB_SPIN(xb_ld(&bar[XB_TOPGEN]) == tg, bar);
            __builtin_amdgcn_fence(__ATOMIC_ACQUIRE, "agent");
            xb_add(&bar[XB_XGEN(b.x)], 1u);
            asm volatile("s_waitcnt vmcnt(0)" ::: "memory");
        } else {
            XB_SPIN(xb_ld(&bar[XB_XGEN(b.x)]) == gen, bar);
            __builtin_amdgcn_fence(__ATOMIC_ACQUIRE, "agent");
            asm volatile("s_waitcnt vmcnt(0)" ::: "memory");
        }
    }
    __syncthreads();
}

namespace pg8 {
constexpr int BM = 256, BK = 64, HALF = 128, HTB = HALF * BK * 2, STAGE_BYTES = 8 * HTB;
__host__ __device__ __forceinline__ int lds_byte(int r, int c) { const int st = (r >> 4) * 2 + (c >> 5), rr = r & 15, cc = c & 31, ob = rr * 64 + cc * 2; return st * 1024 + (ob ^ (((ob >> 9) & 1) << 5)); }
__host__ __device__ __forceinline__ void stage_rc(int b, int& R, int& C) { const int st = b / 1024, sb = b % 1024, swz = sb ^ (((sb >> 9) & 1) << 5); R = (st >> 1) * 16 + swz / 64; C = (st & 1) * 32 + (swz % 64) / 2; }
__host__ __device__ __forceinline__ int perm32(int rho) { const int n = rho >> 4, i = rho & 15; return 8 * (i >> 2) + 4 * n + (i & 3); }

struct GUnit { const char* B; int pm, pn, e, lrow0; };

typedef int i32x8 __attribute__((ext_vector_type(8)));
template <int K, class Epi, class Sched, bool F8 = false>
__device__ __forceinline__ void gemm_phase(LAS unsigned char* lds, const char* Aroot, const Sched& S, const Epi& E) {
    const int tid = threadIdx.x, wid = __builtin_amdgcn_readfirstlane(tid >> 6), lane = tid & 63, wr = wid >> 2, wc = wid & 3, fr = lane & 15, fq = lane >> 4;
    constexpr int EB = F8 ? 1 : 2;
    constexpr int nt = K * EB / (BK * 2);
    static_assert(!Sched::GATHER || nt >= 6, "gather offsets are computed in the second K iteration");
    int Rr[2], Cc[2]; unsigned voffB[2];
#pragma unroll
    for (int i = 0; i < 2; ++i) { int R, C; stage_rc(tid * 16 + i * 8192, R, C); const int Rb = Epi::PERM ? ((R & ~31) + perm32(R & 31)) : R;
        Rr[i] = R; Cc[i] = C; voffB[i] = (unsigned)(Rb * K * EB + C * 2); }
    constexpr size_t kstep = (size_t)(BK * 2);
    constexpr size_t hstep = (size_t)HALF * K * EB;
    const unsigned ldsw = (unsigned)wid * 1024u;
    const int aoff = lds_byte(wr * 64 + fr, fq * 8), boff = lds_byte(wc * 32 + fr, fq * 8);
#define PG8_SA(b, h) (((b) * 2 + (h)) * HTB)
#define PG8_SB(b, h) ((4 + (b) * 2 + (h)) * HTB)
#define PG8_STAGEB(bufoff, gbase) do { _Pragma("unroll") for (int _i = 0; _i < 2; ++_i) \
        __builtin_amdgcn_global_load_lds((const unsigned*)((const char*)(gbase) + voffB[_i]), (LAS unsigned*)(lds + (bufoff) + ldsw + _i * 8192), 16, 0, 0); } while (0)
#define PG8_STAGEA(bufoff, base, o0, o1, kb) do { unsigned _o0 = (o0), _o1 = (o1); asm volatile("" : "+v"(_o0), "+v"(_o1));     \
        const char* _gb = (base) + (size_t)(kb); \
        __builtin_amdgcn_global_load_lds((const unsigned*)(_gb + _o0), (LAS unsigned*)(lds + (bufoff) + ldsw), 16, 0, 0); \
        __builtin_amdgcn_global_load_lds((const unsigned*)(_gb + _o1), (LAS unsigned*)(lds + (bufoff) + ldsw + 8192), 16, 0, 0); } while (0)
#define PG8_LD8(dst, off) do { const u32x4 _p0 = *(const LAS u32x4*)(lds + (off)), _p1 = *(const LAS u32x4*)(lds + (off) + 1024); dst = (i32x8){(int)_p0.x, (int)_p0.y, (int)_p0.z, (int)_p0.w, (int)_p1.x, (int)_p1.y, (int)_p1.z, (int)_p1.w}; } while (0)
#define PG8_LDA(dst, b, h) do { if constexpr (F8) { _Pragma("unroll") for (int m = 0; m < 4; ++m) PG8_LD8(dst##8[m], PG8_SA(b, h) + aoff + m * 2048); } \
        else { _Pragma("unroll") for (int m = 0; m < 4; ++m) _Pragma("unroll") for (int k = 0; k < 2; ++k) dst[m][k] = *(const LAS bf16x8*)(lds + PG8_SA(b, h) + aoff + m * 2048 + k * 1024); } } while (0)
#define PG8_LDB(dst, b, h) do { if constexpr (F8) { _Pragma("unroll") for (int n = 0; n < 2; ++n) PG8_LD8(dst##8[n], PG8_SB(b, h) + boff + n * 2048); } \
        else { _Pragma("unroll") for (int n = 0; n < 2; ++n) _Pragma("unroll") for (int k = 0; k < 2; ++k) dst[n][k] = *(const LAS bf16x8*)(lds + PG8_SB(b, h) + boff + n * 2048 + k * 1024); } } while (0)
#define PG8_MMA(ai, bj, At, Bt) do { __builtin_amdgcn_s_setprio(1); _Pragma("unroll") for (int m = 0; m < 4; ++m) _Pragma("unroll") for (int n = 0; n < 2; ++n) { \
        if constexpr (F8) asm volatile("v_mfma_scale_f32_16x16x128_f8f6f4 %0, %1, %2, %0, %3, %3 op_sel_hi:[0,0,0]" : "+v"(acc[ai][bj][m][n]) : "v"(Bt##8[n]), "v"(At##8[m]), "v"(f8scale)); \
        else { _Pragma("unroll") for (int k = 0; k < 2; ++k) acc[ai][bj][m][n] = __builtin_amdgcn_mfma_f32_16x16x32_bf16(Bt[n][k], At[m][k], acc[ai][bj][m][n], 0, 0, 0); } } \
        __builtin_amdgcn_s_setprio(0); } while (0)
#define PG8_WAIT_V(n) asm volatile("s_waitcnt vmcnt(" #n ")" ::: "memory")
#define PG8_WAIT_L(n) asm volatile("s_waitcnt lgkmcnt(" #n ")" ::: "memory")
#define PG8_BAR __builtin_amdgcn_s_barrier()
#define PG8_SCHED __builtin_amdgcn_sched_barrier(0)
    GUnit cur, nxt; int ui = 0;
    if (!S.next(0, cur)) return;
    f32x4 acc[2][2][4][2];
#pragma unroll
    for (int a = 0; a < 2; ++a)
#pragma unroll
        for (int b = 0; b < 2; ++b)
#pragma unroll
            for (int m = 0; m < 4; ++m)
#pragma unroll
                for (int n = 0; n < 2; ++n) acc[a][b][m][n] = (f32x4){0.f, 0.f, 0.f, 0.f};
    bf16x8 At[4][2], B0[2][2], B1[2][2];
    const int f8scale = 0x7f7f7f7f;
    i32x8 At8[4], B08[2], B18[2];
    unsigned c00, c01, c10, c11;
    const char* cA = Aroot;
    if constexpr (Sched::GATHER) {
        c00 = S.arow(cur, Rr[0]) * (unsigned)(K * EB) + (unsigned)Cc[0] * 2u; c01 = S.arow(cur, Rr[1]) * (unsigned)(K * EB) + (unsigned)Cc[1] * 2u;
        c10 = S.arow(cur, HALF + Rr[0]) * (unsigned)(K * EB) + (unsigned)Cc[0] * 2u; c11 = S.arow(cur, HALF + Rr[1]) * (unsigned)(K * EB) + (unsigned)Cc[1] * 2u;
    } else {
        c00 = (unsigned)(Rr[0] * K * EB + Cc[0] * 2); c01 = (unsigned)(Rr[1] * K * EB + Cc[1] * 2); c10 = c00 + (unsigned)(HALF * K * EB); c11 = c01 + (unsigned)(HALF * K * EB);
        cA = Aroot + (size_t)S.arow(cur, 0) * (size_t)(K * EB);
    }
    const char* cB = cur.B;
    PG8_STAGEB(PG8_SB(0, 0), cB); PG8_STAGEA(PG8_SA(0, 0), cA, c00, c01, 0); PG8_STAGEB(PG8_SB(0, 1), cB + hstep); PG8_STAGEA(PG8_SA(0, 1), cA, c10, c11, 0);
    if (wr == 1) PG8_BAR;
    PG8_WAIT_V(4); PG8_BAR;
    PG8_STAGEB(PG8_SB(1, 0), cB + kstep); PG8_STAGEA(PG8_SA(1, 0), cA, c00, c01, kstep); PG8_STAGEB(PG8_SB(1, 1), cB + hstep + kstep);
    PG8_WAIT_V(6); PG8_BAR;
    for (;;) {
        const bool has_next = S.next(ui + 1, nxt);
        unsigned n00 = c00, n01 = c01, n10 = c10, n11 = c11; const char* nB = cB; const char* nA = cA;
        LAS u32x4* noff_lds = (LAS u32x4*)(lds + NOFF_OFF) + tid;
        if constexpr (Epi::SIDE) __builtin_amdgcn_global_load_lds((const unsigned*)E.side_ptr(cur, tid), (LAS unsigned*)(lds + SIDE_OFF + (ui & 1) * 2048 + wid * 256), 4, 0, 0);
        if (has_next) {
            if constexpr (Sched::GATHER) __builtin_amdgcn_global_load_lds((const unsigned*)S.tok_ptr(nxt, tid), (LAS unsigned*)(lds + TOK_OFF + wid * 256), 4, 0, 0);
            else nA = Aroot + (size_t)S.arow(nxt, 0) * (size_t)(K * EB);
            nB = nxt.B;
        } else if constexpr (Sched::GATHER) { *noff_lds = (u32x4){c00, c01, c10, c11}; }
        for (int t = 0; t < nt; t += 2) {
            const bool last = (t == nt - 2);
            if constexpr (Sched::GATHER) { if (t == 2 && has_next) {
                int tz = tid; asm volatile("" : "+v"(tz));
                int R0, C0, R1, C1; stage_rc(tz * 16, R0, C0); stage_rc(tz * 16 + 8192, R1, C1);
                const LAS int* tk = (const LAS int*)(lds + TOK_OFF);
                u32x4 nn;
                nn.x = S.tok_row(nxt, R0, tk[R0]) * (unsigned)(K * EB) + (unsigned)C0 * 2u; nn.y = S.tok_row(nxt, R1, tk[R1]) * (unsigned)(K * EB) + (unsigned)C1 * 2u;
                nn.z = S.tok_row(nxt, HALF + R0, tk[HALF + R0]) * (unsigned)(K * EB) + (unsigned)C0 * 2u; nn.w = S.tok_row(nxt, HALF + R1, tk[HALF + R1]) * (unsigned)(K * EB) + (unsigned)C1 * 2u;
                *((LAS u32x4*)(lds + NOFF_OFF) + tz) = nn; } }
            const size_t k1 = (size_t)(t + 1) * kstep;
            const size_t k2 = last ? 0 : (size_t)(t + 2) * kstep, k3 = k2 + kstep;
            if constexpr (Sched::GATHER) { if (last) { const u32x4 nn = *noff_lds; n00 = nn.x; n01 = nn.y; n10 = nn.z; n11 = nn.w; } }
            const unsigned a00 = last ? n00 : c00, a01 = last ? n01 : c01, a10 = last ? n10 : c10, a11 = last ? n11 : c11; const char* a2 = last ? nA : cA;
            const char* b2 = last ? nB : cB + (size_t)(t + 2) * kstep; const char* b3 = b2 + kstep;
            PG8_LDB(B0, 0, 0); PG8_SCHED; PG8_LDA(At, 0, 0); PG8_STAGEA(PG8_SA(1, 1), cA, c10, c11, k1);
            PG8_WAIT_L(8); PG8_BAR; PG8_WAIT_L(0); PG8_MMA(0, 0, At, B0); PG8_BAR; PG8_SCHED;
            PG8_LDB(B1, 0, 1); PG8_STAGEB(PG8_SB(0, 0), b2);
            PG8_BAR; PG8_WAIT_L(0); PG8_MMA(0, 1, At, B1); PG8_BAR;
            PG8_LDA(At, 0, 1); PG8_STAGEA(PG8_SA(0, 0), a2, a00, a01, k2);
            PG8_BAR; PG8_WAIT_L(0); PG8_MMA(1, 0, At, B0); PG8_BAR; PG8_SCHED;
            PG8_STAGEB(PG8_SB(0, 1), b2 + hstep);
            PG8_WAIT_V(6); PG8_BAR; PG8_MMA(1, 1, At, B1); PG8_BAR;
            PG8_LDB(B0, 1, 0); PG8_SCHED; PG8_LDA(At, 1, 0); PG8_STAGEA(PG8_SA(0, 1), a2, a10, a11, k2);
            PG8_WAIT_L(8); PG8_BAR; PG8_WAIT_L(0); PG8_MMA(0, 0, At, B0); PG8_BAR; PG8_SCHED;
            PG8_LDB(B1, 1, 1); PG8_STAGEB(PG8_SB(1, 0), b3);
            PG8_BAR; PG8_WAIT_L(0); PG8_MMA(0, 1, At, B1); PG8_BAR;
            PG8_LDA(At, 1, 1); PG8_STAGEA(PG8_SA(1, 0), a2, a00, a01, k3);
            PG8_BAR; PG8_WAIT_L(0); PG8_MMA(1, 0, At, B0); PG8_BAR; PG8_SCHED;
            PG8_STAGEB(PG8_SB(1, 1), b3 + hstep);
            PG8_WAIT_V(6); PG8_BAR; PG8_MMA(1, 1, At, B1); PG8_BAR;
        }
        if (wr == 0) PG8_BAR;
        if constexpr (F8) asm volatile("s_nop 15\n\ts_nop 15" ::: "memory");
        E(acc, cur, wr, wc, fr, fq, lds + (ui & 1) * 2048);
        if (!has_next) break;
#pragma unroll
        for (int a = 0; a < 2; ++a)
#pragma unroll
            for (int b = 0; b < 2; ++b)
#pragma unroll
                for (int m = 0; m < 4; ++m)
#pragma unroll
                    for (int n = 0; n < 2; ++n) acc[a][b][m][n] = (f32x4){0.f, 0.f, 0.f, 0.f};
        cur = nxt; cB = nB; cA = nA; c00 = n00; c01 = n01; c10 = n10; c11 = n11; ++ui;
        if (wr == 1) PG8_BAR;
    }
    PG8_WAIT_V(0);
    PG8_BAR;
#undef PG8_SA
#undef PG8_SB
#undef PG8_STAGEA
#undef PG8_STAGEB
#undef PG8_LDA
#undef PG8_LDB
#undef PG8_MMA
#undef PG8_LD8
#undef PG8_WAIT_V
#undef PG8_WAIT_L
#undef PG8_BAR
#undef PG8_SCHED
}
}
using pg8::GUnit;

struct Args { const float* in[38]; float* out; unsigned char* ws; int ph_lo, ph_hi, bar_region, pad; };
enum { I_X = 0, I_C, I_CTX, I_CCTX, I_WADA, I_BADA, I_GPREMIX, I_GPOSTMIX, I_GPREFFN, I_GPOSTFFN, I_WIN, I_BIN, I_MUP, I_MUN, I_SINKS, I_W0F, I_W0B, I_W2F, I_W2B,
       I_A0F, I_A0B, I_A2F, I_A2B, I_G2, I_KK, I_KA, I_RK, I_LNW, I_LNB, I_WUPA, I_WUPR, I_WOUT, I_WROUTER, I_BROUTER, I_WGU, I_BGU, I_WDN, I_BDN };

__device__ __forceinline__ unsigned pk4_fp8(float a, float b, float c, float d) { int w = 0; w = __builtin_amdgcn_cvt_pk_fp8_f32(a, b, w, false); w = __builtin_amdgcn_cvt_pk_fp8_f32(c, d, w, true); return (unsigned)w; }
typedef float f32x2_t __attribute__((ext_vector_type(2)));
typedef __bf16 bf16x2_t __attribute__((ext_vector_type(2)));
__device__ __forceinline__ unsigned cvt_pk_bf16_asm(float lo, float hi) { unsigned r; asm volatile("v_cvt_pk_bf16_f32 %0, %1, %2" : "=v"(r) : "v"(lo), "v"(hi)); return r; }
__device__ __forceinline__ unsigned cvt_pk_bf16(float lo, float hi) { const f32x2_t v = {lo, hi}; const bf16x2_t b = __builtin_convertvector(v, bf16x2_t); return __builtin_bit_cast(unsigned, b); }

__device__ __forceinline__ void tile_order(int L, int nM, int nN, int& pm, int& pn) {
    const int nwg = nM * nN; int wgid = L;
    { const int q = nwg / 8, r = nwg % 8, xcd = wgid % 8, off = wgid / 8; wgid = (xcd < r ? xcd * (q + 1) : r * (q + 1) + (xcd - r) * q) + off; }
    const int nig = 8 * nN, gid = wgid / nig, fm = gid * 8, gsz = (nM - fm) < 8 ? (nM - fm) : 8;
    pm = fm + ((wgid % nig) % gsz); pn = (wgid % nig) / gsz;
}

struct SchedProj {           static constexpr bool GATHER = false;
    const char* Bt; int G, c;
    __device__ __forceinline__ bool next(int i, GUnit& u) const {
        const int L = i * G + c; constexpr int NXU = 128 * NTILE_N;
        if (L >= NXU + 72) return false;
        int pm, pn;
        if (L < NXU) tile_order(L, 128, NTILE_N, pm, pn); else { const int l2 = L - NXU; pm = 128 + l2 / 9; pn = 2 + l2 % 9; }
        u.pm = pm; u.pn = pn; u.e = 0; u.lrow0 = 0; u.B = Bt + (size_t)pn * 256 * D * 2; return true;
    }
    __device__ __forceinline__ unsigned arow(const GUnit& u, int r) const { return (unsigned)(u.pm * 256 + r); }
};
template <int K> struct SchedDense {
    static constexpr bool GATHER = false;
    const char* Bt; int G, c;
    __device__ __forceinline__ bool next(int i, GUnit& u) const {
        const int L = i * G + c; if (L >= 128 * 4) return false;
        int pm, pn; tile_order(L, 128, 4, pm, pn);
        u.pm = pm; u.pn = pn; u.e = 0; u.lrow0 = 0; u.B = Bt + (size_t)pn * 256 * K * 2; return true;
    }
    __device__ __forceinline__ unsigned arow(const GUnit& u, int r) const { return (unsigned)(u.pm * 256 + r); }
};
template <int NPN, bool GATHER_, int EB = 2> struct SchedMoe {
    static constexpr bool GATHER = GATHER_;
    const char* Bt; int G, c; const LAS int* tstart; const int* cnt; const int* slot_tok; const LAS int* tcnt;
    __device__ __forceinline__ bool next(int i, GUnit& u) const {
        const int L = i * G + c; const int TT = __builtin_amdgcn_readfirstlane(tstart[NE]);
        if (L >= TT * NPN) return false;
        const int rt = L / NPN, pn = L % NPN; int e = 0;
#pragma unroll
        for (int j = 1; j < NE; ++j) e += (tstart[j] <= rt) ? 1 : 0;
        e = __builtin_amdgcn_readfirstlane(e);
        u.pm = rt; u.pn = pn; u.e = e; u.lrow0 = __builtin_amdgcn_readfirstlane((rt - tstart[e]) * 256);
        u.B = Bt + ((size_t)e * (NPN * 256) + (size_t)pn * 256) * DE * EB; return true;
    }
    __device__ __forceinline__ unsigned arow(const GUnit& u, int r) const {
        if (GATHER) { const int lr = u.lrow0 + r; const int n = cnt[u.e]; const unsigned tok = (unsigned)slot_tok[u.e * T + (lr < T ? lr : T - 1)]; return (lr < n) ? tok : 0u; }
        return (unsigned)(u.pm * 256 + r);
    }
    __device__ __forceinline__ const int* tok_ptr(const GUnit& u, int tid) const { const int lr = u.lrow0 + (tid & 255); return slot_tok + u.e * T + (lr < T ? lr : T - 1); }
    __device__ __forceinline__ unsigned tok_row(const GUnit& u, int r, int tok) const { return (u.lrow0 + r < tcnt[u.e]) ? (unsigned)tok : 0u; }
};

struct EpiZ {
    static constexpr bool PERM = true, SIDE = true;
    bf16_t* Z; const float* bias;
    __device__ __forceinline__ const float* side_ptr(const GUnit& u, int tid) const { return bias + u.pn * 256 + (tid & 255); }
    __device__ __forceinline__ void operator()(const f32x4 (&acc)[2][2][4][2], const GUnit& u, int wr, int wc, int fr, int fq, LAS unsigned char* lds) const {
        const int row0 = u.pm * 256 + wr * 64 + fr, col0 = u.pn * 256 + wc * 32 + 8 * fq;
        const LAS float* sb = (const LAS float*)(lds + SIDE_OFF) + 256 + wc * 32 + 8 * fq;
        f32x4 bv[2][2];
#pragma unroll
        for (int bj = 0; bj < 2; ++bj)
#pragma unroll
            for (int n = 0; n < 2; ++n) bv[bj][n] = *(const LAS f32x4*)(sb + bj * 128 + 4 * n);
#pragma unroll
        for (int ai = 0; ai < 2; ++ai)
#pragma unroll
            for (int m = 0; m < 4; ++m) { bf16_t* rowp = Z + (size_t)(row0 + ai * 128 + m * 16) * ZP + col0;
#pragma unroll
                for (int bj = 0; bj < 2; ++bj) { const f32x4 v0 = acc[ai][bj][m][0] + bv[bj][0], v1 = acc[ai][bj][m][1] + bv[bj][1];
                    u32x4 w; w.x = cvt_pk_bf16(v0[0], v0[1]); w.y = cvt_pk_bf16(v0[2], v0[3]); w.z = cvt_pk_bf16(v1[0], v1[1]); w.w = cvt_pk_bf16(v1[2], v1[3]);
                    *(u32x4*)(rowp + bj * 128) = w; } }
    }
};
template <bool SECOND> struct EpiUp {
    static constexpr bool PERM = true, SIDE = false;
    bf16_t* O; const bf16_t* Z;
    __device__ __forceinline__ void operator()(const f32x4 (&acc)[2][2][4][2], const GUnit& u, int wr, int wc, int fr, int fq, LAS unsigned char*) const {
        const int row0 = u.pm * 256 + wr * 64 + fr, col0 = u.pn * 256 + wc * 32 + 8 * fq;
#pragma unroll
        for (int ai = 0; ai < 2; ++ai)
#pragma unroll
            for (int m = 0; m < 4; ++m) { const size_t row = (size_t)(row0 + ai * 128 + m * 16);
#pragma unroll
                for (int bj = 0; bj < 2; ++bj) {
                    const u32x4 g = *(const u32x4*)(Z + row * ZP + ZC_G + (SECOND ? 1024 : 0) + col0 + bj * 128);
                    const f32x4 a0 = acc[ai][bj][m][0], a1 = acc[ai][bj][m][1];
                    float o[8];
                    o[0] = sigmoidf_(lo16(g.x)) * a0[0]; o[1] = sigmoidf_(hi16(g.x)) * a0[1]; o[2] = sigmoidf_(lo16(g.y)) * a0[2]; o[3] = sigmoidf_(hi16(g.y)) * a0[3];
                    o[4] = sigmoidf_(lo16(g.z)) * a1[0]; o[5] = sigmoidf_(hi16(g.z)) * a1[1]; o[6] = sigmoidf_(lo16(g.w)) * a1[2]; o[7] = sigmoidf_(hi16(g.w)) * a1[3];
                    bf16_t* op = O + row * 1024 + col0 + bj * 128;
                    if (SECOND) { const u32x4 p = *(const u32x4*)op;
                        o[0] += lo16(p.x); o[1] += hi16(p.x); o[2] += lo16(p.y); o[3] += hi16(p.y); o[4] += lo16(p.z); o[5] += hi16(p.z); o[6] += lo16(p.w); o[7] += hi16(p.w); }
                    u32x4 w; w.x = cvt_pk_bf16(o[0], o[1]); w.y = cvt_pk_bf16(o[2], o[3]); w.z = cvt_pk_bf16(o[4], o[5]); w.w = cvt_pk_bf16(o[6], o[7]);
                    *(u32x4*)op = w; } }
    }
};
struct EpiMix {
    static constexpr bool PERM = true, SIDE = false;
    bf16_t* C;
    __device__ __forceinline__ void operator()(const f32x4 (&acc)[2][2][4][2], const GUnit& u, int wr, int wc, int fr, int fq, LAS unsigned char*) const {
        const int row0 = u.pm * 256 + wr * 64 + fr, col0 = u.pn * 256 + wc * 32 + 8 * fq;
#pragma unroll
        for (int ai = 0; ai < 2; ++ai)
#pragma unroll
            for (int m = 0; m < 4; ++m) { bf16_t* rowp = C + (size_t)(row0 + ai * 128 + m * 16) * 1024 + col0;
#pragma unroll
                for (int bj = 0; bj < 2; ++bj) { const f32x4 v0 = acc[ai][bj][m][0], v1 = acc[ai][bj][m][1];
                    u32x4 w; w.x = cvt_pk_bf16(v0[0], v0[1]); w.y = cvt_pk_bf16(v0[2], v0[3]); w.z = cvt_pk_bf16(v1[0], v1[1]); w.w = cvt_pk_bf16(v1[2], v1[3]);
                    *(u32x4*)(rowp + bj * 128) = w; } }
    }
};
__device__ __forceinline__ float swiglu1(float g, float up) {
    g = fminf(g, 7.0f); up = fminf(fmaxf(up, -7.0f), 7.0f);
    return (up + 1.0f) * (g * sigmoidf_(1.702f * g));
}
struct EpiMoe1 {
    static constexpr bool PERM = true, SIDE = true;
    bf16_t* H; const float* bgu;
    __device__ __forceinline__ const float* side_ptr(const GUnit& u, int tid) const { return bgu + (size_t)u.e * 2048 + u.pn * 256 + (tid & 255); }
    __device__ __forceinline__ void operator()(const f32x4 (&acc)[2][2][4][2], const GUnit& u, int wr, int wc, int fr, int fq, LAS unsigned char* lds) const {
        const int row0 = u.pm * 256 + wr * 64 + fr, col0 = u.pn * 256 + wc * 32 + 8 * fq;
        const LAS float* b = (const LAS float*)(lds + SIDE_OFF) + 256 + wc * 32 + 8 * fq;
        constexpr float sc = 1.0f / (F8_WSCALE * F8_ASCALE);
#pragma unroll
        for (int bj = 0; bj < 2; ++bj) {
            const f32x4 b0 = *(const LAS f32x4*)(b + bj * 128), b1 = *(const LAS f32x4*)(b + bj * 128 + 4);
#pragma unroll
            for (int ai = 0; ai < 2; ++ai)
#pragma unroll
                for (int m = 0; m < 4; ++m) {
                    const f32x4 v0 = acc[ai][bj][m][0] * sc + b0, v1 = acc[ai][bj][m][1] * sc + b1;
                    *(unsigned*)((unsigned char*)H + (size_t)(row0 + ai * 128 + m * 16) * 1024 + (col0 >> 1) + bj * 64) =
                        pk4_fp8(swiglu1(v0[0], v0[1]) * F8_HSCALE, swiglu1(v0[2], v0[3]) * F8_HSCALE, swiglu1(v1[0], v1[1]) * F8_HSCALE, swiglu1(v1[2], v1[3]) * F8_HSCALE);
                }
        }
    }
};
struct EpiMoe2 {
    static constexpr bool PERM = true, SIDE = true;
    unsigned char* Y; const float* bdn; const float* slot_gate; const LAS int* tcnt;
    __device__ __forceinline__ const float* side_ptr(const GUnit& u, int tid) const {
        const int lr = u.lrow0 + (tid & 255);
        return (tid < 256) ? slot_gate + (size_t)u.e * T + (lr < T ? lr : T - 1) : bdn + (size_t)u.e * 1024 + u.pn * 256 + (tid & 255);
    }
    __device__ __forceinline__ void operator()(const f32x4 (&acc)[2][2][4][2], const GUnit& u, int wr, int wc, int fr, int fq, LAS unsigned char* lds) const {
        const int r0 = wr * 64 + fr, col0 = u.pn * 256 + wc * 32 + 8 * fq;
        const LAS float* sd = (const LAS float*)(lds + SIDE_OFF);
        const LAS float* b = sd + 256 + wc * 32 + 8 * fq; const int n_e = tcnt[u.e];
        constexpr float sc = 1.0f / (F8_WSCALE * F8_HSCALE);
        f32x4 bv[2][2];
#pragma unroll
        for (int bj = 0; bj < 2; ++bj)
#pragma unroll
            for (int n = 0; n < 2; ++n) bv[bj][n] = *(const LAS f32x4*)(b + bj * 128 + 4 * n);
#pragma unroll
        for (int ai = 0; ai < 2; ++ai)
#pragma unroll
            for (int m = 0; m < 4; ++m) { const int r = r0 + ai * 128 + m * 16; const int lr = u.lrow0 + r;
                const float gt = ((lr < n_e) ? sd[r] : 0.0f) * F8_YSCALE;
                unsigned char* rowp = Y + (size_t)(u.pm * 256 + r) * 1024 + col0;
#pragma unroll
                for (int bj = 0; bj < 2; ++bj) { const f32x4 v0 = (acc[ai][bj][m][0] * sc + bv[bj][0]) * gt, v1 = (acc[ai][bj][m][1] * sc + bv[bj][1]) * gt;
                    u32x2 w; w.x = pk4_fp8(v0[0], v0[1], v0[2], v0[3]); w.y = pk4_fp8(v1[0], v1[1], v1[2], v1[3]);
                    *(u32x2*)(rowp + bj * 128) = w; } }
    }
};

__device__ __forceinline__ void p0_transpose_item(const float* W, int K, int N, bf16_t* WT, int row_off, LAS float* scr, int item, int lane) {
    const int nblk = N / 32, kb = item / nblk, nb = item % nblk, k0 = 64 * kb, n0 = 32 * nb;
#pragma unroll 32
    for (int i = 0; i < 32; ++i) { const int kk = 2 * i + (lane >> 5); scr[kk * 33 + (lane & 31)] = W[(size_t)(k0 + kk) * N + n0 + (lane & 31)]; }
    LDS_WAIT(); asm volatile("" ::: "memory");
    const int c = lane & 7;
#pragma unroll
    for (int j = 0; j < 4; ++j) { const int n = (lane >> 3) + 8 * j; const LAS float* s = scr + (8 * c) * 33 + n;
        u32x4 o; o.x = pk2(s[0 * 33], s[1 * 33]); o.y = pk2(s[2 * 33], s[3 * 33]); o.z = pk2(s[4 * 33], s[5 * 33]); o.w = pk2(s[6 * 33], s[7 * 33]);
        *(u32x4*)(WT + (size_t)(row_off + n0 + n) * K + k0 + 8 * c) = o; }
    LDS_WAIT(); asm volatile("" ::: "memory");
}
__device__ __forceinline__ void p0_prologue(const Args& a, LAS unsigned char* lds, int tid, int lane, int wave, int G) {
    unsigned char* ws = a.ws;
    {
        float* MOD = (float*)(ws + WS_CTL) + CW_MOD;
        LAS float* sl = (LAS float*)lds;
        LAS float* red = sl + 9 * 1024;
        if (blockIdx.x < 96) {
            for (int i = tid; i < 9 * 1024; i += 512) { const int r = i >> 10, k = i & 1023; const float v = (r < 8) ? a.in[I_C][r * D + k] : a.in[I_CCTX][k]; sl[i] = v * sigmoidf_(v); }
            __syncthreads();
            for (int it = blockIdx.x; it < 96; it += G) {
                const int n = it * 64 + lane; float acc[9];
#pragma unroll
                for (int r = 0; r < 9; ++r) acc[r] = 0.f;
                const float* w = a.in[I_WADA] + (size_t)(wave * 128) * 6144 + n;
#pragma unroll 32
                for (int kk = 0; kk < 128; ++kk) { const float wv = w[(size_t)kk * 6144];
#pragma unroll
                    for (int r = 0; r < 9; ++r) acc[r] += sl[r * 1024 + wave * 128 + kk] * wv; }
#pragma unroll
                for (int r = 0; r < 9; ++r) red[(wave * 9 + r) * 64 + lane] = acc[r];
                __syncthreads();
                for (int i = tid; i < 9 * 64; i += 512) { const int r = i >> 6, c = i & 63; float s = a.in[I_BADA][it * 64 + c];
#pragma unroll
                    for (int w8 = 0; w8 < 8; ++w8) s += red[(w8 * 9 + r) * 64 + c];
                    MOD[r * 6144 + it * 64 + c] = s; }
                __syncthreads();
            }
        }
        __syncthreads();
    }
    {
        float* misc = (float*)(ws + WS_MISC);
        const int gt = blockIdx.x * 512 + tid, NGT = G * 512;
        for (int n = gt; n < ZP; n += NGT) misc[n] = (n < 2688) ? a.in[I_BIN][n] : ((n < 2816) ? 0.f : a.in[I_BIN][n - 128]);
        for (int n = gt; n < 1024; n += NGT) { const int p = n >> 4, i = n & 15; const float inv = powf(10000.0f, -(float)i / 16.0f); float s, c; sincosf((float)p * inv, &s, &c); misc[ZP + n] = c; misc[ZP + 1024 + n] = s; }
        u32x4* zr = (u32x4*)((bf16_t*)(ws + WS_WIN) + (size_t)2688 * D);
        for (int n = gt; n < 128 * D / 8; n += NGT) zr[n] = (u32x4){0u, 0u, 0u, 0u};
    }
    {
        LAS float* scr = (LAS float*)(lds + wave * 8704);
        const int gw = blockIdx.x * 8 + wave, NGW = G * 8;
        constexpr int J_IN = 16 * (PROJ_SRC / 32), J_UP = 8 * 32, J_OUT = 16 * 32, J_L = 16, J_G2 = 32, J_GU1 = 16 * 64, J_DN1 = 16 * 32;
        constexpr int NITEMS = J_IN + 2 * J_UP + J_OUT + 4 * J_L + J_G2;
        bf16_t* lora = (bf16_t*)(ws + WS_LORA);
        for (int it = gw; it < NITEMS; it += NGW) {
            int r = it;
            if (r < J_IN) { const int nb = r % (PROJ_SRC / 32); p0_transpose_item(a.in[I_WIN], D, PROJ_SRC, (bf16_t*)(ws + WS_WIN), (nb * 32 >= 2688) ? 128 : 0, scr, r, lane); continue; } r -= J_IN;
            if (r < J_UP) { p0_transpose_item(a.in[I_WUPA], 512, D, (bf16_t*)(ws + WS_WUPA), 0, scr, r, lane); continue; } r -= J_UP;
            if (r < J_UP) { p0_transpose_item(a.in[I_WUPR], 512, D, (bf16_t*)(ws + WS_WUPR), 0, scr, r, lane); continue; } r -= J_UP;
            if (r < J_OUT) { p0_transpose_item(a.in[I_WOUT], D, D, (bf16_t*)(ws + WS_WOUT), 0, scr, r, lane); continue; } r -= J_OUT;
            if (r < J_L) { p0_transpose_item(a.in[I_W2F], 64, 512, lora, 0, scr, r, lane); continue; } r -= J_L;
            if (r < J_L) { p0_transpose_item(a.in[I_W2B], 64, 512, lora + 32768, 0, scr, r, lane); continue; } r -= J_L;
            if (r < J_L) { p0_transpose_item(a.in[I_A2F], 64, 512, lora + 2 * 32768, 0, scr, r, lane); continue; } r -= J_L;
            if (r < J_L) { p0_transpose_item(a.in[I_A2B], 64, 512, lora + 3 * 32768, 0, scr, r, lane); continue; } r -= J_L;
            p0_transpose_item(a.in[I_G2], 128, 512, lora + 4 * 32768, 0, scr, r, lane);
        }
    }
}

__device__ __forceinline__ void p0_transpose_item_f8(const float* W, int K, int N, unsigned char* WT, LAS float* scr, int item, int lane, float sc) {
    const int nblk = N / 32, kb = item / nblk, nb = item % nblk, k0 = 64 * kb, n0 = 32 * nb;
#pragma unroll 32
    for (int i = 0; i < 32; ++i) { const int kk = 2 * i + (lane >> 5); scr[kk * 33 + (lane & 31)] = W[(size_t)(k0 + kk) * N + n0 + (lane & 31)] * sc; }
    LDS_WAIT(); asm volatile("" ::: "memory");
    const int c = lane & 7;
#pragma unroll
    for (int j = 0; j < 4; ++j) { const int n = (lane >> 3) + 8 * j; const LAS float* s = scr + (8 * c) * 33 + n;
        u32x2 o; o.x = pk4_fp8(s[0 * 33], s[1 * 33], s[2 * 33], s[3 * 33]); o.y = pk4_fp8(s[4 * 33], s[5 * 33], s[6 * 33], s[7 * 33]);
        *(u32x2*)(WT + (size_t)(n0 + n) * K + k0 + 8 * c) = o; }
    LDS_WAIT(); asm volatile("" ::: "memory");
}
__device__ __forceinline__ int queue_pull(unsigned* q, LAS unsigned char* lds, int tid) {
    volatile LAS int* w = (volatile LAS int*)(lds + RING_BYTES + 256);
    __syncthreads();
    if (tid == 0) *w = (int)__hip_atomic_fetch_add(q, 1u, __ATOMIC_RELAXED, __HIP_MEMORY_SCOPE_AGENT);
    __syncthreads();
    return *w;
}
__device__ __forceinline__ void tr_load(const float* W, int N, int item, int lane, float (&v)[32]) {
    const int nblk = N / 32, kb = item / nblk, nb = item % nblk; const float* p = W + (size_t)(64 * kb + (lane >> 5)) * N + 32 * nb + (lane & 31);
#pragma unroll
    for (int i = 0; i < 32; ++i) v[i] = p[(size_t)(2 * i) * N];
}
__device__ __forceinline__ void tr_store_f8(unsigned char* WT, int K, int N, LAS float* scr, int item, int lane, const float (&v)[32], float sc) {
    const int nblk = N / 32, kb = item / nblk, nb = item % nblk, k0 = 64 * kb, n0 = 32 * nb;
#pragma unroll
    for (int i = 0; i < 32; ++i) scr[(2 * i + (lane >> 5)) * 33 + (lane & 31)] = v[i] * sc;
    LDS_WAIT(); asm volatile("" ::: "memory");
    const int c = lane & 7;
#pragma unroll
    for (int j = 0; j < 4; ++j) { const int n = (lane >> 3) + 8 * j; const LAS float* s = scr + (8 * c) * 33 + n;
        u32x2 o; o.x = pk4_fp8(s[0 * 33], s[1 * 33], s[2 * 33], s[3 * 33]); o.y = pk4_fp8(s[4 * 33], s[5 * 33], s[6 * 33], s[7 * 33]);
        *(u32x2*)(WT + (size_t)(n0 + n) * K + k0 + 8 * c) = o; }
    LDS_WAIT(); asm volatile("" ::: "memory");
}
__device__ __forceinline__ void moe_weight_copies(const Args& a, LAS unsigned char* lds, int tid, int lane, int wave) {
    unsigned char* ws = a.ws;
    LAS float* scr = (LAS float*)(lds + wave * 8704);
    constexpr int J_GU1 = 16 * 64, J_DN1 = 16 * 32, NCHUNK = (NE * J_GU1 + NE * J_DN1) / 128;
    unsigned* q = (unsigned*)(ws + WS_CTL) + CW_QTR;
    for (;;) {
        const int ch = queue_pull(q, lds, tid);
        if (ch >= NCHUNK) break;
        const int r0 = ch * 128 + wave * 16;
        const float* W; unsigned char* WT; int K, N, it0;
        if (r0 < NE * J_GU1) { const int ex = r0 / J_GU1; W = a.in[I_WGU] + (size_t)ex * D * 2048; WT = (unsigned char*)(ws + WS_WGU) + (size_t)ex * 2048 * D; K = D; N = 2048; it0 = r0 % J_GU1; }
        else { const int rr = r0 - NE * J_GU1, ex = rr / J_DN1; W = a.in[I_WDN] + (size_t)ex * DE * D; WT = (unsigned char*)(ws + WS_WDN) + (size_t)ex * D * DE; K = DE; N = D; it0 = rr % J_DN1; }
        float v[32], vn[32];
        tr_load(W, N, it0, lane, v);
#pragma unroll 1
        for (int k = 0; k < 16; ++k) {
            if (k + 1 < 16) tr_load(W, N, it0 + k + 1, lane, vn);
            tr_store_f8(WT, K, N, scr, it0 + k, lane, v, F8_WSCALE);
#pragma unroll
            for (int i = 0; i < 32; ++i) v[i] = vn[i];
        }
    }
}

__device__ __forceinline__ void p1_norm(const Args& a, int lane, int wave, int G) {
    const float* MOD = (const float*)(a.ws + WS_CTL) + CW_MOD;
    bf16_t* HX = (bf16_t*)(a.ws + WS_HX);
    const int gw = blockIdx.x * 8 + wave, NGW = G * 8, rpw = (ROWS + NGW - 1) / NGW;
    const int mbeg = gw * rpw, mend = (mbeg + rpw < ROWS) ? mbeg + rpw : ROWS;
    if (mbeg >= mend) return;
    f32x4 g[4], sh[4], sc[4], v[4], vn[4];
#pragma unroll
    for (int j = 0; j < 4; ++j) g[j] = ((const f32x4*)a.in[I_GPREMIX])[64 * j + lane];
    auto rowp = [&](int m) -> const f32x4* { return (const f32x4*)((m < T) ? a.in[I_X] + (size_t)m * D : a.in[I_CTX] + (size_t)(m - T) * D) + lane; };
    { const f32x4* xr = rowp(mbeg);
#pragma unroll
      for (int j = 0; j < 4; ++j) v[j] = xr[64 * j]; }
    int rcur = -1;
    for (int m = mbeg; m < mend; ++m) {
        if (m + 1 < mend) { const f32x4* xr = rowp(m + 1);
#pragma unroll
            for (int j = 0; j < 4; ++j) vn[j] = xr[64 * j]; }
        const int r = (m < T) ? (m >> 12) : 8;
        if (r != rcur) { rcur = r;
#pragma unroll
            for (int j = 0; j < 4; ++j) { sh[j] = ((const f32x4*)(MOD + r * 6144))[64 * j + lane]; sc[j] = ((const f32x4*)(MOD + r * 6144 + 1024))[64 * j + lane] + 1.0f; } }
        float s = 0.f;
#pragma unroll
        for (int j = 0; j < 4; ++j) s += (v[j].x * v[j].x + v[j].y * v[j].y) + (v[j].z * v[j].z + v[j].w * v[j].w);
        const float rstd = 1.0f / sqrtf(wave_sum(s) * (1.f / D) + RMS_EPS);
        unsigned long long* o8 = (unsigned long long*)(HX + (size_t)m * D) + lane;
#pragma unroll
        for (int j = 0; j < 4; ++j) {
            const f32x4 h = (v[j] * rstd * g[j]) * sc[j] + sh[j];
            o8[64 * j] = (unsigned long long)pk2(h.x, h.y) | ((unsigned long long)pk2(h.z, h.w) << 32);
        }
#pragma unroll
        for (int j = 0; j < 4; ++j) v[j] = vn[j];
    }
}

constexpr size_t WS_ACT = WS_HX;
__device__ __forceinline__ void p3a_pointwise(const Args& a, int tid, int G) {
    unsigned char* ws = a.ws;
    const bf16_t* Z = (const bf16_t*)(ws + WS_Z);
    bf16_t* FB = (bf16_t*)(ws + WS_FEAT); bf16_t* ACT = (bf16_t*)(ws + WS_ACT);
    const float* rc = (const float*)(ws + WS_MISC) + ZP; const float* rs = rc + 1024;
    const int cv = tid % 240, rg = tid / 240;
    float mp[8], mn[8];
    if (tid < 480) {
#pragma unroll
        for (int j = 0; j < 8; ++j) { mp[j] = a.in[I_MUP][8 * cv + j]; mn[j] = a.in[I_MUN][8 * cv + j]; }
    }
    bf16_t* QR = (bf16_t*)(ws + WS_QR); bf16_t* KA = (bf16_t*)(ws + WS_KA); bf16_t* VT = (bf16_t*)(ws + WS_VT);
    for (int unit = blockIdx.x; unit < ROWS / 16; unit += G) {
        const int row0 = unit * 16;
        const bool isx = row0 < T;
        const int slen = isx ? SEQ : CL;
        const int pos0 = isx ? (row0 & (SEQ - 1)) : ((row0 - T) & (CL - 1));
        const int r0 = row0 + 8 * rg, p0 = pos0 + 8 * rg;
        u32x4 rowv[10];
        if (tid < 480) {
            const bf16_t* zp = Z + (size_t)r0 * ZP + ZC_R + 8 * cv;
#pragma unroll
            for (int i = 0; i < 10; ++i) { const int pos = p0 - 1 + i; const bool ok = pos >= 0 && pos < slen;
                const u32x4 v = *(const u32x4*)(ok ? zp + (ptrdiff_t)(i - 1) * ZP : zp);
                rowv[i] = ok ? v : (u32x4){0u, 0u, 0u, 0u}; }
        }
        u32x4 pt1[2], pt2[2];
#pragma unroll
        for (int it = 0; it < 2; ++it) { const int idx = tid + 512 * it;
            if (idx < 16 * 40) { const int tk = idx / 40, j = idx % 40; const int hh = j >> 2, part = (j >> 1) & 1, sub = j & 1;
                const int zc = (hh < 8) ? (ZC_Q + hh * 64) : (ZC_K + (hh - 8) * 64);
                const bf16_t* zp = Z + (size_t)(row0 + tk) * ZP + zc + part * 32 + sub * 8;
                pt1[it] = *(const u32x4*)zp; pt2[it] = *(const u32x4*)(zp + 16); } }
        unsigned short vv[8];
        if (tid < 256) { const int cidx = tid & 127, tg = tid >> 7;
#pragma unroll
            for (int q = 0; q < 8; ++q) vv[q] = Z[(size_t)(row0 + 8 * tg + q) * ZP + ZC_V + cidx]; }
        if (tid < 480) {
#pragma unroll
            for (int i = 0; i < 8; ++i) {
                const u32x4 prv = rowv[i], cur = rowv[i + 1], nxt = rowv[i + 2];
                float o[8];
#pragma unroll
                for (int j = 0; j < 4; ++j) {
                    const float c0 = lo16(cur[j]), c1 = hi16(cur[j]);
                    o[2 * j] = c0 + mp[2 * j] * (lo16(prv[j]) - c0) + mn[2 * j] * (lo16(nxt[j]) - c0);
                    o[2 * j + 1] = c1 + mp[2 * j + 1] * (hi16(prv[j]) - c1) + mn[2 * j + 1] * (hi16(nxt[j]) - c1);
                }
                bf16_t* op;
                if (cv < 64) op = FB + (size_t)F_R * (FEAT_STRIDE / 2) + (size_t)(r0 + i) * RD + 8 * cv;
                else if (cv < 128) op = FB + (size_t)F_A * (FEAT_STRIDE / 2) + (size_t)(r0 + i) * RD + 8 * (cv - 64);
                else if (cv < 192) op = FB + (size_t)F_V * (FEAT_STRIDE / 2) + (size_t)(r0 + i) * RD + 8 * (cv - 128);
                else {
                    op = ACT + (size_t)(r0 + i) * 384 + 8 * (cv - 192);
                    if (cv < 208) {
#pragma unroll
                        for (int j = 0; j < 8; ++j) o[j] = 1.0f - 2.0f * __builtin_amdgcn_rcpf(__expf(2.0f * o[j]) + 1.0f);
                    } else if (cv >= 224) {
#pragma unroll
                        for (int j = 0; j < 8; ++j) o[j] = sigmoidf_(o[j]);
                    }
                }
                u32x4 w; w.x = pk2(o[0], o[1]); w.y = pk2(o[2], o[3]); w.z = pk2(o[4], o[5]); w.w = pk2(o[6], o[7]);
                *(u32x4*)op = w;
            }
        }
#pragma unroll
        for (int it = 0; it < 2; ++it) { const int idx = tid + 512 * it;
            if (idx < 16 * 40) {
                const int tk = idx / 40, j = idx % 40; const int row = row0 + tk, pos = pos0 + tk;
                const int hh = j >> 2, part = (j >> 1) & 1, sub = j & 1;
                const bool isq = hh < 8;
                if (!(isq && !isx)) {
                    const u32x4 t1 = pt1[it], t2 = pt2[it];
                    float x1[8], x2[8], o1[8], o2[8];
#pragma unroll
                    for (int q = 0; q < 4; ++q) { x1[2 * q] = lo16(t1[q]); x1[2 * q + 1] = hi16(t1[q]); x2[2 * q] = lo16(t2[q]); x2[2 * q + 1] = hi16(t2[q]); }
                    if (isx) {
                        const int pp = part ? (pos & 63) : (pos >> 6);
                        const float sc = isq ? (0.125f * 1.44269504089f) : 1.0f;
                        const f32x4 cA = *(const f32x4*)(rc + pp * 16 + sub * 8), cB = *(const f32x4*)(rc + pp * 16 + sub * 8 + 4), sA = *(const f32x4*)(rs + pp * 16 + sub * 8), sB = *(const f32x4*)(rs + pp * 16 + sub * 8 + 4);
#pragma unroll
                        for (int q = 0; q < 8; ++q) { const float c = q < 4 ? cA[q & 3] : cB[q & 3], s = q < 4 ? sA[q & 3] : sB[q & 3];
                            o1[q] = (x1[q] * c - x2[q] * s) * sc; o2[q] = (x2[q] * c + x1[q] * s) * sc; }
                    } else {
#pragma unroll
                        for (int q = 0; q < 8; ++q) { o1[q] = x1[q]; o2[q] = x2[q]; }
                    }
                    u32x4 w1, w2;
#pragma unroll
                    for (int q = 0; q < 4; ++q) { w1[q] = pk2(o1[2 * q], o1[2 * q + 1]); w2[q] = pk2(o2[2 * q], o2[2 * q + 1]); }
                    bf16_t* op = isq ? (QR + (size_t)row * 512 + hh * 64 + part * 32 + sub * 8) : (KA + (size_t)row * 128 + (hh - 8) * 64 + part * 32 + sub * 8);
                    *(u32x4*)op = w1; *(u32x4*)(op + 16) = w2;
                }
            }
        }
        if (tid < 256) {
            const int cidx = tid & 127, tg = tid >> 7; const int g = cidx >> 6, d = cidx & 63;
            u32x4 w; w.x = vv[0] | ((unsigned)vv[1] << 16); w.y = vv[2] | ((unsigned)vv[3] << 16); w.z = vv[4] | ((unsigned)vv[5] << 16); w.w = vv[6] | ((unsigned)vv[7] << 16);
            bf16_t* op;
            if (isx) { const int b = row0 >> 12; op = VT + ((size_t)(b * 2 + g) * 64 + d) * SEQ + pos0 + 8 * tg; }
            else { const int b = (row0 - T) >> 8; op = VT + (size_t)NB * 2 * 64 * SEQ + ((size_t)(b * 2 + g) * 64 + d) * CL + pos0 + 8 * tg; }
            *(u32x4*)op = w;
        }
    }
}

template <int CTRL> __device__ __forceinline__ float dpp_row_add(float x) {
    return x + __builtin_bit_cast(float, __builtin_amdgcn_update_dpp(0, __builtin_bit_cast(int, x), CTRL, 0xf, 0xf, true));
}
__device__ __forceinline__ void p3b_features(const Args& a, LAS unsigned char* lds, int tid, int lane, int wave, int G) {
    unsigned char* ws = a.ws;
    const bf16_t* lora = (const bf16_t*)(ws + WS_LORA);
    const bf16_t* ACT = (const bf16_t*)(ws + WS_ACT);
    bf16_t* FB = (bf16_t*)(ws + WS_FEAT);
    const int h = blockIdx.x & 7;
    constexpr int P64 = 72, P128 = 136;
    LAS bf16_t* WL = (LAS bf16_t*)lds;
    LAS bf16_t* WG2 = WL + 4 * 64 * P64;
    __syncthreads();
    for (int i = tid; i < 4 * 64 * 8; i += 512) { const int m = i >> 9, r = (i >> 3) & 63, c = i & 7; const int ch = 16 * ((r >> 2) & 3) + 4 * (r >> 4) + (r & 3);
        *(LAS u32x4*)(WL + (m * 64 + r) * P64 + 8 * c) = *(const u32x4*)(lora + (size_t)m * 32768 + (size_t)(h * 64 + ch) * 64 + 8 * c); }
    for (int i = tid; i < 64 * 16; i += 512) { const int r = i >> 4, c = i & 15; const int ch = 16 * ((r >> 2) & 3) + 4 * (r >> 4) + (r & 3);
        *(LAS u32x4*)(WG2 + r * P128 + 8 * c) = *(const u32x4*)(lora + (size_t)4 * 32768 + (size_t)(h * 64 + ch) * 128 + 8 * c); }
    __syncthreads();
    const int tk = lane & 15, cg = lane >> 4;
    f32x4 w0f[4], w0b[4], a0f[4], a0b[4], kkw[4], kaw[4];
#pragma unroll
    for (int cs = 0; cs < 4; ++cs) { const int c = h * 64 + 16 * cg + 4 * cs;
        w0f[cs] = *(const f32x4*)(a.in[I_W0F] + c); w0b[cs] = *(const f32x4*)(a.in[I_W0B] + c); a0f[cs] = *(const f32x4*)(a.in[I_A0F] + c); a0b[cs] = *(const f32x4*)(a.in[I_A0B] + c);
        kkw[cs] = *(const f32x4*)(a.in[I_KK] + c); kaw[cs] = *(const f32x4*)(a.in[I_KA] + c); }
    for (int tt = blockIdx.x >> 3; tt < ROWS / 128; tt += (G >> 3)) {
        const int row = tt * 128 + 16 * wave + tk;
        bf16x8 bfr[12];
        const bf16_t* ap = ACT + (size_t)row * 384 + 8 * cg;
#pragma unroll
        for (int kb = 0; kb < 12; ++kb) bfr[kb] = *(const bf16x8*)(ap + 32 * kb);
        bf16_t* frow = FB + (size_t)row * RD + h * 64 + 16 * cg;
        u32x2 kraw[4];
#pragma unroll
        for (int cs = 0; cs < 4; ++cs) kraw[cs] = *(const u32x2*)(frow + (size_t)F_A * (FEAT_STRIDE / 2) + 4 * cs);
        auto store16 = [&](int arr, const f32x4 (&v)[4]) {
            u32x4 w0, w1;
            w0.x = cvt_pk_bf16_asm(v[0][0], v[0][1]); w0.y = cvt_pk_bf16_asm(v[0][2], v[0][3]); w0.z = cvt_pk_bf16_asm(v[1][0], v[1][1]); w0.w = cvt_pk_bf16_asm(v[1][2], v[1][3]);
            w1.x = cvt_pk_bf16_asm(v[2][0], v[2][1]); w1.y = cvt_pk_bf16_asm(v[2][2], v[2][3]); w1.z = cvt_pk_bf16_asm(v[3][0], v[3][1]); w1.w = cvt_pk_bf16_asm(v[3][2], v[3][3]);
            u32x4* p = (u32x4*)(frow + (size_t)arr * (FEAT_STRIDE / 2)); p[0] = w0; p[1] = w1;
        };
        auto lora_mm = [&](int m, int kb0, f32x4 (&acc)[4]) {
#pragma unroll
            for (int cs = 0; cs < 4; ++cs) acc[cs] = (f32x4){0.f, 0.f, 0.f, 0.f};
            const int nkb = (m == 4) ? 4 : 2;
#pragma unroll
            for (int kb = 0; kb < 4; ++kb) if (kb < nkb) {
#pragma unroll
                for (int cs = 0; cs < 4; ++cs) {
                    const bf16x8 afr = (m == 4) ? *(const LAS bf16x8*)(WG2 + (16 * cs + tk) * P128 + 32 * kb + 8 * cg) : *(const LAS bf16x8*)(WL + (m * 64 + 16 * cs + tk) * P64 + 32 * kb + 8 * cg);
                    acc[cs] = __builtin_amdgcn_mfma_f32_16x16x32_bf16(afr, bfr[kb0 + kb], acc[cs], 0, 0, 0);
                }
            }
        };
        f32x4 acc[4];
        lora_mm(0, 0, acc);
#pragma unroll
        for (int cs = 0; cs < 4; ++cs)
#pragma unroll
            for (int j = 0; j < 4; ++j) { float x = -0.60653065971f * sigmoidf_(acc[cs][j] + w0f[cs][j]);
                x = dpp_row_add<0x111>(x); x = dpp_row_add<0x112>(x); x = dpp_row_add<0x114>(x); x = dpp_row_add<0x118>(x);
                acc[cs][j] = __builtin_amdgcn_exp2f(x * 1.44269504089f); }
        store16(F_WF, acc);
        lora_mm(1, 2, acc);
#pragma unroll
        for (int cs = 0; cs < 4; ++cs)
#pragma unroll
            for (int j = 0; j < 4; ++j) { float x = -0.60653065971f * sigmoidf_(acc[cs][j] + w0b[cs][j]);
                x = dpp_row_add<0x101>(x); x = dpp_row_add<0x102>(x); x = dpp_row_add<0x104>(x); x = dpp_row_add<0x108>(x);
                acc[cs][j] = __builtin_amdgcn_exp2f(x * 1.44269504089f); }
        store16(F_WB, acc);
        lora_mm(4, 8, acc);
        asm volatile("s_nop 7\n\ts_nop 7" ::: "memory");
        store16(F_G, acc);
        f32x4 iclf[4], iclb[4];
        lora_mm(2, 4, iclf);
        lora_mm(3, 6, iclb);
#pragma unroll
        for (int cs = 0; cs < 4; ++cs)
#pragma unroll
            for (int j = 0; j < 4; ++j) { iclf[cs][j] = sigmoidf_(iclf[cs][j] + a0f[cs][j]); iclb[cs][j] = sigmoidf_(iclb[cs][j] + a0b[cs][j]); }
        f32x4 kv[4]; float nrm = 0.f;
#pragma unroll
        for (int cs = 0; cs < 4; ++cs) {
            kv[cs] = (f32x4){lo16(kraw[cs].x), hi16(kraw[cs].x), lo16(kraw[cs].y), hi16(kraw[cs].y)};
            const f32x4 kk = kv[cs] * kkw[cs];
            nrm += (kk[0] * kk[0] + kk[1] * kk[1]) + (kk[2] * kk[2] + kk[3] * kk[3]);
        }
        nrm += __shfl_xor(nrm, 16); nrm += __shfl_xor(nrm, 32);
        const float inv = 1.0f / fmaxf(sqrtf(nrm), 1e-12f);
        f32x4 oa[4], obf[4], obb[4], okf[4], okb[4];
#pragma unroll
        for (int cs = 0; cs < 4; ++cs) {
            const f32x4 kkn = kv[cs] * kkw[cs] * inv;
            oa[cs] = -kkn; obf[cs] = kkn * iclf[cs]; obb[cs] = kkn * iclb[cs];
            okf[cs] = kv[cs] * ((iclf[cs] - 1.0f) * kaw[cs] + 1.0f); okb[cs] = kv[cs] * ((iclb[cs] - 1.0f) * kaw[cs] + 1.0f);
        }
        store16(F_A, oa); store16(F_BF, obf); store16(F_BB, obb); store16(F_KF, okf); store16(F_KB, okb);
    }
}

__device__ __forceinline__ void p4_attention(const Args& a, LAS unsigned char* lds, int tid, int lane, int wave, int G) {
    unsigned char* ws = a.ws;
    const bf16_t* QR = (const bf16_t*)(ws + WS_QR); const bf16_t* KA = (const bf16_t*)(ws + WS_KA); const bf16_t* VT = (const bf16_t*)(ws + WS_VT);
    bf16_t* ATT = (bf16_t*)(ws + WS_ATT);
    constexpr int KP = 72;
    LAS bf16_t* Ks0 = (LAS bf16_t*)lds;
    const int qi = lane & 31, hf = lane >> 5;
    unsigned* qatt = (unsigned*)(ws + WS_CTL) + CW_QATT;
    for (int it = 0;; ++it) {
        int upull = 0; if ((it & 1) == 0) { upull = queue_pull(qatt, lds, tid); *(volatile LAS int*)(lds + RING_BYTES + 260) = upull; } else upull = *(volatile LAS int*)(lds + RING_BYTES + 260);
        const int unit = 2 * upull + (it & 1);
        if (unit >= NB * NKV * (SEQ / 64)) break;
        const int qb = unit & 63, g = (unit >> 6) & 1, b = unit >> 7;
        const int q0 = qb * 64;
        const int head = g * 4 + (wave >> 1), qloc = 32 * (wave & 1) + qi;
        const size_t qrow = (size_t)b * SEQ + q0 + qloc;
        bf16x8 qf[4];
#pragma unroll
        for (int s = 0; s < 4; ++s) qf[s] = *(const bf16x8*)(QR + qrow * 512 + head * 64 + 16 * s + 8 * hf);
        float m = a.in[I_SINKS][head] * 1.44269504089f, lsum = hf ? 0.f : 1.f;
        f32x16 O0, O1;
#pragma unroll
        for (int r = 0; r < 16; ++r) { O0[r] = 0.f; O1[r] = 0.f; }
        const int rr = tid >> 3, ch = tid & 7;
        auto tile_ok = [&](int kt) -> bool { const int kp = q0 - 128 + 64 * kt; return kt >= 5 || (kp >= 0 && kp < SEQ); };
        u32x4 kreg[3], vreg[3];
        auto fetch_tile = [&](int kt, u32x4& kr, u32x4& vr) {
            int kp0 = q0 - 128 + 64 * kt; kp0 = kp0 < 0 ? 0 : (kp0 > SEQ - 64 ? SEQ - 64 : kp0);
            const bf16_t* kp = (kt < 5) ? KA + ((size_t)b * SEQ + kp0 + rr) * 128 + g * 64 + 8 * ch
                                        : KA + ((size_t)T + b * CL + 64 * (kt - 5) + rr) * 128 + g * 64 + 8 * ch;
            const bf16_t* vp = (kt < 5) ? VT + ((size_t)(b * 2 + g) * 64 + rr) * SEQ + kp0 + 8 * ch
                                        : VT + (size_t)NB * 2 * 64 * SEQ + ((size_t)(b * 2 + g) * 64 + rr) * CL + 64 * (kt - 5) + 8 * ch;
            kr = *(const u32x4*)kp; vr = *(const u32x4*)vp;
        };
        fetch_tile(0, kreg[0], vreg[0]);
        fetch_tile(1, kreg[1], vreg[1]);
        int par = 0;
        __syncthreads();
#pragma unroll
        for (int kt = 0; kt < 9; ++kt) {
            const bool ok = tile_ok(kt);
            LAS bf16_t* Ks = Ks0 + par * (2 * 64 * KP); LAS bf16_t* Vs = Ks + 64 * KP;
            if (ok) {
                *(LAS u32x4*)(Ks + rr * KP + 8 * ch) = kreg[kt % 3]; *(LAS u32x4*)(Vs + rr * KP + 8 * ch) = vreg[kt % 3];
                __syncthreads();
            }
            if (kt + 2 < 9) fetch_tile(kt + 2, kreg[(kt + 2) % 3], vreg[(kt + 2) % 3]);
            if (ok) {
                f32x16 X0, X1;
#pragma unroll
                for (int r = 0; r < 16; ++r) { X0[r] = 0.f; X1[r] = 0.f; }
#pragma unroll
                for (int s = 0; s < 4; ++s) {
                    const bf16x8 k0 = *(const LAS bf16x8*)(Ks + qi * KP + 16 * s + 8 * hf), k1 = *(const LAS bf16x8*)(Ks + (32 + qi) * KP + 16 * s + 8 * hf);
                    X0 = __builtin_amdgcn_mfma_f32_32x32x16_bf16(k0, qf[s], X0, 0, 0, 0);
                    X1 = __builtin_amdgcn_mfma_f32_32x32x16_bf16(k1, qf[s], X1, 0, 0, 0);
                }
                if (kt == 0 || kt == 4) {
#pragma unroll
                    for (int r = 0; r < 16; ++r) { const int k0i = (r & 3) + 8 * (r >> 2) + 4 * hf, k1i = 32 + k0i;
                        const bool v0 = (kt == 0) ? (k0i >= qloc) : (k0i <= qloc), v1 = (kt == 0) ? (k1i >= qloc) : (k1i <= qloc);
                        X0[r] = v0 ? X0[r] : -1e30f; X1[r] = v1 ? X1[r] : -1e30f; }
                }
                float mx0 = X0[0], mx1 = X1[0];
#pragma unroll
                for (int r = 1; r < 16; ++r) { mx0 = __builtin_fmaxf(mx0, X0[r]); mx1 = __builtin_fmaxf(mx1, X1[r]); }
                float mx = __builtin_fmaxf(mx0, mx1);
                mx = __builtin_fmaxf(mx, __shfl_xor(mx, 32));
                const float mn = __builtin_fmaxf(m, mx);
                if (__any(mn > m)) {
                    const float alpha = __builtin_amdgcn_exp2f(m - mn);
                    lsum *= alpha;
#pragma unroll
                    for (int r = 0; r < 16; ++r) { O0[r] *= alpha; O1[r] *= alpha; }
                    m = mn;
                }
                float ps0 = 0.f, ps1 = 0.f;
#pragma unroll
                for (int r = 0; r < 16; ++r) { X0[r] = __builtin_amdgcn_exp2f(X0[r] - m); X1[r] = __builtin_amdgcn_exp2f(X1[r] - m); ps0 += X0[r]; ps1 += X1[r]; }
                lsum += ps0 + ps1;
#pragma unroll
                for (int kg = 0; kg < 2; ++kg)
#pragma unroll
                    for (int s2 = 0; s2 < 2; ++s2) {
                        bf16x8 pf;
#pragma unroll
                        for (int j = 0; j < 4; ++j) { const float p0 = kg ? X1[8 * s2 + 2 * j] : X0[8 * s2 + 2 * j], p1 = kg ? X1[8 * s2 + 2 * j + 1] : X0[8 * s2 + 2 * j + 1];
                            const unsigned w = cvt_pk_bf16(p0, p1); pf[2 * j] = (short)(w & 0xffff); pf[2 * j + 1] = (short)(w >> 16); }
                        const int kb = 32 * kg + 16 * s2 + 4 * hf;
#pragma unroll
                        for (int dg = 0; dg < 2; ++dg) {
                            const LAS bf16_t* vr = Vs + (32 * dg + qi) * KP + kb;
                            const s16x4 va = *(const LAS s16x4*)vr, vb = *(const LAS s16x4*)(vr + 8);
                            bf16x8 vf; vf[0] = va[0]; vf[1] = va[1]; vf[2] = va[2]; vf[3] = va[3]; vf[4] = vb[0]; vf[5] = vb[1]; vf[6] = vb[2]; vf[7] = vb[3];
                            if (dg == 0) O0 = __builtin_amdgcn_mfma_f32_32x32x16_bf16(vf, pf, O0, 0, 0, 0);
                            else O1 = __builtin_amdgcn_mfma_f32_32x32x16_bf16(vf, pf, O1, 0, 0, 0);
                        }
                    }
                par ^= 1;
            }
        }
        const float ltot = lsum + __shfl_xor(lsum, 32);
        const float inv = 1.0f / ltot;
        bf16_t* op = ATT + qrow * 512 + head * 64;
#pragma unroll
        for (int dg = 0; dg < 2; ++dg)
#pragma unroll
            for (int rq = 0; rq < 4; ++rq) {
                const int d0 = 32 * dg + 8 * rq + 4 * hf;
                u32x2 w;
                if (dg == 0) { w.x = cvt_pk_bf16(O0[4 * rq] * inv, O0[4 * rq + 1] * inv); w.y = cvt_pk_bf16(O0[4 * rq + 2] * inv, O0[4 * rq + 3] * inv); }
                else { w.x = cvt_pk_bf16(O1[4 * rq] * inv, O1[4 * rq + 1] * inv); w.y = cvt_pk_bf16(O1[4 * rq + 2] * inv, O1[4 * rq + 3] * inv); }
                *(u32x2*)(op + d0) = w;
            }
    }
}

template <int CTRL> __device__ __forceinline__ float dpp_add(float x) {
    return x + __builtin_bit_cast(float, __builtin_amdgcn_update_dpp(0, __builtin_bit_cast(int, x), CTRL, 0xf, 0xf, false));
}
__device__ __forceinline__ float row16_sum(float x) { x = dpp_add<0x128>(x); x = dpp_add<0x124>(x); x = dpp_add<0x122>(x); x = dpp_add<0x121>(x); return x; }
template <int VAR> __device__ __forceinline__ void p4_scan(const Args& a, LAS unsigned char* lds, int tid, int lane, int wave, int G) {
    unsigned char* ws = a.ws;
    const bf16_t* FB = (const bf16_t*)(ws + WS_FEAT);
    constexpr int TS = 32, NBLK = (CL + SEQ) / TS;
    constexpr int OPF = TS * 5 * 64;
    LAS float* OPS = (LAS float*)lds;
    LAS float* VB = OPS + 2 * OPF;
    LAS float* YBUF = VB + 2 * TS * 32;
    const int rl = 4 * wave + (lane >> 4), cg = lane & 15;
    for (int unit = blockIdx.x; unit < NB * NH * 4; unit += G) {
        const int half = unit & 1, dir = (unit >> 1) & 1, h = (unit >> 2) & 7, b = unit >> 5;
        const size_t astr = FEAT_STRIDE / 2;
        const bf16_t* arrp[5] = { FB + (size_t)(dir ? F_WB : F_WF) * astr, FB + (size_t)F_A * astr, FB + (size_t)(dir ? F_BB : F_BF) * astr, FB + (size_t)(dir ? F_KB : F_KF) * astr, FB + (size_t)F_R * astr };
        const bf16_t* vp = FB + (size_t)F_V * astr;
        bf16_t* Y = (bf16_t*)(ws + (dir ? WS_YB : WS_YF));
        auto row_of = [&](int s) -> int { return (s < CL) ? (T + b * CL + (dir ? (CL - 1 - s) : s)) : (b * SEQ + (dir ? (SEQ - 1 - (s - CL)) : (s - CL))); };
        u32x2 pre[6];
        auto fetch = [&](int blk) {
#pragma unroll
            for (int it = 0; it < 6; ++it) { const int q = tid + 512 * it; pre[it] = (u32x2){0u, 0u};
                if (q < TS * 88) { const int st = q / 88, rem = q % 88; const int row = row_of(blk * TS + st);
                    if (rem < 80) { const int ar = rem >> 4, ci = rem & 15; const bf16_t* p = (ar == 0 ? arrp[0] : ar == 1 ? arrp[1] : ar == 2 ? arrp[2] : ar == 3 ? arrp[3] : arrp[4]);
                        pre[it] = *(const u32x2*)(p + (size_t)row * RD + h * 64 + 4 * ci); }
                    else { const int ci = rem - 80; pre[it] = *(const u32x2*)(vp + (size_t)row * RD + h * 64 + half * 32 + 4 * ci); } } }
        };
        auto commit = [&](int buf) {
#pragma unroll
            for (int it = 0; it < 6; ++it) { const int q = tid + 512 * it;
                if (q < TS * 88) { const int st = q / 88, rem = q % 88;
                    f32x4 v = (f32x4){lo16(pre[it].x), hi16(pre[it].x), lo16(pre[it].y), hi16(pre[it].y)};
                    if (SCAN_CHUNKED && rem < 16) { v[0] = __expf(v[0]) - 1.0f; v[1] = __expf(v[1]) - 1.0f; v[2] = __expf(v[2]) - 1.0f; v[3] = __expf(v[3]) - 1.0f; }
                    if (rem < 80) *(LAS f32x4*)(OPS + buf * OPF + st * 320 + rem * 4) = v;
                    else *(LAS f32x4*)(VB + buf * TS * 32 + st * 32 + (rem - 80) * 4) = v; } }
        };
        __syncthreads();
        fetch(0); commit(0);
        __syncthreads();
        f32x4 S = (f32x4){0.f, 0.f, 0.f, 0.f};
        for (int blk = 0; blk < NBLK; ++blk) {
            const int buf = blk & 1;
            if (blk + 1 < NBLK) fetch(blk + 1);
            const LAS float* ob = OPS + buf * OPF + 4 * cg; const LAS float* vb = VB + buf * TS * 32 + rl; LAS float* yb = YBUF + buf * TS * 32 + rl;
            float ykeep = 0.f;
            f32x4 qw[3], qa[3], qb[3], qk[3], qr[3]; float qv[3];
#define SCAN_LOAD(st_, sl_) do { qw[sl_] = *(const LAS f32x4*)(ob + (st_) * 320); qa[sl_] = *(const LAS f32x4*)(ob + (st_) * 320 + 64); qb[sl_] = *(const LAS f32x4*)(ob + (st_) * 320 + 128); \
                qk[sl_] = *(const LAS f32x4*)(ob + (st_) * 320 + 192); qr[sl_] = *(const LAS f32x4*)(ob + (st_) * 320 + 256); qv[sl_] = vb[(st_) * 32]; } while (0)
            SCAN_LOAD(0, 0); SCAN_LOAD(1, 1);
#pragma unroll
            for (int st = 0; st < TS; ++st) {
                if (st + 2 < TS && (VAR != 2 || st < 1)) SCAN_LOAD(st + 2, (st + 2) % 3);
                const f32x4 ow = qw[st % 3], av = DBG_NOA ? (f32x4){0.f, 0.f, 0.f, 0.f} : qa[st % 3], bv = DBG_NOB ? (f32x4){0.f, 0.f, 0.f, 0.f} : qb[st % 3], kv = qk[st % 3], rv = qr[st % 3]; const float vi = qv[st % 3];
                float sa = fmaf(S[3], av[3], fmaf(S[2], av[2], fmaf(S[1], av[1], S[0] * av[0])));
                const f32x4 S1 = S + S * ow + kv * vi;
                if (VAR != 1) sa = row16_sum(sa);
                S = S1 + bv * sa;
                float y = fmaf(S[3], rv[3], fmaf(S[2], rv[2], fmaf(S[1], rv[1], S[0] * rv[0])));
                if (VAR != 1) y = row16_sum(y);
                ykeep = (cg == (st & 15)) ? y : ykeep;
                if ((st & 15) == 15) yb[((st & ~15) + cg) * 32] = ykeep;
            }
#undef SCAN_LOAD
            if (blk + 1 < NBLK) commit(buf ^ 1);
            __syncthreads();
            if (blk >= CL / TS) {
                const int st = tid >> 4, pr = tid & 15;
                const int row = row_of(blk * TS + st);
                const float y0 = YBUF[buf * TS * 32 + st * 32 + 2 * pr], y1 = YBUF[buf * TS * 32 + st * 32 + 2 * pr + 1];
                *(unsigned*)(Y + (size_t)row * RD + h * 64 + half * 32 + 2 * pr) = pk2(y0, y1);
            }
        }
    }
}

constexpr int CS_SLOT = 16384, CS_AT = 0, CS_RT = 2304, CS_BH = 4608, CS_KH = 6912, CS_VV = 9216, CS_AAK = 11520, CS_TT = 12800, CS_ARK = 14080, CS_GC = 15360;
constexpr int CS_SCR = 4 * CS_SLOT, CS_SCR_BYTES = 6144, CS_BT = 0, CS_KT = 2304, CS_NN = 4608, CS_FLAGS = CS_SCR + 4 * CS_SCR_BYTES;
typedef short v4i16_t __attribute__((ext_vector_type(4)));
__device__ __forceinline__ bf16x8 pack8(f32x4 x, f32x4 y) {
    u32x4 w; w.x = cvt_pk_bf16(x[0], x[1]); w.y = cvt_pk_bf16(x[2], x[3]); w.z = cvt_pk_bf16(y[0], y[1]); w.w = cvt_pk_bf16(y[2], y[3]);
    return __builtin_bit_cast(bf16x8, w);
}
__device__ __forceinline__ bf16x8 join8(s16x4 x, s16x4 y) { bf16x8 r; r[0] = x[0]; r[1] = x[1]; r[2] = x[2]; r[3] = x[3]; r[4] = y[0]; r[5] = y[1]; r[6] = y[2]; r[7] = y[3]; return r; }
__device__ __forceinline__ s16x4 lds_tr4(const LAS unsigned char* p) { return __builtin_bit_cast(s16x4, __builtin_amdgcn_ds_read_tr16_b64_v4i16((LAS v4i16_t*)p)); }
template <int CTRL> __device__ __forceinline__ float dpp_shr_add(float x) {
    return x + __builtin_bit_cast(float, __builtin_amdgcn_update_dpp(0, __builtin_bit_cast(int, x), CTRL, 0xf, 0xf, true));
}
template <bool TEST> __device__ __forceinline__ void p4_scan_chunked(const Args& a, LAS unsigned char* lds, int tid, int lane, int wave, int G) {
    unsigned char* ws = a.ws;
    const bf16_t* FB = (const bf16_t*)(ws + WS_FEAT);
    const size_t astr = FEAT_STRIDE / 2;
    constexpr int NCH = (CL + SEQ) / 16;
    volatile LAS unsigned* flags = (volatile LAS unsigned*)(lds + CS_FLAGS);
    for (int unit = blockIdx.x; unit < NB * NH * 2; unit += G) {
        const int dir = unit & 1, h = (unit >> 1) & 7, b = unit >> 4;
        __syncthreads();
        for (int i = tid; i < (CS_FLAGS + 64) / 16; i += 512) *(LAS u32x4*)(lds + 16 * i) = (u32x4){0u, 0u, 0u, 0u};
        __syncthreads();
        auto row_of = [&](int s) -> int { return (s < CL) ? (T + b * CL + (dir ? (CL - 1 - s) : s)) : (b * SEQ + (dir ? (SEQ - 1 - (s - CL)) : (s - CL))); };
        if (wave < 4) {
            const int il = lane & 15, g = lane >> 4, ich = 16 * wave + il;
            bf16_t* Y = (bf16_t*)(ws + (dir ? WS_YB : WS_YF));
            f32x4 ST[4];
#pragma unroll
            for (int jt = 0; jt < 4; ++jt) ST[jt] = (f32x4){0.f, 0.f, 0.f, 0.f};
            const f32x4 zero4 = (f32x4){0.f, 0.f, 0.f, 0.f}; const s16x4 z16 = (s16x4){0, 0, 0, 0};
            const int troff = (4 * g + (il >> 2)) * 144 + 8 * (il & 3);
            for (int c = 0; c < NCH; ++c) {
                const int slot = c & 3; LAS unsigned char* sb = lds + slot * CS_SLOT;
                while (flags[slot] != (unsigned)(c + 1)) __builtin_amdgcn_s_sleep(1);
                __builtin_amdgcn_fence(__ATOMIC_ACQUIRE, "workgroup");
#ifdef PROBE_SCANV
                if (a.bar_region && PROBE_SCANV == 1) { if (lane == 0) __hip_atomic_fetch_add((LAS unsigned*)(lds + CS_FLAGS) + 4 + slot, 1u, __ATOMIC_RELEASE, __HIP_MEMORY_SCOPE_WORKGROUP); continue; }
#endif
                const bf16x8 sf0 = pack8(ST[0], ST[1]), sf1 = pack8(ST[2], ST[3]);
                const LAS unsigned char* atp = sb + CS_AT + il * 144 + 8 * g;
                const bf16x8 a0 = join8(*(const LAS s16x4*)(atp), *(const LAS s16x4*)(atp + 32)), a1 = join8(*(const LAS s16x4*)(atp + 64), *(const LAS s16x4*)(atp + 96));
                const LAS unsigned char* rtp = sb + CS_RT + il * 144 + 8 * g;
                const bf16x8 r0 = join8(*(const LAS s16x4*)(rtp), *(const LAS s16x4*)(rtp + 32)), r1 = join8(*(const LAS s16x4*)(rtp + 64), *(const LAS s16x4*)(rtp + 96));
                const bf16x8 aak = *(const LAS bf16x8*)(sb + CS_AAK + il * 80 + 16 * g);
                const bf16x8 ttf = *(const LAS bf16x8*)(sb + CS_TT + il * 80 + 16 * g);
                const bf16x8 ark = *(const LAS bf16x8*)(sb + CS_ARK + il * 80 + 16 * g);
                const s16x4 vv = lds_tr4(sb + CS_VV + troff + 32 * wave);
                f32x4 zw1 = zero4, zyy = zero4, zuu = zero4; asm volatile("" : "+v"(zw1), "+v"(zyy), "+v"(zuu));
                f32x4 w1 = __builtin_amdgcn_mfma_f32_16x16x32_bf16(a0, sf0, zw1, 0, 0, 0);
                w1 = __builtin_amdgcn_mfma_f32_16x16x32_bf16(a1, sf1, w1, 0, 0, 0);
                w1 = __builtin_amdgcn_mfma_f32_16x16x32_bf16(aak, join8(vv, z16), w1, 0, 0, 0);
                f32x4 yy = __builtin_amdgcn_mfma_f32_16x16x32_bf16(r0, sf0, zyy, 0, 0, 0);
                yy = __builtin_amdgcn_mfma_f32_16x16x32_bf16(r1, sf1, yy, 0, 0, 0);
                const bf16x8 w1f = pack8(w1, zero4);
                const f32x4 uu = __builtin_amdgcn_mfma_f32_16x16x32_bf16(ttf, w1f, zuu, 0, 0, 0);
                bf16x8 uv; { u32x4 w; w.x = cvt_pk_bf16(uu[0], uu[1]); w.y = cvt_pk_bf16(uu[2], uu[3]); const u32x2 v2 = __builtin_bit_cast(u32x2, vv); w.z = v2.x; w.w = v2.y; uv = __builtin_bit_cast(bf16x8, w); }
#pragma unroll
                for (int jt = 0; jt < 4; ++jt) {
                    const f32x4 gc = *(const LAS f32x4*)(sb + CS_GC + (16 * jt + 4 * g) * 4);
                    const bf16x8 bk = join8(lds_tr4(sb + CS_BH + troff + 32 * jt), lds_tr4(sb + CS_KH + troff + 32 * jt));
                    ST[jt] = __builtin_amdgcn_mfma_f32_16x16x32_bf16(bk, uv, ST[jt] * gc, 0, 0, 0);
                }
                yy = __builtin_amdgcn_mfma_f32_16x16x32_bf16(ark, uv, yy, 0, 0, 0);
                asm volatile("s_waitcnt lgkmcnt(0)" ::: "memory");
                if (lane == 0) __hip_atomic_fetch_add((LAS unsigned*)(lds + CS_FLAGS) + 4 + slot, 1u, __ATOMIC_RELEASE, __HIP_MEMORY_SCOPE_WORKGROUP);
                if (c >= CL / 16) {
#pragma unroll
                    for (int rg = 0; rg < 4; ++rg) { const int row = row_of(16 * c + 4 * g + rg); Y[(size_t)row * RD + h * 64 + ich] = (bf16_t)f2bf(yy[rg]); }
                }
            }
        } else {
            const int p = wave - 4, jg = lane >> 4, t = lane & 15;
            LAS unsigned char* scr = lds + CS_SCR + p * CS_SCR_BYTES;
            u32x4 raw[6][2];
            auto load_raw = [&](int c) {
                const size_t ro = (size_t)row_of(16 * c + t) * RD + h * 64 + 16 * jg;
#pragma unroll
                for (int hf = 0; hf < 2; ++hf) {
                    raw[0][hf] = *(const u32x4*)(FB + (size_t)(dir ? F_WB : F_WF) * astr + ro + 8 * hf); raw[1][hf] = *(const u32x4*)(FB + (size_t)F_A * astr + ro + 8 * hf);
                    raw[2][hf] = *(const u32x4*)(FB + (size_t)(dir ? F_BB : F_BF) * astr + ro + 8 * hf); raw[3][hf] = *(const u32x4*)(FB + (size_t)(dir ? F_KB : F_KF) * astr + ro + 8 * hf);
                    raw[4][hf] = *(const u32x4*)(FB + (size_t)F_R * astr + ro + 8 * hf); raw[5][hf] = *(const u32x4*)(FB + (size_t)F_V * astr + ro + 8 * hf); }
            };
            load_raw(p);
            const int tn = lane & 15, gq = lane >> 4;
            for (int c = p; c < NCH; c += 4) {
                const int slot = c & 3; LAS unsigned char* sb = lds + slot * CS_SLOT;
#ifdef PROBE_SCANV
                if (a.bar_region && PROBE_SCANV == 2) { while (flags[4 + slot] != (unsigned)(4 * (c >> 2))) __builtin_amdgcn_s_sleep(1); if (lane == 0) flags[slot] = (unsigned)(c + 1); continue; }
#endif
                float Gc[16], Gi[16], Gp[16], G15[16];
#pragma unroll
                for (int q = 0; q < 8; ++q) { const unsigned w = raw[0][q >> 2][q & 3]; Gc[2 * q] = lo16(w); Gc[2 * q + 1] = hi16(w); }
#pragma unroll
                for (int q = 0; q < 16; ++q) { Gi[q] = __builtin_amdgcn_rcpf(Gc[q]);
                    Gp[q] = __builtin_bit_cast(float, __builtin_amdgcn_update_dpp(0x3f800000, __builtin_bit_cast(int, Gc[q]), 0x111, 0xf, 0xf, false));
                    G15[q] = __builtin_bit_cast(float, __builtin_amdgcn_update_dpp(0, __builtin_bit_cast(int, Gc[q]), 0x15F, 0xf, 0xf, false)); }
                while (flags[4 + slot] != (unsigned)(4 * (c >> 2))) __builtin_amdgcn_s_sleep(1);
                __builtin_amdgcn_fence(__ATOMIC_ACQUIRE, "workgroup");
                {
                    u32x4 wa[2], wr[2], wb[2], wk[2], wbh[2], wkh[2];
#pragma unroll
                    for (int q = 0; q < 8; ++q) {
                        const unsigned ua = raw[1][q >> 2][q & 3], ub = raw[2][q >> 2][q & 3], uk = raw[3][q >> 2][q & 3], ur = raw[4][q >> 2][q & 3];
                        const float a0 = lo16(ua) * Gp[2 * q], a1 = hi16(ua) * Gp[2 * q + 1], r0 = lo16(ur) * Gc[2 * q], r1 = hi16(ur) * Gc[2 * q + 1];
                        const float b0 = lo16(ub) * Gi[2 * q], b1 = hi16(ub) * Gi[2 * q + 1], k0 = lo16(uk) * Gi[2 * q], k1 = hi16(uk) * Gi[2 * q + 1];
                        wa[q >> 2][q & 3] = cvt_pk_bf16(a0, a1); wr[q >> 2][q & 3] = cvt_pk_bf16(r0, r1); wb[q >> 2][q & 3] = cvt_pk_bf16(b0, b1); wk[q >> 2][q & 3] = cvt_pk_bf16(k0, k1);
                        wbh[q >> 2][q & 3] = cvt_pk_bf16(b0 * G15[2 * q], b1 * G15[2 * q + 1]); wkh[q >> 2][q & 3] = cvt_pk_bf16(k0 * G15[2 * q], k1 * G15[2 * q + 1]);
                    }
                    const int ro = t * 144 + 32 * jg;
#pragma unroll
                    for (int hf = 0; hf < 2; ++hf) {
                        *(LAS u32x4*)(sb + CS_AT + ro + 16 * hf) = wa[hf]; *(LAS u32x4*)(sb + CS_RT + ro + 16 * hf) = wr[hf];
                        *(LAS u32x4*)(scr + CS_BT + ro + 16 * hf) = wb[hf]; *(LAS u32x4*)(scr + CS_KT + ro + 16 * hf) = wk[hf];
                        *(LAS u32x4*)(sb + CS_BH + ro + 16 * hf) = wbh[hf]; *(LAS u32x4*)(sb + CS_KH + ro + 16 * hf) = wkh[hf];
                        *(LAS u32x4*)(sb + CS_VV + ro + 16 * hf) = raw[5][hf];
                    }
                    if (t == 15) {
#pragma unroll
                        for (int q = 0; q < 4; ++q) *(LAS f32x4*)(sb + CS_GC + (16 * jg + 4 * q) * 4) = (f32x4){Gc[4 * q], Gc[4 * q + 1], Gc[4 * q + 2], Gc[4 * q + 3]};
                    }
                }
                if (c + 4 < NCH) load_raw(c + 4);
                asm volatile("s_waitcnt lgkmcnt(0)" ::: "memory");
                f32x4 m0 = (f32x4){0.f, 0.f, 0.f, 0.f}, m1 = m0, m3 = m0, m4 = m0;
                asm volatile("" : "+v"(m0), "+v"(m1), "+v"(m3), "+v"(m4));
#pragma unroll
                for (int ks = 0; ks < 2; ++ks) {
                    const bf16x8 xa = *(const LAS bf16x8*)(sb + CS_AT + tn * 144 + 64 * ks + 16 * gq), xr = *(const LAS bf16x8*)(sb + CS_RT + tn * 144 + 64 * ks + 16 * gq);
                    const bf16x8 yb = *(const LAS bf16x8*)(scr + CS_BT + tn * 144 + 64 * ks + 16 * gq), yk = *(const LAS bf16x8*)(scr + CS_KT + tn * 144 + 64 * ks + 16 * gq);
                    m0 = __builtin_amdgcn_mfma_f32_16x16x32_bf16(yb, xa, m0, 0, 0, 0);
                    m1 = __builtin_amdgcn_mfma_f32_16x16x32_bf16(yk, xa, m1, 0, 0, 0);
                    m3 = __builtin_amdgcn_mfma_f32_16x16x32_bf16(yb, xr, m3, 0, 0, 0);
                    m4 = __builtin_amdgcn_mfma_f32_16x16x32_bf16(yk, xr, m4, 0, 0, 0);
                }
                {
                    f32x4 n0, q1, q3, q4;
#pragma unroll
                    for (int rg = 0; rg < 4; ++rg) { const int s = 4 * gq + rg; const bool lt = s < tn, le = s <= tn;
                        n0[rg] = lt ? m0[rg] : 0.f; q1[rg] = lt ? m1[rg] : 0.f; q3[rg] = le ? m3[rg] : 0.f; q4[rg] = le ? m4[rg] : 0.f;
                        *(LAS float*)(scr + CS_NN + (s * 16 + tn) * 4) = n0[rg]; }
                    u32x2 w1; w1.x = cvt_pk_bf16(q1[0], q1[1]); w1.y = cvt_pk_bf16(q1[2], q1[3]);
                    *(LAS u32x2*)(sb + CS_AAK + tn * 80 + 16 * gq) = w1;
                    u32x4 w3; w3.x = cvt_pk_bf16(q3[0], q3[1]); w3.y = cvt_pk_bf16(q3[2], q3[3]); w3.z = cvt_pk_bf16(q4[0], q4[1]); w3.w = cvt_pk_bf16(q4[2], q4[3]);
                    *(LAS u32x4*)(sb + CS_ARK + tn * 80 + 16 * gq) = w3;
                }
                asm volatile("s_waitcnt lgkmcnt(0)" ::: "memory");
                float Tc[16];
#pragma unroll
                for (int s = 0; s < 16; ++s) Tc[s] = (s == tn) ? 1.0f : 0.0f;
                {
                    const LAS f32x4* NR = (const LAS f32x4*)(scr + CS_NN);
                    f32x4 cq[4], nq[4];
#pragma unroll
                    for (int k = 0; k < 4; ++k) { cq[k] = NR[4 * 14 + k]; nq[k] = cq[k]; }
#pragma unroll
                    for (int s = 14; s >= 0; --s) {
                        if (s > 0) {
#pragma unroll
                            for (int k = 0; k < 4; ++k) if (4 * k + 3 > s - 1) nq[k] = NR[4 * (s - 1) + k];
                        }
                        float acc0 = 0.f, acc1 = 0.f;
#pragma unroll
                        for (int q = s + 1; q < 16; ++q) { if (q & 1) acc1 += Tc[q] * cq[q >> 2][q & 3]; else acc0 += Tc[q] * cq[q >> 2][q & 3]; }
                        Tc[s] = (s < tn) ? (acc0 + acc1) : Tc[s];
#pragma unroll
                        for (int k = 0; k < 4; ++k) cq[k] = nq[k];
                    }
                }
                if (lane < 16) {
#pragma unroll
                    for (int g4 = 0; g4 < 4; ++g4) { u32x2 w; w.x = cvt_pk_bf16(Tc[4 * g4], Tc[4 * g4 + 1]); w.y = cvt_pk_bf16(Tc[4 * g4 + 2], Tc[4 * g4 + 3]); *(LAS u32x2*)(sb + CS_TT + tn * 80 + 16 * g4) = w; }
                }
                __builtin_amdgcn_fence(__ATOMIC_RELEASE, "workgroup");
                asm volatile("s_waitcnt lgkmcnt(0)" ::: "memory");
                if (lane == 0) flags[slot] = (unsigned)(c + 1);
            }
        }
    }
}

__device__ __forceinline__ void p5_rwkv_out(const Args& a, int lane, int wave, int G) {
    unsigned char* ws = a.ws;
    const bf16_t* FB = (const bf16_t*)(ws + WS_FEAT); const size_t astr = FEAT_STRIDE / 2;
    const bf16_t* YF = (const bf16_t*)(ws + WS_YF); const bf16_t* YBk = (const bf16_t*)(ws + WS_YB);
    bf16_t* RWK = (bf16_t*)(ws + WS_RWK);
    const int gw = blockIdx.x * 8 + wave, NGW = G * 8;
    const int c0 = 8 * lane;
    float lnw[8], lnb[8], rk[8];
#pragma unroll
    for (int j = 0; j < 8; ++j) { lnw[j] = a.in[I_LNW][c0 + j]; lnb[j] = a.in[I_LNB][c0 + j]; rk[j] = a.in[I_RK][c0 + j]; }
    auto ld8 = [&](const bf16_t* p, float (&o)[8]) { const u32x4 w = *(const u32x4*)p;
#pragma unroll
        for (int j = 0; j < 4; ++j) { o[2 * j] = lo16(w[j]); o[2 * j + 1] = hi16(w[j]); } };
    const int rpw = (T + NGW - 1) / NGW, mbeg = gw * rpw, mend = (mbeg + rpw < T) ? mbeg + rpw : T;
    if (mbeg >= mend) return;
    u32x4 nx[7];
    auto ldrow = [&](int m) { const size_t o = (size_t)m * RD + c0;
        nx[0] = *(const u32x4*)(YF + o); nx[1] = *(const u32x4*)(YBk + o); nx[2] = *(const u32x4*)(FB + F_R * astr + o); nx[3] = *(const u32x4*)(FB + F_KF * astr + o);
        nx[4] = *(const u32x4*)(FB + F_KB * astr + o); nx[5] = *(const u32x4*)(FB + F_V * astr + o); nx[6] = *(const u32x4*)(FB + F_G * astr + o); };
    auto up8 = [&](const u32x4 w, float (&o)[8]) {
#pragma unroll
        for (int j = 0; j < 4; ++j) { o[2 * j] = lo16(w[j]); o[2 * j + 1] = hi16(w[j]); } };
    ldrow(mbeg);
    for (int m = mbeg; m < mend; ++m) {
        const size_t o = (size_t)m * RD + c0;
        float yf[8], yb[8], r[8], kf[8], kb[8], v[8], g[8];
        up8(nx[0], yf); up8(nx[1], yb); up8(nx[2], r); up8(nx[3], kf); up8(nx[4], kb); up8(nx[5], v); up8(nx[6], g);
        if (m + 1 < mend) ldrow(m + 1);
        float s = 0.f, bs = 0.f;
#pragma unroll
        for (int j = 0; j < 8; ++j) { yf[j] += yb[j]; s += yf[j]; bs += r[j] * (kf[j] + kb[j]) * rk[j]; }
        s += __shfl_xor(s, 1); s += __shfl_xor(s, 2); s += __shfl_xor(s, 4);
        bs += __shfl_xor(bs, 1); bs += __shfl_xor(bs, 2); bs += __shfl_xor(bs, 4);
        const float mean = s * (1.f / 64.f); float q = 0.f;
#pragma unroll
        for (int j = 0; j < 8; ++j) { yf[j] -= mean; q += yf[j] * yf[j]; }
        q += __shfl_xor(q, 1); q += __shfl_xor(q, 2); q += __shfl_xor(q, 4);
        const float rstd = 1.0f / sqrtf(q * (1.f / 64.f) + GN_EPS);
        float out[8];
#pragma unroll
        for (int j = 0; j < 8; ++j) out[j] = (yf[j] * rstd * lnw[j] + lnb[j] + bs * v[j]) * g[j];
        u32x4 w; w.x = pk2(out[0], out[1]); w.y = pk2(out[2], out[3]); w.z = pk2(out[4], out[5]); w.w = pk2(out[6], out[7]);
        *(u32x4*)(RWK + o) = w;
    }
}

template <bool PROBE> __device__ __forceinline__ void p9_postmix_router(const Args& a, LAS unsigned char* lds, int tid, int lane, int wave, int G) {
    unsigned char* ws = a.ws;
    const float* MOD = (const float*)(ws + WS_CTL) + CW_MOD;
    const bf16_t* MIX = (const bf16_t*)(ws + WS_MIX);
    bf16_t* HF = (bf16_t*)(ws + (PROBE ? WS_H + 160 * MiB : WS_HF));
    int* cnt = (int*)(ws + WS_CTL) + (PROBE ? 12000 : CW_CNT);
    int* slot_tok = (int*)(ws + (PROBE ? WS_H + 240 * MiB : WS_SLOT_TOK)); float* slot_gate = (float*)(ws + (PROBE ? WS_H + 248 * MiB : WS_SLOT_GATE)); unsigned* tokk = (unsigned*)(ws + (PROBE ? WS_H + 256 * MiB : WS_TOKK));
    constexpr int HP = 1028;
    LAS float* HL = (LAS float*)lds;
    LAS float* PART = HL + 16 * HP;
    LAS int* SEL_E = (LAS int*)(lds + 90112); LAS float* SEL_G = (LAS float*)(lds + 90112 + 2048); LAS int* SEL_M = (LAS int*)(lds + 90112 + 4096);
    LAS int* HIST = (LAS int*)(lds + 90112 + 6144); LAS int* BASE = HIST + 32;
    int nsel = 0;
    const int ti = lane & 15, kq = lane >> 4;
    float wb0[32], wb1[32];
    {
        const float* wr = a.in[I_WROUTER];
#pragma unroll
        for (int ks = 0; ks < 32; ++ks) { const int k = 128 * wave + 4 * ks + kq; wb0[ks] = wr[k * NE + ti]; wb1[ks] = wr[k * NE + 16 + ti]; }
    }
    const float brt = a.in[I_BROUTER][lane & 31];
    for (int unit = blockIdx.x; unit < T / 16; unit += G) {
        const int tok0 = unit * 16;
        __syncthreads();
        {
            const int m0 = tok0 + 2 * wave; const int b = m0 >> 12;
            f32x4 v[2][4]; float s[2] = {0.f, 0.f};
#pragma unroll
            for (int tt = 0; tt < 2; ++tt) { const u32x2* mr = (const u32x2*)(MIX + (size_t)(m0 + tt) * D) + lane;
#pragma unroll
                for (int j = 0; j < 4; ++j) { const u32x2 w = mr[64 * j]; v[tt][j] = (f32x4){lo16(w.x), hi16(w.x), lo16(w.y), hi16(w.y)}; s[tt] += (v[tt][j].x * v[tt][j].x + v[tt][j].y * v[tt][j].y) + (v[tt][j].z * v[tt][j].z + v[tt][j].w * v[tt][j].w); } }
            f32x4 xv[2][4];
#pragma unroll
            for (int tt = 0; tt < 2; ++tt) { const f32x4* xr = (const f32x4*)(a.in[I_X] + (size_t)(m0 + tt) * D) + lane;
#pragma unroll
                for (int j = 0; j < 4; ++j) xv[tt][j] = xr[64 * j]; }
#pragma unroll
            for (int o = 1; o < 64; o <<= 1) { s[0] += __shfl_xor(s[0], o); s[1] += __shfl_xor(s[1], o); }
            float s2[2] = {0.f, 0.f};
#pragma unroll
            for (int j = 0; j < 4; ++j) {
                const f32x4 g = ((const f32x4*)a.in[I_GPOSTMIX])[64 * j + lane], gt = ((const f32x4*)(MOD + b * 6144 + 2048))[64 * j + lane];
#pragma unroll
                for (int tt = 0; tt < 2; ++tt) {
                    const float rstd = __builtin_amdgcn_rsqf(s[tt] * (1.f / D) + RMS_EPS);
                    v[tt][j] = xv[tt][j] + gt * (v[tt][j] * rstd * g);
                    s2[tt] += (v[tt][j].x * v[tt][j].x + v[tt][j].y * v[tt][j].y) + (v[tt][j].z * v[tt][j].z + v[tt][j].w * v[tt][j].w);
                }
            }
#pragma unroll
            for (int o = 1; o < 64; o <<= 1) { s2[0] += __shfl_xor(s2[0], o); s2[1] += __shfl_xor(s2[1], o); }
#pragma unroll
            for (int j = 0; j < 4; ++j) {
                const f32x4 g = ((const f32x4*)a.in[I_GPREFFN])[64 * j + lane], sh = ((const f32x4*)(MOD + b * 6144 + 3072))[64 * j + lane], sc = ((const f32x4*)(MOD + b * 6144 + 4096))[64 * j + lane];
#pragma unroll
                for (int tt = 0; tt < 2; ++tt) {
                    const float rstd2 = __builtin_amdgcn_rsqf(s2[tt] * (1.f / D) + RMS_EPS);
                    const f32x4 hv = (v[tt][j] * rstd2 * g) * (sc + 1.0f) + sh;
                    ((unsigned*)((unsigned char*)HF + (size_t)(m0 + tt) * D))[64 * j + lane] = pk4_fp8(hv.x * F8_ASCALE, hv.y * F8_ASCALE, hv.z * F8_ASCALE, hv.w * F8_ASCALE);
                    *(LAS f32x4*)(HL + (2 * wave + tt) * HP + 256 * j + 4 * lane) = hv;
                }
            }
        }
        __syncthreads();
        {
            f32x4 acc0 = (f32x4){0.f, 0.f, 0.f, 0.f}, acc1 = acc0;
#pragma unroll
            for (int ks = 0; ks < 32; ++ks) {
                const float av = HL[ti * HP + 128 * wave + 4 * ks + kq];
                acc0 = __builtin_amdgcn_mfma_f32_16x16x4f32(av, wb0[ks], acc0, 0, 0, 0);
                acc1 = __builtin_amdgcn_mfma_f32_16x16x4f32(av, wb1[ks], acc1, 0, 0, 0);
            }
#pragma unroll
            for (int r = 0; r < 4; ++r) { PART[(wave * 16 + 4 * kq + r) * 32 + ti] = acc0[r]; PART[(wave * 16 + 4 * kq + r) * 32 + 16 + ti] = acc1[r]; }
        }
        __syncthreads();
        {
            const int tl = 2 * wave + (lane >> 5); const int m = tok0 + tl;
            const int e = lane & 31;
            float lg = brt;
#pragma unroll
            for (int w = 0; w < 8; ++w) lg += PART[(w * 16 + tl) * 32 + e];
            float tv[4]; int ti4[4];
#pragma unroll
            for (int k = 0; k < 4; ++k) {
                float bv = lg; int bi = e;
#pragma unroll
                for (int o = 1; o < 32; o <<= 1) { const float ov = __shfl_xor(bv, o); const int oi = __shfl_xor(bi, o); if (ov > bv || (ov == bv && oi < bi)) { bv = ov; bi = oi; } }
                tv[k] = bv; ti4[k] = bi;
                if (e == bi) lg = -3.0e38f;
            }
            const float e1 = __expf(tv[1] - tv[0]), e2 = __expf(tv[2] - tv[0]), e3 = __expf(tv[3] - tv[0]);
            const float inv = 1.0f / (1.0f + e1 + e2 + e3);
            if (e < 4) {
                const int ek = e == 0 ? ti4[0] : e == 1 ? ti4[1] : e == 2 ? ti4[2] : ti4[3];
                const float gk = (e == 0 ? 1.0f : e == 1 ? e1 : e == 2 ? e2 : e3) * inv;
                const int si = nsel * 64 + tl * 4 + e;
                SEL_E[si] = ek; SEL_G[si] = gk; SEL_M[si] = m;
            }
        }
        ++nsel;
    }
    __syncthreads();
    if (tid < 32) HIST[tid] = 0;
    __syncthreads();
    int my_e = 0, my_lr = 0; const bool have = tid < nsel * 64;
    if (have) { my_e = SEL_E[tid]; my_lr = __hip_atomic_fetch_add(HIST + my_e, 1, __ATOMIC_RELAXED, __HIP_MEMORY_SCOPE_WORKGROUP); }
    __syncthreads();
    if (tid < 32) { const int n = HIST[tid]; BASE[tid] = n ? atomicAdd(cnt + tid, n) : 0; }
    __syncthreads();
    if (have) { const int rank = BASE[my_e] + my_lr; const int m = SEL_M[tid];
        slot_tok[my_e * T + rank] = m; slot_gate[(size_t)my_e * T + rank] = SEL_G[tid];
        tokk[m * 4 + (tid & 3)] = ((unsigned)my_e << 20) | (unsigned)rank; }
}

__device__ __forceinline__ void moe_table(const Args& a, LAS int* tstart, int tid) {
    const int* cnt = (const int*)(a.ws + WS_CTL) + CW_CNT;
    __syncthreads();
    if (tid < 32) {
        const int n = __hip_atomic_load(cnt + tid, __ATOMIC_RELAXED, __HIP_MEMORY_SCOPE_AGENT); const int tl = (n + 255) >> 8;
        int incl = tl;
#pragma unroll
        for (int o = 1; o < 32; o <<= 1) { const int v = __shfl_up(incl, o, 32); if (tid >= o) incl += v; }
        tstart[tid] = incl - tl; tstart[TCNT_OFF / 4 - RING_BYTES / 4 + tid] = n; if (tid == 31) tstart[NE] = incl;
    }
    __syncthreads();
}

__device__ __forceinline__ void p12_combine(const Args& a, LAS int* tstart, int lane, int wave, int G) {
    unsigned char* ws = a.ws;
    const float* MOD = (const float*)(ws + WS_CTL) + CW_MOD;
    const unsigned char* YB = (const unsigned char*)(ws + WS_YBUF); const unsigned* tokk = (const unsigned*)(ws + WS_TOKK);
    const bf16_t* MIX = (const bf16_t*)(ws + WS_MIX);
    const int gw = blockIdx.x * 8 + wave, NGW = G * 8, rpw = (T + NGW - 1) / NGW;
    const int mbeg = gw * rpw, mend = (mbeg + rpw < T) ? mbeg + rpw : T;
    if (mbeg >= mend) return;
    f32x4 gf[4], gmx[4];
    int bcur = -1;
    unsigned yw[4][4]; f32x4 xr[4]; u32x2 mw[4];
    auto ldrow = [&](int m, const u32x4 tk4) {
#pragma unroll
        for (int k = 0; k < 4; ++k) {
            const unsigned tk = tk4[k]; const int e = (int)(tk >> 20), rank = (int)(tk & 0xfffffu);
            const unsigned* yr = (const unsigned*)(YB + ((size_t)tstart[e] * 256 + rank) * D) + lane;
#pragma unroll
            for (int j = 0; j < 4; ++j) yw[k][j] = yr[64 * j];
        }
#pragma unroll
        for (int j = 0; j < 4; ++j) { xr[j] = ((const f32x4*)(a.in[I_X] + (size_t)m * D))[64 * j + lane]; mw[j] = ((const u32x2*)(MIX + (size_t)m * D))[64 * j + lane]; }
    };
    u32x4 tkn = *(const u32x4*)(tokk + mbeg * 4);
    ldrow(mbeg, tkn);
    if (mbeg + 1 < mend) tkn = *(const u32x4*)(tokk + (mbeg + 1) * 4);
    for (int m = mbeg; m < mend; ++m) {
        const int b = m >> 12;
        if (b != bcur) { bcur = b;
#pragma unroll
            for (int j = 0; j < 4; ++j) { gf[j] = ((const f32x4*)a.in[I_GPOSTFFN])[64 * j + lane] * ((const f32x4*)(MOD + b * 6144 + 5120))[64 * j + lane];
                gmx[j] = ((const f32x4*)a.in[I_GPOSTMIX])[64 * j + lane] * ((const f32x4*)(MOD + b * 6144 + 2048))[64 * j + lane]; } }
        f32x4 x0[4], mv[4]; float sm = 0.f;
#pragma unroll
        for (int j = 0; j < 4; ++j) { x0[j] = xr[j]; const u32x2 w = mw[j]; mv[j] = (f32x4){lo16(w.x), hi16(w.x), lo16(w.y), hi16(w.y)};
            sm += (mv[j].x * mv[j].x + mv[j].y * mv[j].y) + (mv[j].z * mv[j].z + mv[j].w * mv[j].w); }
        f32x4 y[4]; float s = 0.f;
#pragma unroll
        for (int j = 0; j < 4; ++j) { y[j] = (f32x4){0.f, 0.f, 0.f, 0.f};
#pragma unroll
            for (int k = 0; k < 4; ++k) { const f32x2_t lo = __builtin_amdgcn_cvt_pk_f32_fp8((int)yw[k][j], false), hi = __builtin_amdgcn_cvt_pk_f32_fp8((int)yw[k][j], true); y[j] += (f32x4){lo.x, lo.y, hi.x, hi.y}; }
            s += (y[j][0] * y[j][0] + y[j][1] * y[j][1]) + (y[j][2] * y[j][2] + y[j][3] * y[j][3]); }
        if (m + 1 < mend) { const u32x4 tk4 = tkn; if (m + 2 < mend) tkn = *(const u32x4*)(tokk + (m + 2) * 4); ldrow(m + 1, tk4); }
#pragma unroll
        for (int o = 1; o < 64; o <<= 1) { s += __shfl_xor(s, o); sm += __shfl_xor(sm, o); }
        const float rstd = __builtin_amdgcn_rsqf(s * (1.f / D) + RMS_EPS * F8_YSCALE * F8_YSCALE);
        const float rstdm = __builtin_amdgcn_rsqf(sm * (1.f / D) + RMS_EPS);
#pragma unroll
        for (int j = 0; j < 4; ++j) {
            const f32x4 x1 = x0[j] + gmx[j] * (mv[j] * rstdm);
            ((f32x4*)(a.out + (size_t)m * D))[64 * j + lane] = x1 + gf[j] * (y[j] * rstd);
        }
    }
}

constexpr int N_PHASES = 13;
__global__ void __launch_bounds__(512, 2) mega_fwd(Args args) {
    extern __shared__ __attribute__((aligned(16))) unsigned char lds_raw[];
    LAS unsigned char* lds = (LAS unsigned char*)lds_raw;
    const int tid = threadIdx.x, lane = tid & 63, wave = __builtin_amdgcn_readfirstlane(tid >> 6);
    const int G = gridDim.x;
    volatile LAS unsigned* MISC = (volatile LAS unsigned*)(lds + MISC_OFF);
    LAS int* tstart = (LAS int*)(lds + RING_BYTES);
    for (int u = tid; u < (LDS_BYTES - RING_BYTES) / 4; u += 512) ((LAS unsigned*)(lds + RING_BYTES))[u] = 0u;
    __syncthreads();
    unsigned char* ws = args.ws;
    const int lo = args.ph_lo, hi = args.ph_hi;
    unsigned* barw = (unsigned*)(ws + WS_CTL) + (args.bar_region ? (131072 + (args.bar_region - 1) * 4096) : CW_BAR);
    XcdBarrier bar; bar.bar = barw; bar.x = 0; bar.st = nullptr;
    if (hi - lo > 1) bar = xcd_barrier_post(barw, MISC + 8);
#ifndef PH_MASK
#define PH_MASK 0x1FFF
#endif
#define IN(k) (((PH_MASK >> (k)) & 1) && lo <= (k) && (k) < hi)
#define SEAM(k) do { if (IN(k) && IN((k) + 1)) xcd_barrier(bar); } while (0)

    if (IN(0)) { p0_prologue(args, lds, tid, lane, wave, G); SEAM(0); }
    if (IN(1)) { p1_norm(args, lane, wave, G); SEAM(1); }
    if (IN(2)) {
        SchedProj S{(const char*)(ws + WS_WIN), G, (int)blockIdx.x};
        EpiZ E{(bf16_t*)(ws + WS_Z), (const float*)(ws + WS_MISC)};
        pg8::gemm_phase<1024, EpiZ, SchedProj>(lds, (const char*)(ws + WS_HX), S, E);
        SEAM(2);
    }
    if (IN(3)) { p3a_pointwise(args, tid, G); if (IN(4)) xcd_barrier(bar); p3b_features(args, lds, tid, lane, wave, G); SEAM(3); }
    if (IN(5)) { if (SCAN_CHUNKED && !SCAN_FORCE_DIRECT) p4_scan_chunked<false>(args, lds, tid, lane, wave, G); else p4_scan<0>(args, lds, tid, lane, wave, G);
        p4_attention(args, lds, tid, lane, wave, G);
        moe_weight_copies(args, lds, tid, lane, wave);
        SEAM(5); }
#if DBG_SCAN
    if (IN(6) && blockIdx.x == 0) {
        const bf16_t* Yt = (const bf16_t*)(ws + (DBG_DIR ? WS_YB : WS_YF)); const bf16_t* Y2 = (const bf16_t*)(ws + 272 * MiB);
        LAS float* red = (LAS float*)lds; float* dbg = (float*)(ws + WS_CTL) + 12288;
        int first = -1; float worst = 0.f;
        for (int ci = 0; ci < 256; ++ci) {
            float e2 = 0.f, r2 = 0.f;
            for (int i = tid; i < 16 * 512; i += 512) { const int cc = DBG_DIR ? (255 - ci) : ci; const size_t o = (size_t)(cc * 16) * 512 + i; const float yt = bf2f(Yt[o]), y2 = bf2f(Y2[o]); e2 += (yt - y2) * (yt - y2); r2 += yt * yt; }
            e2 = wave_sum(e2); r2 = wave_sum(r2);
            __syncthreads(); if (lane == 0) { red[wave] = e2; red[8 + wave] = r2; } __syncthreads();
            float E = 0.f, R = 0.f; for (int w8 = 0; w8 < 8; ++w8) { E += red[w8]; R += red[8 + w8]; }
            const float rel = sqrtf(E / fmaxf(R, 1e-20f));
            if (first < 0 && !(rel < 0.03f)) first = ci;
            if (ci == DBG_CHUNK) { worst = rel;
                if (DBG_MODE == 2) { float z = 0.f; for (int i = tid; i < 16 * 512; i += 512) { const int cc = DBG_DIR ? (255 - ci) : ci; z += ((Y2[(size_t)(cc * 16) * 512 + i] & 0x7fff) > 0x7f80) ? 1.f : 0.f; }
                    z = wave_sum(z); __syncthreads(); if (lane == 0) red[16 + wave] = z; __syncthreads(); float Z = 0.f; for (int w8 = 0; w8 < 8; ++w8) Z += red[16 + w8]; worst = Z / 8192.f; } }
        }
        if (tid == 0) dbg[0] = DBG_MODE ? worst : ((first < 0) ? 0.f : (float)(first + 1) / 256.f);
    }
#endif
    if (IN(6)) {
        p5_rwkv_out(args, lane, wave, G);
        SchedDense<512> S{(const char*)(ws + WS_WUPA), G, (int)blockIdx.x};
        EpiUp<false> E{(bf16_t*)(ws + WS_MERGED), (const bf16_t*)(ws + WS_Z)};
        pg8::gemm_phase<512, EpiUp<false>, SchedDense<512>>(lds, (const char*)(ws + WS_ATT), S, E);
        SEAM(6);
    }
    if (IN(7)) {
        SchedDense<512> S{(const char*)(ws + WS_WUPR), G, (int)blockIdx.x};
        EpiUp<true> E{(bf16_t*)(ws + WS_MERGED), (const bf16_t*)(ws + WS_Z)};
        pg8::gemm_phase<512, EpiUp<true>, SchedDense<512>>(lds, (const char*)(ws + WS_RWK), S, E);
        SEAM(7);
    }
    if (IN(8)) {
        SchedDense<1024> S{(const char*)(ws + WS_WOUT), G, (int)blockIdx.x};
        EpiMix E{(bf16_t*)(ws + WS_MIX)};
        pg8::gemm_phase<1024, EpiMix, SchedDense<1024>>(lds, (const char*)(ws + WS_MERGED), S, E);
        SEAM(8);
    }
    if (IN(9)) { p9_postmix_router<false>(args, lds, tid, lane, wave, G); SEAM(9); }
    if (IN(10)) {
        moe_table(args, tstart, tid);
        SchedMoe<8, true, 1> S{(const char*)(ws + WS_WGU), G, (int)blockIdx.x, tstart, (const int*)(ws + WS_CTL) + CW_CNT, (const int*)(ws + WS_SLOT_TOK), (const LAS int*)(lds + TCNT_OFF)};
        EpiMoe1 E{(bf16_t*)(ws + WS_H), args.in[I_BGU]};
        pg8::gemm_phase<1024, EpiMoe1, SchedMoe<8, true, 1>, true>(lds, (const char*)(ws + WS_HF), S, E);
        SEAM(10);
    }
    if (IN(11)) {
        moe_table(args, tstart, tid);
        SchedMoe<4, false, 1> S{(const char*)(ws + WS_WDN), G, (int)blockIdx.x, tstart, (const int*)(ws + WS_CTL) + CW_CNT, (const int*)(ws + WS_SLOT_TOK), (const LAS int*)(lds + TCNT_OFF)};
        EpiMoe2 E{(unsigned char*)(ws + WS_YBUF), args.in[I_BDN], (const float*)(ws + WS_SLOT_GATE), (const LAS int*)(lds + TCNT_OFF)};
        pg8::gemm_phase<1024, EpiMoe2, SchedMoe<4, false, 1>, true>(lds, (const char*)(ws + WS_H), S, E);
        SEAM(11);
    }
    if (IN(12)) { moe_table(args, tstart, tid); p12_combine(args, tstart, lane, wave, G); }
#ifdef PROBE_PHASE
    if (lo == 15 && blockIdx.x == 0 && tid < 32) { unsigned* ctl = (unsigned*)(ws + WS_CTL); if (tid == 0) { ctl[CW_QATT] = 0u; ctl[CW_QTR] = PROBE_QTR0; } ctl[CW_CNT + tid] = 0u; }
    if (lo == 16) p9_postmix_router<true>(args, lds, tid, lane, wave, G);
    if (lo == 18) p4_attention(args, lds, tid, lane, wave, G);
    if (lo == 13) p3a_pointwise(args, tid, G);
    if (lo == 14) p3b_features(args, lds, tid, lane, wave, G);
#endif
#undef IN
#undef SEAM
}

extern "C" void kernel_launch(void* const* d_in, const int* in_sizes, int n_in, void* d_out, int out_size, void* d_ws, size_t ws_size, hipStream_t stream) {
    static int grid = 0;
    if (grid == 0) {
        if (n_in != 38 || out_size != T * D || ws_size < WS_END) { fprintf(stderr, "kernel_launch: unexpected problem shape (n_in %d, out %d, ws %zu)\n", n_in, out_size, ws_size); grid = -1; return; }
        int dev = 0, cus = 0, per_cu = 0;
        if (hipGetDevice(&dev) != hipSuccess || hipDeviceGetAttribute(&cus, hipDeviceAttributeMultiprocessorCount, dev) != hipSuccess) { grid = -1; return; }
        if (hipFuncSetAttribute((const void*)mega_fwd, hipFuncAttributeMaxDynamicSharedMemorySize, LDS_BYTES) != hipSuccess) { fprintf(stderr, "kernel_launch: hipFuncSetAttribute failed\n"); grid = -1; return; }
        if (hipOccupancyMaxActiveBlocksPerMultiprocessor(&per_cu, (const void*)mega_fwd, 512, LDS_BYTES) != hipSuccess || per_cu < 1) fprintf(stderr, "kernel_launch: occupancy query says %d\n", per_cu);
        (void)hipGetLastError();
        grid = cus;
    }
    if (grid < 0) return;
    (void)hipMemsetAsync((char*)d_ws + WS_CTL, 0, CTL_BYTES, stream);
    Args a{};
    for (int i = 0; i < 38; ++i) a.in[i] = (const float*)d_in[i];
    a.out = (float*)d_out; a.ws = (unsigned char*)d_ws;
#if MK_ONE_LAUNCH
    a.ph_lo = 0; a.ph_hi = N_PHASES;
    hipLaunchKernelGGL(mega_fwd, dim3(grid), dim3(512), LDS_BYTES, stream, a);
#ifdef PROBE_PHASE
#ifdef PROBE_PRE
    { a.ph_lo = PROBE_PRE; a.ph_hi = PROBE_PRE + 1; hipLaunchKernelGGL(mega_fwd, dim3(grid), dim3(512), LDS_BYTES, stream, a); }
#endif
    for (int rep = 0; rep < PROBE_REPS; ++rep) { a.ph_lo = PROBE_PHASE; a.ph_hi = PROBE_HI; a.bar_region = 1 + rep; hipLaunchKernelGGL(mega_fwd, dim3(grid), dim3(512), LDS_BYTES, stream, a); }
#endif
#else
    for (int p = 0; p < N_PHASES; ++p) { a.ph_lo = p; a.ph_hi = p + 1; hipLaunchKernelGGL(mega_fwd, dim3(grid), dim3(512), LDS_BYTES, stream, a); }
#endif
}
```

```cpp
#include <hip/hip_runtime.h>
#include <cstdio>
#include <cstdint>

#ifndef MK_ONE_LAUNCH
#define MK_ONE_LAUNCH 1
#endif
#ifndef PROBE_QTR0
#define PROBE_QTR0 0u
#endif
#ifndef PROBE_HI
#define PROBE_HI (PROBE_PHASE + 1)
#endif
#ifndef SCAN_CHUNKED
#define SCAN_CHUNKED 1
#endif
#ifndef SCAN_FORCE_DIRECT
#define SCAN_FORCE_DIRECT 0
#endif
#ifndef DBG_SCAN
#define DBG_SCAN 0
#define DBG_DIR 0
#define DBG_MODE 0
#define DBG_CHUNK 0
#endif
#ifndef DBG_NOA
#define DBG_NOA 0
#define DBG_NOB 0
#endif
#ifndef DBG_D
#define DBG_D 0
#endif
#ifndef DBG_TI
#define DBG_TI 0
#endif
#ifndef CS_LOCKSTEP
#define CS_LOCKSTEP 0
#endif

#define GAS __attribute__((address_space(1)))
#define LAS __attribute__((address_space(3)))
typedef unsigned short bf16_t;
typedef short bf16x8 __attribute__((ext_vector_type(8)));
typedef short s16x4 __attribute__((ext_vector_type(4)));
typedef float f32x4 __attribute__((ext_vector_type(4)));
typedef float f32x16 __attribute__((ext_vector_type(16)));
typedef unsigned u32x4 __attribute__((ext_vector_type(4)));
typedef unsigned u32x2 __attribute__((ext_vector_type(2)));

constexpr int NB = 8, SEQ = 4096, T = NB * SEQ, D = 1024, CL = 256, TC = NB * CL, ROWS = T + TC;
constexpr int NH = 8, HD = 64, NKV = 2, RD = 512;
constexpr int NE = 32, TOPK = 4, DE = 1024;
constexpr int PROJ_SRC = 4736;
constexpr int ZP = 4864;
constexpr int ZC_Q = 0, ZC_K = 512, ZC_V = 640, ZC_R = 768, ZC_RK = 1280, ZC_RV = 1792, ZC_LORA = 2304, ZC_G = 2816;
constexpr int NTILE_N = ZP / 256;
constexpr float RMS_EPS = 1e-6f, GN_EPS = 64e-5f;
constexpr float F8_WSCALE = 32.0f, F8_ASCALE = 4.0f, F8_HSCALE = 8.0f, F8_YSCALE = 32.0f, F8_GWSCALE = 32.0f, F8_GASCALE = 4.0f, F8_ZSCALE = 8.0f, F8_BSCALE = 64.0f, F8_KSCALE = 8.0f, F8_MSCALE = 16.0f;

constexpr size_t MiB = 1u << 20;
constexpr size_t WS_CTL = 0, CTL_BYTES = 1 * MiB;
constexpr size_t WS_WIN = 1 * MiB;
constexpr size_t WS_WUPA = 11 * MiB, WS_WUPR = 12 * MiB;
constexpr size_t WS_WOUT = 13 * MiB;
constexpr size_t WS_LORA = 15 * MiB;
constexpr size_t WS_MISC = 15 * MiB + 512 * 1024;
constexpr size_t WS_WGU = 16 * MiB;
constexpr size_t WS_WDN = 144 * MiB;
constexpr size_t WS_HX = 208 * MiB;
constexpr size_t WS_YF = 208 * MiB, WS_YB = 240 * MiB;
constexpr size_t WS_HF = 208 * MiB;
constexpr size_t WS_Z = 276 * MiB;
constexpr size_t WS_SLOT_TOK = 272 * MiB;
constexpr size_t WS_FEAT = 599 * MiB;
constexpr size_t FEAT_STRIDE = 34 * MiB;
constexpr size_t WS_MERGED = 769 * MiB;
constexpr size_t WS_MIX = 599 * MiB;
constexpr size_t WS_QR = 939 * MiB;
constexpr size_t WS_RWK = 939 * MiB;
constexpr size_t WS_KA = 971 * MiB;
constexpr size_t WS_VT = 980 * MiB;
constexpr size_t WS_ATT = 990 * MiB;
constexpr size_t WS_HX8 = 990 * MiB;
constexpr size_t WS_WIN8 = WS_WIN + (size_t)2816 * D * 2;
constexpr int NT_BF = 11, NT_F8 = 8;
constexpr size_t WS_SLOT_GATE = 276 * MiB;
constexpr size_t WS_TOKK = 280 * MiB;
constexpr size_t WS_H = 281 * MiB;
constexpr int MAXTILES = 544, MAXSLOT = MAXTILES * 256;
constexpr size_t WS_YBUF = 417 * MiB;
constexpr size_t WS_END = 1024 * MiB;
static_assert(WS_YBUF + (size_t)MAXSLOT * 1024 <= WS_MIX, "ws map");
static_assert(WS_H + (size_t)MAXSLOT * 1024 <= WS_YBUF, "ws map");
static_assert(WS_Z + (size_t)ROWS * ZP * 2 <= WS_FEAT, "ws map");
static_assert(WS_FEAT + 10 * FEAT_STRIDE <= WS_QR, "ws map");
static_assert(WS_ATT + (size_t)T * 512 * 2 <= WS_END, "ws map");
static_assert(WS_VT + 9 * MiB <= WS_ATT && WS_KA + (size_t)ROWS * 128 * 2 <= WS_VT, "ws map");
enum { F_R = 0, F_V, F_A, F_KF, F_KB, F_BF, F_BB, F_WF, F_WB, F_G };
constexpr int CW_BAR = 4096;
constexpr int CW_CNT = 8192;
constexpr int CW_QATT = 8320, CW_QTR = 8384;
constexpr int CW_MDONE = 9216;
constexpr int CW_MOD = 16384;
static_assert((CW_MOD + 9 * 6144) * 4 <= (int)CTL_BYTES, "ctl");

constexpr int RING_BYTES = 131072;
constexpr int MISC_OFF = RING_BYTES + 320;
constexpr int LDS_BYTES = 147456;
constexpr int TCNT_OFF = RING_BYTES + 384;
constexpr int TEXP_OFF = RING_BYTES + 1024;
constexpr int NOFF_OFF = RING_BYTES + 2048;
constexpr int TOK_OFF = RING_BYTES + 10240;
constexpr int SIDE_OFF = RING_BYTES + 12288;
static_assert(SIDE_OFF + 4096 <= LDS_BYTES, "lds map");

#define LDS_WAIT() asm volatile("s_waitcnt lgkmcnt(0)" ::: "memory")
#define VM_WAIT() asm volatile("s_waitcnt vmcnt(0)" ::: "memory")
__device__ __forceinline__ float bf2f(unsigned b) { return __uint_as_float(b << 16); }
__device__ __forceinline__ unsigned f2bf(float f) { unsigned u = __float_as_uint(f); return (u + 0x7fffu + ((u >> 16) & 1u)) >> 16; }
__device__ __forceinline__ unsigned pk2(float lo, float hi) { return f2bf(lo) | (f2bf(hi) << 16); }
__device__ __forceinline__ float lo16(unsigned w) { return __uint_as_float(w << 16); }
__device__ __forceinline__ float hi16(unsigned w) { return __uint_as_float(w & 0xffff0000u); }
__device__ __forceinline__ float sigmoidf_(float x) { return __builtin_amdgcn_rcpf(1.0f + __expf(-x)); }
__device__ __forceinline__ float wave_sum(float v) {
#pragma unroll
    for (int o = 1; o < 64; o <<= 1) v += __shfl_xor(v, o);
    return v;
}

#define XB_TMO      128
#define XB_XCNT(j)  (256  + 64 * (j))
#define XB_XSUB(j)  (1280 + 64 * (j))
#define XB_XGEN(j)  (2304 + 64 * (j))
#define XB_TOP      3328
#define XB_TOPGEN   3392
#define XCD_BAR_WORDS 3456
#define XB_SPIN_CAP (1u << 22)
__device__ __forceinline__ unsigned xb_ld(unsigned* p)              { return __hip_atomic_load(p, __ATOMIC_RELAXED, __HIP_MEMORY_SCOPE_AGENT); }
__device__ __forceinline__ unsigned xb_add(unsigned* p, unsigned v) { return __hip_atomic_fetch_add(p, v, __ATOMIC_RELAXED, __HIP_MEMORY_SCOPE_AGENT); }
__device__ __forceinline__ unsigned xb_xcc_id() { return (unsigned)__builtin_amdgcn_s_getreg((3 << 11) | 20) & 0xFu; }
#define XB_SPIN(cond, bar) do { unsigned _sp = 0; while (cond) { __builtin_amdgcn_s_sleep(1); \
    if ((++_sp & 255u) == 0u) { if (xb_ld(&(bar)[XB_TMO])) break; if (_sp > XB_SPIN_CAP) { atomicAdd(&(bar)[XB_TMO], 1u); break; } } } } while (0)
struct XcdBarrier { unsigned* bar; unsigned x; volatile LAS unsigned* st; };
__device__ __forceinline__ XcdBarrier xcd_barrier_post(unsigned* bar, volatile LAS unsigned* st) {
    XcdBarrier b; b.bar = bar; b.x = xb_xcc_id(); b.st = st;
    if (threadIdx.x == 0) (void)xb_add(&bar[XB_XCNT(b.x)], 1u);
    return b;
}
__device__ __forceinline__ void xcd_barrier_complete(unsigned* bar, unsigned x, unsigned& nloc, unsigned& nx) {
    const unsigned G = gridDim.x * gridDim.y * gridDim.z;
    unsigned sum, cnt, mine, sp = 0u;
    for (;;) {
        sum = 0u; cnt = 0u; mine = 0u;
#pragma unroll
        for (unsigned j = 0; j < 16; ++j) { const unsigned c = xb_ld(&bar[XB_XCNT(j)]); sum += c; cnt += (c > 0u) ? 1u : 0u; mine = (j == x) ? c : mine; }
        if (sum == G) break;
        __builtin_amdgcn_s_sleep(1);
        if ((++sp & 255u) == 0u) { if (xb_ld(&bar[XB_TMO])) break; if (sp > XB_SPIN_CAP) { atomicAdd(&bar[XB_TMO], 1u); break; } }
    }
    nloc = mine > 0u ? mine : 1u; nx = cnt > 0u ? cnt : 1u;
}
__device__ __forceinline__ void xcd_barrier(const XcdBarrier& b) {
    asm volatile("s_waitcnt vmcnt(0)" ::: "memory");
    __syncthreads();
    if (threadIdx.x == 0) {
        unsigned* bar = b.bar;
        __builtin_amdgcn_s_waitcnt(0);
        unsigned nloc = b.st[0], nx = b.st[1];
        if (nloc == 0u) { xcd_barrier_complete(bar, b.x, nloc, nx); b.st[0] = nloc; b.st[1] = nx; }
        const unsigned old = xb_add(&bar[XB_XSUB(b.x)], 1u);
        const unsigned gen = old / nloc;
        if (old + 1u == (gen + 1u) * nloc) {
            __builtin_amdgcn_fence(__ATOMIC_RELEASE, "agent");
            asm volatile("s_waitcnt vmcnt(0)" ::: "memory");
            const unsigned og = xb_add(&bar[XB_TOP], 1u);
            const unsigned tgt = (og / nx + 1u) * nx;
            if (og + 1u != tgt) XB_SPIN(xb_ld(&bar[XB_TOP]) < tgt, bar);
            __builtin_amdgcn_fence(__ATOMIC_ACQUIRE, "agent");
            xb_add(&bar[XB_XGEN(b.x)], 1u);
            asm volatile("s_waitcnt vmcnt(0)" ::: "memory");
        } else {
            XB_SPIN(xb_ld(&bar[XB_XGEN(b.x)]) == gen, bar);
            __builtin_amdgcn_fence(__ATOMIC_ACQUIRE, "agent");
            asm volatile("s_waitcnt vmcnt(0)" ::: "memory");
        }
    }
    __syncthreads();
}

namespace pg8 {
constexpr int BM = 256, BK = 64, HALF = 128, HTB = HALF * BK * 2, STAGE_BYTES = 8 * HTB;
__host__ __device__ __forceinline__ int lds_byte(int r, int c) { const int st = (r >> 4) * 2 + (c >> 5), rr = r & 15, cc = c & 31, ob = rr * 64 + cc * 2; return st * 1024 + (ob ^ (((ob >> 9) & 1) << 5)); }
__host__ __device__ __forceinline__ void stage_rc(int b, int& R, int& C) { const int st = b / 1024, sb = b % 1024, swz = sb ^ (((sb >> 9) & 1) << 5); R = (st >> 1) * 16 + swz / 64; C = (st & 1) * 32 + (swz % 64) / 2; }
__host__ __device__ __forceinline__ int perm32(int rho) { const int n = rho >> 4, i = rho & 15; return 8 * (i >> 2) + 4 * n + (i & 3); }

struct GUnit { const char* B; int pm, pn, e, lrow0; };

typedef int i32x8 __attribute__((ext_vector_type(8)));
template <class E, class = void> struct epi_pub { static constexpr bool v = false; };
template <class E> struct epi_pub<E, decltype((void)E::PUBLISH)> { static constexpr bool v = E::PUBLISH; };
template <int K, class Epi, class Sched, bool F8 = false>
__device__ __forceinline__ void gemm_phase(LAS unsigned char* lds, const char* Aroot, const Sched& S, const Epi& E) {
    const int tid = threadIdx.x, wid = __builtin_amdgcn_readfirstlane(tid >> 6), lane = tid & 63, wr = wid >> 2, wc = wid & 3, fr = lane & 15, fq = lane >> 4;
    constexpr int EB = F8 ? 1 : 2;
    constexpr int nt = K * EB / (BK * 2);
    static_assert(!Sched::GATHER || nt >= 6, "gather offsets are computed in the second K iteration");
    int Rr[2], Cc[2]; unsigned voffB[2];
#pragma unroll
    for (int i = 0; i < 2; ++i) { int R, C; stage_rc(tid * 16 + i * 8192, R, C); const int Rb = !Epi::PERM ? R : (Epi::PERMG ? ((R >> 5) * 64 + ((R >> 2) & 3) * 16 + (R & 3) * 2 + ((R >> 4) & 1)) : ((R >> 5) * 64 + ((R >> 2) & 3) * 16 + ((R >> 4) & 1) * 4 + (R & 3)));
        Rr[i] = R; Cc[i] = C; voffB[i] = (unsigned)(Rb * K * EB + C * 2); }
    constexpr size_t kstep = (size_t)(BK * 2);
    constexpr size_t hstep = (size_t)(Epi::PERM ? 8 : HALF) * K * EB;
    const unsigned ldsw = (unsigned)wid * 1024u;
    const int aoff = lds_byte(wr * 64 + fr, fq * 8), boff = lds_byte(wc * 32 + fr, fq * 8);
#define PG8_SA(b, h) (((b) * 2 + (h)) * HTB)
#define PG8_SB(b, h) ((4 + (b) * 2 + (h)) * HTB)
#define PG8_STAGEB(bufoff, gbase) do { _Pragma("unroll") for (int _i = 0; _i < 2; ++_i) \
        __builtin_amdgcn_global_load_lds((const unsigned*)((const char*)(gbase) + voffB[_i]), (LAS unsigned*)(lds + (bufoff) + ldsw + _i * 8192), 16, 0, 0); } while (0)
#define PG8_STAGEA(bufoff, base, o0, o1, kb) do { unsigned _o0 = (o0), _o1 = (o1); asm volatile("" : "+v"(_o0), "+v"(_o1));     \
        const char* _gb = (base) + (size_t)(kb); \
        __builtin_amdgcn_global_load_lds((const unsigned*)(_gb + _o0), (LAS unsigned*)(lds + (bufoff) + ldsw), 16, 0, 0); \
        __builtin_amdgcn_global_load_lds((const unsigned*)(_gb + _o1), (LAS unsigned*)(lds + (bufoff) + ldsw + 8192), 16, 0, 0); } while (0)
#define PG8_LD8(dst, off) do { const u32x4 _p0 = *(const LAS u32x4*)(lds + (off)), _p1 = *(const LAS u32x4*)(lds + (off) + 1024); dst = (i32x8){(int)_p0.x, (int)_p0.y, (int)_p0.z, (int)_p0.w, (int)_p1.x, (int)_p1.y, (int)_p1.z, (int)_p1.w}; } while (0)
#define PG8_LDA(dst, b, h) do { if constexpr (F8) { _Pragma("unroll") for (int m = 0; m < 4; ++m) PG8_LD8(dst##8[m], PG8_SA(b, h) + aoff + m * 2048); } \
        else { _Pragma("unroll") for (int m = 0; m < 4; ++m) _Pragma("unroll") for (int k = 0; k < 2; ++k) dst[m][k] = *(const LAS bf16x8*)(lds + PG8_SA(b, h) + aoff + m * 2048 + k * 1024); } } while (0)
#define PG8_LDB(dst, b, h) do { if constexpr (F8) { _Pragma("unroll") for (int n = 0; n < 2; ++n) PG8_LD8(dst##8[n], PG8_SB(b, h) + boff + n * 2048); } \
        else { _Pragma("unroll") for (int n = 0; n < 2; ++n) _Pragma("unroll") for (int k = 0; k < 2; ++k) dst[n][k] = *(const LAS bf16x8*)(lds + PG8_SB(b, h) + boff + n * 2048 + k * 1024); } } while (0)
#define PG8_MMA(ai, bj, At, Bt) do { __builtin_amdgcn_s_setprio(1); _Pragma("unroll") for (int m = 0; m < 4; ++m) _Pragma("unroll") for (int n = 0; n < 2; ++n) { \
        if constexpr (F8) asm volatile("v_mfma_scale_f32_16x16x128_f8f6f4 %0, %1, %2, %0, %3, %3 op_sel_hi:[0,0,0]" : "+v"(acc[ai][bj][m][n]) : "v"(Bt##8[n]), "v"(At##8[m]), "v"(f8scale)); \
        else { _Pragma("unroll") for (int k = 0; k < 2; ++k) acc[ai][bj][m][n] = __builtin_amdgcn_mfma_f32_16x16x32_bf16(Bt[n][k], At[m][k], acc[ai][bj][m][n], 0, 0, 0); } } \
        __builtin_amdgcn_s_setprio(0); } while (0)
#define PG8_MMA0(ai, bj, At, Bt) do { __builtin_amdgcn_s_setprio(1); _Pragma("unroll") for (int m = 0; m < 4; ++m) _Pragma("unroll") for (int n = 0; n < 2; ++n) { \
        asm volatile("v_mfma_scale_f32_16x16x128_f8f6f4 %0, %1, %2, 0, %3, %3 op_sel_hi:[0,0,0]" : "=&v"(acc[ai][bj][m][n]) : "v"(Bt##8[n]), "v"(At##8[m]), "v"(f8scale)); } \
        __builtin_amdgcn_s_setprio(0); } while (0)
#define PG8_MMAF(ai, bj, At, Bt) do { if constexpr (!F8) PG8_MMA(ai, bj, At, Bt); else { if (t == 0) PG8_MMA0(ai, bj, At, Bt); else PG8_MMA(ai, bj, At, Bt); } } while (0)
#define PG8_WAIT_V(n) asm volatile("s_waitcnt vmcnt(" #n ")" ::: "memory")
#define PG8_WAIT_L(n) asm volatile("s_waitcnt lgkmcnt(" #n ")" ::: "memory")
#define PG8_BAR __builtin_amdgcn_s_barrier()
#define PG8_SCHED __builtin_amdgcn_sched_barrier(0)
    GUnit cur, nxt; int ui = 0;
    if (!S.next(0, cur)) return;
    f32x4 acc[2][2][4][2];
    if constexpr (!F8)
#pragma unroll
    for (int a = 0; a < 2; ++a)
#pragma unroll
        for (int b = 0; b < 2; ++b)
#pragma unroll
            for (int m = 0; m < 4; ++m)
#pragma unroll
                for (int n = 0; n < 2; ++n) acc[a][b][m][n] = (f32x4){0.f, 0.f, 0.f, 0.f};
    bf16x8 At[4][2], B0[2][2], B1[2][2];
    const int f8scale = 0x7f7f7f7f;
    i32x8 At8[4], B08[2], B18[2];
    unsigned c00, c01, c10, c11;
    const char* cA = Aroot;
    if constexpr (Sched::GATHER) {
        c00 = S.arow(cur, Rr[0]) * (unsigned)(K * EB) + (unsigned)Cc[0] * 2u; c01 = S.arow(cur, Rr[1]) * (unsigned)(K * EB) + (unsigned)Cc[1] * 2u;
        c10 = S.arow(cur, HALF + Rr[0]) * (unsigned)(K * EB) + (unsigned)Cc[0] * 2u; c11 = S.arow(cur, HALF + Rr[1]) * (unsigned)(K * EB) + (unsigned)Cc[1] * 2u;
    } else {
        c00 = (unsigned)(Rr[0] * K * EB + Cc[0] * 2); c01 = (unsigned)(Rr[1] * K * EB + Cc[1] * 2); c10 = c00 + (unsigned)(HALF * K * EB); c11 = c01 + (unsigned)(HALF * K * EB);
        cA = S.aroot(Aroot, cur) + (size_t)S.arow(cur, 0) * (size_t)(K * EB);
    }
    const char* cB = cur.B;
    int pend = -1;
    PG8_STAGEB(PG8_SB(0, 0), cB); PG8_STAGEA(PG8_SA(0, 0), cA, c00, c01, 0); PG8_STAGEB(PG8_SB(0, 1), cB + hstep); PG8_STAGEA(PG8_SA(0, 1), cA, c10, c11, 0);
    if (wr == 1) PG8_BAR;
    PG8_WAIT_V(4); PG8_BAR;
    PG8_STAGEB(PG8_SB(1, 0), cB + kstep); PG8_STAGEA(PG8_SA(1, 0), cA, c00, c01, kstep); PG8_STAGEB(PG8_SB(1, 1), cB + hstep + kstep);
    PG8_WAIT_V(6); PG8_BAR;
    for (;;) {
        const bool has_next = S.next(ui + 1, nxt);
        unsigned n00 = c00, n01 = c01, n10 = c10, n11 = c11; const char* nB = cB; const char* nA = cA;
        LAS u32x4* noff_lds = (LAS u32x4*)(lds + NOFF_OFF) + tid;
        if constexpr (Epi::SIDE) __builtin_amdgcn_global_load_lds((const unsigned*)E.side_ptr(cur, tid), (LAS unsigned*)(lds + SIDE_OFF + (ui & 1) * 2048 + wid * 256), 4, 0, 0);
        if (has_next) {
            if constexpr (Sched::GATHER) __builtin_amdgcn_global_load_lds((const unsigned*)S.tok_ptr(nxt, tid), (LAS unsigned*)(lds + TOK_OFF + wid * 256), 4, 0, 0);
            else nA = S.aroot(Aroot, nxt) + (size_t)S.arow(nxt, 0) * (size_t)(K * EB);
            nB = nxt.B;
        } else if constexpr (Sched::GATHER) { *noff_lds = (u32x4){c00, c01, c10, c11}; }
        for (int t = 0; t < nt; t += 2) {
            const bool last = (t == nt - 2);
            if constexpr (Sched::GATHER) { if (t == 2 && has_next) {
                int tz = tid; asm volatile("" : "+v"(tz));
                int R0, C0, R1, C1; stage_rc(tz * 16, R0, C0); stage_rc(tz * 16 + 8192, R1, C1);
                const LAS int* tk = (const LAS int*)(lds + TOK_OFF);
                u32x4 nn;
                nn.x = S.tok_row(nxt, R0, tk[R0]) * (unsigned)(K * EB) + (unsigned)C0 * 2u; nn.y = S.tok_row(nxt, R1, tk[R1]) * (unsigned)(K * EB) + (unsigned)C1 * 2u;
                nn.z = S.tok_row(nxt, HALF + R0, tk[HALF + R0]) * (unsigned)(K * EB) + (unsigned)C0 * 2u; nn.w = S.tok_row(nxt, HALF + R1, tk[HALF + R1]) * (unsigned)(K * EB) + (unsigned)C1 * 2u;
                *((LAS u32x4*)(lds + NOFF_OFF) + tz) = nn; } }
            const size_t k1 = (size_t)(t + 1) * kstep;
            const size_t k2 = last ? 0 : (size_t)(t + 2) * kstep, k3 = k2 + kstep;
            if constexpr (Sched::GATHER) { if (last) { const u32x4 nn = *noff_lds; n00 = nn.x; n01 = nn.y; n10 = nn.z; n11 = nn.w; } }
            const unsigned a00 = last ? n00 : c00, a01 = last ? n01 : c01, a10 = last ? n10 : c10, a11 = last ? n11 : c11; const char* a2 = last ? nA : cA;
            const char* b2 = last ? nB : cB + (size_t)(t + 2) * kstep; const char* b3 = b2 + kstep;
            PG8_LDB(B0, 0, 0); PG8_SCHED; PG8_LDA(At, 0, 0); PG8_STAGEA(PG8_SA(1, 1), cA, c10, c11, k1);
            PG8_WAIT_L(8); PG8_BAR; PG8_WAIT_L(0); PG8_MMAF(0, 0, At, B0); PG8_BAR; PG8_SCHED;
            PG8_LDB(B1, 0, 1); PG8_STAGEB(PG8_SB(0, 0), b2);
            PG8_BAR; PG8_WAIT_L(0); PG8_MMAF(0, 1, At, B1); PG8_BAR;
            PG8_LDA(At, 0, 1); PG8_STAGEA(PG8_SA(0, 0), a2, a00, a01, k2);
            PG8_BAR; PG8_WAIT_L(0); PG8_MMAF(1, 0, At, B0); PG8_BAR; PG8_SCHED;
            PG8_STAGEB(PG8_SB(0, 1), b2 + hstep);
            PG8_WAIT_V(6); PG8_BAR; PG8_MMAF(1, 1, At, B1); PG8_BAR;
            PG8_LDB(B0, 1, 0); PG8_SCHED; PG8_LDA(At, 1, 0); PG8_STAGEA(PG8_SA(0, 1), a2, a10, a11, k2);
            PG8_WAIT_L(8); PG8_BAR; PG8_WAIT_L(0); PG8_MMA(0, 0, At, B0); PG8_BAR; PG8_SCHED;
            PG8_LDB(B1, 1, 1); PG8_STAGEB(PG8_SB(1, 0), b3);
            PG8_BAR; PG8_WAIT_L(0); PG8_MMA(0, 1, At, B1); PG8_BAR;
            PG8_LDA(At, 1, 1); PG8_STAGEA(PG8_SA(1, 0), a2, a00, a01, k3);
            PG8_BAR; PG8_WAIT_L(0); PG8_MMA(1, 0, At, B0); PG8_BAR; PG8_SCHED;
            PG8_STAGEB(PG8_SB(1, 1), b3 + hstep);
            PG8_WAIT_V(6); PG8_BAR; PG8_MMA(1, 1, At, B1); PG8_BAR;
        }
        if (wr == 0) PG8_BAR;
        if constexpr (F8) asm volatile("s_nop 15\n\ts_nop 15" ::: "memory");
        E(acc, cur, wr, wc, fr, fq, lds + (ui & 1) * 2048);
        if constexpr (epi_pub<Epi>::v) { if (pend >= 0) E.publish(pend, tid); pend = cur.pm; }
        if (!has_next) break;
        if constexpr (!F8) if (!(Epi::KEEP && nxt.e == 1))
#pragma unroll
        for (int a = 0; a < 2; ++a)
#pragma unroll
            for (int b = 0; b < 2; ++b)
#pragma unroll
                for (int m = 0; m < 4; ++m)
#pragma unroll
                    for (int n = 0; n < 2; ++n) acc[a][b][m][n] = (f32x4){0.f, 0.f, 0.f, 0.f};
        cur = nxt; cB = nB; cA = nA; c00 = n00; c01 = n01; c10 = n10; c11 = n11; ++ui;
        if (wr == 1) PG8_BAR;
    }
    PG8_WAIT_V(0);
    PG8_BAR;
    if constexpr (epi_pub<Epi>::v) { if (pend >= 0) E.publish(pend, tid); }
#undef PG8_SA
#undef PG8_SB
#undef PG8_STAGEA
#undef PG8_STAGEB
#undef PG8_LDA
#undef PG8_LDB
#undef PG8_MMA
#undef PG8_MMA0
#undef PG8_MMAF
#undef PG8_LD8
#undef PG8_WAIT_V
#undef PG8_WAIT_L
#undef PG8_BAR
#undef PG8_SCHED
}
}
using pg8::GUnit;

struct Args { const float* in[38]; float* out; unsigned char* ws; int ph_lo, ph_hi, bar_region, pad; };
enum { I_X = 0, I_C, I_CTX, I_CCTX, I_WADA, I_BADA, I_GPREMIX, I_GPOSTMIX, I_GPREFFN, I_GPOSTFFN, I_WIN, I_BIN, I_MUP, I_MUN, I_SINKS, I_W0F, I_W0B, I_W2F, I_W2B,
       I_A0F, I_A0B, I_A2F, I_A2B, I_G2, I_KK, I_KA, I_RK, I_LNW, I_LNB, I_WUPA, I_WUPR, I_WOUT, I_WROUTER, I_BROUTER, I_WGU, I_BGU, I_WDN, I_BDN };

__device__ __forceinline__ unsigned pk4_fp8(float a, float b, float c, float d) { int w = 0; w = __builtin_amdgcn_cvt_pk_fp8_f32(a, b, w, false); w = __builtin_amdgcn_cvt_pk_fp8_f32(c, d, w, true); return (unsigned)w; }
typedef float f32x2_t __attribute__((ext_vector_type(2)));
typedef __bf16 bf16x2_t __attribute__((ext_vector_type(2)));
__device__ __forceinline__ unsigned cvt_pk_bf16_asm(float lo, float hi) { unsigned r; asm volatile("v_cvt_pk_bf16_f32 %0, %1, %2" : "=v"(r) : "v"(lo), "v"(hi)); return r; }
__device__ __forceinline__ unsigned cvt_pk_bf16(float lo, float hi) { const f32x2_t v = {lo, hi}; const bf16x2_t b = __builtin_convertvector(v, bf16x2_t); return __builtin_bit_cast(unsigned, b); }

__device__ __forceinline__ void tile_order(int L, int nM, int nN, int& pm, int& pn) {
    const int nwg = nM * nN; int wgid = L;
    { const int q = nwg / 8, r = nwg % 8, xcd = wgid % 8, off = wgid / 8; wgid = (xcd < r ? xcd * (q + 1) : r * (q + 1) + (xcd - r) * q) + off; }
    const int nig = 8 * nN, gid = wgid / nig, fm = gid * 8, gsz = (nM - fm) < 8 ? (nM - fm) : 8;
    pm = fm + ((wgid % nig) % gsz); pn = (wgid % nig) / gsz;
}

struct SchedProj {           static constexpr bool GATHER = false;
    const char* Bt; int G, c, ibeg, iend;
    __device__ __forceinline__ bool next(int i, GUnit& u) const {
        i += ibeg; if (i >= iend) return false;
        const int L = i * G + c; constexpr int NXU = 128 * NT_BF;
        if (L >= NXU + 72) return false;
        int pm, pn;
        if (L < NXU) tile_order(L, 128, NT_BF, pm, pn); else { const int l2 = L - NXU; pm = 128 + l2 / 9; pn = 2 + l2 % 9; }
        u.pm = pm; u.pn = pn; u.e = 0; u.lrow0 = 0; u.B = Bt + (size_t)pn * 256 * D * 2; return true;
    }
    __device__ __forceinline__ unsigned arow(const GUnit& u, int r) const { return (unsigned)(u.pm * 256 + r); }
    __device__ __forceinline__ const char* aroot(const char* A, const GUnit&) const { return A; }
};
struct SchedProj8 {          static constexpr bool GATHER = false;
    const char* Bt; int G, c;
    __device__ __forceinline__ bool next(int i, GUnit& u) const {
        const int L = i * G + c; if (L >= 128 * NT_F8) return false;
        int pm, pn; tile_order(L, 128, NT_F8, pm, pn);
        u.pm = pm; u.pn = NT_BF + pn; u.e = 0; u.lrow0 = 0; u.B = Bt + (size_t)pn * 256 * D; return true;
    }
    __device__ __forceinline__ unsigned arow(const GUnit& u, int r) const { return (unsigned)(u.pm * 256 + r); }
    __device__ __forceinline__ const char* aroot(const char* A, const GUnit&) const { return A; }
};
template <int K> struct SchedDense {
    static constexpr bool GATHER = false;
    const char* Bt; int G, c;
    __device__ __forceinline__ bool next(int i, GUnit& u) const {
        const int L = i * G + c; if (L >= 128 * 4) return false;
        int pm, pn; tile_order(L, 128, 4, pm, pn);
        u.pm = pm; u.pn = pn; u.e = 0; u.lrow0 = 0; u.B = Bt + (size_t)pn * 256 * K * 2; return true;
    }
    __device__ __forceinline__ unsigned arow(const GUnit& u, int r) const { return (unsigned)(u.pm * 256 + r); }
    __device__ __forceinline__ const char* aroot(const char* A, const GUnit&) const { return A; }
};
template <int NPN, bool GATHER_, int EB = 2> struct SchedMoe {
    static constexpr bool GATHER = GATHER_;
    const char* Bt; int G, c; const LAS int* tstart; const int* cnt; const int* slot_tok; const LAS int* tcnt; int ibeg, iend; const unsigned* done;
    __device__ __forceinline__ bool next(int i, GUnit& u) const {
        i += ibeg; if (i >= iend) return false;
        const int L = i * G + c; const int TT = __builtin_amdgcn_readfirstlane(tstart[NE]);
        if (L >= TT * NPN) return false;
        const int rt = L / NPN, pn = L % NPN;
        if constexpr (!GATHER_) { if (done != nullptr && i >= 8) {
            const GAS unsigned* p = (const GAS unsigned*)(done + rt);
            for (unsigned spins = 0; __hip_atomic_load(p, __ATOMIC_RELAXED, __HIP_MEMORY_SCOPE_AGENT) < 8u && spins < (1u << 24); ++spins) __builtin_amdgcn_s_sleep(2);
            asm volatile("buffer_inv sc1" ::: "memory"); } }
        const int e = __builtin_amdgcn_readfirstlane((int)((const LAS unsigned char*)tstart)[(TEXP_OFF - RING_BYTES) + rt]);
        u.pm = rt; u.pn = pn; u.e = e; u.lrow0 = __builtin_amdgcn_readfirstlane((rt - tstart[e]) * 256);
        u.B = Bt + ((size_t)e * (NPN * 256) + (size_t)pn * 256) * DE * EB; return true;
    }
    __device__ __forceinline__ unsigned arow(const GUnit& u, int r) const {
        if (GATHER) { const int lr = u.lrow0 + r; const int n = cnt[u.e]; const unsigned tok = (unsigned)slot_tok[u.e * T + (lr < T ? lr : T - 1)]; return (lr < n) ? tok : 0u; }
        return (unsigned)(u.pm * 256 + r);
    }
    __device__ __forceinline__ const char* aroot(const char* A, const GUnit&) const { return A; }
    __device__ __forceinline__ const int* tok_ptr(const GUnit& u, int tid) const { const int lr = u.lrow0 + (tid & 255); return slot_tok + u.e * T + (lr < T ? lr : T - 1); }
    __device__ __forceinline__ unsigned tok_row(const GUnit& u, int r, int tok) const { return (u.lrow0 + r < tcnt[u.e]) ? (unsigned)tok : 0u; }
};

struct EpiZ {
    static constexpr bool PERM = true, SIDE = true, KEEP = false, PERMG = false;
    bf16_t* Z; const float* bias; float sc;
    __device__ __forceinline__ const float* side_ptr(const GUnit& u, int tid) const { return bias + u.pn * 256 + (tid & 255); }
    __device__ __forceinline__ void operator()(const f32x4 (&acc)[2][2][4][2], const GUnit& u, int wr, int wc, int fr, int fq, LAS unsigned char* lds) const {
        const int row0 = u.pm * 256 + wr * 64 + fr, col0 = u.pn * 256 + wc * 64 + 16 * fq;
        const LAS float* sb = (const LAS float*)(lds + SIDE_OFF) + 256 + wc * 64 + 16 * fq;
        f32x4 bv[2][2];
#pragma unroll
        for (int bj = 0; bj < 2; ++bj)
#pragma unroll
            for (int n = 0; n < 2; ++n) bv[bj][n] = *(const LAS f32x4*)(sb + 8 * bj + 4 * n);
#pragma unroll
        for (int ai = 0; ai < 2; ++ai)
#pragma unroll
            for (int m = 0; m < 4; ++m) { bf16_t* rowp = Z + (size_t)(row0 + ai * 128 + m * 16) * ZP + col0;
#pragma unroll
                for (int bj = 0; bj < 2; ++bj) { const f32x4 v0 = acc[ai][bj][m][0] * sc + bv[bj][0], v1 = acc[ai][bj][m][1] * sc + bv[bj][1];
                    u32x4 w; w.x = cvt_pk_bf16(v0[0], v0[1]); w.y = cvt_pk_bf16(v0[2], v0[3]); w.z = cvt_pk_bf16(v1[0], v1[1]); w.w = cvt_pk_bf16(v1[2], v1[3]);
                    *(u32x4*)(rowp + bj * 8) = w; } }
    }
};
struct EpiZ8 {
    static constexpr bool PERM = true, SIDE = true, KEEP = false, PERMG = false;
    bf16_t* Z; const float* bias; float sc;
    __device__ __forceinline__ const float* side_ptr(const GUnit& u, int tid) const { return bias + u.pn * 256 + (tid & 255); }
    __device__ __forceinline__ void operator()(const f32x4 (&acc)[2][2][4][2], const GUnit& u, int wr, int wc, int fr, int fq, LAS unsigned char* lds) const {
        const int row0 = u.pm * 256 + wr * 64 + fr, col0 = u.pn * 256 + wc * 64 + 16 * fq;
        const LAS float* sb = (const LAS float*)(lds + SIDE_OFF) + 256 + wc * 64 + 16 * fq;
        f32x4 bv[2][2];
#pragma unroll
        for (int bj = 0; bj < 2; ++bj)
#pragma unroll
            for (int n = 0; n < 2; ++n) bv[bj][n] = *(const LAS f32x4*)(sb + 8 * bj + 4 * n) * F8_ZSCALE;
        const float s8 = sc * F8_ZSCALE;
#pragma unroll
        for (int ai = 0; ai < 2; ++ai)
#pragma unroll
            for (int m = 0; m < 4; ++m) { unsigned char* rowp = (unsigned char*)Z + (size_t)(row0 + ai * 128 + m * 16) * (ZP * 2) + ZC_G * 2 + (col0 - ZC_G);
                u32x4 w;
#pragma unroll
                for (int bj = 0; bj < 2; ++bj) { const f32x4 v0 = acc[ai][bj][m][0] * s8 + bv[bj][0], v1 = acc[ai][bj][m][1] * s8 + bv[bj][1];
                    w[2 * bj] = pk4_fp8(v0[0], v0[1], v0[2], v0[3]); w[2 * bj + 1] = pk4_fp8(v1[0], v1[1], v1[2], v1[3]); }
                *(u32x4*)rowp = w; }
    }
};
__device__ __forceinline__ float sig8(float z8) { return __builtin_amdgcn_rcpf(1.0f + __builtin_amdgcn_exp2f(z8 * (-1.44269504089f / F8_ZSCALE))); }
template <bool SECOND> struct EpiUp {
    static constexpr bool PERM = true, SIDE = false, KEEP = false, PERMG = false;
    bf16_t* O; const bf16_t* Z;
    __device__ __forceinline__ void operator()(const f32x4 (&acc)[2][2][4][2], const GUnit& u, int wr, int wc, int fr, int fq, LAS unsigned char*) const {
        const int row0 = u.pm * 256 + wr * 64 + fr, col0 = u.pn * 256 + wc * 32 + 8 * fq;
#pragma unroll
        for (int ai = 0; ai < 2; ++ai)
#pragma unroll
            for (int m = 0; m < 4; ++m) { const size_t row = (size_t)(row0 + ai * 128 + m * 16);
#pragma unroll
                for (int bj = 0; bj < 2; ++bj) {
                    const u32x2 g = *(const u32x2*)((const unsigned char*)Z + row * (ZP * 2) + ZC_G * 2 + (SECOND ? 1024 : 0) + col0 + bj * 128);
                    const f32x2_t g0 = __builtin_amdgcn_cvt_pk_f32_fp8((int)g.x, false), g1 = __builtin_amdgcn_cvt_pk_f32_fp8((int)g.x, true), g2 = __builtin_amdgcn_cvt_pk_f32_fp8((int)g.y, false), g3 = __builtin_amdgcn_cvt_pk_f32_fp8((int)g.y, true);
                    const f32x4 a0 = acc[ai][bj][m][0], a1 = acc[ai][bj][m][1];
                    float o[8];
                    o[0] = sig8(g0.x) * a0[0]; o[1] = sig8(g0.y) * a0[1]; o[2] = sig8(g1.x) * a0[2]; o[3] = sig8(g1.y) * a0[3];
                    o[4] = sig8(g2.x) * a1[0]; o[5] = sig8(g2.y) * a1[1]; o[6] = sig8(g3.x) * a1[2]; o[7] = sig8(g3.y) * a1[3];
                    bf16_t* op = O + row * 1024 + col0 + bj * 128;
                    if (SECOND) { const u32x4 p = *(const u32x4*)op;
                        o[0] += lo16(p.x); o[1] += hi16(p.x); o[2] += lo16(p.y); o[3] += hi16(p.y); o[4] += lo16(p.z); o[5] += hi16(p.z); o[6] += lo16(p.w); o[7] += hi16(p.w); }
                    u32x4 w; w.x = cvt_pk_bf16(o[0], o[1]); w.y = cvt_pk_bf16(o[2], o[3]); w.z = cvt_pk_bf16(o[4], o[5]); w.w = cvt_pk_bf16(o[6], o[7]);
                    *(u32x4*)op = w; } }
    }
};
struct SchedUp2 {   static constexpr bool GATHER = false;
    const char* BtA; long long dB, dA; int G, c;
    __device__ __forceinline__ bool next(int i, GUnit& u) const {
        const int L = (i >> 1) * G + c; if (L >= 128 * 4) return false;
        int pm, pn; tile_order(L, 128, 4, pm, pn);
        u.pm = pm; u.pn = pn; u.e = i & 1; u.lrow0 = 0; u.B = BtA + (long long)(i & 1) * dB + (size_t)pn * 256 * 512 * 2; return true;
    }
    __device__ __forceinline__ unsigned arow(const GUnit& u, int r) const { return (unsigned)(u.pm * 256 + r); }
    __device__ __forceinline__ const char* aroot(const char* A, const GUnit& u) const { return A + (long long)u.e * dA; }
};
struct EpiUp2 {
    static constexpr bool PERM = true, SIDE = false, KEEP = true, PERMG = false;
    bf16_t* O; const bf16_t* Z;
    __device__ __forceinline__ static void un16(const u32x4 g, float (&z)[16]) {
#pragma unroll
        for (int w = 0; w < 4; ++w) { const f32x2_t lo = __builtin_amdgcn_cvt_pk_f32_fp8((int)g[w], false), hi = __builtin_amdgcn_cvt_pk_f32_fp8((int)g[w], true); z[4 * w] = lo.x; z[4 * w + 1] = lo.y; z[4 * w + 2] = hi.x; z[4 * w + 3] = hi.y; } }
    __device__ __forceinline__ void operator()(f32x4 (&acc)[2][2][4][2], const GUnit& u, int wr, int wc, int fr, int fq, LAS unsigned char*) const {
        const int row0 = u.pm * 256 + wr * 64 + fr, col0 = u.pn * 256 + wc * 64 + 16 * fq;
        constexpr float cz = -1.44269504089f / F8_ZSCALE;
        if (u.e == 0) {
#pragma unroll
            for (int ai = 0; ai < 2; ++ai)
#pragma unroll
                for (int m = 0; m < 4; ++m) { const unsigned char* gp = (const unsigned char*)Z + (size_t)(row0 + ai * 128 + m * 16) * (ZP * 2) + ZC_G * 2 + col0;
                    float za[16], zr[16]; un16(*(const u32x4*)gp, za); un16(*(const u32x4*)(gp + 1024), zr);
                    float rt[16];
#pragma unroll
                    for (int j = 0; j < 16; ++j) rt[j] = (1.0f + __builtin_amdgcn_exp2f(zr[j] * cz)) * __builtin_amdgcn_rcpf(1.0f + __builtin_amdgcn_exp2f(za[j] * cz));
#pragma unroll
                    for (int bj = 0; bj < 2; ++bj)
#pragma unroll
                        for (int n = 0; n < 2; ++n) { const int o = 8 * bj + 4 * n; acc[ai][bj][m][n] = acc[ai][bj][m][n] * (f32x4){rt[o], rt[o + 1], rt[o + 2], rt[o + 3]}; }
                }
        } else {
#pragma unroll
            for (int ai = 0; ai < 2; ++ai)
#pragma unroll
                for (int m = 0; m < 4; ++m) { const size_t row = (size_t)(row0 + ai * 128 + m * 16);
                    float zr[16]; un16(*(const u32x4*)((const unsigned char*)Z + row * (ZP * 2) + ZC_G * 2 + 1024 + col0), zr);
#pragma unroll
                    for (int bj = 0; bj < 2; ++bj) { const f32x4 a0 = acc[ai][bj][m][0], a1 = acc[ai][bj][m][1]; const int o = 8 * bj;
                        u32x4 w; w.x = cvt_pk_bf16(sig8(zr[o]) * a0[0], sig8(zr[o + 1]) * a0[1]); w.y = cvt_pk_bf16(sig8(zr[o + 2]) * a0[2], sig8(zr[o + 3]) * a0[3]);
                        w.z = cvt_pk_bf16(sig8(zr[o + 4]) * a1[0], sig8(zr[o + 5]) * a1[1]); w.w = cvt_pk_bf16(sig8(zr[o + 6]) * a1[2], sig8(zr[o + 7]) * a1[3]);
                        *(u32x4*)(O + row * 1024 + col0 + 8 * bj) = w; } }
        }
    }
};
struct EpiMix {
    static constexpr bool PERM = true, SIDE = false, KEEP = false, PERMG = false;
    unsigned char* C;
    __device__ __forceinline__ void operator()(const f32x4 (&acc)[2][2][4][2], const GUnit& u, int wr, int wc, int fr, int fq, LAS unsigned char*) const {
        const int row0 = u.pm * 256 + wr * 64 + fr, col0 = u.pn * 256 + wc * 64 + 16 * fq;
#pragma unroll
        for (int ai = 0; ai < 2; ++ai)
#pragma unroll
            for (int m = 0; m < 4; ++m) { u32x4 w;
#pragma unroll
                for (int bj = 0; bj < 2; ++bj) { const f32x4 v0 = acc[ai][bj][m][0] * F8_MSCALE, v1 = acc[ai][bj][m][1] * F8_MSCALE;
                    w[2 * bj] = pk4_fp8(v0[0], v0[1], v0[2], v0[3]); w[2 * bj + 1] = pk4_fp8(v1[0], v1[1], v1[2], v1[3]); }
                *(u32x4*)(C + (size_t)(row0 + ai * 128 + m * 16) * 1024 + col0) = w; }
    }
};
__device__ __forceinline__ float swiglu1(float g, float up) {
    g = fminf(g, 7.0f); up = fminf(fmaxf(up, -7.0f), 7.0f);
    return (up + 1.0f) * (g * sigmoidf_(1.702f * g));
}
struct EpiMoe1 {
    static constexpr bool PERM = true, SIDE = true, KEEP = false, PERMG = true, PUBLISH = true;
    bf16_t* H; const float* bgu; unsigned* done;
    __device__ __forceinline__ void publish(int pm, int tid) const { if (tid == 0) (void)__hip_atomic_fetch_add((GAS unsigned*)(done + pm), 1u, __ATOMIC_RELAXED, __HIP_MEMORY_SCOPE_AGENT); }
    __device__ __forceinline__ const float* side_ptr(const GUnit& u, int tid) const { return bgu + (size_t)u.e * 2048 + u.pn * 256 + (tid & 255); }
    __device__ __forceinline__ void operator()(const f32x4 (&acc)[2][2][4][2], const GUnit& u, int wr, int wc, int fr, int fq, LAS unsigned char* lds) const {
        const int row0 = u.pm * 256 + wr * 64 + fr, col0 = u.pn * 256 + wc * 64 + 16 * fq;
        const LAS float* b = (const LAS float*)(lds + SIDE_OFF) + 256 + wc * 64 + 16 * fq;
        constexpr float sc = 1.0f / (F8_WSCALE * F8_ASCALE), scg = sc * F8_HSCALE, cexp = -1.702f * 1.44269504089f / F8_HSCALE;
        f32x4 bg[2], bu[2];
#pragma unroll
        for (int bj = 0; bj < 2; ++bj) { const f32x4 t0 = *(const LAS f32x4*)(b + 8 * bj), t1 = *(const LAS f32x4*)(b + 8 * bj + 4);
            bg[bj] = (f32x4){t0[0], t0[2], t1[0], t1[2]} * F8_HSCALE; bu[bj] = (f32x4){t0[1], t0[3], t1[1], t1[3]}; }
#pragma unroll
        for (int ai = 0; ai < 2; ++ai)
#pragma unroll
            for (int m = 0; m < 4; ++m) { u32x2 w;
#pragma unroll
                for (int bj = 0; bj < 2; ++bj) {
                    f32x4 g8 = acc[ai][bj][m][0] * scg + bg[bj], up = acc[ai][bj][m][1] * sc + bu[bj];
#pragma unroll
                    for (int r = 0; r < 4; ++r) { g8[r] = fminf(g8[r], 7.0f * F8_HSCALE); up[r] = __builtin_amdgcn_fmed3f(up[r], -7.0f, 7.0f); }
                    f32x4 ex = g8 * cexp;
#pragma unroll
                    for (int r = 0; r < 4; ++r) ex[r] = __builtin_amdgcn_exp2f(ex[r]);
                    f32x4 rc = ex + 1.0f;
#pragma unroll
                    for (int r = 0; r < 4; ++r) rc[r] = __builtin_amdgcn_rcpf(rc[r]);
                    const f32x4 s8 = g8 * rc, h8 = up * s8 + s8;
                    w[bj] = pk4_fp8(h8[0], h8[1], h8[2], h8[3]); }
                __hip_atomic_store((GAS unsigned long long*)((unsigned char*)H + (size_t)(row0 + ai * 128 + m * 16) * 1024 + (col0 >> 1)), __builtin_bit_cast(unsigned long long, w), __ATOMIC_RELAXED, __HIP_MEMORY_SCOPE_AGENT); }
    }
};
struct EpiMoe2 {
    static constexpr bool PERM = true, SIDE = true, KEEP = false, PERMG = false;
    unsigned char* Y; const float* bdn; const float* slot_gate; const LAS int* tcnt;
    __device__ __forceinline__ const float* side_ptr(const GUnit& u, int tid) const {
        const int lr = u.lrow0 + (tid & 255);
        return (tid < 256) ? slot_gate + (size_t)u.e * T + (lr < T ? lr : T - 1) : bdn + (size_t)u.e * 1024 + u.pn * 256 + (tid & 255);
    }
    __device__ __forceinline__ void operator()(const f32x4 (&acc)[2][2][4][2], const GUnit& u, int wr, int wc, int fr, int fq, LAS unsigned char* lds) const {
        const int r0 = wr * 64 + fr, col0 = u.pn * 256 + wc * 64 + 16 * fq;
        const LAS float* sd = (const LAS float*)(lds + SIDE_OFF);
        const LAS float* b = sd + 256 + wc * 64 + 16 * fq; const int n_e = tcnt[u.e];
        constexpr float sc = 1.0f / (F8_WSCALE * F8_HSCALE);
        f32x4 bv[2][2];
#pragma unroll
        for (int bj = 0; bj < 2; ++bj)
#pragma unroll
            for (int n = 0; n < 2; ++n) bv[bj][n] = *(const LAS f32x4*)(b + 8 * bj + 4 * n);
#pragma unroll
        for (int ai = 0; ai < 2; ++ai)
#pragma unroll
            for (int m = 0; m < 4; ++m) { const int r = r0 + ai * 128 + m * 16; const int lr = u.lrow0 + r;
                const float gt = ((lr < n_e) ? sd[r] : 0.0f) * F8_YSCALE;
                u32x4 w;
#pragma unroll
                for (int bj = 0; bj < 2; ++bj) { const f32x4 v0 = (acc[ai][bj][m][0] * sc + bv[bj][0]) * gt, v1 = (acc[ai][bj][m][1] * sc + bv[bj][1]) * gt;
                    w[2 * bj] = pk4_fp8(v0[0], v0[1], v0[2], v0[3]); w[2 * bj + 1] = pk4_fp8(v1[0], v1[1], v1[2], v1[3]); }
                *(u32x4*)(Y + (size_t)(u.pm * 256 + r) * 1024 + col0) = w; }
    }
};

__device__ __forceinline__ void p0_transpose_item(const float* W, int K, int N, bf16_t* WT, int row_off, LAS float* scr, int item, int lane) {
    const int nblk = N / 32, kb = item / nblk, nb = item % nblk, k0 = 64 * kb, n0 = 32 * nb;
#pragma unroll 32
    for (int i = 0; i < 32; ++i) { const int kk = 2 * i + (lane >> 5); scr[kk * 33 + (lane & 31)] = W[(size_t)(k0 + kk) * N + n0 + (lane & 31)]; }
    LDS_WAIT(); asm volatile("" ::: "memory");
    const int c = lane & 7;
#pragma unroll
    for (int j = 0; j < 4; ++j) { const int n = (lane >> 3) + 8 * j; const LAS float* s = scr + (8 * c) * 33 + n;
        u32x4 o; o.x = pk2(s[0 * 33], s[1 * 33]); o.y = pk2(s[2 * 33], s[3 * 33]); o.z = pk2(s[4 * 33], s[5 * 33]); o.w = pk2(s[6 * 33], s[7 * 33]);
        *(u32x4*)(WT + (size_t)(row_off + n0 + n) * K + k0 + 8 * c) = o; }
    LDS_WAIT(); asm volatile("" ::: "memory");
}
__device__ __forceinline__ void tr_load(const float* W, int N, int item, int lane, float (&v)[32]) {
    const int nblk = N / 32, kb = item / nblk, nb = item % nblk; const float* p = W + (size_t)(64 * kb + (lane >> 5)) * N + 32 * nb + (lane & 31);
#pragma unroll
    for (int i = 0; i < 32; ++i) v[i] = p[(size_t)(2 * i) * N];
}
__device__ __forceinline__ void tr_store_f8(unsigned char* WT, int K, int N, LAS float* scr, int item, int lane, const float (&v)[32], float sc) {
    const int nblk = N / 32, kb = item / nblk, nb = item % nblk, k0 = 64 * kb, n0 = 32 * nb;
#pragma unroll
    for (int i = 0; i < 32; ++i) scr[(2 * i + (lane >> 5)) * 33 + (lane & 31)] = v[i] * sc;
    LDS_WAIT(); asm volatile("" ::: "memory");
    const int c = lane & 7;
#pragma unroll
    for (int j = 0; j < 4; ++j) { const int n = (lane >> 3) + 8 * j; const LAS float* s = scr + (8 * c) * 33 + n;
        u32x2 o; o.x = pk4_fp8(s[0 * 33], s[1 * 33], s[2 * 33], s[3 * 33]); o.y = pk4_fp8(s[4 * 33], s[5 * 33], s[6 * 33], s[7 * 33]);
        *(u32x2*)(WT + (size_t)(n0 + n) * K + k0 + 8 * c) = o; }
    LDS_WAIT(); asm volatile("" ::: "memory");
}
__device__ __forceinline__ void p0_prologue(const Args& a, LAS unsigned char* lds, int tid, int lane, int wave, int G) {
    unsigned char* ws = a.ws;
    {
        float* MOD = (float*)(ws + WS_CTL) + CW_MOD;
        LAS float* sl = (LAS float*)lds;
        LAS float* red = sl + 9 * 1024;
        if (blockIdx.x < 192) {
            for (int i = tid; i < 9 * 1024; i += 512) { const int r = i >> 10, k = i & 1023; const float v = (r < 8) ? a.in[I_C][r * D + k] : a.in[I_CCTX][k]; sl[i] = v * sigmoidf_(v); }
            __syncthreads();
            for (int it = blockIdx.x; it < 192; it += G) {
                const int kh = lane >> 5, col = lane & 31, k0 = wave * 128 + kh * 64; float acc[9];
#pragma unroll
                for (int r = 0; r < 9; ++r) acc[r] = 0.f;
                const float* w = a.in[I_WADA] + (size_t)k0 * 6144 + it * 32 + col;
#pragma unroll 32
                for (int kk = 0; kk < 64; ++kk) { const float wv = w[(size_t)kk * 6144];
#pragma unroll
                    for (int r = 0; r < 9; ++r) acc[r] += sl[r * 1024 + k0 + kk] * wv; }
#pragma unroll
                for (int r = 0; r < 9; ++r) red[((wave * 2 + kh) * 9 + r) * 32 + col] = acc[r];
                __syncthreads();
                for (int i = tid; i < 9 * 32; i += 512) { const int r = i >> 5, c = i & 31; float s = a.in[I_BADA][it * 32 + c];
#pragma unroll
                    for (int w16 = 0; w16 < 16; ++w16) s += red[(w16 * 9 + r) * 32 + c];
                    MOD[r * 6144 + it * 32 + c] = s; }
                __syncthreads();
            }
        }
        __syncthreads();
    }
    {
        float* misc = (float*)(ws + WS_MISC);
        const int gt = blockIdx.x * 512 + tid, NGT = G * 512;
        for (int n = gt; n < ZP; n += NGT) misc[n] = (n < 2688) ? a.in[I_BIN][n] : ((n < 2816) ? 0.f : a.in[I_BIN][n - 128]);
        for (int n = gt; n < 1024; n += NGT) { const int p = n >> 4, i = n & 15; const float inv = powf(10000.0f, -(float)i / 16.0f); float s, c; sincosf((float)p * inv, &s, &c); misc[ZP + n] = c; misc[ZP + 1024 + n] = s; }
        u32x4* zr = (u32x4*)((bf16_t*)(ws + WS_WIN) + (size_t)2688 * D);
        for (int n = gt; n < 128 * D / 8; n += NGT) zr[n] = (u32x4){0u, 0u, 0u, 0u};
    }
    {
        LAS float* scr = (LAS float*)(lds + wave * 8704);
        const int gw = blockIdx.x * 8 + wave, NGW = G * 8;
        constexpr int J_IN = 16 * (PROJ_SRC / 32), J_UP = 8 * 32, J_OUT = 16 * 32, J_L = 16, J_G2 = 32, J_GU1 = 16 * 64, J_DN1 = 16 * 32;
        constexpr int NITEMS = J_IN + 2 * J_UP + J_OUT + 4 * J_L + J_G2;
        bf16_t* lora = (bf16_t*)(ws + WS_LORA);
        for (int it = gw; it < NITEMS; it += NGW) {
            int r = it;
            if (r < J_IN) { const int nb = r % (PROJ_SRC / 32);
                if (nb * 32 >= 2688) { float v[32]; tr_load(a.in[I_WIN], PROJ_SRC, r, lane, v); tr_store_f8((unsigned char*)(ws + WS_WIN8) - (size_t)2688 * D, D, PROJ_SRC, scr, r, lane, v, F8_GWSCALE); }
                else p0_transpose_item(a.in[I_WIN], D, PROJ_SRC, (bf16_t*)(ws + WS_WIN), 0, scr, r, lane);
                continue; } r -= J_IN;
            if (r < J_UP) { p0_transpose_item(a.in[I_WUPA], 512, D, (bf16_t*)(ws + WS_WUPA), 0, scr, r, lane); continue; } r -= J_UP;
            if (r < J_UP) { p0_transpose_item(a.in[I_WUPR], 512, D, (bf16_t*)(ws + WS_WUPR), 0, scr, r, lane); continue; } r -= J_UP;
            if (r < J_OUT) { p0_transpose_item(a.in[I_WOUT], D, D, (bf16_t*)(ws + WS_WOUT), 0, scr, r, lane); continue; } r -= J_OUT;
            if (r < J_L) { p0_transpose_item(a.in[I_W2F], 64, 512, lora, 0, scr, r, lane); continue; } r -= J_L;
            if (r < J_L) { p0_transpose_item(a.in[I_W2B], 64, 512, lora + 32768, 0, scr, r, lane); continue; } r -= J_L;
            if (r < J_L) { p0_transpose_item(a.in[I_A2F], 64, 512, lora + 2 * 32768, 0, scr, r, lane); continue; } r -= J_L;
            if (r < J_L) { p0_transpose_item(a.in[I_A2B], 64, 512, lora + 3 * 32768, 0, scr, r, lane); continue; } r -= J_L;
            p0_transpose_item(a.in[I_G2], 128, 512, lora + 4 * 32768, 0, scr, r, lane);
        }
    }
}

__device__ __forceinline__ void p0_transpose_item_f8(const float* W, int K, int N, unsigned char* WT, LAS float* scr, int item, int lane, float sc) {
    const int nblk = N / 32, kb = item / nblk, nb = item % nblk, k0 = 64 * kb, n0 = 32 * nb;
#pragma unroll 32
    for (int i = 0; i < 32; ++i) { const int kk = 2 * i + (lane >> 5); scr[kk * 33 + (lane & 31)] = W[(size_t)(k0 + kk) * N + n0 + (lane & 31)] * sc; }
    LDS_WAIT(); asm volatile("" ::: "memory");
    const int c = lane & 7;
#pragma unroll
    for (int j = 0; j < 4; ++j) { const int n = (lane >> 3) + 8 * j; const LAS float* s = scr + (8 * c) * 33 + n;
        u32x2 o; o.x = pk4_fp8(s[0 * 33], s[1 * 33], s[2 * 33], s[3 * 33]); o.y = pk4_fp8(s[4 * 33], s[5 * 33], s[6 * 33], s[7 * 33]);
        *(u32x2*)(WT + (size_t)(n0 + n) * K + k0 + 8 * c) = o; }
    LDS_WAIT(); asm volatile("" ::: "memory");
}
__device__ __forceinline__ int queue_pull(unsigned* q, LAS unsigned char* lds, int tid) {
    volatile LAS int* w = (volatile LAS int*)(lds + RING_BYTES + 256);
    __syncthreads();
    if (tid == 0) *w = (int)__hip_atomic_fetch_add(q, 1u, __ATOMIC_RELAXED, __HIP_MEMORY_SCOPE_AGENT);
    __syncthreads();
    return *w;
}
constexpr int CP_GU_CHUNKS = NE * (2048 / 256) * (D / 128) / 8, CP_DN_CHUNKS = NE * (D / 256) * (DE / 128) / 8;
__device__ __forceinline__ void moe_copy_chunk(const Args& a, int ch, int lane, int wave, int b0 = 0, int b1 = 8) {
    unsigned char* ws = a.ws;
    const int g = ch * 8 + wave;
    const float* W; unsigned char* WT; int K, N, blk;
    if (g < NE * 64) { const int ex = g >> 6; W = a.in[I_WGU] + (size_t)ex * D * 2048; WT = (unsigned char*)(ws + WS_WGU) + (size_t)ex * 2048 * D; K = D; N = 2048; blk = g & 63; }
    else { const int g2 = g - NE * 64, ex = g2 >> 5; W = a.in[I_WDN] + (size_t)ex * DE * D; WT = (unsigned char*)(ws + WS_WDN) + (size_t)ex * D * DE; K = DE; N = D; blk = g2 & 31; }
    const int nblk = N / 256, kb = blk / nblk, nb = blk % nblk, k0 = 128 * kb + 16 * (lane & 7), n0 = 256 * nb + 4 * (lane >> 3);
    const float* p = W + (size_t)k0 * N + n0;
    unsigned char* q = WT + (size_t)n0 * K + k0;
    f32x4 v[2][16];
#pragma unroll
    for (int bt = 0; bt < 8; ++bt) if (bt == b0) {
#pragma unroll
        for (int i = 0; i < 16; ++i) v[bt & 1][i] = *(const f32x4*)(p + (size_t)i * N + 32 * bt); }
#pragma unroll
    for (int bt = 0; bt < 8; ++bt) if (bt >= b0 && bt < b1) {
        if (bt + 1 < b1) {
#pragma unroll
            for (int i = 0; i < 16; ++i) v[(bt + 1) & 1][i] = *(const f32x4*)(p + (size_t)i * N + 32 * (bt + 1));
        }
#pragma unroll
        for (int c = 0; c < 4; ++c) {
            u32x4 o;
#pragma unroll
            for (int d = 0; d < 4; ++d) o[d] = pk4_fp8(v[bt & 1][4 * d][c] * F8_WSCALE, v[bt & 1][4 * d + 1][c] * F8_WSCALE, v[bt & 1][4 * d + 2][c] * F8_WSCALE, v[bt & 1][4 * d + 3][c] * F8_WSCALE);
            *(u32x4*)(q + (size_t)(32 * bt + c) * K) = o;
        }
    }
}

__device__ __forceinline__ void p1_norm(const Args& a, int lane, int wave, int G) {
    const float* MOD = (const float*)(a.ws + WS_CTL) + CW_MOD;
    bf16_t* HX = (bf16_t*)(a.ws + WS_HX);
    const int gw = blockIdx.x * 8 + wave, NGW = G * 8, rpw = (ROWS + NGW - 1) / NGW;
    const int mbeg = gw * rpw, mend = (mbeg + rpw < ROWS) ? mbeg + rpw : ROWS;
    if (mbeg >= mend) return;
    f32x4 g[4], sh[4], sc[4], v[4], vn[4];
#pragma unroll
    for (int j = 0; j < 4; ++j) g[j] = ((const f32x4*)a.in[I_GPREMIX])[64 * j + lane];
    auto rowp = [&](int m) -> const f32x4* { return (const f32x4*)((m < T) ? a.in[I_X] + (size_t)m * D : a.in[I_CTX] + (size_t)(m - T) * D) + lane; };
    { const f32x4* xr = rowp(mbeg);
#pragma unroll
      for (int j = 0; j < 4; ++j) v[j] = xr[64 * j]; }
    int rcur = -1;
    for (int m = mbeg; m < mend; ++m) {
        if (m + 1 < mend) { const f32x4* xr = rowp(m + 1);
#pragma unroll
            for (int j = 0; j < 4; ++j) vn[j] = xr[64 * j]; }
        const int r = (m < T) ? (m >> 12) : 8;
        if (r != rcur) { rcur = r;
#pragma unroll
            for (int j = 0; j < 4; ++j) { sh[j] = ((const f32x4*)(MOD + r * 6144))[64 * j + lane]; sc[j] = ((const f32x4*)(MOD + r * 6144 + 1024))[64 * j + lane] + 1.0f; } }
        float s = 0.f;
#pragma unroll
        for (int j = 0; j < 4; ++j) s += (v[j].x * v[j].x + v[j].y * v[j].y) + (v[j].z * v[j].z + v[j].w * v[j].w);
        const float rstd = 1.0f / sqrtf(wave_sum(s) * (1.f / D) + RMS_EPS);
        unsigned long long* o8 = (unsigned long long*)(HX + (size_t)m * D) + lane;
#pragma unroll
        for (int j = 0; j < 4; ++j) {
            const f32x4 h = (v[j] * rstd * g[j]) * sc[j] + sh[j];
            o8[64 * j] = (unsigned long long)pk2(h.x, h.y) | ((unsigned long long)pk2(h.z, h.w) << 32);
            if (m < T) ((unsigned*)(a.ws + WS_HX8 + (size_t)m * D))[64 * j + lane] = pk4_fp8(h.x * F8_GASCALE, h.y * F8_GASCALE, h.z * F8_GASCALE, h.w * F8_GASCALE);
        }
#pragma unroll
        for (int j = 0; j < 4; ++j) v[j] = vn[j];
    }
}

constexpr size_t WS_ACT = WS_HX;
__device__ __forceinline__ void p3a_pointwise(const Args& a, int tid, int G) {
    unsigned char* ws = a.ws;
    const bf16_t* Z = (const bf16_t*)(ws + WS_Z);
    bf16_t* FB = (bf16_t*)(ws + WS_FEAT); bf16_t* ACT = (bf16_t*)(ws + WS_ACT);
    const float* rc = (const float*)(ws + WS_MISC) + ZP; const float* rs = rc + 1024;
    const int cv = tid % 240, rg = tid / 240;
    float mp[8], mn[8];
    if (tid < 480) {
#pragma unroll
        for (int j = 0; j < 8; ++j) { mp[j] = a.in[I_MUP][8 * cv + j]; mn[j] = a.in[I_MUN][8 * cv + j]; }
    }
    bf16_t* QR = (bf16_t*)(ws + WS_QR); bf16_t* KA = (bf16_t*)(ws + WS_KA); bf16_t* VT = (bf16_t*)(ws + WS_VT);
    for (int unit = blockIdx.x; unit < ROWS / 16; unit += G) {
        const int row0 = unit * 16;
        const bool isx = row0 < T;
        const int slen = isx ? SEQ : CL;
        const int pos0 = isx ? (row0 & (SEQ - 1)) : ((row0 - T) & (CL - 1));
        const int r0 = row0 + 8 * rg, p0 = pos0 + 8 * rg;
        u32x4 rowv[10];
        if (tid < 480) {
            const bf16_t* zp = Z + (size_t)r0 * ZP + ZC_R + 8 * cv;
#pragma unroll
            for (int i = 0; i < 10; ++i) { const int pos = p0 - 1 + i; const bool ok = pos >= 0 && pos < slen;
                const u32x4 v = *(const u32x4*)(ok ? zp + (ptrdiff_t)(i - 1) * ZP : zp);
                rowv[i] = ok ? v : (u32x4){0u, 0u, 0u, 0u}; }
        }
        u32x4 pt1[2], pt2[2];
#pragma unroll
        for (int it = 0; it < 2; ++it) { const int idx = tid + 512 * it;
            if (idx < 16 * 40) { const int tk = idx / 40, j = idx % 40; const int hh = j >> 2, part = (j >> 1) & 1, sub = j & 1;
                const int zc = (hh < 8) ? (ZC_Q + hh * 64) : (ZC_K + (hh - 8) * 64);
                const bf16_t* zp = Z + (size_t)(row0 + tk) * ZP + zc + part * 32 + sub * 8;
                pt1[it] = *(const u32x4*)zp; pt2[it] = *(const u32x4*)(zp + 16); } }
        unsigned short vv[8];
        if (tid < 256) { const int cidx = tid & 127, tg = tid >> 7;
#pragma unroll
            for (int q = 0; q < 8; ++q) vv[q] = Z[(size_t)(row0 + 8 * tg + q) * ZP + ZC_V + cidx]; }
        if (tid < 480) {
#pragma unroll
            for (int i = 0; i < 8; ++i) {
                const u32x4 prv = rowv[i], cur = rowv[i + 1], nxt = rowv[i + 2];
                float o[8];
#pragma unroll
                for (int j = 0; j < 4; ++j) {
                    const float c0 = lo16(cur[j]), c1 = hi16(cur[j]);
                    o[2 * j] = c0 + mp[2 * j] * (lo16(prv[j]) - c0) + mn[2 * j] * (lo16(nxt[j]) - c0);
                    o[2 * j + 1] = c1 + mp[2 * j + 1] * (hi16(prv[j]) - c1) + mn[2 * j + 1] * (hi16(nxt[j]) - c1);
                }
                bf16_t* op;
                if (cv < 64) op = FB + (size_t)F_R * (FEAT_STRIDE / 2) + (size_t)(r0 + i) * RD + 8 * cv;
                else if (cv < 128) op = FB + (size_t)F_A * (FEAT_STRIDE / 2) + (size_t)(r0 + i) * RD + 8 * (cv - 64);
                else if (cv < 192) op = FB + (size_t)F_V * (FEAT_STRIDE / 2) + (size_t)(r0 + i) * RD + 8 * (cv - 128);
                else {
                    op = ACT + (size_t)(r0 + i) * 384 + 8 * (cv - 192);
                    if (cv < 208) {
#pragma unroll
                        for (int j = 0; j < 8; ++j) o[j] = 1.0f - 2.0f * __builtin_amdgcn_rcpf(__expf(2.0f * o[j]) + 1.0f);
                    } else if (cv >= 224) {
#pragma unroll
                        for (int j = 0; j < 8; ++j) o[j] = sigmoidf_(o[j]);
                    }
                }
                u32x4 w; w.x = pk2(o[0], o[1]); w.y = pk2(o[2], o[3]); w.z = pk2(o[4], o[5]); w.w = pk2(o[6], o[7]);
                *(u32x4*)op = w;
            }
        }
#pragma unroll
        for (int it = 0; it < 2; ++it) { const int idx = tid + 512 * it;
            if (idx < 16 * 40) {
                const int tk = idx / 40, j = idx % 40; const int row = row0 + tk, pos = pos0 + tk;
                const int hh = j >> 2, part = (j >> 1) & 1, sub = j & 1;
                const bool isq = hh < 8;
                if (!(isq && !isx)) {
                    const u32x4 t1 = pt1[it], t2 = pt2[it];
                    float x1[8], x2[8], o1[8], o2[8];
#pragma unroll
                    for (int q = 0; q < 4; ++q) { x1[2 * q] = lo16(t1[q]); x1[2 * q + 1] = hi16(t1[q]); x2[2 * q] = lo16(t2[q]); x2[2 * q + 1] = hi16(t2[q]); }
                    if (isx) {
                        const int pp = part ? (pos & 63) : (pos >> 6);
                        const float sc = isq ? (0.125f * 1.44269504089f) : 1.0f;
                        const f32x4 cA = *(const f32x4*)(rc + pp * 16 + sub * 8), cB = *(const f32x4*)(rc + pp * 16 + sub * 8 + 4), sA = *(const f32x4*)(rs + pp * 16 + sub * 8), sB = *(const f32x4*)(rs + pp * 16 + sub * 8 + 4);
#pragma unroll
                        for (int q = 0; q < 8; ++q) { const float c = q < 4 ? cA[q & 3] : cB[q & 3], s = q < 4 ? sA[q & 3] : sB[q & 3];
                            o1[q] = (x1[q] * c - x2[q] * s) * sc; o2[q] = (x2[q] * c + x1[q] * s) * sc; }
                    } else {
#pragma unroll
                        for (int q = 0; q < 8; ++q) { o1[q] = x1[q]; o2[q] = x2[q]; }
                    }
                    u32x4 w1, w2;
#pragma unroll
                    for (int q = 0; q < 4; ++q) { w1[q] = pk2(o1[2 * q], o1[2 * q + 1]); w2[q] = pk2(o2[2 * q], o2[2 * q + 1]); }
                    bf16_t* op = isq ? (QR + (size_t)row * 512 + hh * 64 + part * 32 + sub * 8) : (KA + (size_t)row * 128 + (hh - 8) * 64 + part * 32 + sub * 8);
                    *(u32x4*)op = w1; *(u32x4*)(op + 16) = w2;
                }
            }
        }
        if (tid < 256) {
            const int cidx = tid & 127, tg = tid >> 7; const int g = cidx >> 6, d = cidx & 63;
            u32x4 w; w.x = vv[0] | ((unsigned)vv[1] << 16); w.y = vv[2] | ((unsigned)vv[3] << 16); w.z = vv[4] | ((unsigned)vv[5] << 16); w.w = vv[6] | ((unsigned)vv[7] << 16);
            bf16_t* op;
            if (isx) { const int b = row0 >> 12; op = VT + ((size_t)(b * 2 + g) * 64 + d) * SEQ + pos0 + 8 * tg; }
            else { const int b = (row0 - T) >> 8; op = VT + (size_t)NB * 2 * 64 * SEQ + ((size_t)(b * 2 + g) * 64 + d) * CL + pos0 + 8 * tg; }
            *(u32x4*)op = w;
        }
    }
}

template <int CTRL> __device__ __forceinline__ float dpp_row_add(float x) {
    return x + __builtin_bit_cast(float, __builtin_amdgcn_update_dpp(0, __builtin_bit_cast(int, x), CTRL, 0xf, 0xf, true));
}
__device__ __forceinline__ void p3b_features(const Args& a, LAS unsigned char* lds, int tid, int lane, int wave, int G) {
    unsigned char* ws = a.ws;
    const bf16_t* lora = (const bf16_t*)(ws + WS_LORA);
    const bf16_t* ACT = (const bf16_t*)(ws + WS_ACT);
    bf16_t* FB = (bf16_t*)(ws + WS_FEAT);
    const int h = blockIdx.x & 7;
    constexpr int P64 = 72, P128 = 136;
    LAS bf16_t* WL = (LAS bf16_t*)lds;
    LAS bf16_t* WG2 = WL + 4 * 64 * P64;
    __syncthreads();
    for (int i = tid; i < 4 * 64 * 8; i += 512) { const int m = i >> 9, r = (i >> 3) & 63, c = i & 7; const int ch = 16 * ((r >> 2) & 3) + 4 * (r >> 4) + (r & 3);
        *(LAS u32x4*)(WL + (m * 64 + r) * P64 + 8 * c) = *(const u32x4*)(lora + (size_t)m * 32768 + (size_t)(h * 64 + ch) * 64 + 8 * c); }
    for (int i = tid; i < 64 * 16; i += 512) { const int r = i >> 4, c = i & 15; const int ch = 16 * ((r >> 2) & 3) + 4 * (r >> 4) + (r & 3);
        *(LAS u32x4*)(WG2 + r * P128 + 8 * c) = *(const u32x4*)(lora + (size_t)4 * 32768 + (size_t)(h * 64 + ch) * 128 + 8 * c); }
    __syncthreads();
    const int tk = lane & 15, cg = lane >> 4;
    f32x4 w0f[4], w0b[4], a0f[4], a0b[4], kkw[4], kaw[4];
#pragma unroll
    for (int cs = 0; cs < 4; ++cs) { const int c = h * 64 + 16 * cg + 4 * cs;
        w0f[cs] = *(const f32x4*)(a.in[I_W0F] + c); w0b[cs] = *(const f32x4*)(a.in[I_W0B] + c); a0f[cs] = *(const f32x4*)(a.in[I_A0F] + c); a0b[cs] = *(const f32x4*)(a.in[I_A0B] + c);
        kkw[cs] = *(const f32x4*)(a.in[I_KK] + c); kaw[cs] = *(const f32x4*)(a.in[I_KA] + c); }
    for (int tt = blockIdx.x >> 3; tt < ROWS / 128; tt += (G >> 3)) {
        const int row = tt * 128 + 16 * wave + tk;
        bf16x8 bfr[12];
        const bf16_t* ap = ACT + (size_t)row * 384 + 8 * cg;
#pragma unroll
        for (int kb = 0; kb < 12; ++kb) bfr[kb] = *(const bf16x8*)(ap + 32 * kb);
        bf16_t* frow = FB + (size_t)row * RD + h * 64 + 16 * cg;
        u32x2 kraw[4];
#pragma unroll
        for (int cs = 0; cs < 4; ++cs) kraw[cs] = *(const u32x2*)(frow + (size_t)F_A * (FEAT_STRIDE / 2) + 4 * cs);
        auto store16 = [&](int arr, const f32x4 (&v)[4]) {
            u32x4 w0, w1;
            w0.x = cvt_pk_bf16_asm(v[0][0], v[0][1]); w0.y = cvt_pk_bf16_asm(v[0][2], v[0][3]); w0.z = cvt_pk_bf16_asm(v[1][0], v[1][1]); w0.w = cvt_pk_bf16_asm(v[1][2], v[1][3]);
            w1.x = cvt_pk_bf16_asm(v[2][0], v[2][1]); w1.y = cvt_pk_bf16_asm(v[2][2], v[2][3]); w1.z = cvt_pk_bf16_asm(v[3][0], v[3][1]); w1.w = cvt_pk_bf16_asm(v[3][2], v[3][3]);
            u32x4* p = (u32x4*)(frow + (size_t)arr * (FEAT_STRIDE / 2)); p[0] = w0; p[1] = w1;
        };
        auto lora_mm = [&](int m, int kb0, f32x4 (&acc)[4]) {
#pragma unroll
            for (int cs = 0; cs < 4; ++cs) acc[cs] = (f32x4){0.f, 0.f, 0.f, 0.f};
            const int nkb = (m == 4) ? 4 : 2;
#pragma unroll
            for (int kb = 0; kb < 4; ++kb) if (kb < nkb) {
#pragma unroll
                for (int cs = 0; cs < 4; ++cs) {
                    const bf16x8 afr = (m == 4) ? *(const LAS bf16x8*)(WG2 + (16 * cs + tk) * P128 + 32 * kb + 8 * cg) : *(const LAS bf16x8*)(WL + (m * 64 + 16 * cs + tk) * P64 + 32 * kb + 8 * cg);
                    acc[cs] = __builtin_amdgcn_mfma_f32_16x16x32_bf16(afr, bfr[kb0 + kb], acc[cs], 0, 0, 0);
                }
            }
        };
        f32x4 acc[4];
        lora_mm(0, 0, acc);
#pragma unroll
        for (int cs = 0; cs < 4; ++cs)
#pragma unroll
            for (int j = 0; j < 4; ++j) { float x = -0.60653065971f * sigmoidf_(acc[cs][j] + w0f[cs][j]);
                x = dpp_row_add<0x111>(x); x = dpp_row_add<0x112>(x); x = dpp_row_add<0x114>(x); x = dpp_row_add<0x118>(x);
                acc[cs][j] = __builtin_amdgcn_exp2f(x * 1.44269504089f); }
        store16(F_WF, acc);
        lora_mm(1, 2, acc);
#pragma unroll
        for (int cs = 0; cs < 4; ++cs)
#pragma unroll
            for (int j = 0; j < 4; ++j) { float x = -0.60653065971f * sigmoidf_(acc[cs][j] + w0b[cs][j]);
                x = dpp_row_add<0x101>(x); x = dpp_row_add<0x102>(x); x = dpp_row_add<0x104>(x); x = dpp_row_add<0x108>(x);
                acc[cs][j] = __builtin_amdgcn_exp2f(x * 1.44269504089f); }
        store16(F_WB, acc);
        lora_mm(4, 8, acc);
        asm volatile("s_nop 7\n\ts_nop 7" ::: "memory");
        store16(F_G, acc);
        f32x4 iclf[4], iclb[4];
        lora_mm(2, 4, iclf);
        lora_mm(3, 6, iclb);
#pragma unroll
        for (int cs = 0; cs < 4; ++cs)
#pragma unroll
            for (int j = 0; j < 4; ++j) { iclf[cs][j] = sigmoidf_(iclf[cs][j] + a0f[cs][j]); iclb[cs][j] = sigmoidf_(iclb[cs][j] + a0b[cs][j]); }
        f32x4 kv[4]; float nrm = 0.f;
#pragma unroll
        for (int cs = 0; cs < 4; ++cs) {
            kv[cs] = (f32x4){lo16(kraw[cs].x), hi16(kraw[cs].x), lo16(kraw[cs].y), hi16(kraw[cs].y)};
            const f32x4 kk = kv[cs] * kkw[cs];
            nrm += (kk[0] * kk[0] + kk[1] * kk[1]) + (kk[2] * kk[2] + kk[3] * kk[3]);
        }
        nrm += __shfl_xor(nrm, 16); nrm += __shfl_xor(nrm, 32);
        const float inv = 1.0f / fmaxf(sqrtf(nrm), 1e-12f);
        f32x4 oa[4], obf[4], obb[4], okf[4], okb[4];
#pragma unroll
        for (int cs = 0; cs < 4; ++cs) {
            const f32x4 kkn = kv[cs] * kkw[cs] * inv;
            oa[cs] = -kkn; obf[cs] = kkn * iclf[cs]; obb[cs] = kkn * iclb[cs];
            okf[cs] = kv[cs] * ((iclf[cs] - 1.0f) * kaw[cs] + 1.0f); okb[cs] = kv[cs] * ((iclb[cs] - 1.0f) * kaw[cs] + 1.0f);
        }
        auto store16f8 = [&](int arr, const f32x4 (&v)[4], float scl) {
            u32x4 w;
#pragma unroll
            for (int cs = 0; cs < 4; ++cs) w[cs] = pk4_fp8(v[cs][0] * scl, v[cs][1] * scl, v[cs][2] * scl, v[cs][3] * scl);
            *(u32x4*)((unsigned char*)(FB + (size_t)arr * (FEAT_STRIDE / 2)) + (size_t)row * RD + h * 64 + 16 * cg) = w;
        };
        store16(F_A, oa); store16f8(F_BF, obf, F8_BSCALE); store16f8(F_BB, obb, F8_BSCALE); store16f8(F_KF, okf, F8_KSCALE); store16f8(F_KB, okb, F8_KSCALE);
    }
}

__device__ __forceinline__ bool p4_attention(const Args& a, LAS unsigned char* lds, int tid, int lane, int wave, int G, int max_units = 1 << 30) {
    unsigned char* ws = a.ws;
    const bf16_t* QR = (const bf16_t*)(ws + WS_QR); const bf16_t* KA = (const bf16_t*)(ws + WS_KA); const bf16_t* VT = (const bf16_t*)(ws + WS_VT);
    bf16_t* ATT = (bf16_t*)(ws + WS_ATT);
    constexpr int KP = 72;
    LAS bf16_t* Ks0 = (LAS bf16_t*)lds;
    const int qi = lane & 31, hf = lane >> 5;
    unsigned* qatt = (unsigned*)(ws + WS_CTL) + CW_QATT;
    for (int it = 0; it < max_units; ++it) {
        int upull = 0; if ((it & 1) == 0) { upull = queue_pull(qatt, lds, tid); *(volatile LAS int*)(lds + RING_BYTES + 260) = upull; } else upull = *(volatile LAS int*)(lds + RING_BYTES + 260);
        const int unit = 2 * upull + (it & 1);
        if (unit >= NB * NKV * (SEQ / 64)) return false;
        const int qb = unit & 63, g = (unit >> 6) & 1, b = unit >> 7;
        const int q0 = qb * 64;
        const int head = g * 4 + (wave >> 1), qloc = 32 * (wave & 1) + qi;
        const size_t qrow = (size_t)b * SEQ + q0 + qloc;
        bf16x8 qf[4];
#pragma unroll
        for (int s = 0; s < 4; ++s) qf[s] = *(const bf16x8*)(QR + qrow * 512 + head * 64 + 16 * s + 8 * hf);
        float m = a.in[I_SINKS][head] * 1.44269504089f, lsum = hf ? 0.f : 1.f;
        f32x16 O0, O1;
#pragma unroll
        for (int r = 0; r < 16; ++r) { O0[r] = 0.f; O1[r] = 0.f; }
        const int rr = tid >> 3, ch = tid & 7;
        auto tile_ok = [&](int kt) -> bool { const int kp = q0 - 128 + 64 * kt; return kt >= 5 || (kp >= 0 && kp < SEQ); };
        u32x4 kreg[3], vreg[3];
        auto fetch_tile = [&](int kt, u32x4& kr, u32x4& vr) {
            int kp0 = q0 - 128 + 64 * kt; kp0 = kp0 < 0 ? 0 : (kp0 > SEQ - 64 ? SEQ - 64 : kp0);
            const bf16_t* kp = (kt < 5) ? KA + ((size_t)b * SEQ + kp0 + rr) * 128 + g * 64 + 8 * ch
                                        : KA + ((size_t)T + b * CL + 64 * (kt - 5) + rr) * 128 + g * 64 + 8 * ch;
            const bf16_t* vp = (kt < 5) ? VT + ((size_t)(b * 2 + g) * 64 + rr) * SEQ + kp0 + 8 * ch
                                        : VT + (size_t)NB * 2 * 64 * SEQ + ((size_t)(b * 2 + g) * 64 + rr) * CL + 64 * (kt - 5) + 8 * ch;
            kr = *(const u32x4*)kp; vr = *(const u32x4*)vp;
        };
        fetch_tile(0, kreg[0], vreg[0]);
        fetch_tile(1, kreg[1], vreg[1]);
        int par = 0;
        __syncthreads();
#pragma unroll
        for (int kt = 0; kt < 9; ++kt) {
            const bool ok = tile_ok(kt);
            LAS bf16_t* Ks = Ks0 + par * (2 * 64 * KP); LAS bf16_t* Vs = Ks + 64 * KP;
            if (ok) {
                *(LAS u32x4*)(Ks + rr * KP + 8 * ch) = kreg[kt % 3]; *(LAS u32x4*)(Vs + rr * KP + 8 * ch) = vreg[kt % 3];
                __syncthreads();
            }
            if (kt + 2 < 9) fetch_tile(kt + 2, kreg[(kt + 2) % 3], vreg[(kt + 2) % 3]);
            if (ok) {
                f32x16 X0, X1;
#pragma unroll
                for (int r = 0; r < 16; ++r) { X0[r] = 0.f; X1[r] = 0.f; }
#pragma unroll
                for (int s = 0; s < 4; ++s) {
                    const bf16x8 k0 = *(const LAS bf16x8*)(Ks + qi * KP + 16 * s + 8 * hf), k1 = *(const LAS bf16x8*)(Ks + (32 + qi) * KP + 16 * s + 8 * hf);
                    X0 = __builtin_amdgcn_mfma_f32_32x32x16_bf16(k0, qf[s], X0, 0, 0, 0);
                    X1 = __builtin_amdgcn_mfma_f32_32x32x16_bf16(k1, qf[s], X1, 0, 0, 0);
                }
                if (kt == 0 || kt == 4) {
#pragma unroll
                    for (int r = 0; r < 16; ++r) { const int k0i = (r & 3) + 8 * (r >> 2) + 4 * hf, k1i = 32 + k0i;
                        const bool v0 = (kt == 0) ? (k0i >= qloc) : (k0i <= qloc), v1 = (kt == 0) ? (k1i >= qloc) : (k1i <= qloc);
                        X0[r] = v0 ? X0[r] : -1e30f; X1[r] = v1 ? X1[r] : -1e30f; }
                }
                float mx0 = X0[0], mx1 = X1[0];
#pragma unroll
                for (int r = 1; r < 16; ++r) { mx0 = __builtin_fmaxf(mx0, X0[r]); mx1 = __builtin_fmaxf(mx1, X1[r]); }
                float mx = __builtin_fmaxf(mx0, mx1);
                mx = __builtin_fmaxf(mx, __shfl_xor(mx, 32));
                const float mn = __builtin_fmaxf(m, mx);
                if (__any(mn > m)) {
                    const float alpha = __builtin_amdgcn_exp2f(m - mn);
                    lsum *= alpha;
#pragma unroll
                    for (int r = 0; r < 16; ++r) { O0[r] *= alpha; O1[r] *= alpha; }
                    m = mn;
                }
                float ps0 = 0.f, ps1 = 0.f;
#pragma unroll
                for (int r = 0; r < 16; ++r) { X0[r] = __builtin_amdgcn_exp2f(X0[r] - m); X1[r] = __builtin_amdgcn_exp2f(X1[r] - m); ps0 += X0[r]; ps1 += X1[r]; }
                lsum += ps0 + ps1;
#pragma unroll
                for (int kg = 0; kg < 2; ++kg)
#pragma unroll
                    for (int s2 = 0; s2 < 2; ++s2) {
                        bf16x8 pf;
#pragma unroll
                        for (int j = 0; j < 4; ++j) { const float p0 = kg ? X1[8 * s2 + 2 * j] : X0[8 * s2 + 2 * j], p1 = kg ? X1[8 * s2 + 2 * j + 1] : X0[8 * s2 + 2 * j + 1];
                            const unsigned w = cvt_pk_bf16(p0, p1); pf[2 * j] = (short)(w & 0xffff); pf[2 * j + 1] = (short)(w >> 16); }
                        const int kb = 32 * kg + 16 * s2 + 4 * hf;
#pragma unroll
                        for (int dg = 0; dg < 2; ++dg) {
                            const LAS bf16_t* vr = Vs + (32 * dg + qi) * KP + kb;
                            const s16x4 va = *(const LAS s16x4*)vr, vb = *(const LAS s16x4*)(vr + 8);
                            bf16x8 vf; vf[0] = va[0]; vf[1] = va[1]; vf[2] = va[2]; vf[3] = va[3]; vf[4] = vb[0]; vf[5] = vb[1]; vf[6] = vb[2]; vf[7] = vb[3];
                            if (dg == 0) O0 = __builtin_amdgcn_mfma_f32_32x32x16_bf16(vf, pf, O0, 0, 0, 0);
                            else O1 = __builtin_amdgcn_mfma_f32_32x32x16_bf16(vf, pf, O1, 0, 0, 0);
                        }
                    }
                par ^= 1;
            }
        }
        const float ltot = lsum + __shfl_xor(lsum, 32);
        const float inv = 1.0f / ltot;
        bf16_t* op = ATT + qrow * 512 + head * 64;
#pragma unroll
        for (int dg = 0; dg < 2; ++dg)
#pragma unroll
            for (int pr = 0; pr < 2; ++pr) {
                u32x2 wa, wb;
                if (dg == 0) { wa.x = cvt_pk_bf16(O0[8 * pr] * inv, O0[8 * pr + 1] * inv); wa.y = cvt_pk_bf16(O0[8 * pr + 2] * inv, O0[8 * pr + 3] * inv); wb.x = cvt_pk_bf16(O0[8 * pr + 4] * inv, O0[8 * pr + 5] * inv); wb.y = cvt_pk_bf16(O0[8 * pr + 6] * inv, O0[8 * pr + 7] * inv); }
                else { wa.x = cvt_pk_bf16(O1[8 * pr] * inv, O1[8 * pr + 1] * inv); wa.y = cvt_pk_bf16(O1[8 * pr + 2] * inv, O1[8 * pr + 3] * inv); wb.x = cvt_pk_bf16(O1[8 * pr + 4] * inv, O1[8 * pr + 5] * inv); wb.y = cvt_pk_bf16(O1[8 * pr + 6] * inv, O1[8 * pr + 7] * inv); }
                const u32x2 sx = __builtin_amdgcn_permlane32_swap(wa.x, wb.x, false, false), sy = __builtin_amdgcn_permlane32_swap(wa.y, wb.y, false, false);
                const u32x4 w = (u32x4){sx.x, sy.x, sx.y, sy.y};
                *(u32x4*)(op + 32 * dg + 16 * pr + 8 * hf) = w;
            }
    }
    return true;
}

template <int CTRL> __device__ __forceinline__ float dpp_add(float x) {
    return x + __builtin_bit_cast(float, __builtin_amdgcn_update_dpp(0, __builtin_bit_cast(int, x), CTRL, 0xf, 0xf, false));
}
__device__ __forceinline__ float row16_sum(float x) { x = dpp_add<0x128>(x); x = dpp_add<0x124>(x); x = dpp_add<0x122>(x); x = dpp_add<0x121>(x); return x; }
template <int VAR> __device__ __forceinline__ void p4_scan(const Args& a, LAS unsigned char* lds, int tid, int lane, int wave, int G) {
    unsigned char* ws = a.ws;
    const bf16_t* FB = (const bf16_t*)(ws + WS_FEAT);
    constexpr int TS = 32, NBLK = (CL + SEQ) / TS;
    constexpr int OPF = TS * 5 * 64;
    LAS float* OPS = (LAS float*)lds;
    LAS float* VB = OPS + 2 * OPF;
    LAS float* YBUF = VB + 2 * TS * 32;
    const int rl = 4 * wave + (lane >> 4), cg = lane & 15;
    for (int unit = blockIdx.x; unit < NB * NH * 4; unit += G) {
        const int half = unit & 1, dir = (unit >> 1) & 1, h = (unit >> 2) & 7, b = unit >> 5;
        const size_t astr = FEAT_STRIDE / 2;
        const bf16_t* arrp[5] = { FB + (size_t)(dir ? F_WB : F_WF) * astr, FB + (size_t)F_A * astr, FB + (size_t)(dir ? F_BB : F_BF) * astr, FB + (size_t)(dir ? F_KB : F_KF) * astr, FB + (size_t)F_R * astr };
        const bf16_t* vp = FB + (size_t)F_V * astr;
        bf16_t* Y = (bf16_t*)(ws + (dir ? WS_YB : WS_YF));
        auto row_of = [&](int s) -> int { return (s < CL) ? (T + b * CL + (dir ? (CL - 1 - s) : s)) : (b * SEQ + (dir ? (SEQ - 1 - (s - CL)) : (s - CL))); };
        u32x2 pre[6];
        auto fetch = [&](int blk) {
#pragma unroll
            for (int it = 0; it < 6; ++it) { const int q = tid + 512 * it; pre[it] = (u32x2){0u, 0u};
                if (q < TS * 88) { const int st = q / 88, rem = q % 88; const int row = row_of(blk * TS + st);
                    if (rem < 80) { const int ar = rem >> 4, ci = rem & 15; const bf16_t* p = (ar == 0 ? arrp[0] : ar == 1 ? arrp[1] : ar == 2 ? arrp[2] : ar == 3 ? arrp[3] : arrp[4]);
                        pre[it] = *(const u32x2*)(p + (size_t)row * RD + h * 64 + 4 * ci); }
                    else { const int ci = rem - 80; pre[it] = *(const u32x2*)(vp + (size_t)row * RD + h * 64 + half * 32 + 4 * ci); } } }
        };
        auto commit = [&](int buf) {
#pragma unroll
            for (int it = 0; it < 6; ++it) { const int q = tid + 512 * it;
                if (q < TS * 88) { const int st = q / 88, rem = q % 88;
                    f32x4 v = (f32x4){lo16(pre[it].x), hi16(pre[it].x), lo16(pre[it].y), hi16(pre[it].y)};
                    if (SCAN_CHUNKED && rem < 16) { v[0] = __expf(v[0]) - 1.0f; v[1] = __expf(v[1]) - 1.0f; v[2] = __expf(v[2]) - 1.0f; v[3] = __expf(v[3]) - 1.0f; }
                    if (rem < 80) *(LAS f32x4*)(OPS + buf * OPF + st * 320 + rem * 4) = v;
                    else *(LAS f32x4*)(VB + buf * TS * 32 + st * 32 + (rem - 80) * 4) = v; } }
        };
        __syncthreads();
        fetch(0); commit(0);
        __syncthreads();
        f32x4 S = (f32x4){0.f, 0.f, 0.f, 0.f};
        for (int blk = 0; blk < NBLK; ++blk) {
            const int buf = blk & 1;
            if (blk + 1 < NBLK) fetch(blk + 1);
            const LAS float* ob = OPS + buf * OPF + 4 * cg; const LAS float* vb = VB + buf * TS * 32 + rl; LAS float* yb = YBUF + buf * TS * 32 + rl;
            float ykeep = 0.f;
            f32x4 qw[3], qa[3], qb[3], qk[3], qr[3]; float qv[3];
#define SCAN_LOAD(st_, sl_) do { qw[sl_] = *(const LAS f32x4*)(ob + (st_) * 320); qa[sl_] = *(const LAS f32x4*)(ob + (st_) * 320 + 64); qb[sl_] = *(const LAS f32x4*)(ob + (st_) * 320 + 128); \
                qk[sl_] = *(const LAS f32x4*)(ob + (st_) * 320 + 192); qr[sl_] = *(const LAS f32x4*)(ob + (st_) * 320 + 256); qv[sl_] = vb[(st_) * 32]; } while (0)
            SCAN_LOAD(0, 0); SCAN_LOAD(1, 1);
#pragma unroll
            for (int st = 0; st < TS; ++st) {
                if (st + 2 < TS && (VAR != 2 || st < 1)) SCAN_LOAD(st + 2, (st + 2) % 3);
                const f32x4 ow = qw[st % 3], av = DBG_NOA ? (f32x4){0.f, 0.f, 0.f, 0.f} : qa[st % 3], bv = DBG_NOB ? (f32x4){0.f, 0.f, 0.f, 0.f} : qb[st % 3], kv = qk[st % 3], rv = qr[st % 3]; const float vi = qv[st % 3];
                float sa = fmaf(S[3], av[3], fmaf(S[2], av[2], fmaf(S[1], av[1], S[0] * av[0])));
                const f32x4 S1 = S + S * ow + kv * vi;
                if (VAR != 1) sa = row16_sum(sa);
                S = S1 + bv * sa;
                float y = fmaf(S[3], rv[3], fmaf(S[2], rv[2], fmaf(S[1], rv[1], S[0] * rv[0])));
                if (VAR != 1) y = row16_sum(y);
                ykeep = (cg == (st & 15)) ? y : ykeep;
                if ((st & 15) == 15) yb[((st & ~15) + cg) * 32] = ykeep;
            }
#undef SCAN_LOAD
            if (blk + 1 < NBLK) commit(buf ^ 1);
            __syncthreads();
            if (blk >= CL / TS) {
                const int st = tid >> 4, pr = tid & 15;
                const int row = row_of(blk * TS + st);
                const float y0 = YBUF[buf * TS * 32 + st * 32 + 2 * pr], y1 = YBUF[buf * TS * 32 + st * 32 + 2 * pr + 1];
                *(unsigned*)(Y + (size_t)row * RD + h * 64 + half * 32 + 2 * pr) = pk2(y0, y1);
            }
        }
    }
}

constexpr int CS_SLOT = 16384, CS_AT = 0, CS_RT = 2304, CS_BH = 4608, CS_KH = 6912, CS_VV = 9216, CS_AAK = 11520, CS_TT = 12800, CS_ARK = 14080, CS_GC = 15360;
constexpr int CS_NS = 6;
constexpr int CS_SCR = CS_NS * CS_SLOT, CS_SCR_BYTES = 6144, CS_BT = 0, CS_KT = 2304, CS_NN = 4608, CS_FLAGS = CS_SCR + 4 * CS_SCR_BYTES;
static_assert(CS_FLAGS + 64 <= RING_BYTES, "scan ring");
typedef short v4i16_t __attribute__((ext_vector_type(4)));
__device__ __forceinline__ bf16x8 pack8(f32x4 x, f32x4 y) {
    u32x4 w; w.x = cvt_pk_bf16(x[0], x[1]); w.y = cvt_pk_bf16(x[2], x[3]); w.z = cvt_pk_bf16(y[0], y[1]); w.w = cvt_pk_bf16(y[2], y[3]);
    return __builtin_bit_cast(bf16x8, w);
}
__device__ __forceinline__ bf16x8 join8(s16x4 x, s16x4 y) { bf16x8 r; r[0] = x[0]; r[1] = x[1]; r[2] = x[2]; r[3] = x[3]; r[4] = y[0]; r[5] = y[1]; r[6] = y[2]; r[7] = y[3]; return r; }
__device__ __forceinline__ s16x4 lds_tr4(const LAS unsigned char* p) { return __builtin_bit_cast(s16x4, __builtin_amdgcn_ds_read_tr16_b64_v4i16((LAS v4i16_t*)p)); }
template <int CTRL> __device__ __forceinline__ float dpp_shr_add(float x) {
    return x + __builtin_bit_cast(float, __builtin_amdgcn_update_dpp(0, __builtin_bit_cast(int, x), CTRL, 0xf, 0xf, true));
}
template <bool TEST> __device__ __forceinline__ void p4_scan_chunked(const Args& a, LAS unsigned char* lds, int tid, int lane, int wave, int G) {
    unsigned char* ws = a.ws;
    const bf16_t* FB = (const bf16_t*)(ws + WS_FEAT);
    const size_t astr = FEAT_STRIDE / 2;
    constexpr int NCH = (CL + SEQ) / 16;
    volatile LAS unsigned* flags = (volatile LAS unsigned*)(lds + CS_FLAGS);
    for (int unit = blockIdx.x; unit < NB * NH * 2; unit += G) {
        const int dir = unit & 1, h = (unit >> 1) & 7, b = unit >> 4;
        __syncthreads();
        for (int i = tid; i < (CS_FLAGS + 64) / 16; i += 512) *(LAS u32x4*)(lds + 16 * i) = (u32x4){0u, 0u, 0u, 0u};
        __syncthreads();
        auto row_of = [&](int s) -> int { return (s < CL) ? (T + b * CL + (dir ? (CL - 1 - s) : s)) : (b * SEQ + (dir ? (SEQ - 1 - (s - CL)) : (s - CL))); };
        const bool is_cons = (wave & 3) < 2; const int role = (wave & 1) + 2 * (wave >> 2);
        if (is_cons) {
            const int il = lane & 15, g = lane >> 4, ich = 16 * role + il;
            bf16_t* Y = (bf16_t*)(ws + (dir ? WS_YB : WS_YF));
            f32x4 ST[4];
#pragma unroll
            for (int jt = 0; jt < 4; ++jt) ST[jt] = (f32x4){0.f, 0.f, 0.f, 0.f};
            const f32x4 zero4 = (f32x4){0.f, 0.f, 0.f, 0.f}; const s16x4 z16 = (s16x4){0, 0, 0, 0};
            const int troff = (4 * g + (il >> 2)) * 144 + 8 * (il & 3);
            for (int c = 0; c < NCH; ++c) {
                const int slot = c % CS_NS; LAS unsigned char* sb = lds + slot * CS_SLOT;
                while (flags[slot] != (unsigned)(c + 1)) __builtin_amdgcn_s_sleep(1);
                __builtin_amdgcn_fence(__ATOMIC_ACQUIRE, "workgroup");
#ifdef PROBE_SCANV
                if (a.bar_region && PROBE_SCANV == 1) { if (lane == 0) __hip_atomic_fetch_add((LAS unsigned*)(lds + CS_FLAGS) + CS_NS + slot, 1u, __ATOMIC_RELEASE, __HIP_MEMORY_SCOPE_WORKGROUP); continue; }
#endif
                const bf16x8 sf0 = pack8(ST[0], ST[1]), sf1 = pack8(ST[2], ST[3]);
                const LAS unsigned char* atp = sb + CS_AT + il * 144 + 8 * g;
                const bf16x8 a0 = join8(*(const LAS s16x4*)(atp), *(const LAS s16x4*)(atp + 32)), a1 = join8(*(const LAS s16x4*)(atp + 64), *(const LAS s16x4*)(atp + 96));
                const LAS unsigned char* rtp = sb + CS_RT + il * 144 + 8 * g;
                const bf16x8 r0 = join8(*(const LAS s16x4*)(rtp), *(const LAS s16x4*)(rtp + 32)), r1 = join8(*(const LAS s16x4*)(rtp + 64), *(const LAS s16x4*)(rtp + 96));
                const bf16x8 aak = *(const LAS bf16x8*)(sb + CS_AAK + il * 80 + 16 * g);
                const bf16x8 ttf = *(const LAS bf16x8*)(sb + CS_TT + il * 80 + 16 * g);
                const bf16x8 ark = *(const LAS bf16x8*)(sb + CS_ARK + il * 80 + 16 * g);
                const s16x4 vv = lds_tr4(sb + CS_VV + troff + 32 * role);
                f32x4 zw1 = zero4, zyy = zero4, zuu = zero4; asm volatile("" : "+v"(zw1), "+v"(zyy), "+v"(zuu));
                f32x4 w1 = __builtin_amdgcn_mfma_f32_16x16x32_bf16(a0, sf0, zw1, 0, 0, 0);
                w1 = __builtin_amdgcn_mfma_f32_16x16x32_bf16(a1, sf1, w1, 0, 0, 0);
                w1 = __builtin_amdgcn_mfma_f32_16x16x32_bf16(aak, join8(vv, z16), w1, 0, 0, 0);
                f32x4 yy = __builtin_amdgcn_mfma_f32_16x16x32_bf16(sf0, r0, zyy, 0, 0, 0);
                yy = __builtin_amdgcn_mfma_f32_16x16x32_bf16(sf1, r1, yy, 0, 0, 0);
                const bf16x8 w1f = pack8(w1, zero4);
                const f32x4 uu = __builtin_amdgcn_mfma_f32_16x16x32_bf16(ttf, w1f, zuu, 0, 0, 0);
                bf16x8 uv; { u32x4 w; w.x = cvt_pk_bf16(uu[0], uu[1]); w.y = cvt_pk_bf16(uu[2], uu[3]); const u32x2 v2 = __builtin_bit_cast(u32x2, vv); w.z = v2.x; w.w = v2.y; uv = __builtin_bit_cast(bf16x8, w); }
#pragma unroll
                for (int jt = 0; jt < 4; ++jt) {
                    const f32x4 gc = *(const LAS f32x4*)(sb + CS_GC + (16 * jt + 4 * g) * 4);
                    const bf16x8 bk = join8(lds_tr4(sb + CS_BH + troff + 32 * jt), lds_tr4(sb + CS_KH + troff + 32 * jt));
                    ST[jt] = __builtin_amdgcn_mfma_f32_16x16x32_bf16(bk, uv, ST[jt] * gc, 0, 0, 0);
                }
                yy = __builtin_amdgcn_mfma_f32_16x16x32_bf16(uv, ark, yy, 0, 0, 0);
                asm volatile("s_waitcnt lgkmcnt(0)" ::: "memory");
                if (lane == 0) __hip_atomic_fetch_add((LAS unsigned*)(lds + CS_FLAGS) + CS_NS + slot, 1u, __ATOMIC_RELEASE, __HIP_MEMORY_SCOPE_WORKGROUP);
                if (c >= CL / 16) {
                    { const int row = row_of(16 * c + il); u32x2 w; w.x = cvt_pk_bf16(yy[0], yy[1]); w.y = cvt_pk_bf16(yy[2], yy[3]); *(u32x2*)(Y + (size_t)row * RD + h * 64 + 16 * role + 4 * g) = w; }
                }
            }
        } else {
            const int p = role, jg = lane >> 4, t = lane & 15;
            __builtin_amdgcn_s_setprio(2);
            LAS unsigned char* scr = lds + CS_SCR + p * CS_SCR_BYTES;
            u32x4 raw[6][2];
            auto load_raw = [&](int c) {
                const size_t ro = (size_t)row_of(16 * c + t) * RD + h * 64 + 16 * jg;
#pragma unroll
                for (int hf = 0; hf < 2; ++hf) {
                    raw[0][hf] = *(const u32x4*)(FB + (size_t)(dir ? F_WB : F_WF) * astr + ro + 8 * hf); raw[1][hf] = *(const u32x4*)(FB + (size_t)F_A * astr + ro + 8 * hf);
                    raw[4][hf] = *(const u32x4*)(FB + (size_t)F_R * astr + ro + 8 * hf); raw[5][hf] = *(const u32x4*)(FB + (size_t)F_V * astr + ro + 8 * hf); }
                const size_t ro8 = (size_t)row_of(16 * c + t) * RD + h * 64 + 16 * jg;
                raw[2][0] = *(const u32x4*)((const unsigned char*)(FB + (size_t)(dir ? F_BB : F_BF) * astr) + ro8); raw[3][0] = *(const u32x4*)((const unsigned char*)(FB + (size_t)(dir ? F_KB : F_KF) * astr) + ro8);
            };
            load_raw(p);
            const int tn = lane & 15, gq = lane >> 4;
            for (int c = p; c < NCH; c += 4) {
                const int slot = c % CS_NS; LAS unsigned char* sb = lds + slot * CS_SLOT;
#ifdef PROBE_SCANV
                if (a.bar_region && PROBE_SCANV == 2) { while (flags[CS_NS + slot] != (unsigned)(4 * (c / CS_NS))) __builtin_amdgcn_s_sleep(1); if (lane == 0) flags[slot] = (unsigned)(c + 1); continue; }
#endif
                float Gc[16], Gi[16], Gp[16], G15[16];
#pragma unroll
                for (int q = 0; q < 8; ++q) { const unsigned w = raw[0][q >> 2][q & 3]; Gc[2 * q] = lo16(w); Gc[2 * q + 1] = hi16(w); }
#pragma unroll
                for (int q = 0; q < 16; ++q) { Gi[q] = __builtin_amdgcn_rcpf(Gc[q]);
                    Gp[q] = __builtin_bit_cast(float, __builtin_amdgcn_update_dpp(0x3f800000, __builtin_bit_cast(int, Gc[q]), 0x111, 0xf, 0xf, false));
                    G15[q] = __builtin_bit_cast(float, __builtin_amdgcn_update_dpp(0, __builtin_bit_cast(int, Gc[q]), 0x15F, 0xf, 0xf, false)); }
                while (flags[CS_NS + slot] != (unsigned)(4 * (c / CS_NS))) __builtin_amdgcn_s_sleep(1);
                __builtin_amdgcn_fence(__ATOMIC_ACQUIRE, "workgroup");
                u32x4 wa[2], wr[2], wb[2], wk[2];
                {
                    u32x4 wbh[2], wkh[2];
                    float bfv[16], kfv[16];
#pragma unroll
                    for (int w4 = 0; w4 < 4; ++w4) {
                        const f32x2_t bl = __builtin_amdgcn_cvt_pk_f32_fp8((int)raw[2][0][w4], false), bh = __builtin_amdgcn_cvt_pk_f32_fp8((int)raw[2][0][w4], true);
                        const f32x2_t kl = __builtin_amdgcn_cvt_pk_f32_fp8((int)raw[3][0][w4], false), kh = __builtin_amdgcn_cvt_pk_f32_fp8((int)raw[3][0][w4], true);
                        bfv[4 * w4] = bl.x; bfv[4 * w4 + 1] = bl.y; bfv[4 * w4 + 2] = bh.x; bfv[4 * w4 + 3] = bh.y; kfv[4 * w4] = kl.x; kfv[4 * w4 + 1] = kl.y; kfv[4 * w4 + 2] = kh.x; kfv[4 * w4 + 3] = kh.y;
                    }
#pragma unroll
                    for (int q = 0; q < 8; ++q) {
                        const unsigned ua = raw[1][q >> 2][q & 3], ur = raw[4][q >> 2][q & 3];
                        const float a0 = lo16(ua) * Gp[2 * q], a1 = hi16(ua) * Gp[2 * q + 1], r0 = lo16(ur) * Gc[2 * q], r1 = hi16(ur) * Gc[2 * q + 1];
                        const float b0 = bfv[2 * q] * (1.0f / F8_BSCALE) * Gi[2 * q], b1 = bfv[2 * q + 1] * (1.0f / F8_BSCALE) * Gi[2 * q + 1], k0 = kfv[2 * q] * (1.0f / F8_KSCALE) * Gi[2 * q], k1 = kfv[2 * q + 1] * (1.0f / F8_KSCALE) * Gi[2 * q + 1];
                        wa[q >> 2][q & 3] = cvt_pk_bf16(a0, a1); wr[q >> 2][q & 3] = cvt_pk_bf16(r0, r1); wb[q >> 2][q & 3] = cvt_pk_bf16(b0, b1); wk[q >> 2][q & 3] = cvt_pk_bf16(k0, k1);
                        wbh[q >> 2][q & 3] = cvt_pk_bf16(b0 * G15[2 * q], b1 * G15[2 * q + 1]); wkh[q >> 2][q & 3] = cvt_pk_bf16(k0 * G15[2 * q], k1 * G15[2 * q + 1]);
                    }
                    const int ro = t * 144 + 32 * jg;
#pragma unroll
                    for (int hf = 0; hf < 2; ++hf) {
                        *(LAS u32x4*)(sb + CS_AT + ro + 16 * hf) = wa[hf]; *(LAS u32x4*)(sb + CS_RT + ro + 16 * hf) = wr[hf];
                        *(LAS u32x4*)(sb + CS_BH + ro + 16 * hf) = wbh[hf]; *(LAS u32x4*)(sb + CS_KH + ro + 16 * hf) = wkh[hf];
                        *(LAS u32x4*)(sb + CS_VV + ro + 16 * hf) = raw[5][hf];
                    }
                    if (t == 15) {
#pragma unroll
                        for (int q = 0; q < 4; ++q) *(LAS f32x4*)(sb + CS_GC + (16 * jg + 4 * q) * 4) = (f32x4){Gc[4 * q], Gc[4 * q + 1], Gc[4 * q + 2], Gc[4 * q + 3]};
                    }
                }
                if (c + 4 < NCH) load_raw(c + 4);
                f32x4 m0 = (f32x4){0.f, 0.f, 0.f, 0.f}, m1 = m0, m3 = m0, m4 = m0;
                asm volatile("" : "+v"(m0), "+v"(m1), "+v"(m3), "+v"(m4));
#pragma unroll
                for (int ks = 0; ks < 2; ++ks) {
                    const bf16x8 xa = __builtin_bit_cast(bf16x8, wa[ks]), xr = __builtin_bit_cast(bf16x8, wr[ks]), yb = __builtin_bit_cast(bf16x8, wb[ks]), yk = __builtin_bit_cast(bf16x8, wk[ks]);
                    m0 = __builtin_amdgcn_mfma_f32_16x16x32_bf16(yb, xa, m0, 0, 0, 0);
                    m1 = __builtin_amdgcn_mfma_f32_16x16x32_bf16(yk, xa, m1, 0, 0, 0);
                    m3 = __builtin_amdgcn_mfma_f32_16x16x32_bf16(yb, xr, m3, 0, 0, 0);
                    m4 = __builtin_amdgcn_mfma_f32_16x16x32_bf16(yk, xr, m4, 0, 0, 0);
                }
                {
                    f32x4 n0, q1, q3, q4;
#pragma unroll
                    for (int rg = 0; rg < 4; ++rg) { const int s = 4 * gq + rg; const bool lt = s < tn, le = s <= tn;
                        n0[rg] = lt ? m0[rg] : 0.f; q1[rg] = lt ? m1[rg] : 0.f; q3[rg] = le ? m3[rg] : 0.f; q4[rg] = le ? m4[rg] : 0.f;
                        *(LAS float*)(scr + CS_NN + (s * 16 + tn) * 4) = n0[rg]; }
                    u32x2 w1; w1.x = cvt_pk_bf16(q1[0], q1[1]); w1.y = cvt_pk_bf16(q1[2], q1[3]);
                    *(LAS u32x2*)(sb + CS_AAK + tn * 80 + 16 * gq) = w1;
                    u32x4 w3; w3.x = cvt_pk_bf16(q3[0], q3[1]); w3.y = cvt_pk_bf16(q3[2], q3[3]); w3.z = cvt_pk_bf16(q4[0], q4[1]); w3.w = cvt_pk_bf16(q4[2], q4[3]);
                    *(LAS u32x4*)(sb + CS_ARK + tn * 80 + 16 * gq) = w3;
                }
                asm volatile("s_waitcnt lgkmcnt(0)" ::: "memory");
                float Tc[16];
#pragma unroll
                for (int s = 0; s < 16; ++s) Tc[s] = (s == tn) ? 1.0f : 0.0f;
                {
                    const LAS f32x4* NR = (const LAS f32x4*)(scr + CS_NN);
                    f32x4 cq[4], nq[4];
#pragma unroll
                    for (int k = 0; k < 4; ++k) { cq[k] = NR[4 * 14 + k]; nq[k] = cq[k]; }
#pragma unroll
                    for (int s = 14; s >= 0; --s) {
                        if (s > 0) {
#pragma unroll
                            for (int k = 0; k < 4; ++k) if (4 * k + 3 > s - 1) nq[k] = NR[4 * (s - 1) + k];
                        }
                        float acc0 = 0.f, acc1 = 0.f;
#pragma unroll
                        for (int q = s + 1; q < 16; ++q) { if (q & 1) acc1 += Tc[q] * cq[q >> 2][q & 3]; else acc0 += Tc[q] * cq[q >> 2][q & 3]; }
                        Tc[s] = (s < tn) ? (acc0 + acc1) : Tc[s];
#pragma unroll
                        for (int k = 0; k < 4; ++k) cq[k] = nq[k];
                    }
                }
                if (lane < 16) {
#pragma unroll
                    for (int g4 = 0; g4 < 4; ++g4) { u32x2 w; w.x = cvt_pk_bf16(Tc[4 * g4], Tc[4 * g4 + 1]); w.y = cvt_pk_bf16(Tc[4 * g4 + 2], Tc[4 * g4 + 3]); *(LAS u32x2*)(sb + CS_TT + tn * 80 + 16 * g4) = w; }
                }
                __builtin_amdgcn_fence(__ATOMIC_RELEASE, "workgroup");
                asm volatile("s_waitcnt lgkmcnt(0)" ::: "memory");
                if (lane == 0) flags[slot] = (unsigned)(c + 1);
            }
            __builtin_amdgcn_s_setprio(0);
        }
    }
}

__device__ __forceinline__ void p5_rwkv_out(const Args& a, int lane, int wave, int G) {
    unsigned char* ws = a.ws;
    const bf16_t* FB = (const bf16_t*)(ws + WS_FEAT); const size_t astr = FEAT_STRIDE / 2;
    const bf16_t* YF = (const bf16_t*)(ws + WS_YF); const bf16_t* YBk = (const bf16_t*)(ws + WS_YB);
    bf16_t* RWK = (bf16_t*)(ws + WS_RWK);
    const int gw = blockIdx.x * 8 + wave, NGW = G * 8;
    const int c0 = 8 * lane;
    float lnw[8], lnb[8], rk[8];
#pragma unroll
    for (int j = 0; j < 8; ++j) { lnw[j] = a.in[I_LNW][c0 + j]; lnb[j] = a.in[I_LNB][c0 + j]; rk[j] = a.in[I_RK][c0 + j]; }
    auto ld8 = [&](const bf16_t* p, float (&o)[8]) { const u32x4 w = *(const u32x4*)p;
#pragma unroll
        for (int j = 0; j < 4; ++j) { o[2 * j] = lo16(w[j]); o[2 * j + 1] = hi16(w[j]); } };
    const int rpw = (T + NGW - 1) / NGW, mbeg = gw * rpw, mend = (mbeg + rpw < T) ? mbeg + rpw : T;
    if (mbeg >= mend) return;
    u32x4 nx[7];
    auto ldrow = [&](int m) { const size_t o = (size_t)m * RD + c0;
        nx[0] = *(const u32x4*)(YF + o); nx[1] = *(const u32x4*)(YBk + o); nx[2] = *(const u32x4*)(FB + F_R * astr + o);
        { const u32x2 a8 = *(const u32x2*)((const unsigned char*)(FB + F_KF * astr) + o), b8 = *(const u32x2*)((const unsigned char*)(FB + F_KB * astr) + o); nx[3] = (u32x4){a8.x, a8.y, b8.x, b8.y}; }
        nx[5] = *(const u32x4*)(FB + F_V * astr + o); nx[6] = *(const u32x4*)(FB + F_G * astr + o); };
    auto up8f8 = [&](unsigned w0, unsigned w1, float (&o)[8]) {
        const f32x2_t p0 = __builtin_amdgcn_cvt_pk_f32_fp8((int)w0, false), p1 = __builtin_amdgcn_cvt_pk_f32_fp8((int)w0, true), p2 = __builtin_amdgcn_cvt_pk_f32_fp8((int)w1, false), p3 = __builtin_amdgcn_cvt_pk_f32_fp8((int)w1, true);
        o[0] = p0.x; o[1] = p0.y; o[2] = p1.x; o[3] = p1.y; o[4] = p2.x; o[5] = p2.y; o[6] = p3.x; o[7] = p3.y; };
    auto up8 = [&](const u32x4 w, float (&o)[8]) {
#pragma unroll
        for (int j = 0; j < 4; ++j) { o[2 * j] = lo16(w[j]); o[2 * j + 1] = hi16(w[j]); } };
    ldrow(mbeg);
    for (int m = mbeg; m < mend; ++m) {
        const size_t o = (size_t)m * RD + c0;
        float yf[8], yb[8], r[8], kf[8], kb[8], v[8], g[8];
        up8(nx[0], yf); up8(nx[1], yb); up8(nx[2], r); up8f8(nx[3].x, nx[3].y, kf); up8f8(nx[3].z, nx[3].w, kb); up8(nx[5], v); up8(nx[6], g);
        if (m + 1 < mend) ldrow(m + 1);
        float s = 0.f, bs = 0.f;
#pragma unroll
        for (int j = 0; j < 8; ++j) { yf[j] += yb[j]; s += yf[j]; bs += r[j] * ((kf[j] + kb[j]) * (1.0f / F8_KSCALE)) * rk[j]; }
        s += __shfl_xor(s, 1); s += __shfl_xor(s, 2); s += __shfl_xor(s, 4);
        bs += __shfl_xor(bs, 1); bs += __shfl_xor(bs, 2); bs += __shfl_xor(bs, 4);
        const float mean = s * (1.f / 64.f); float q = 0.f;
#pragma unroll
        for (int j = 0; j < 8; ++j) { yf[j] -= mean; q += yf[j] * yf[j]; }
        q += __shfl_xor(q, 1); q += __shfl_xor(q, 2); q += __shfl_xor(q, 4);
        const float rstd = 1.0f / sqrtf(q * (1.f / 64.f) + GN_EPS);
        float out[8];
#pragma unroll
        for (int j = 0; j < 8; ++j) out[j] = (yf[j] * rstd * lnw[j] + lnb[j] + bs * v[j]) * g[j];
        u32x4 w; w.x = pk2(out[0], out[1]); w.y = pk2(out[2], out[3]); w.z = pk2(out[4], out[5]); w.w = pk2(out[6], out[7]);
        *(u32x4*)(RWK + o) = w;
    }
}

template <bool PROBE> __device__ __forceinline__ void p9_postmix_router(const Args& a, LAS unsigned char* lds, int tid, int lane, int wave, int G) {
    unsigned char* ws = a.ws;
    const float* MOD = (const float*)(ws + WS_CTL) + CW_MOD;
    const bf16_t* MIX = (const bf16_t*)(ws + WS_MIX);
    bf16_t* HF = (bf16_t*)(ws + (PROBE ? WS_H + 160 * MiB : WS_HF));
    int* cnt = (int*)(ws + WS_CTL) + (PROBE ? 12000 : CW_CNT);
    int* slot_tok = (int*)(ws + (PROBE ? WS_H + 240 * MiB : WS_SLOT_TOK)); float* slot_gate = (float*)(ws + (PROBE ? WS_H + 248 * MiB : WS_SLOT_GATE)); unsigned* tokk = (unsigned*)(ws + (PROBE ? WS_H + 256 * MiB : WS_TOKK));
    constexpr int HP = 1028;
    LAS float* HL = (LAS float*)lds;
    LAS float* PART = HL + 16 * HP;
    LAS int* SEL_E = (LAS int*)(lds + 90112); LAS float* SEL_G = (LAS float*)(lds + 90112 + 2048); LAS int* SEL_M = (LAS int*)(lds + 90112 + 4096);
    LAS int* HIST = (LAS int*)(lds + 90112 + 6144); LAS int* BASE = HIST + 32;
    int nsel = 0;
    const int ti = lane & 15, kq = lane >> 4;
    float wb0[32], wb1[32];
    {
        const float* wr = a.in[I_WROUTER];
#pragma unroll
        for (int ks = 0; ks < 32; ++ks) { const int k = 128 * wave + 4 * ks + kq; wb0[ks] = wr[k * NE + ti]; wb1[ks] = wr[k * NE + 16 + ti]; }
    }
    const float brt = a.in[I_BROUTER][lane & 31];
    const int upw = (T / 16 + G - 1) / G, ubeg = blockIdx.x * upw, uend = (ubeg + upw < T / 16) ? ubeg + upw : T / 16;
    unsigned mwN[2][4]; f32x4 xvN[2][4];
    auto ldrows = [&](int unit) { const int m0 = unit * 16 + 2 * wave;
#pragma unroll
        for (int tt = 0; tt < 2; ++tt) { const unsigned* mr = (const unsigned*)((const unsigned char*)MIX + (size_t)(m0 + tt) * D) + lane; const f32x4* xr = (const f32x4*)(a.in[I_X] + (size_t)(m0 + tt) * D) + lane;
#pragma unroll
            for (int j = 0; j < 4; ++j) { mwN[tt][j] = mr[64 * j]; xvN[tt][j] = xr[64 * j]; } } };
    f32x4 gmix[4], gffn[4], shf[4]; int bcur = -1;
    if (ubeg < uend) ldrows(ubeg);
    for (int unit = ubeg; unit < uend; ++unit) {
        const int tok0 = unit * 16;
        __syncthreads();
        {
            const int m0 = tok0 + 2 * wave; const int b = m0 >> 12;
            if (b != bcur) { bcur = b;
#pragma unroll
                for (int j = 0; j < 4; ++j) { gmix[j] = ((const f32x4*)a.in[I_GPOSTMIX])[64 * j + lane] * ((const f32x4*)(MOD + b * 6144 + 2048))[64 * j + lane];
                    gffn[j] = ((const f32x4*)a.in[I_GPREFFN])[64 * j + lane] * (((const f32x4*)(MOD + b * 6144 + 4096))[64 * j + lane] + 1.0f); shf[j] = ((const f32x4*)(MOD + b * 6144 + 3072))[64 * j + lane]; } }
            f32x4 v[2][4], xv[2][4]; float s[2] = {0.f, 0.f};
#pragma unroll
            for (int tt = 0; tt < 2; ++tt)
#pragma unroll
                for (int j = 0; j < 4; ++j) { const f32x2_t wl = __builtin_amdgcn_cvt_pk_f32_fp8((int)mwN[tt][j], false), wh = __builtin_amdgcn_cvt_pk_f32_fp8((int)mwN[tt][j], true); xv[tt][j] = xvN[tt][j]; v[tt][j] = (f32x4){wl.x, wl.y, wh.x, wh.y}; s[tt] += (v[tt][j].x * v[tt][j].x + v[tt][j].y * v[tt][j].y) + (v[tt][j].z * v[tt][j].z + v[tt][j].w * v[tt][j].w); }
#pragma unroll
            for (int o = 1; o < 64; o <<= 1) { s[0] += __shfl_xor(s[0], o); s[1] += __shfl_xor(s[1], o); }
            float s2[2] = {0.f, 0.f};
#pragma unroll
            for (int j = 0; j < 4; ++j) {
#pragma unroll
                for (int tt = 0; tt < 2; ++tt) {
                    const float rstd = __builtin_amdgcn_rsqf(s[tt] * (1.f / D) + RMS_EPS * F8_MSCALE * F8_MSCALE);
                    v[tt][j] = xv[tt][j] + gmix[j] * (v[tt][j] * rstd);
                    s2[tt] += (v[tt][j].x * v[tt][j].x + v[tt][j].y * v[tt][j].y) + (v[tt][j].z * v[tt][j].z + v[tt][j].w * v[tt][j].w);
                }
            }
#pragma unroll
            for (int o = 1; o < 64; o <<= 1) { s2[0] += __shfl_xor(s2[0], o); s2[1] += __shfl_xor(s2[1], o); }
#pragma unroll
            for (int j = 0; j < 4; ++j) {
#pragma unroll
                for (int tt = 0; tt < 2; ++tt) {
                    const float rstd2 = __builtin_amdgcn_rsqf(s2[tt] * (1.f / D) + RMS_EPS);
                    const f32x4 hv = (v[tt][j] * rstd2) * gffn[j] + shf[j];
                    ((unsigned*)((unsigned char*)HF + (size_t)(m0 + tt) * D))[64 * j + lane] = pk4_fp8(hv.x * F8_ASCALE, hv.y * F8_ASCALE, hv.z * F8_ASCALE, hv.w * F8_ASCALE);
                    *(LAS f32x4*)(HL + (2 * wave + tt) * HP + 256 * j + 4 * lane) = hv;
                }
            }
            if (unit + 1 < uend) ldrows(unit + 1);
        }
        __syncthreads();
        {
            f32x4 acc0 = (f32x4){0.f, 0.f, 0.f, 0.f}, acc1 = acc0;
#pragma unroll
            for (int ks = 0; ks < 32; ++ks) {
                const float av = HL[ti * HP + 128 * wave + 4 * ks + kq];
                acc0 = __builtin_amdgcn_mfma_f32_16x16x4f32(av, wb0[ks], acc0, 0, 0, 0);
                acc1 = __builtin_amdgcn_mfma_f32_16x16x4f32(av, wb1[ks], acc1, 0, 0, 0);
            }
#pragma unroll
            for (int r = 0; r < 4; ++r) { PART[(wave * 16 + 4 * kq + r) * 32 + ti] = acc0[r]; PART[(wave * 16 + 4 * kq + r) * 32 + 16 + ti] = acc1[r]; }
        }
        __syncthreads();
        {
            const int tl = 2 * wave + (lane >> 5); const int m = tok0 + tl;
            const int e = lane & 31;
            float lg = brt;
#pragma unroll
            for (int w = 0; w < 8; ++w) lg += PART[(w * 16 + tl) * 32 + e];
            float tv[4]; int ti4[4];
#pragma unroll
            for (int k = 0; k < 4; ++k) {
                float bv = lg; int bi = e;
#pragma unroll
                for (int o = 1; o < 32; o <<= 1) { const float ov = __shfl_xor(bv, o); const int oi = __shfl_xor(bi, o); if (ov > bv || (ov == bv && oi < bi)) { bv = ov; bi = oi; } }
                tv[k] = bv; ti4[k] = bi;
                if (e == bi) lg = -3.0e38f;
            }
            const float e1 = __expf(tv[1] - tv[0]), e2 = __expf(tv[2] - tv[0]), e3 = __expf(tv[3] - tv[0]);
            const float inv = 1.0f / (1.0f + e1 + e2 + e3);
            if (e < 4) {
                const int ek = e == 0 ? ti4[0] : e == 1 ? ti4[1] : e == 2 ? ti4[2] : ti4[3];
                const float gk = (e == 0 ? 1.0f : e == 1 ? e1 : e == 2 ? e2 : e3) * inv;
                const int si = nsel * 64 + tl * 4 + e;
                SEL_E[si] = ek; SEL_G[si] = gk; SEL_M[si] = m;
            }
        }
        ++nsel;
    }
    __syncthreads();
    if (tid < 32) HIST[tid] = 0;
    __syncthreads();
    int my_e = 0, my_lr = 0; const bool have = tid < nsel * 64;
    if (have) { my_e = SEL_E[tid]; my_lr = __hip_atomic_fetch_add(HIST + my_e, 1, __ATOMIC_RELAXED, __HIP_MEMORY_SCOPE_WORKGROUP); }
    __syncthreads();
    if (tid < 32) { const int n = HIST[tid]; BASE[tid] = n ? atomicAdd(cnt + tid, n) : 0; }
    __syncthreads();
    if (have) { const int rank = BASE[my_e] + my_lr; const int m = SEL_M[tid];
        slot_tok[my_e * T + rank] = m; slot_gate[(size_t)my_e * T + rank] = SEL_G[tid];
        tokk[m * 4 + (tid & 3)] = ((unsigned)my_e << 20) | (unsigned)rank; }
}

__device__ __forceinline__ void moe_wait_tiles(const unsigned* done, int G, int c, int TT, int i0, int i1, int tid) {
    const int i = i0 + tid;
    if (i < i1) { const int L = i * G + c;
        if (L < TT * 4) { const GAS unsigned* p = (const GAS unsigned*)(done + (L >> 2));
            for (unsigned spins = 0; __hip_atomic_load(p, __ATOMIC_RELAXED, __HIP_MEMORY_SCOPE_AGENT) < 8u && spins < (1u << 24); ++spins) __builtin_amdgcn_s_sleep(2); } }
    __syncthreads();
    __builtin_amdgcn_fence(__ATOMIC_ACQUIRE, "agent");
}

__device__ __forceinline__ void moe_table(const Args& a, LAS int* tstart, int tid) {
    const int* cnt = (const int*)(a.ws + WS_CTL) + CW_CNT;
    __syncthreads();
    if (tid < 32) {
        const int n = __hip_atomic_load(cnt + tid, __ATOMIC_RELAXED, __HIP_MEMORY_SCOPE_AGENT); const int tl = (n + 255) >> 8;
        int incl = tl;
#pragma unroll
        for (int o = 1; o < 32; o <<= 1) { const int v = __shfl_up(incl, o, 32); if (tid >= o) incl += v; }
        tstart[tid] = incl - tl; tstart[TCNT_OFF / 4 - RING_BYTES / 4 + tid] = n; if (tid == 31) tstart[NE] = incl;
    }
    __syncthreads();
    { LAS unsigned char* texp = (LAS unsigned char*)tstart + (TEXP_OFF - RING_BYTES); const int TT = tstart[NE];
      for (int rt = tid; rt < TT && rt < MAXTILES; rt += 512) { int e = 0;
#pragma unroll
          for (int j = 1; j < NE; ++j) e += (tstart[j] <= rt) ? 1 : 0;
          texp[rt] = (unsigned char)e; } }
    __syncthreads();
}

__device__ __forceinline__ void p12_combine(const Args& a, LAS int* tstart, int lane, int wave, int G) {
    unsigned char* ws = a.ws;
    const float* MOD = (const float*)(ws + WS_CTL) + CW_MOD;
    const unsigned char* YB = (const unsigned char*)(ws + WS_YBUF); const unsigned* tokk = (const unsigned*)(ws + WS_TOKK);
    const bf16_t* MIX = (const bf16_t*)(ws + WS_MIX);
    const int gw = blockIdx.x * 8 + wave, NGW = G * 8, rpw = (T + NGW - 1) / NGW;
    const int mbeg = gw * rpw, mend = (mbeg + rpw < T) ? mbeg + rpw : T;
    if (mbeg >= mend) return;
    f32x4 gf[4], gmx[4];
    int bcur = -1;
    unsigned yw[4][4]; f32x4 xr[4]; unsigned mw[4];
    auto ldrow = [&](int m, const u32x4 tk4) {
#pragma unroll
        for (int k = 0; k < 4; ++k) {
            const unsigned tk = tk4[k]; const int e = (int)(tk >> 20), rank = (int)(tk & 0xfffffu);
            const unsigned* yr = (const unsigned*)(YB + ((size_t)tstart[e] * 256 + rank) * D) + lane;
#pragma unroll
            for (int j = 0; j < 4; ++j) yw[k][j] = yr[64 * j];
        }
#pragma unroll
        for (int j = 0; j < 4; ++j) { xr[j] = ((const f32x4*)(a.in[I_X] + (size_t)m * D))[64 * j + lane]; mw[j] = ((const unsigned*)((const unsigned char*)MIX + (size_t)m * D))[64 * j + lane]; }
    };
    u32x4 tkn = *(const u32x4*)(tokk + mbeg * 4);
    ldrow(mbeg, tkn);
    if (mbeg + 1 < mend) tkn = *(const u32x4*)(tokk + (mbeg + 1) * 4);
    for (int m = mbeg; m < mend; ++m) {
        const int b = m >> 12;
        if (b != bcur) { bcur = b;
#pragma unroll
            for (int j = 0; j < 4; ++j) { gf[j] = ((const f32x4*)a.in[I_GPOSTFFN])[64 * j + lane] * ((const f32x4*)(MOD + b * 6144 + 5120))[64 * j + lane];
                gmx[j] = ((const f32x4*)a.in[I_GPOSTMIX])[64 * j + lane] * ((const f32x4*)(MOD + b * 6144 + 2048))[64 * j + lane]; } }
        f32x4 x0[4], mv[4]; float sm = 0.f;
#pragma unroll
        for (int j = 0; j < 4; ++j) { x0[j] = xr[j]; const f32x2_t wl = __builtin_amdgcn_cvt_pk_f32_fp8((int)mw[j], false), wh = __builtin_amdgcn_cvt_pk_f32_fp8((int)mw[j], true); mv[j] = (f32x4){wl.x, wl.y, wh.x, wh.y};
            sm += (mv[j].x * mv[j].x + mv[j].y * mv[j].y) + (mv[j].z * mv[j].z + mv[j].w * mv[j].w); }
        f32x4 y[4]; float s = 0.f;
#pragma unroll
        for (int j = 0; j < 4; ++j) { y[j] = (f32x4){0.f, 0.f, 0.f, 0.f};
#pragma unroll
            for (int k = 0; k < 4; ++k) { const f32x2_t lo = __builtin_amdgcn_cvt_pk_f32_fp8((int)yw[k][j], false), hi = __builtin_amdgcn_cvt_pk_f32_fp8((int)yw[k][j], true); y[j] += (f32x4){lo.x, lo.y, hi.x, hi.y}; }
            s += (y[j][0] * y[j][0] + y[j][1] * y[j][1]) + (y[j][2] * y[j][2] + y[j][3] * y[j][3]); }
        if (m + 1 < mend) { const u32x4 tk4 = tkn; if (m + 2 < mend) tkn = *(const u32x4*)(tokk + (m + 2) * 4); ldrow(m + 1, tk4); }
#pragma unroll
        for (int o = 1; o < 64; o <<= 1) { s += __shfl_xor(s, o); sm += __shfl_xor(sm, o); }
        const float rstd = __builtin_amdgcn_rsqf(s * (1.f / D) + RMS_EPS * F8_YSCALE * F8_YSCALE);
        const float rstdm = __builtin_amdgcn_rsqf(sm * (1.f / D) + RMS_EPS * F8_MSCALE * F8_MSCALE);
#pragma unroll
        for (int j = 0; j < 4; ++j) {
            const f32x4 x1 = x0[j] + gmx[j] * (mv[j] * rstdm);
            ((f32x4*)(a.out + (size_t)m * D))[64 * j + lane] = x1 + gf[j] * (y[j] * rstd);
        }
    }
}

constexpr int N_PHASES = 13;
__global__ void __launch_bounds__(512, 2) mega_fwd(Args args) {
    extern __shared__ __attribute__((aligned(16))) unsigned char lds_raw[];
    LAS unsigned char* lds = (LAS unsigned char*)lds_raw;
    const int tid = threadIdx.x, lane = tid & 63, wave = __builtin_amdgcn_readfirstlane(tid >> 6);
    const int G = gridDim.x;
    volatile LAS unsigned* MISC = (volatile LAS unsigned*)(lds + MISC_OFF);
    LAS int* tstart = (LAS int*)(lds + RING_BYTES);
    for (int u = tid; u < (LDS_BYTES - RING_BYTES) / 4; u += 512) ((LAS unsigned*)(lds + RING_BYTES))[u] = 0u;
    __syncthreads();
    unsigned char* ws = args.ws;
    const int lo = args.ph_lo, hi = args.ph_hi;
    unsigned* barw = (unsigned*)(ws + WS_CTL) + (args.bar_region ? (131072 + (args.bar_region - 1) * 4096) : CW_BAR);
    XcdBarrier bar; bar.bar = barw; bar.x = 0; bar.st = nullptr;
    if (hi - lo > 1) bar = xcd_barrier_post(barw, MISC + 8);
#ifndef PH_MASK
#define PH_MASK 0x1FFF
#endif
#define IN(k) (((PH_MASK >> (k)) & 1) && lo <= (k) && (k) < hi)
#define SEAM(k) do { if (IN(k) && IN((k) + 1)) xcd_barrier(bar); } while (0)

    if (IN(0)) { p0_prologue(args, lds, tid, lane, wave, G); SEAM(0); }
    if (IN(1)) { p1_norm(args, lane, wave, G); SEAM(1); }
    if (IN(2)) {
        SchedProj S{(const char*)(ws + WS_WIN), G, (int)blockIdx.x, 0, 1 << 30};
        EpiZ E{(bf16_t*)(ws + WS_Z), (const float*)(ws + WS_MISC), 1.0f};
        pg8::gemm_phase<1024, EpiZ, SchedProj>(lds, (const char*)(ws + WS_HX), S, E);
        SchedProj8 S8{(const char*)(ws + WS_WIN8), G, (int)blockIdx.x};
        EpiZ8 E8{(bf16_t*)(ws + WS_Z), (const float*)(ws + WS_MISC), 1.0f / (F8_GWSCALE * F8_GASCALE)};
        pg8::gemm_phase<1024, EpiZ8, SchedProj8, true>(lds, (const char*)(ws + WS_HX8), S8, E8);
        SEAM(2);
    }
    if (IN(3)) { p3a_pointwise(args, tid, G); if (IN(4)) xcd_barrier(bar); p3b_features(args, lds, tid, lane, wave, G); SEAM(3); }
    if (IN(5)) { if (SCAN_CHUNKED && !SCAN_FORCE_DIRECT) p4_scan_chunked<false>(args, lds, tid, lane, wave, G); else p4_scan<0>(args, lds, tid, lane, wave, G);
        { unsigned* q = (unsigned*)(ws + WS_CTL) + CW_QTR;
          bool att = true, cpy = true;
          while (att || cpy) {
              if (att) att = p4_attention(args, lds, tid, lane, wave, G, 2);
              if (cpy) { const int ch = queue_pull(q, lds, tid); if (ch >= 2 * (CP_GU_CHUNKS + CP_DN_CHUNKS)) cpy = false; else moe_copy_chunk(args, ch >> 1, lane, wave, 4 * (ch & 1), 4 * (ch & 1) + 4); }
          } }
        SEAM(5); }
#if DBG_SCAN
    if (IN(6) && blockIdx.x == 0) {
        const bf16_t* Yt = (const bf16_t*)(ws + (DBG_DIR ? WS_YB : WS_YF)); const bf16_t* Y2 = (const bf16_t*)(ws + 272 * MiB);
        LAS float* red = (LAS float*)lds; float* dbg = (float*)(ws + WS_CTL) + 12288;
        int first = -1; float worst = 0.f;
        for (int ci = 0; ci < 256; ++ci) {
            float e2 = 0.f, r2 = 0.f;
            for (int i = tid; i < 16 * 512; i += 512) { const int cc = DBG_DIR ? (255 - ci) : ci; const size_t o = (size_t)(cc * 16) * 512 + i; const float yt = bf2f(Yt[o]), y2 = bf2f(Y2[o]); e2 += (yt - y2) * (yt - y2); r2 += yt * yt; }
            e2 = wave_sum(e2); r2 = wave_sum(r2);
            __syncthreads(); if (lane == 0) { red[wave] = e2; red[8 + wave] = r2; } __syncthreads();
            float E = 0.f, R = 0.f; for (int w8 = 0; w8 < 8; ++w8) { E += red[w8]; R += red[8 + w8]; }
            const float rel = sqrtf(E / fmaxf(R, 1e-20f));
            if (first < 0 && !(rel < 0.03f)) first = ci;
            if (ci == DBG_CHUNK) { worst = rel;
                if (DBG_MODE == 2) { float z = 0.f; for (int i = tid; i < 16 * 512; i += 512) { const int cc = DBG_DIR ? (255 - ci) : ci; z += ((Y2[(size_t)(cc * 16) * 512 + i] & 0x7fff) > 0x7f80) ? 1.f : 0.f; }
                    z = wave_sum(z); __syncthreads(); if (lane == 0) red[16 + wave] = z; __syncthreads(); float Z = 0.f; for (int w8 = 0; w8 < 8; ++w8) Z += red[16 + w8]; worst = Z / 8192.f; } }
        }
        if (tid == 0) dbg[0] = DBG_MODE ? worst : ((first < 0) ? 0.f : (float)(first + 1) / 256.f);
    }
#endif
    if (IN(6)) { p5_rwkv_out(args, lane, wave, G); SEAM(6); }
    if (IN(7)) {
        SchedUp2 S{(const char*)(ws + WS_WUPA), (long long)WS_WUPR - (long long)WS_WUPA, (long long)WS_RWK - (long long)WS_ATT, G, (int)blockIdx.x};
        EpiUp2 E{(bf16_t*)(ws + WS_MERGED), (const bf16_t*)(ws + WS_Z)};
        pg8::gemm_phase<512, EpiUp2, SchedUp2>(lds, (const char*)(ws + WS_ATT), S, E);
        SEAM(7);
    }
    if (IN(8)) {
        SchedDense<1024> S{(const char*)(ws + WS_WOUT), G, (int)blockIdx.x};
        EpiMix E{(unsigned char*)(ws + WS_MIX)};
        pg8::gemm_phase<1024, EpiMix, SchedDense<1024>>(lds, (const char*)(ws + WS_MERGED), S, E);
        SEAM(8);
    }
    if (IN(9)) { p9_postmix_router<false>(args, lds, tid, lane, wave, G); SEAM(9); }
    if (IN(10)) {
        moe_table(args, tstart, tid);
        SchedMoe<8, true, 1> S{(const char*)(ws + WS_WGU), G, (int)blockIdx.x, tstart, (const int*)(ws + WS_CTL) + CW_CNT, (const int*)(ws + WS_SLOT_TOK), (const LAS int*)(lds + TCNT_OFF), 0, 1 << 30, nullptr};
        EpiMoe1 E{(bf16_t*)(ws + WS_H), args.in[I_BGU], (unsigned*)(ws + WS_CTL) + CW_MDONE};
        pg8::gemm_phase<1024, EpiMoe1, SchedMoe<8, true, 1>, true>(lds, (const char*)(ws + WS_HF), S, E);
    }
    if (IN(11)) {
        if (!IN(10)) moe_table(args, tstart, tid);
        const int TT = tstart[NE]; const int cr = ((int)blockIdx.x + G - (TT * 8) % G) % G;
        const unsigned* done = (const unsigned*)(ws + WS_CTL) + CW_MDONE;
        EpiMoe2 E{(unsigned char*)(ws + WS_YBUF), args.in[I_BDN], (const float*)(ws + WS_SLOT_GATE), (const LAS int*)(lds + TCNT_OFF)};
        if (IN(10)) moe_wait_tiles(done, G, cr, TT, 0, 8, tid);
        SchedMoe<4, false, 1> S{(const char*)(ws + WS_WDN), G, cr, tstart, (const int*)(ws + WS_CTL) + CW_CNT, (const int*)(ws + WS_SLOT_TOK), (const LAS int*)(lds + TCNT_OFF), 0, 1 << 30, IN(10) ? done : nullptr};
        pg8::gemm_phase<1024, EpiMoe2, SchedMoe<4, false, 1>, true>(lds, (const char*)(ws + WS_H), S, E);
        SEAM(11);
    }
    if (IN(12)) { if (!IN(11)) moe_table(args, tstart, tid);
        p12_combine(args, tstart, lane, wave, G); }
#ifdef PROBE_PHASE
    if (lo == 15 && blockIdx.x == 0 && tid < 32) { unsigned* ctl = (unsigned*)(ws + WS_CTL); if (tid == 0) { ctl[CW_QATT] = 0u; ctl[CW_QTR] = PROBE_QTR0; } ctl[CW_CNT + tid] = 0u; }
    if (lo == 16) p9_postmix_router<true>(args, lds, tid, lane, wave, G);
    if (lo == 18) (void)p4_attention(args, lds, tid, lane, wave, G);
    if (lo == 13) p3a_pointwise(args, tid, G);
    if (lo == 14) p3b_features(args, lds, tid, lane, wave, G);
#endif
#undef IN
#undef SEAM
}

extern "C" void kernel_launch(void* const* d_in, const int* in_sizes, int n_in, void* d_out, int out_size, void* d_ws, size_t ws_size, hipStream_t stream) {
    static int grid = 0;
    if (grid == 0) {
        if (n_in != 38 || out_size != T * D || ws_size < WS_END) { fprintf(stderr, "kernel_launch: unexpected problem shape (n_in %d, out %d, ws %zu)\n", n_in, out_size, ws_size); grid = -1; return; }
        int dev = 0, cus = 0, per_cu = 0;
        if (hipGetDevice(&dev) != hipSuccess || hipDeviceGetAttribute(&cus, hipDeviceAttributeMultiprocessorCount, dev) != hipSuccess) { grid = -1; return; }
        if (hipFuncSetAttribute((const void*)mega_fwd, hipFuncAttributeMaxDynamicSharedMemorySize, LDS_BYTES) != hipSuccess) { fprintf(stderr, "kernel_launch: hipFuncSetAttribute failed\n"); grid = -1; return; }
        if (hipOccupancyMaxActiveBlocksPerMultiprocessor(&per_cu, (const void*)mega_fwd, 512, LDS_BYTES) != hipSuccess || per_cu < 1) fprintf(stderr, "kernel_launch: occupancy query says %d\n", per_cu);
        (void)hipGetLastError();
        grid = cus;
    }
    if (grid < 0) return;
#ifdef PROBE_PHASE
    (void)hipMemsetAsync((char*)d_ws + WS_CTL, 0, CTL_BYTES, stream);
#else
    (void)hipMemsetAsync((char*)d_ws + WS_CTL, 0, (size_t)CW_MOD * 4, stream);
#endif
    Args a{};
    for (int i = 0; i < 38; ++i) a.in[i] = (const float*)d_in[i];
    a.out = (float*)d_out; a.ws = (unsigned char*)d_ws;
#if MK_ONE_LAUNCH
    a.ph_lo = 0; a.ph_hi = N_PHASES;
    hipLaunchKernelGGL(mega_fwd, dim3(grid), dim3(512), LDS_BYTES, stream, a);
#ifdef PROBE_PHASE
#ifdef PROBE_PRE
    { a.ph_lo = PROBE_PRE; a.ph_hi = PROBE_PRE + 1; hipLaunchKernelGGL(mega_fwd, dim3(grid), dim3(512), LDS_BYTES, stream, a); }
#endif
    for (int rep = 0; rep < PROBE_REPS; ++rep) { a.ph_lo = PROBE_PHASE; a.ph_hi = PROBE_HI; a.bar_region = 1 + rep; hipLaunchKernelGGL(mega_fwd, dim3(grid), dim3(512), LDS_BYTES, stream, a); }
#endif
#else
    for (int p = 0; p < N_PHASES; ++p) { a.ph_lo = p; a.ph_hi = p + 1; hipLaunchKernelGGL(mega_fwd, dim3(grid), dim3(512), LDS_BYTES, stream, a); }
#endif
}
```
